# Optimizing an MI355X kernel written in HIP

```python
import math
import jax, jax.numpy as jnp
from jax import lax
import numpy as np

D_MODEL = 1024
BATCH = 32
SEQ = 2048
DEPTH = 1
DEC_BATCH = 16
DEC_SEQ = 16
PAST_LEN = 4096

CHUNK = 64
HEAD_DIM = 64
H_A = 8
H_B = 8
W_A = H_A * HEAD_DIM
W_B = H_B * HEAD_DIM
BAND_CHUNKS = 8
BAND_PAST = BAND_CHUNKS * CHUNK
BAND_LEN = BAND_PAST + CHUNK
MAX_REL = 128
Q_BLOCK = 128
PLE_DIM = 256
PEER_HEADS = 8
PEER_DK = 128
N_KEYS = 128
N_EXPERTS = N_KEYS * N_KEYS
PEER_TOPK = 16
PEER_TOKEN_BLOCK = 256
RMS_EPS = 1e-6
FORGET_BIAS_INIT = 3.0
IN_W = 3 * W_A + H_A + 3 * W_B + 2 * D_MODEL
IN_SPLITS = [int(s) for s in np.cumsum([W_A, W_A, W_A, H_A, W_B, W_B, W_B, D_MODEL])]

kernel_name = "fox_chunkband_peer_streaming_encoder"


def rms_norm(x, g):
    xf = x.astype(jnp.float32)
    y = xf * lax.rsqrt(jnp.mean(xf * xf, axis=-1, keepdims=True) + RMS_EPS)
    return (y * g.astype(jnp.float32)).astype(x.dtype)


def mixer_projections(h, g_mix, w_in, b_f, qn_a, kn_a, qn_b, kn_b):
    B, T, _ = h.shape
    n1 = rms_norm(h, g_mix)
    z = n1 @ w_in
    qa, ka, va, fl, qb, kb, vb, ga, gb = jnp.split(z, IN_SPLITS, axis=-1)
    qa = rms_norm(qa.reshape(B, T, H_A, HEAD_DIM), qn_a)
    ka = rms_norm(ka.reshape(B, T, H_A, HEAD_DIM), kn_a)
    va = va.reshape(B, T, H_A, HEAD_DIM)
    qb = rms_norm(qb.reshape(B, T, H_B, HEAD_DIM), qn_b)
    kb = rms_norm(kb.reshape(B, T, H_B, HEAD_DIM), kn_b)
    vb = vb.reshape(B, T, H_B, HEAD_DIM)
    log_f = jax.nn.log_sigmoid(fl.astype(jnp.float32) + b_f.astype(jnp.float32))
    return qa, ka, va, log_f, qb, kb, vb, jax.nn.sigmoid(ga), jax.nn.sigmoid(gb)


def forgetting_attention_prompt(q, k, v, log_f):
    B, T, H, Dh = q.shape
    c = jnp.cumsum(log_f, axis=1)
    cT = c.transpose(0, 2, 1)
    nb = T // Q_BLOCK
    qb = q.reshape(B, nb, Q_BLOCK, H, Dh).transpose(1, 0, 2, 3, 4)
    cb = cT.reshape(B, H, nb, Q_BLOCK).transpose(2, 0, 1, 3)
    kpos = jnp.arange(T)
    scale = HEAD_DIM ** -0.5

    def block(args):
        i, qi, ci = args
        s = jnp.einsum('bqhd,bkhd->bhqk', qi, k).astype(jnp.float32) * scale
        s = s + ci[..., None] - cT[:, :, None, :]
        qpos = i * Q_BLOCK + jnp.arange(Q_BLOCK)
        s = jnp.where(kpos[None, :] <= qpos[:, None], s, -jnp.inf)
        p = jax.nn.softmax(s, axis=-1).astype(v.dtype)
        return jnp.einsum('bhqk,bkhd->bqhd', p, v)

    out = lax.map(block, (jnp.arange(nb), qb, cb))
    return out.transpose(1, 0, 2, 3, 4).reshape(B, T, H * Dh)


def forgetting_attention_sample(q, k_new, v_new, logf_new, k_cache, v_cache, logf_cache):
    B, n, H, Dh = q.shape
    P = k_cache.shape[1]
    k = jnp.concatenate([k_cache.astype(k_new.dtype), k_new], axis=1)
    v = jnp.concatenate([v_cache.astype(v_new.dtype), v_new], axis=1)
    c = jnp.cumsum(jnp.concatenate([logf_cache.astype(jnp.float32), logf_new], axis=1), axis=1)
    cT = c.transpose(0, 2, 1)
    s = jnp.einsum('bqhd,bkhd->bhqk', q, k).astype(jnp.float32) * (HEAD_DIM ** -0.5)
    s = s + cT[:, :, P:, None] - cT[:, :, None, :]
    mask = jnp.arange(P + n)[None, :] <= (P + jnp.arange(n))[:, None]
    s = jnp.where(mask, s, -jnp.inf)
    p = jax.nn.softmax(s, axis=-1).astype(v.dtype)
    return jnp.einsum('bhqk,bkhd->bqhd', p, v).reshape(B, n, H * Dh)


def rel_bias_lookup(rel_bias, rel):
    idx = jnp.clip(rel, -MAX_REL, MAX_REL) + MAX_REL
    return rel_bias[:, idx].astype(jnp.float32)


def chunk_band_prompt(q, k, v, rel_bias):
    B, T, H, Dh = q.shape
    nc = T // CHUNK
    kp = jnp.pad(k, ((0, 0), (BAND_PAST, 0), (0, 0), (0, 0)))
    vp = jnp.pad(v, ((0, 0), (BAND_PAST, 0), (0, 0), (0, 0)))
    qc = q.reshape(B, nc, CHUNK, H, Dh).transpose(1, 0, 2, 3, 4)
    i = jnp.arange(CHUNK)
    j = jnp.arange(BAND_LEN)
    bias = rel_bias_lookup(rel_bias, (j[None, :] - BAND_PAST) - i[:, None])
    scale = HEAD_DIM ** -0.5

    def chunk(args):
        c, qi = args
        kb = lax.dynamic_slice_in_dim(kp, c * CHUNK, BAND_LEN, axis=1)
        vb = lax.dynamic_slice_in_dim(vp, c * CHUNK, BAND_LEN, axis=1)
        s = jnp.einsum('bqhd,bkhd->bhqk', qi, kb).astype(jnp.float32) * scale + bias
        s = jnp.where(j >= BAND_PAST - c * CHUNK, s, -jnp.inf)
        p = jax.nn.softmax(s, axis=-1).astype(vb.dtype)
        return jnp.einsum('bhqk,bkhd->bqhd', p, vb)

    out = lax.map(chunk, (jnp.arange(nc), qc))
    return out.transpose(1, 0, 2, 3, 4).reshape(B, T, H * Dh)


def chunk_band_sample(q, k_new, v_new, k_cache, v_cache, rel_bias):
    B, n, H, Dh = q.shape
    L = k_cache.shape[1]
    k = jnp.concatenate([k_cache.astype(k_new.dtype), k_new], axis=1)
    v = jnp.concatenate([v_cache.astype(v_new.dtype), v_new], axis=1)
    i = jnp.arange(n)
    j = jnp.arange(L + n)
    bias = rel_bias_lookup(rel_bias, (j[None, :] - L) - i[:, None])
    s = jnp.einsum('bqhd,bkhd->bhqk', q, k).astype(jnp.float32) * (HEAD_DIM ** -0.5) + bias
    p = jax.nn.softmax(s, axis=-1).astype(v.dtype)
    return jnp.einsum('bhqk,bkhd->bqhd', p, v).reshape(B, n, H * Dh)


def peer_ffn(x, w_q, sub_keys, u, v):
    T, D = x.shape
    pad = (-T) % PEER_TOKEN_BLOCK
    xb = jnp.pad(x, ((0, pad), (0, 0))).reshape(-1, PEER_TOKEN_BLOCK, D)

    def block(xi):
        t = xi.shape[0]
        q = (xi @ w_q).reshape(t, PEER_HEADS, 2, PEER_DK // 2)
        s = jnp.einsum('thpc,hpnc->thpn', q, sub_keys).astype(jnp.float32)
        top_s, top_i = lax.top_k(s, PEER_TOPK)
        cand_s = (top_s[:, :, 0, :, None] + top_s[:, :, 1, None, :]).reshape(t, PEER_HEADS, PEER_TOPK * PEER_TOPK)
        cand_i = (top_i[:, :, 0, :, None] * N_KEYS + top_i[:, :, 1, None, :]).reshape(t, PEER_HEADS, PEER_TOPK * PEER_TOPK)
        best_s, pos = lax.top_k(cand_s, PEER_TOPK)
        idx = jnp.take_along_axis(cand_i, pos, axis=-1)
        g = jax.nn.softmax(best_s, axis=-1)
        hid = jax.nn.gelu(jnp.einsum('thkd,td->thk', u[idx], xi).astype(jnp.float32))
        wgt = (g * hid).astype(xi.dtype)
        return jnp.einsum('thk,thkd->td', wgt, v[idx])

    return lax.map(block, xb).reshape(-1, D)[:T]


def merge_and_channel(h, ya, yb, ga, gb, p_l, w_up_a, w_up_b, w_out, g_ffn, peer_wq, peer_subkeys,
                      peer_u, peer_v, g_ple, w_ple_gate, w_ple_proj):
    merged = ga * (ya @ w_up_a) + gb * (yb @ w_up_b)
    h = h + merged @ w_out
    B, T, D = h.shape
    n2 = rms_norm(h, g_ffn)
    h = h + peer_ffn(n2.reshape(B * T, D), peer_wq, peer_subkeys, peer_u, peer_v).reshape(B, T, D)
    gate = jax.nn.sigmoid(rms_norm(h, g_ple) @ w_ple_gate)
    return h + gate * (p_l @ w_ple_proj)


def setup_inputs(seed: int = 0) -> dict:
    key = jax.random.key(seed)
    ks = jax.random.split(key, 28)
    nrm = lambda k, shape, s=1.0: jax.random.normal(k, shape, jnp.float32) * s
    lb = min(BAND_PAST, PAST_LEN)
    return {
        "x_prompt": nrm(ks[0], (BATCH, SEQ, D_MODEL)),
        "x_sample": nrm(ks[1], (DEC_BATCH, DEC_SEQ, D_MODEL)),
        "cache_a_k": nrm(ks[2], (DEPTH, DEC_BATCH, PAST_LEN, H_A, HEAD_DIM)),
        "cache_a_v": nrm(ks[3], (DEPTH, DEC_BATCH, PAST_LEN, H_A, HEAD_DIM)),
        "cache_a_logf": jax.nn.log_sigmoid(nrm(ks[4], (DEPTH, DEC_BATCH, PAST_LEN, H_A)) + FORGET_BIAS_INIT),
        "cache_b_k": nrm(ks[5], (DEPTH, DEC_BATCH, lb, H_B, HEAD_DIM)),
        "cache_b_v": nrm(ks[6], (DEPTH, DEC_BATCH, lb, H_B, HEAD_DIM)),
        "p_prompt": nrm(ks[7], (DEPTH, BATCH, SEQ, PLE_DIM)),
        "p_sample": nrm(ks[8], (DEPTH, DEC_BATCH, DEC_SEQ, PLE_DIM)),
        "g_mix": 1.0 + nrm(ks[9], (DEPTH, D_MODEL), 0.02),
        "w_in": nrm(ks[10], (DEPTH, D_MODEL, IN_W), D_MODEL ** -0.5),
        "b_f": FORGET_BIAS_INIT + nrm(ks[11], (DEPTH, H_A), 0.1),
        "qn_a": 1.0 + nrm(ks[12], (DEPTH, HEAD_DIM), 0.02),
        "kn_a": 1.0 + nrm(ks[13], (DEPTH, HEAD_DIM), 0.02),
        "qn_b": 1.0 + nrm(ks[14], (DEPTH, HEAD_DIM), 0.02),
        "kn_b": 1.0 + nrm(ks[15], (DEPTH, HEAD_DIM), 0.02),
        "rel_bias_b": nrm(ks[16], (DEPTH, H_B, 2 * MAX_REL + 1), 0.1),
        "w_up_a": nrm(ks[17], (DEPTH, W_A, D_MODEL), W_A ** -0.5),
        "w_up_b": nrm(ks[18], (DEPTH, W_B, D_MODEL), W_B ** -0.5),
        "w_out": nrm(ks[19], (DEPTH, D_MODEL, D_MODEL), D_MODEL ** -0.5),
        "g_ffn": 1.0 + nrm(ks[20], (DEPTH, D_MODEL), 0.02),
        "peer_wq": nrm(ks[21], (DEPTH, D_MODEL, PEER_HEADS * PEER_DK), D_MODEL ** -0.5),
        "peer_subkeys": nrm(ks[22], (DEPTH, PEER_HEADS, 2, N_KEYS, PEER_DK // 2), (PEER_DK // 2) ** -0.5),
        "peer_u": nrm(ks[23], (DEPTH, N_EXPERTS, D_MODEL), D_MODEL ** -0.5),
        "peer_v": nrm(ks[24], (DEPTH, N_EXPERTS, D_MODEL), 0.25),
        "g_ple": 1.0 + nrm(ks[25], (DEPTH, D_MODEL), 0.02),
        "w_ple_gate": nrm(ks[26], (DEPTH, D_MODEL, D_MODEL), D_MODEL ** -0.5),
        "w_ple_proj": nrm(ks[27], (DEPTH, PLE_DIM, D_MODEL), PLE_DIM ** -0.5),
    }


def reference(x_prompt, x_sample, cache_a_k, cache_a_v, cache_a_logf, cache_b_k, cache_b_v, p_prompt, p_sample,
              g_mix, w_in, b_f, qn_a, kn_a, qn_b, kn_b, rel_bias_b, w_up_a, w_up_b, w_out, g_ffn,
              peer_wq, peer_subkeys, peer_u, peer_v, g_ple, w_ple_gate, w_ple_proj):
    hp, hs = x_prompt, x_sample
    akp, avp, afp, bkp, bvp = [], [], [], [], []
    aks, avs, afs, bks, bvs = [], [], [], [], []
    for l in range(DEPTH):
        proj = (g_mix[l], w_in[l], b_f[l], qn_a[l], kn_a[l], qn_b[l], kn_b[l])
        chan = (w_up_a[l], w_up_b[l], w_out[l], g_ffn[l], peer_wq[l], peer_subkeys[l], peer_u[l], peer_v[l],
                g_ple[l], w_ple_gate[l], w_ple_proj[l])
        qa, ka, va, lf, qb, kb, vb, ga, gb = mixer_projections(hp, *proj)
        ya = forgetting_attention_prompt(qa, ka, va, lf)
        yb = chunk_band_prompt(qb, kb, vb, rel_bias_b[l])
        hp = merge_and_channel(hp, ya, yb, ga, gb, p_prompt[l], *chan)
        akp.append(ka); avp.append(va); afp.append(lf)
        bkp.append(kb[:, -BAND_PAST:]); bvp.append(vb[:, -BAND_PAST:])
        qa, ka, va, lf, qb, kb, vb, ga, gb = mixer_projections(hs, *proj)
        ya = forgetting_attention_sample(qa, ka, va, lf, cache_a_k[l], cache_a_v[l], cache_a_logf[l])
        yb = chunk_band_sample(qb, kb, vb, cache_b_k[l], cache_b_v[l], rel_bias_b[l])
        hs = merge_and_channel(hs, ya, yb, ga, gb, p_sample[l], *chan)
        aks.append(ka); avs.append(va); afs.append(lf); bks.append(kb); bvs.append(vb)
    return (hp, hs,
            jnp.stack(akp), jnp.stack(avp), jnp.stack(afp), jnp.stack(bkp), jnp.stack(bvp),
            jnp.stack(aks), jnp.stack(avs), jnp.stack(afs), jnp.stack(bks), jnp.stack(bvs))
```

```cpp
#include <hip/hip_runtime.h>
#include <hip/hip_cooperative_groups.h>
#include <cstdio>
namespace cg = cooperative_groups;

typedef unsigned short u16;
typedef unsigned int u32;
typedef short bf16x8 __attribute__((ext_vector_type(8)));
typedef short s16x4 __attribute__((ext_vector_type(4)));
typedef float f32x4 __attribute__((ext_vector_type(4)));
typedef unsigned int u32x4 __attribute__((ext_vector_type(4)));
typedef unsigned int u32x2 __attribute__((ext_vector_type(2)));
typedef __bf16 bf16x2_t __attribute__((ext_vector_type(2)));

#define DI __device__ __forceinline__

constexpr int TP = 65536, TS = 256, TT = TP + TS;
constexpr float LOG2E = 1.4426950408889634f;
constexpr float EPS = 1e-6f;

constexpr size_t O_AK_P = 67371008, O_AV_P = 100925440, O_AF_P = 134479872, O_BK_P = 135004160,
                 O_BV_P = 143392768, O_AK_S = 151781376, O_AV_S = 151912448, O_AF_S = 152043520,
                 O_BK_S = 152045568, O_BV_S = 152176640;

constexpr size_t SZ_ACT = (size_t)TT * 1024 * 2;
constexpr size_t SZ_HALF = (size_t)TT * 512 * 2;
constexpr size_t W_XB = 0;
constexpr size_t W_QKV = SZ_ACT;
constexpr size_t W_GA = W_QKV + 6 * SZ_HALF;
constexpr size_t W_GB = W_GA + SZ_ACT;
constexpr size_t W_PB = W_GB + SZ_ACT;
constexpr size_t W_WIN = W_PB + (size_t)TT * 256 * 2;
constexpr size_t W_WUPA = W_WIN + (size_t)5120 * 1024 * 2;
constexpr size_t W_WUPB = W_WUPA + 1024 * 512 * 2;
constexpr size_t W_WOUT = W_WUPB + 1024 * 512 * 2;
constexpr size_t W_WQ = W_WOUT + 1024 * 1024 * 2;
constexpr size_t W_WG = W_WQ + 1024 * 1024 * 2;
constexpr size_t W_WPP = W_WG + 1024 * 1024 * 2;
constexpr size_t W_UB = W_WPP + 1024 * 256 * 2;
constexpr size_t W_VB = W_UB + (size_t)16384 * 1024 * 2;
constexpr size_t W_SK = W_VB + (size_t)16384 * 1024 * 2;
constexpr size_t W_RS1 = W_SK + 131072 * 2;
constexpr size_t W_SSQ2 = W_RS1 + (size_t)TT * 4;
constexpr size_t W_RS3 = W_SSQ2 + (size_t)TT * 64;
constexpr size_t W_CUMP = W_RS3 + (size_t)TT * 4;
constexpr size_t W_CUMS = W_CUMP + (size_t)256 * 2048 * 4;
constexpr size_t W_END = W_CUMS + (size_t)128 * 4112 * 4 + 1024;

struct Params {
  const float *x_p, *x_s, *cak, *cav, *caf, *cbk, *cbv, *p_p, *p_s, *g_mix, *w_in, *b_f, *qn_a, *kn_a,
      *qn_b, *kn_b, *relb, *w_up_a, *w_up_b, *w_out, *g_ffn, *peer_wq, *peer_sk, *peer_u, *peer_v, *g_ple,
      *w_gate, *w_proj;
  float* out;
  char* ws;
};

constexpr int SMEM_BYTES = 128 * 129 * 4 + 2 * 64 * 17 * 4 + 256;

DI u16 f2bf(float x) { u32 u = __float_as_uint(x); u += 0x7fffu + ((u >> 16) & 1u); return (u16)(u >> 16); }
DI float bf2f(u16 h) { return __uint_as_float(((u32)h) << 16); }
DI u32 pack2(float a, float b) { return (u32)f2bf(a) | ((u32)f2bf(b) << 16); }
DI float wave_sum(float v) {
#pragma unroll
  for (int o = 32; o; o >>= 1) v += __shfl_xor(v, o);
  return v;
}
DI f32x4 mfma16(bf16x8 a, bf16x8 b, f32x4 c) { return __builtin_amdgcn_mfma_f32_16x16x32_bf16(a, b, c, 0, 0, 0); }
DI float sigmoidf_(float x) { return 1.f / (1.f + __expf(-x)); }
DI u32 mono(float x) { u32 u = __float_as_uint(x); u32 m = (u32)((int)u >> 31) | 0x80000000u; return u ^ m; }
DI float unmono(u32 k) { u32 m = ((k >> 31) - 1u) | 0x80000000u; return __uint_as_float(k ^ m); }
DI void insert16(u32 (&L)[16], u32 x) {
#pragma unroll
  for (int s = 0; s < 16; s++) { u32 mx = max(L[s], x); x = min(L[s], x); L[s] = mx; }
}
DI float gelu_tanh(float x) {
  float u = 0.7978845608028654f * (x + 0.044715f * x * x * x);
  float t = 1.f - 2.f / (1.f + __expf(2.f * u));
  return 0.5f * x * (1.f + t);
}

constexpr int GSTR = 72;
DI void gemm_mainloop(const u16* __restrict__ A, int lda, const u16* __restrict__ B, int ldb, int K, u16* smem,
                      f32x4 (&acc)[4][4]) {
  const int tid = threadIdx.x, lane = tid & 63, w = tid >> 6, wm = w >> 1, wn = w & 1, r = lane & 15, quad = lane >> 4;
  u16* As = smem;
  u16* Bs = smem + 128 * GSTR;
  u32x4 ra[4], rb[4];
  const int lrow = tid >> 3, lch = tid & 7;
  const u16* ap = A + (size_t)lrow * lda + lch * 8;
  const u16* bp = B + (size_t)lrow * ldb + lch * 8;
#pragma unroll
  for (int i = 0; i < 4; i++) {
    ra[i] = *(const u32x4*)(ap + (size_t)i * 32 * lda);
    rb[i] = *(const u32x4*)(bp + (size_t)i * 32 * ldb);
  }
  const int nk = K >> 6;
#pragma unroll 1
  for (int kt = 0; kt < nk; kt++) {
    __syncthreads();
#pragma unroll
    for (int i = 0; i < 4; i++) {
      *(u32x4*)(As + (lrow + i * 32) * GSTR + lch * 8) = ra[i];
      *(u32x4*)(Bs + (lrow + i * 32) * GSTR + lch * 8) = rb[i];
    }
    __syncthreads();
    if (kt + 1 < nk) {
#pragma unroll
      for (int i = 0; i < 4; i++) {
        ra[i] = *(const u32x4*)(ap + (size_t)i * 32 * lda + (kt + 1) * 64);
        rb[i] = *(const u32x4*)(bp + (size_t)i * 32 * ldb + (kt + 1) * 64);
      }
    }
#pragma unroll
    for (int ks = 0; ks < 2; ks++) {
      bf16x8 af[4], bfr[4];
#pragma unroll
      for (int mi = 0; mi < 4; mi++) af[mi] = *(const bf16x8*)(As + (wm * 64 + mi * 16 + r) * GSTR + ks * 32 + quad * 8);
#pragma unroll
      for (int ni = 0; ni < 4; ni++) bfr[ni] = *(const bf16x8*)(Bs + (wn * 64 + ni * 16 + r) * GSTR + ks * 32 + quad * 8);
#pragma unroll
      for (int mi = 0; mi < 4; mi++)
#pragma unroll
        for (int ni = 0; ni < 4; ni++) acc[mi][ni] = mfma16(af[mi], bfr[ni], acc[mi][ni]);
    }
  }
}

DI void zero_acc(f32x4 (&acc)[4][4]) {
#pragma unroll
  for (int i = 0; i < 4; i++)
#pragma unroll
    for (int j = 0; j < 4; j++) acc[i][j] = (f32x4){0.f, 0.f, 0.f, 0.f};
}

DI void transpose_tile(const float* __restrict__ W, int ldw, int K, const float* __restrict__ g, u16* __restrict__ dst,
                       int k0, int n0, int nsrc0, float* tile) {
  const int tid = threadIdx.x;
  __syncthreads();
  {
    const int ty = tid >> 4, tx = tid & 15;
#pragma unroll
    for (int i = 0; i < 4; i++) {
      int k = ty + i * 16;
      f32x4 v = *(const f32x4*)(W + (size_t)(k0 + k) * ldw + nsrc0 + tx * 4);
      float s = g ? g[k0 + k] : 1.f;
      tile[k * 65 + tx * 4 + 0] = v[0] * s;
      tile[k * 65 + tx * 4 + 1] = v[1] * s;
      tile[k * 65 + tx * 4 + 2] = v[2] * s;
      tile[k * 65 + tx * 4 + 3] = v[3] * s;
    }
  }
  __syncthreads();
  {
    const int n = tid >> 2, kc = (tid & 3) * 16;
    u32 pk[8];
#pragma unroll
    for (int i = 0; i < 8; i++) pk[i] = pack2(tile[(kc + 2 * i) * 65 + n], tile[(kc + 2 * i + 1) * 65 + n]);
    u16* d = dst + (size_t)(n0 + n) * K + k0 + kc;
    *(u32x4*)d = (u32x4){pk[0], pk[1], pk[2], pk[3]};
    *(u32x4*)(d + 8) = (u32x4){pk[4], pk[5], pk[6], pk[7]};
  }
}

DI void conv_unit(const float* __restrict__ src, u16* __restrict__ dst, size_t base, const float* __restrict__ colscale) {
  const int tid = threadIdx.x;
#pragma unroll
  for (int i = 0; i < 4; i++) {
    size_t e = base + (size_t)i * 1024 + tid * 4;
    f32x4 v = *(const f32x4*)(src + e);
    if (colscale) {
      f32x4 gg = *(const f32x4*)(colscale + (e & 1023));
      v = v * gg;
    }
    *(u32x2*)(dst + e) = (u32x2){pack2(v[0], v[1]), pack2(v[2], v[3])};
  }
}

DI void phase0(const Params& P, char* smem) {
  const int tid = threadIdx.x, lane = tid & 63, w = tid >> 6;
  char* ws = P.ws;
  {
    float* tile = (float*)smem;
    constexpr int T_WIN = 16 * 80, T_UP = 8 * 16, T_SQ = 256, T_PP = 4 * 16;
    constexpr int NT = T_WIN + 2 * T_UP + 3 * T_SQ + T_PP;
    for (int t = blockIdx.x; t < NT; t += gridDim.x) {
      int u = t;
      if (u < T_WIN) {
        int kt = u / 80, nt = u % 80;
        int n0 = nt * 64;
        int ns = n0 < 1536 ? n0 : n0 + 8;
        transpose_tile(P.w_in, 5128, 1024, P.g_mix, (u16*)(ws + W_WIN), kt * 64, n0, ns, tile);
        continue;
      }
      u -= T_WIN;
      if (u < T_UP) { transpose_tile(P.w_up_a, 1024, 512, nullptr, (u16*)(ws + W_WUPA), (u / 16) * 64, (u % 16) * 64, (u % 16) * 64, tile); continue; }
      u -= T_UP;
      if (u < T_UP) { transpose_tile(P.w_up_b, 1024, 512, nullptr, (u16*)(ws + W_WUPB), (u / 16) * 64, (u % 16) * 64, (u % 16) * 64, tile); continue; }
      u -= T_UP;
      if (u < T_SQ) { transpose_tile(P.w_out, 1024, 1024, nullptr, (u16*)(ws + W_WOUT), (u / 16) * 64, (u % 16) * 64, (u % 16) * 64, tile); continue; }
      u -= T_SQ;
      if (u < T_SQ) { transpose_tile(P.peer_wq, 1024, 1024, P.g_ffn, (u16*)(ws + W_WQ), (u / 16) * 64, (u % 16) * 64, (u % 16) * 64, tile); continue; }
      u -= T_SQ;
      if (u < T_SQ) { transpose_tile(P.w_gate, 1024, 1024, P.g_ple, (u16*)(ws + W_WG), (u / 16) * 64, (u % 16) * 64, (u % 16) * 64, tile); continue; }
      u -= T_SQ;
      transpose_tile(P.w_proj, 1024, 256, nullptr, (u16*)(ws + W_WPP), (u / 16) * 64, (u % 16) * 64, (u % 16) * 64, tile);
    }
  }
  {
    constexpr int U_UB = 4096, U_VB = 4096, U_SK = 32, U_PP = 4096, U_PS = 16;
    constexpr int NU = U_UB + U_VB + U_SK + U_PP + U_PS;
    for (int t = blockIdx.x; t < NU; t += gridDim.x) {
      int u = t;
      if (u < U_UB) { conv_unit(P.peer_u, (u16*)(ws + W_UB), (size_t)u * 4096, P.g_ffn); continue; }
      u -= U_UB;
      if (u < U_VB) { conv_unit(P.peer_v, (u16*)(ws + W_VB), (size_t)u * 4096, nullptr); continue; }
      u -= U_VB;
      if (u < U_SK) { conv_unit(P.peer_sk, (u16*)(ws + W_SK), (size_t)u * 4096, nullptr); continue; }
      u -= U_SK;
      if (u < U_PP) { conv_unit(P.p_p, (u16*)(ws + W_PB), (size_t)u * 4096, nullptr); continue; }
      u -= U_PP;
      conv_unit(P.p_s, (u16*)(ws + W_PB) + (size_t)TP * 256, (size_t)u * 4096, nullptr);
    }
  }
  {
    float* wfl = (float*)smem;
    __syncthreads();
    for (int i = tid; i < 8192; i += 256) {
      int k = i >> 3, h = i & 7;
      wfl[h * 1024 + k] = P.g_mix[k] * P.w_in[(size_t)k * 5128 + 1536 + h];
    }
    __syncthreads();
    u16* XB = (u16*)(ws + W_XB);
    float* RS1 = (float*)(ws + W_RS1);
    for (int t = blockIdx.x * 4 + w; t < TT; t += gridDim.x * 4) {
      const float* xr = t < TP ? P.x_p + (size_t)t * 1024 : P.x_s + (size_t)(t - TP) * 1024;
      f32x4 v[4];
#pragma unroll
      for (int i = 0; i < 4; i++) v[i] = *(const f32x4*)(xr + i * 256 + lane * 4);
      float ss = 0.f;
#pragma unroll
      for (int i = 0; i < 4; i++) ss += v[i][0] * v[i][0] + v[i][1] * v[i][1] + v[i][2] * v[i][2] + v[i][3] * v[i][3];
      float dots[8];
#pragma unroll
      for (int h = 0; h < 8; h++) {
        float d = 0.f;
#pragma unroll
        for (int i = 0; i < 4; i++) {
          f32x4 wv = *(const f32x4*)(wfl + h * 1024 + i * 256 + lane * 4);
          d += v[i][0] * wv[0] + v[i][1] * wv[1] + v[i][2] * wv[2] + v[i][3] * wv[3];
        }
        dots[h] = d;
      }
      ss = wave_sum(ss);
#pragma unroll
      for (int h = 0; h < 8; h++) dots[h] = wave_sum(dots[h]);
      float rs = rsqrtf(ss * (1.f / 1024.f) + EPS);
#pragma unroll
      for (int i = 0; i < 4; i++)
        *(u32x2*)(XB + (size_t)t * 1024 + i * 256 + lane * 4) = (u32x2){pack2(v[i][0], v[i][1]), pack2(v[i][2], v[i][3])};
      if (lane == 0) RS1[t] = rs;
      float myd = dots[0];
#pragma unroll
      for (int h = 1; h < 8; h++) myd = (lane == h) ? dots[h] : myd;
      if (lane < 8) {
        float z = rs * myd + P.b_f[lane];
        float lf = fminf(z, 0.f) - log1pf(expf(-fabsf(z)));
        float* o = t < TP ? P.out + O_AF_P + (size_t)t * 8 : P.out + O_AF_S + (size_t)(t - TP) * 8;
        o[lane] = lf;
      }
    }
  }
}

DI void phase1_scans(const Params& P) {
  const int lane = threadIdx.x & 63;
  const int gw = blockIdx.x * 4 + (threadIdx.x >> 6), nw = gridDim.x * 4;
  float* CUMP = (float*)(P.ws + W_CUMP);
  float* CUMS = (float*)(P.ws + W_CUMS);
  for (int row = gw; row < 384; row += nw) {
    float carry = 0.f;
    if (row < 256) {
      int b = row >> 3, h = row & 7;
      const float* src = P.out + O_AF_P + (size_t)b * 2048 * 8 + h;
      for (int p0 = 0; p0 < 2048; p0 += 64) {
        float v = src[(size_t)(p0 + lane) * 8];
#pragma unroll
        for (int o = 1; o < 64; o <<= 1) { float n = __shfl_up(v, o); if (lane >= o) v += n; }
        v += carry;
        CUMP[(size_t)row * 2048 + p0 + lane] = v * LOG2E;
        carry = __shfl(v, 63);
      }
    } else {
      int rr = row - 256;
      int b = rr >> 3, h = rr & 7;
      const float* src = P.caf + (size_t)b * 4096 * 8 + h;
      for (int p0 = 0; p0 < 4096; p0 += 64) {
        float v = src[(size_t)(p0 + lane) * 8];
#pragma unroll
        for (int o = 1; o < 64; o <<= 1) { float n = __shfl_up(v, o); if (lane >= o) v += n; }
        v += carry;
        CUMS[(size_t)rr * 4112 + p0 + lane] = v * LOG2E;
        carry = __shfl(v, 63);
      }
      {
        float v = lane < 16 ? P.out[O_AF_S + (size_t)(b * 16 + lane) * 8 + h] : 0.f;
#pragma unroll
        for (int o = 1; o < 64; o <<= 1) { float n = __shfl_up(v, o); if (lane >= o) v += n; }
        v += carry;
        if (lane < 16) CUMS[(size_t)rr * 4112 + 4096 + lane] = v * LOG2E;
      }
    }
  }
}

DI void phase1_tile(const Params& P, int tile, char* smem) {
  const int tid = threadIdx.x, lane = tid & 63, w = tid >> 6, wm = w >> 1, wn = w & 1, r = lane & 15, quad = lane >> 4;
  const int mt = tile / 40, nt = tile % 40;
  const int m0 = mt * 128, n0 = nt * 128;
  char* ws = P.ws;
  f32x4 acc[4][4];
  zero_acc(acc);
  gemm_mainloop((const u16*)(ws + W_XB) + (size_t)m0 * 1024, 1024, (const u16*)(ws + W_WIN) + (size_t)n0 * 1024, 1024, 1024,
                (u16*)smem, acc);
  const float* RS1 = (const float*)(ws + W_RS1);
  const int ncol0 = n0 + wn * 64;
  const bool sample = m0 >= TP;
  if (ncol0 < 3072) {
    const int seg = ncol0 >> 9, hc = ncol0 & 511;
    const bool normed = (seg != 2 && seg != 5);
    const float* gain = seg == 0 ? P.qn_a : seg == 1 ? P.kn_a : seg == 3 ? P.qn_b : P.kn_b;
    const float qs = (seg == 0 || seg == 3) ? 0.125f * LOG2E : 1.f;
    float gn[4];
#pragma unroll
    for (int ni = 0; ni < 4; ni++) gn[ni] = normed ? gain[ni * 16 + r] * qs : 1.f;
    u16* dstb = (u16*)(ws + W_QKV + (size_t)seg * SZ_HALF);
#pragma unroll
    for (int mi = 0; mi < 4; mi++) {
#pragma unroll
      for (int j = 0; j < 4; j++) {
        const int row = m0 + wm * 64 + mi * 16 + quad * 4 + j;
        const float rs = RS1[row];
        float v[4];
#pragma unroll
        for (int ni = 0; ni < 4; ni++) v[ni] = acc[mi][ni][j] * rs;
        if (normed) {
          float ss = v[0] * v[0] + v[1] * v[1] + v[2] * v[2] + v[3] * v[3];
          ss += __shfl_xor(ss, 1);
          ss += __shfl_xor(ss, 2);
          ss += __shfl_xor(ss, 4);
          ss += __shfl_xor(ss, 8);
          float inv = rsqrtf(ss * (1.f / 64.f) + EPS);
#pragma unroll
          for (int ni = 0; ni < 4; ni++) v[ni] *= inv * gn[ni];
        }
        u16* d = dstb + (size_t)row * 512 + hc + r;
#pragma unroll
        for (int ni = 0; ni < 4; ni++) d[ni * 16] = f2bf(v[ni]);
        float* o = nullptr;
        if (seg == 1 || seg == 2) {
          o = sample ? P.out + (seg == 1 ? O_AK_S : O_AV_S) + (size_t)(row - TP) * 512
                     : P.out + (seg == 1 ? O_AK_P : O_AV_P) + (size_t)row * 512;
        } else if (seg == 4 || seg == 5) {
          if (sample) o = P.out + (seg == 4 ? O_BK_S : O_BV_S) + (size_t)(row - TP) * 512;
          else {
            int pos = row & 2047, b = row >> 11;
            if (pos >= 1536) o = P.out + (seg == 4 ? O_BK_P : O_BV_P) + ((size_t)b * 512 + (pos - 1536)) * 512;
          }
        }
        if (o) {
          o += hc + r;
#pragma unroll
          for (int ni = 0; ni < 4; ni++) o[ni * 16] = v[ni];
        }
      }
    }
  } else {
    u16* dstb = ncol0 < 4096 ? (u16*)(ws + W_GA) + (ncol0 - 3072) : (u16*)(ws + W_GB) + (ncol0 - 4096);
#pragma unroll
    for (int mi = 0; mi < 4; mi++) {
#pragma unroll
      for (int j = 0; j < 4; j++) {
        const int row = m0 + wm * 64 + mi * 16 + quad * 4 + j;
        const float rs = RS1[row];
        u16* d = dstb + (size_t)row * 1024 + r;
#pragma unroll
        for (int ni = 0; ni < 4; ni++) d[ni * 16] = f2bf(sigmoidf_(acc[mi][ni][j] * rs));
      }
    }
  }
}

constexpr int ASTR = 72;
constexpr int TAB_OFF = 36864;
struct AttnState { f32x4 o[4]; float m, l; };

DI s16x4 tr_read(const u16* p) {
  return __builtin_amdgcn_ds_read_tr16_b64_v4i16((__attribute__((address_space(3))) s16x4*)(p));
}

template <int MODE>
DI void attn_step(const u16* Ks, const u16* Vs, const bf16x8 (&qf)[2], AttnState& st, int kpos0, int qpos, int qlim,
                  float cq, const float* cum, const float* tab, bool domask) {
  const int lane = threadIdx.x & 63, r = lane & 15, quad = lane >> 4;
  f32x4 s[2];
#pragma unroll
  for (int t = 0; t < 2; t++) {
    f32x4 a4 = (f32x4){0.f, 0.f, 0.f, 0.f};
#pragma unroll
    for (int ks = 0; ks < 2; ks++) {
      bf16x8 kf = *(const bf16x8*)(Ks + (t * 16 + r) * ASTR + ks * 32 + quad * 8);
      a4 = mfma16(kf, qf[ks], a4);
    }
    s[t] = a4;
  }
#pragma unroll
  for (int t = 0; t < 2; t++) {
    const int kb = kpos0 + t * 16 + quad * 4;
    if (MODE == 0) {
      f32x4 c4 = *(const f32x4*)(cum + kb);
#pragma unroll
      for (int j = 0; j < 4; j++) s[t][j] += cq - c4[j];
    } else {
#pragma unroll
      for (int j = 0; j < 4; j++) {
        int rel = kb + j - qpos;
        rel = min(max(rel, -128), 128) + 128;
        s[t][j] += tab[rel];
      }
    }
    if (domask) {
#pragma unroll
      for (int j = 0; j < 4; j++)
        if (kb + j > qlim) s[t][j] = -1e30f;
    }
  }
  float mx = fmaxf(fmaxf(fmaxf(s[0][0], s[0][1]), fmaxf(s[0][2], s[0][3])), fmaxf(fmaxf(s[1][0], s[1][1]), fmaxf(s[1][2], s[1][3])));
  mx = fmaxf(mx, __shfl_xor(mx, 16));
  mx = fmaxf(mx, __shfl_xor(mx, 32));
  const float mn = fmaxf(st.m, mx);
  const float alpha = __builtin_amdgcn_exp2f(st.m - mn);
  float p[8];
  float ls = 0.f;
#pragma unroll
  for (int t = 0; t < 2; t++)
#pragma unroll
    for (int j = 0; j < 4; j++) { p[t * 4 + j] = __builtin_amdgcn_exp2f(s[t][j] - mn); ls += p[t * 4 + j]; }
  st.l = st.l * alpha + ls;
  st.m = mn;
#pragma unroll
  for (int dt = 0; dt < 4; dt++) st.o[dt] = st.o[dt] * alpha;
  u32x4 pk = (u32x4){pack2(p[0], p[1]), pack2(p[2], p[3]), pack2(p[4], p[5]), pack2(p[6], p[7])};
  bf16x8 pf = __builtin_bit_cast(bf16x8, pk);
  const int qq = (lane & 15) >> 2, pp = lane & 3;
#pragma unroll
  for (int dt = 0; dt < 4; dt++) {
    s16x4 lo = tr_read(Vs + (quad * 4 + qq) * ASTR + dt * 16 + pp * 4);
    s16x4 hi = tr_read(Vs + (16 + quad * 4 + qq) * ASTR + dt * 16 + pp * 4);
    bf16x8 vf = __builtin_shufflevector(lo, hi, 0, 1, 2, 3, 4, 5, 6, 7);
    st.o[dt] = mfma16(vf, pf, st.o[dt]);
  }
}

template <int MODE>
DI void attn_prompt_item(const Params& P, char* smem, int b, int h, int qt) {
  const int tid = threadIdx.x, lane = tid & 63, w = tid >> 6, r = lane & 15, quad = lane >> 4;
  char* ws = P.ws;
  const u16* Q = (const u16*)(ws + W_QKV + (size_t)(MODE == 0 ? 0 : 3) * SZ_HALF);
  const u16* Kg = (const u16*)(ws + W_QKV + (size_t)(MODE == 0 ? 1 : 4) * SZ_HALF);
  const u16* Vg = (const u16*)(ws + W_QKV + (size_t)(MODE == 0 ? 2 : 5) * SZ_HALF);
  u16* Y = (u16*)(ws + W_XB + (size_t)(MODE == 0 ? 0 : 1) * SZ_HALF);
  u16* Ks = (u16*)smem;
  u16* Vs = Ks + 64 * ASTR;
  float* tab = (float*)(smem + TAB_OFF);
  __syncthreads();
  if (MODE == 1) {
    for (int i = tid; i < 257; i += 256) tab[i] = P.relb[h * 257 + i] * LOG2E;
  }
  const int q0 = qt * 64;
  const int qpos = q0 + w * 16 + r;
  const size_t tokq = (size_t)b * 2048 + qpos;
  bf16x8 qf[2];
#pragma unroll
  for (int ks = 0; ks < 2; ks++) qf[ks] = *(const bf16x8*)(Q + tokq * 512 + h * 64 + ks * 32 + quad * 8);
  const float* cum = (const float*)(ws + W_CUMP) + (size_t)(b * 8 + h) * 2048;
  const float cq = MODE == 0 ? cum[qpos] : 0.f;
  AttnState st;
#pragma unroll
  for (int dt = 0; dt < 4; dt++) st.o[dt] = (f32x4){0.f, 0.f, 0.f, 0.f};
  st.m = -1e30f;
  st.l = 0.f;
  const int kt_lo = MODE == 0 ? 0 : max(0, qt - 8), kt_hi = qt;
  u32x4 rk[2], rv[2];
  const int lkey = tid >> 3, lch = tid & 7;
  const u16* kp = Kg + ((size_t)b * 2048 + lkey) * 512 + h * 64 + lch * 8;
  const u16* vp = Vg + ((size_t)b * 2048 + lkey) * 512 + h * 64 + lch * 8;
#pragma unroll
  for (int i = 0; i < 2; i++) {
    rk[i] = *(const u32x4*)(kp + (size_t)(kt_lo * 64 + i * 32) * 512);
    rv[i] = *(const u32x4*)(vp + (size_t)(kt_lo * 64 + i * 32) * 512);
  }
  for (int kt = kt_lo; kt <= kt_hi; kt++) {
    __syncthreads();
#pragma unroll
    for (int i = 0; i < 2; i++) {
      *(u32x4*)(Ks + (lkey + i * 32) * ASTR + lch * 8) = rk[i];
      *(u32x4*)(Vs + (lkey + i * 32) * ASTR + lch * 8) = rv[i];
    }
    __syncthreads();
    if (kt < kt_hi) {
#pragma unroll
      for (int i = 0; i < 2; i++) {
        rk[i] = *(const u32x4*)(kp + (size_t)((kt + 1) * 64 + i * 32) * 512);
        rv[i] = *(const u32x4*)(vp + (size_t)((kt + 1) * 64 + i * 32) * 512);
      }
    }
    const bool diag = (MODE == 0) && (kt == qt);
#pragma unroll
    for (int half = 0; half < 2; half++) {
      const int kpos0 = kt * 64 + half * 32;
      if (diag && kpos0 > q0 + w * 16 + 15) continue;
      attn_step<MODE>(Ks + half * 32 * ASTR, Vs + half * 32 * ASTR, qf, st, kpos0, qpos, qpos, cq, cum, tab, diag);
    }
  }
  float lt = st.l;
  lt += __shfl_xor(lt, 16);
  lt += __shfl_xor(lt, 32);
  const float inv = 1.f / lt;
#pragma unroll
  for (int dt = 0; dt < 4; dt++) {
    u32x2 o2 = (u32x2){pack2(st.o[dt][0] * inv, st.o[dt][1] * inv), pack2(st.o[dt][2] * inv, st.o[dt][3] * inv)};
    *(u32x2*)(Y + tokq * 512 + h * 64 + dt * 16 + quad * 4) = o2;
  }
}

template <int MODE>
DI void attn_sample_item(const Params& P, char* smem, int b, int h) {
  const int tid = threadIdx.x, lane = tid & 63, w = tid >> 6, r = lane & 15, quad = lane >> 4;
  constexpr int L = MODE == 0 ? 4096 : 512;
  char* ws = P.ws;
  const u16* Q = (const u16*)(ws + W_QKV + (size_t)(MODE == 0 ? 0 : 3) * SZ_HALF);
  const u16* Kn = (const u16*)(ws + W_QKV + (size_t)(MODE == 0 ? 1 : 4) * SZ_HALF);
  const u16* Vn = (const u16*)(ws + W_QKV + (size_t)(MODE == 0 ? 2 : 5) * SZ_HALF);
  u16* Y = (u16*)(ws + W_XB + (size_t)(MODE == 0 ? 0 : 1) * SZ_HALF);
  u16* Kw = (u16*)smem + w * (2 * 32 * ASTR);
  u16* Vw = Kw + 32 * ASTR;
  float* tab = (float*)(smem + TAB_OFF);
  __syncthreads();
  if (MODE == 1) {
    for (int i = tid; i < 257; i += 256) tab[i] = P.relb[h * 257 + i] * LOG2E;
  }
  __syncthreads();
  const float* ck = (MODE == 0 ? P.cak : P.cbk) + ((size_t)b * L * 8 + h) * 64;
  const float* cv = (MODE == 0 ? P.cav : P.cbv) + ((size_t)b * L * 8 + h) * 64;
  const size_t tokbase = (size_t)TP + b * 16;
  bf16x8 qf[2];
#pragma unroll
  for (int ks = 0; ks < 2; ks++) qf[ks] = *(const bf16x8*)(Q + (tokbase + r) * 512 + h * 64 + ks * 32 + quad * 8);
  const int qpos = L + r;
  const float* cum = (const float*)(ws + W_CUMS) + (size_t)(b * 8 + h) * 4112;
  const float cq = MODE == 0 ? cum[qpos] : 0.f;
  AttnState st;
#pragma unroll
  for (int dt = 0; dt < 4; dt++) st.o[dt] = (f32x4){0.f, 0.f, 0.f, 0.f};
  st.m = -1e30f;
  st.l = 0.f;
  const int kbeg = w * (L / 4), kend = kbeg + L / 4;
  for (int k0 = kbeg; k0 < kend; k0 += 32) {
    {
      f32x4 kr[8];
#pragma unroll
      for (int i = 0; i < 8; i++) kr[i] = *(const f32x4*)(ck + (size_t)(k0 + i * 4 + quad) * 512 + r * 4);
#pragma unroll
      for (int i = 0; i < 8; i++)
        *(u32x2*)(Kw + (i * 4 + quad) * ASTR + r * 4) = (u32x2){pack2(kr[i][0], kr[i][1]), pack2(kr[i][2], kr[i][3])};
    }
    {
      f32x4 vr[8];
#pragma unroll
      for (int i = 0; i < 8; i++) vr[i] = *(const f32x4*)(cv + (size_t)(k0 + i * 4 + quad) * 512 + r * 4);
#pragma unroll
      for (int i = 0; i < 8; i++)
        *(u32x2*)(Vw + (i * 4 + quad) * ASTR + r * 4) = (u32x2){pack2(vr[i][0], vr[i][1]), pack2(vr[i][2], vr[i][3])};
    }
    asm volatile("s_waitcnt lgkmcnt(0)" ::: "memory");
    __builtin_amdgcn_wave_barrier();
    attn_step<MODE>(Kw, Vw, qf, st, k0, qpos, qpos, cq, cum, tab, false);
    __builtin_amdgcn_wave_barrier();
  }
  if (w == 0) {
#pragma unroll
    for (int i = 0; i < 2; i++) {
      int c = lane + i * 64;
      int key = c >> 3, ch = c & 7;
      u32x4 kk = *(const u32x4*)(Kn + (tokbase + key) * 512 + h * 64 + ch * 8);
      u32x4 vv = *(const u32x4*)(Vn + (tokbase + key) * 512 + h * 64 + ch * 8);
      *(u32x4*)(Kw + key * ASTR + ch * 8) = kk;
      *(u32x4*)(Vw + key * ASTR + ch * 8) = vv;
      *(u32x4*)(Kw + (16 + key) * ASTR + ch * 8) = (u32x4){0u, 0u, 0u, 0u};
      *(u32x4*)(Vw + (16 + key) * ASTR + ch * 8) = (u32x4){0u, 0u, 0u, 0u};
    }
    asm volatile("s_waitcnt lgkmcnt(0)" ::: "memory");
    __builtin_amdgcn_wave_barrier();
    attn_step<MODE>(Kw, Vw, qf, st, L, qpos, MODE == 0 ? qpos : L + 15, cq, cum, tab, true);
  }
  __syncthreads();
  float* comb = (float*)smem;
  float lt = st.l;
  lt += __shfl_xor(lt, 16);
  lt += __shfl_xor(lt, 32);
#pragma unroll
  for (int dt = 0; dt < 4; dt++)
#pragma unroll
    for (int j = 0; j < 4; j++) comb[(w * 16 + r) * 68 + dt * 16 + quad * 4 + j] = st.o[dt][j];
  if (quad == 0) {
    comb[(w * 16 + r) * 68 + 64] = st.m;
    comb[(w * 16 + r) * 68 + 65] = lt;
  }
  __syncthreads();
  if (w == 0) {
    float mw[4], M = -1e30f;
#pragma unroll
    for (int i = 0; i < 4; i++) { mw[i] = comb[(i * 16 + r) * 68 + 64]; M = fmaxf(M, mw[i]); }
    float Ls = 0.f, scl[4];
#pragma unroll
    for (int i = 0; i < 4; i++) { scl[i] = __builtin_amdgcn_exp2f(mw[i] - M); Ls += scl[i] * comb[(i * 16 + r) * 68 + 65]; }
    const float inv = 1.f / Ls;
#pragma unroll
    for (int dt = 0; dt < 4; dt++) {
      float ov[4];
#pragma unroll
      for (int j = 0; j < 4; j++) {
        float a = 0.f;
#pragma unroll
        for (int i = 0; i < 4; i++) a += scl[i] * comb[(i * 16 + r) * 68 + dt * 16 + quad * 4 + j];
        ov[j] = a * inv;
      }
      *(u32x2*)(Y + (tokbase + r) * 512 + h * 64 + dt * 16 + quad * 4) = (u32x2){pack2(ov[0], ov[1]), pack2(ov[2], ov[3])};
    }
  }
}

DI void phase2(const Params& P, char* smem) {
  constexpr int N_SA = 128, N_PA = 8192, N_PB = 8192, N_SB = 128;
  for (int it = blockIdx.x; it < N_SA + N_PA + N_PB + N_SB; it += gridDim.x) {
    int u = it;
    if (u < N_SA) { attn_sample_item<0>(P, smem, u >> 3, u & 7); continue; }
    u -= N_SA;
    if (u < N_PA) { int qt = 31 - (u >> 8), bh = u & 255; attn_prompt_item<0>(P, smem, bh >> 3, bh & 7, qt); continue; }
    u -= N_PA;
    if (u < N_PB) { int qt = 31 - (u >> 8), bh = u & 255; attn_prompt_item<1>(P, smem, bh >> 3, bh & 7, qt); continue; }
    u -= N_PB;
    attn_sample_item<1>(P, smem, u >> 3, u & 7);
  }
}

DI void phase3_tile(const Params& P, int tile, char* smem) {
  const int tid = threadIdx.x, lane = tid & 63, w = tid >> 6, wm = w >> 1, wn = w & 1, r = lane & 15, quad = lane >> 4;
  const int mt = tile >> 3, nt = tile & 7;
  const int m0 = mt * 128, n0 = nt * 128;
  char* ws = P.ws;
  const u16* YA = (const u16*)(ws + W_XB);
  const u16* YB = YA + (size_t)TT * 512;
  const u16* GA = (const u16*)(ws + W_GA);
  const u16* GB = (const u16*)(ws + W_GB);
  u16* MRG = (u16*)(ws + W_QKV);
  f32x4 acc[4][4];
  zero_acc(acc);
  gemm_mainloop(YA + (size_t)m0 * 512, 512, (const u16*)(ws + W_WUPA) + (size_t)n0 * 512, 512, 512, (u16*)smem, acc);
  const size_t lofs = (size_t)(m0 + wm * 64 + quad * 4) * 1024 + n0 + wn * 64 + r;
  {
    const u16* gp = GA + lofs;
    u16* mp = MRG + lofs;
#pragma unroll
    for (int mi = 0; mi < 4; mi++) {
#pragma unroll
      for (int j = 0; j < 4; j++)
#pragma unroll
        for (int ni = 0; ni < 4; ni++)
          mp[(mi * 16 + j) * 1024 + ni * 16] = f2bf(acc[mi][ni][j] * bf2f(gp[(mi * 16 + j) * 1024 + ni * 16]));
      __builtin_amdgcn_sched_barrier(0);
    }
  }
  zero_acc(acc);
  gemm_mainloop(YB + (size_t)m0 * 512, 512, (const u16*)(ws + W_WUPB) + (size_t)n0 * 512, 512, 512, (u16*)smem, acc);
  {
    const u16* gp = GB + lofs;
    u16* mp = MRG + lofs;
#pragma unroll
    for (int mi = 0; mi < 4; mi++) {
#pragma unroll
      for (int j = 0; j < 4; j++)
#pragma unroll
        for (int ni = 0; ni < 4; ni++) {
          float m = bf2f(mp[(mi * 16 + j) * 1024 + ni * 16]) + acc[mi][ni][j] * bf2f(gp[(mi * 16 + j) * 1024 + ni * 16]);
          mp[(mi * 16 + j) * 1024 + ni * 16] = f2bf(m);
        }
      __builtin_amdgcn_sched_barrier(0);
    }
  }
}

DI void phase4_tile(const Params& P, int tile, char* smem) {
  const int tid = threadIdx.x, lane = tid & 63, w = tid >> 6, wm = w >> 1, wn = w & 1, r = lane & 15, quad = lane >> 4;
  const int mt = tile >> 3, nt = tile & 7;
  const int m0 = mt * 128, n0 = nt * 128;
  char* ws = P.ws;
  const u16* MRG = (const u16*)(ws + W_QKV);
  u16* H1B = (u16*)(ws + W_QKV + SZ_ACT);
  float* SSQ2 = (float*)(ws + W_SSQ2);
  f32x4 acc[4][4];
  zero_acc(acc);
  gemm_mainloop(MRG + (size_t)m0 * 1024, 1024, (const u16*)(ws + W_WOUT) + (size_t)n0 * 1024, 1024, 1024, (u16*)smem, acc);
  const float* xb = m0 < TP ? P.x_p : P.x_s - (size_t)TP * 1024;
#pragma unroll
  for (int mi = 0; mi < 4; mi++)
#pragma unroll
    for (int j = 0; j < 4; j++) {
      const size_t row = m0 + wm * 64 + mi * 16 + quad * 4 + j;
      float ss = 0.f;
#pragma unroll
      for (int ni = 0; ni < 4; ni++) {
        const int col = n0 + wn * 64 + ni * 16 + r;
        float h1 = xb[row * 1024 + col] + acc[mi][ni][j];
        P.out[row * 1024 + col] = h1;
        H1B[row * 1024 + col] = f2bf(h1);
        ss += h1 * h1;
      }
      ss += __shfl_xor(ss, 1);
      ss += __shfl_xor(ss, 2);
      ss += __shfl_xor(ss, 4);
      ss += __shfl_xor(ss, 8);
      if (r == 0) SSQ2[row * 16 + nt * 2 + wn] = ss;
    }
}

DI void phase5_tile(const Params& P, int tile, char* smem) {
  const int tid = threadIdx.x, lane = tid & 63, w = tid >> 6, wm = w >> 1, wn = w & 1, r = lane & 15, quad = lane >> 4;
  const int mt = tile >> 3, nt = tile & 7;
  const int m0 = mt * 128, n0 = nt * 128;
  char* ws = P.ws;
  const u16* H1B = (const u16*)(ws + W_QKV + SZ_ACT);
  u16* QP = (u16*)(ws + W_QKV + 2 * SZ_ACT);
  const float* SSQ2 = (const float*)(ws + W_SSQ2);
  float* rs_s = (float*)(smem + 2 * 128 * GSTR * 2);
  __syncthreads();
  if (tid < 128) {
    float s = 0.f;
#pragma unroll
    for (int i = 0; i < 16; i++) s += SSQ2[(size_t)(m0 + tid) * 16 + i];
    rs_s[tid] = rsqrtf(s * (1.f / 1024.f) + EPS);
  }
  f32x4 acc[4][4];
  zero_acc(acc);
  gemm_mainloop(H1B + (size_t)m0 * 1024, 1024, (const u16*)(ws + W_WQ) + (size_t)n0 * 1024, 1024, 1024, (u16*)smem, acc);
#pragma unroll
  for (int mi = 0; mi < 4; mi++)
#pragma unroll
    for (int j = 0; j < 4; j++) {
      const int lr = wm * 64 + mi * 16 + quad * 4 + j;
      const size_t row = m0 + lr;
      const float rs = rs_s[lr];
#pragma unroll
      for (int ni = 0; ni < 4; ni++) {
        const int col = n0 + wn * 64 + ni * 16 + r;
        QP[row * 1024 + col] = f2bf(acc[mi][ni][j] * rs);
      }
    }
}

DI void phase6a_unit(const Params& P, int unit, char* smem) {
  const int tid = threadIdx.x, lane = tid & 63, w = tid >> 6, r = lane & 15, quad = lane >> 4;
  char* ws = P.ws;
  const u16* QP = (const u16*)(ws + W_QKV + 2 * SZ_ACT);
  const u16* SK = (const u16*)(ws + W_SK);
  u32x2* SEL = (u32x2*)(ws + W_GA);
  float* sc = (float*)smem;
  u32* lists = (u32*)(smem + 128 * 129 * 4);
  unsigned char* tabi = (unsigned char*)(smem + 128 * 129 * 4 + 128 * 17 * 4);
  unsigned char* tabj = tabi + 64;
  const int tok0 = unit * 64;
  __syncthreads();
  if (tid == 0) {
    int s = 0;
    for (int i = 0; i < 16; i++)
      for (int j = 0; j < 16; j++)
        if ((i + 1) * (j + 1) <= 16) { tabi[s] = (unsigned char)i; tabj[s] = (unsigned char)j; s++; }
  }
  for (int h = 0; h < 8; h++) {
#pragma unroll
    for (int p = 0; p < 2; p++) {
      const int hp = h * 2 + p;
      bf16x8 qf[2];
#pragma unroll
      for (int ks = 0; ks < 2; ks++)
        qf[ks] = *(const bf16x8*)(QP + (size_t)(tok0 + w * 16 + r) * 1024 + hp * 64 + ks * 32 + quad * 8);
#pragma unroll
      for (int nt = 0; nt < 8; nt++) {
        f32x4 a4 = (f32x4){0.f, 0.f, 0.f, 0.f};
#pragma unroll
        for (int ks = 0; ks < 2; ks++) {
          bf16x8 kf = *(const bf16x8*)(SK + (size_t)(hp * 128 + nt * 16 + r) * 64 + ks * 32 + quad * 8);
          a4 = mfma16(kf, qf[ks], a4);
        }
        float* d = sc + (p * 64 + w * 16 + r) * 129 + nt * 16 + quad * 4;
        d[0] = a4[0]; d[1] = a4[1]; d[2] = a4[2]; d[3] = a4[3];
      }
    }
    __syncthreads();
    if (tid < 128) {
      u32 L[16];
#pragma unroll
      for (int s = 0; s < 16; s++) L[s] = 0u;
      const float* row = sc + tid * 129;
#pragma unroll 4
      for (int i = 0; i < 128; i++) {
        u32 k = (mono(row[i]) & ~127u) | (u32)i;
        insert16(L, k);
      }
#pragma unroll
      for (int s = 0; s < 16; s++) lists[tid * 17 + s] = L[s];
    }
    __syncthreads();
    if (tid < 64) {
      u32 a[16], bq[16];
      float fa[16], fb[16];
#pragma unroll
      for (int s = 0; s < 16; s++) {
        a[s] = lists[tid * 17 + s];
        bq[s] = lists[(64 + tid) * 17 + s];
        fa[s] = unmono(a[s] & ~127u);
        fb[s] = unmono(bq[s] & ~127u);
      }
      u32 L2[16];
#pragma unroll
      for (int s = 0; s < 16; s++) L2[s] = 0u;
      {
        int slot = 0;
#pragma unroll
        for (int i = 0; i < 16; i++)
#pragma unroll
          for (int j = 0; j < 16; j++)
            if ((i + 1) * (j + 1) <= 16) {
              float sum = fa[i] + fb[j];
              u32 key = (mono(sum) & ~63u) | (u32)slot;
              slot++;
              insert16(L2, key);
            }
      }
      float val[16];
      u32 idx[16];
      float mx = -1e30f;
#pragma unroll
      for (int s = 0; s < 16; s++) {
        u32 sl = L2[s] & 63u;
        int i = tabi[sl], j = tabj[sl];
        u32 au = lists[tid * 17 + i], bu = lists[(64 + tid) * 17 + j];
        val[s] = unmono(au & ~127u) + unmono(bu & ~127u);
        idx[s] = (au & 127u) * 128u + (bu & 127u);
        mx = fmaxf(mx, val[s]);
      }
      float sum = 0.f;
#pragma unroll
      for (int s = 0; s < 16; s++) { val[s] = __expf(val[s] - mx); sum += val[s]; }
      const float inv = 1.f / sum;
      u32x2* dst = SEL + ((size_t)(tok0 + tid) * 8 + h) * 16;
#pragma unroll
      for (int s = 0; s < 16; s++) dst[s] = (u32x2){idx[s], __float_as_uint(val[s] * inv)};
    }
  }
}

DI float dot2bf(u32 a, u32 b, float c) {
  return __builtin_amdgcn_fdot2_f32_bf16(__builtin_bit_cast(bf16x2_t, a), __builtin_bit_cast(bf16x2_t, b), c, false);
}
DI float dot8(u32x4 a, u32x4 b, float acc) {
  acc = dot2bf(a.x, b.x, acc);
  acc = dot2bf(a.y, b.y, acc);
  acc = dot2bf(a.z, b.z, acc);
  acc = dot2bf(a.w, b.w, acc);
  return acc;
}

DI void phase6b(const Params& P) {
  const int lane = threadIdx.x & 63;
  const int gw = blockIdx.x * 4 + (threadIdx.x >> 6), nw = gridDim.x * 4;
  char* ws = P.ws;
  u16* H1B = (u16*)(ws + W_QKV + SZ_ACT);
  const u16* UB = (const u16*)(ws + W_UB);
  const u16* VB = (const u16*)(ws + W_VB);
  const u32x2* SEL = (const u32x2*)(ws + W_GA);
  const float* SSQ2 = (const float*)(ws + W_SSQ2);
  float* RS3 = (float*)(ws + W_RS3);
  for (int t = gw; t < TT; t += nw) {
    float ssq = lane < 16 ? SSQ2[(size_t)t * 16 + lane] : 0.f;
    ssq = wave_sum(ssq);
    const float rs2 = rsqrtf(ssq * (1.f / 1024.f) + EPS);
    const u32x4 xa = *(const u32x4*)(H1B + (size_t)t * 1024 + lane * 16);
    const u32x4 xb = *(const u32x4*)(H1B + (size_t)t * 1024 + lane * 16 + 8);
    const u32x2 e0 = SEL[(size_t)t * 128 + lane];
    const u32x2 e1 = SEL[(size_t)t * 128 + 64 + lane];
    float wv[2];
#pragma unroll
    for (int rd = 0; rd < 2; rd++) {
      const int idxv = (int)(rd ? e1[0] : e0[0]);
      float p[64];
#pragma unroll
      for (int c = 0; c < 8; c++) {
        u32x4 ua[8], ub[8];
#pragma unroll
        for (int i = 0; i < 8; i++) {
          int e = __builtin_amdgcn_readlane(idxv, c * 8 + i);
          const u16* up = UB + (size_t)e * 1024 + lane * 16;
          ua[i] = *(const u32x4*)up;
          ub[i] = *(const u32x4*)(up + 8);
        }
#pragma unroll
        for (int i = 0; i < 8; i++) p[c * 8 + i] = dot8(ub[i], xb, dot8(ua[i], xa, 0.f));
      }
#pragma unroll
      for (int i = 0; i < 32; i++) { float keep = (lane & 32) ? p[i + 32] : p[i]; float send = (lane & 32) ? p[i] : p[i + 32]; p[i] = keep + __shfl_xor(send, 32); }
#pragma unroll
      for (int i = 0; i < 16; i++) { float keep = (lane & 16) ? p[i + 16] : p[i]; float send = (lane & 16) ? p[i] : p[i + 16]; p[i] = keep + __shfl_xor(send, 16); }
#pragma unroll
      for (int i = 0; i < 8; i++) { float keep = (lane & 8) ? p[i + 8] : p[i]; float send = (lane & 8) ? p[i] : p[i + 8]; p[i] = keep + __shfl_xor(send, 8); }
#pragma unroll
      for (int i = 0; i < 4; i++) { float keep = (lane & 4) ? p[i + 4] : p[i]; float send = (lane & 4) ? p[i] : p[i + 4]; p[i] = keep + __shfl_xor(send, 4); }
#pragma unroll
      for (int i = 0; i < 2; i++) { float keep = (lane & 2) ? p[i + 2] : p[i]; float send = (lane & 2) ? p[i] : p[i + 2]; p[i] = keep + __shfl_xor(send, 2); }
      { float keep = (lane & 1) ? p[1] : p[0]; float send = (lane & 1) ? p[0] : p[1]; p[0] = keep + __shfl_xor(send, 1); }
      const float g = __uint_as_float(rd ? e1[1] : e0[1]);
      wv[rd] = g * gelu_tanh(rs2 * p[0]);
    }
    float oacc[16];
#pragma unroll
    for (int i = 0; i < 16; i++) oacc[i] = 0.f;
#pragma unroll
    for (int rd = 0; rd < 2; rd++) {
      const int idxv = (int)(rd ? e1[0] : e0[0]);
      const int wbits = (int)__float_as_uint(wv[rd]);
#pragma unroll
      for (int c = 0; c < 8; c++) {
        u32x4 va[8], vb[8];
#pragma unroll
        for (int i = 0; i < 8; i++) {
          int e = __builtin_amdgcn_readlane(idxv, c * 8 + i);
          const u16* vp = VB + (size_t)e * 1024 + lane * 16;
          va[i] = *(const u32x4*)vp;
          vb[i] = *(const u32x4*)(vp + 8);
        }
#pragma unroll
        for (int i = 0; i < 8; i++) {
          const float wgt = __uint_as_float((u32)__builtin_amdgcn_readlane(wbits, c * 8 + i));
#pragma unroll
          for (int q = 0; q < 4; q++) {
            oacc[2 * q] += wgt * __uint_as_float(va[i][q] << 16);
            oacc[2 * q + 1] += wgt * __uint_as_float(va[i][q] & 0xffff0000u);
            oacc[8 + 2 * q] += wgt * __uint_as_float(vb[i][q] << 16);
            oacc[8 + 2 * q + 1] += wgt * __uint_as_float(vb[i][q] & 0xffff0000u);
          }
        }
      }
    }
    float* hrow = P.out + (size_t)t * 1024 + lane * 16;
    float ss = 0.f;
    float h2[16];
#pragma unroll
    for (int i = 0; i < 4; i++) {
      f32x4 hv = *(const f32x4*)(hrow + i * 4);
#pragma unroll
      for (int c = 0; c < 4; c++) { h2[i * 4 + c] = hv[c] + oacc[i * 4 + c]; ss += h2[i * 4 + c] * h2[i * 4 + c]; }
      *(f32x4*)(hrow + i * 4) = (f32x4){h2[i * 4], h2[i * 4 + 1], h2[i * 4 + 2], h2[i * 4 + 3]};
    }
    *(u32x4*)(H1B + (size_t)t * 1024 + lane * 16) = (u32x4){pack2(h2[0], h2[1]), pack2(h2[2], h2[3]), pack2(h2[4], h2[5]), pack2(h2[6], h2[7])};
    *(u32x4*)(H1B + (size_t)t * 1024 + lane * 16 + 8) = (u32x4){pack2(h2[8], h2[9]), pack2(h2[10], h2[11]), pack2(h2[12], h2[13]), pack2(h2[14], h2[15])};
    ss = wave_sum(ss);
    if (lane == 0) RS3[t] = rsqrtf(ss * (1.f / 1024.f) + EPS);
  }
}

DI void phase7_tile(const Params& P, int tile, char* smem) {
  const int tid = threadIdx.x, lane = tid & 63, w = tid >> 6, wm = w >> 1, wn = w & 1, r = lane & 15, quad = lane >> 4;
  const int mt = tile >> 3, nt = tile & 7;
  const int m0 = mt * 128, n0 = nt * 128;
  char* ws = P.ws;
  const u16* H2B = (const u16*)(ws + W_QKV + SZ_ACT);
  const u16* PB = (const u16*)(ws + W_PB);
  const float* RS3 = (const float*)(ws + W_RS3);
  f32x4 acc[4][4], acc2[4][4];
  zero_acc(acc);
  gemm_mainloop(H2B + (size_t)m0 * 1024, 1024, (const u16*)(ws + W_WG) + (size_t)n0 * 1024, 1024, 1024, (u16*)smem, acc);
  zero_acc(acc2);
  gemm_mainloop(PB + (size_t)m0 * 256, 256, (const u16*)(ws + W_WPP) + (size_t)n0 * 256, 256, 256, (u16*)smem, acc2);
  float* op = P.out + (size_t)(m0 + wm * 64 + quad * 4) * 1024 + n0 + wn * 64 + r;
  const float* rp = RS3 + m0 + wm * 64 + quad * 4;
#pragma unroll
  for (int mi = 0; mi < 4; mi++) {
#pragma unroll
    for (int j = 0; j < 4; j++) {
      const float rs = rp[mi * 16 + j];
#pragma unroll
      for (int ni = 0; ni < 4; ni++) {
        float h2 = op[(mi * 16 + j) * 1024 + ni * 16];
        op[(mi * 16 + j) * 1024 + ni * 16] = h2 + sigmoidf_(rs * acc[mi][ni][j]) * acc2[mi][ni][j];
      }
    }
    __builtin_amdgcn_sched_barrier(0);
  }
}

__global__ void __launch_bounds__(256) fwd_megakernel(Params P) {
  __shared__ __attribute__((aligned(16))) char smem[SMEM_BYTES];
  cg::grid_group grid = cg::this_grid();
  phase0(P, smem);
  grid.sync();
  phase1_scans(P);
  for (int t = blockIdx.x; t < 514 * 40; t += gridDim.x) phase1_tile(P, t, smem);
  grid.sync();
  phase2(P, smem);
  grid.sync();
  for (int t = blockIdx.x; t < 514 * 8; t += gridDim.x) phase3_tile(P, t, smem);
  grid.sync();
  for (int t = blockIdx.x; t < 514 * 8; t += gridDim.x) phase4_tile(P, t, smem);
  grid.sync();
  for (int t = blockIdx.x; t < 514 * 8; t += gridDim.x) phase5_tile(P, t, smem);
  grid.sync();
  for (int t = blockIdx.x; t < TT / 64; t += gridDim.x) phase6a_unit(P, t, smem);
  grid.sync();
  phase6b(P);
  grid.sync();
  for (int t = blockIdx.x; t < 514 * 8; t += gridDim.x) phase7_tile(P, t, smem);
}

extern "C" void kernel_launch(void* const* d_in, const int* in_sizes, int n_in, void* d_out, int out_size, void* d_ws,
                              size_t ws_size, hipStream_t stream) {
  static int grid_blocks = 0;
  if (!grid_blocks) {
    int dev = 0, cus = 0, per_cu = 0;
    hipGetDevice(&dev);
    hipDeviceGetAttribute(&cus, hipDeviceAttributeMultiprocessorCount, dev);
    hipOccupancyMaxActiveBlocksPerMultiprocessor(&per_cu, fwd_megakernel, 256, 0);
    if (per_cu > 2) per_cu = 2;
    if (per_cu < 1) per_cu = 1;
    grid_blocks = cus * per_cu;
  }
  if (ws_size < W_END) { fprintf(stderr, "workspace too small: %zu < %zu\n", ws_size, (size_t)W_END); return; }
  Params p{};
  const float** pf = (const float**)&p;
  for (int i = 0; i < 28; i++) pf[i] = (const float*)d_in[i];
  p.out = (float*)d_out;
  p.ws = (char*)d_ws;
  void* args[] = {&p};
  hipError_t e = hipLaunchCooperativeKernel((void*)fwd_megakernel, dim3(grid_blocks), dim3(256), args, 0, stream);
  if (e != hipSuccess) fprintf(stderr, "cooperative launch failed: %s (grid %d)\n", hipGetErrorString(e), grid_blocks);
}
```

```cpp
#include <hip/hip_runtime.h>
#include <hip/hip_cooperative_groups.h>
#include <cstdio>
namespace cg = cooperative_groups;

typedef unsigned short u16;
typedef unsigned int u32;
typedef short bf16x8 __attribute__((ext_vector_type(8)));
typedef short s16x4 __attribute__((ext_vector_type(4)));
typedef float f32x4 __attribute__((ext_vector_type(4)));
typedef unsigned int u32x4 __attribute__((ext_vector_type(4)));
typedef unsigned int u32x2 __attribute__((ext_vector_type(2)));
typedef __bf16 bf16x2_t __attribute__((ext_vector_type(2)));

#define DI __device__ __forceinline__
#define LAUNDER(x) asm volatile("" : "+v"(x))

constexpr int TP = 65536, TS = 256, TT = TP + TS;
constexpr float LOG2E = 1.4426950408889634f;
constexpr float EPS = 1e-6f;

constexpr size_t O_AK_P = 67371008, O_AV_P = 100925440, O_AF_P = 134479872, O_BK_P = 135004160,
                 O_BV_P = 143392768, O_AK_S = 151781376, O_AV_S = 151912448, O_AF_S = 152043520,
                 O_BK_S = 152045568, O_BV_S = 152176640;

constexpr size_t SZ_ACT = (size_t)TT * 1024 * 2;
constexpr size_t SZ_HALF = (size_t)TT * 512 * 2;
constexpr size_t W_XB = 0;
constexpr size_t W_QKV = SZ_ACT;
constexpr size_t W_GA = W_QKV + 6 * SZ_HALF;
constexpr size_t W_GB = W_GA + SZ_ACT;
constexpr size_t W_PB = W_GB + SZ_ACT;
constexpr size_t W_WIN = W_PB + (size_t)TT * 256 * 2;
constexpr size_t W_WUPA = W_WIN + (size_t)5120 * 1024 * 2;
constexpr size_t W_WUPB = W_WUPA + 1024 * 512 * 2;
constexpr size_t W_WOUT = W_WUPB + 1024 * 512 * 2;
constexpr size_t W_WQ = W_WOUT + 1024 * 1024 * 2;
constexpr size_t W_WG = W_WQ + 1024 * 1024 * 2;
constexpr size_t W_WPP = W_WG + 1024 * 1024 * 2;
constexpr size_t W_UB = W_WPP + 1024 * 256 * 2;
constexpr size_t W_VB = W_UB + (size_t)16384 * 1024 * 2;
constexpr size_t W_SK = W_VB + (size_t)16384 * 1024 * 2;
constexpr size_t W_RS1 = W_SK + 131072 * 2;
constexpr size_t W_SSQ2 = W_RS1 + (size_t)TT * 4;
constexpr size_t W_RS3 = W_SSQ2 + (size_t)TT * 64;
constexpr size_t W_CUMP = W_RS3 + (size_t)TT * 4;
constexpr size_t W_CUMS = W_CUMP + (size_t)256 * 2048 * 4;
constexpr size_t W_END = W_CUMS + (size_t)128 * 4112 * 4 + 1024;

struct Params {
  const float *x_p, *x_s, *cak, *cav, *caf, *cbk, *cbv, *p_p, *p_s, *g_mix, *w_in, *b_f, *qn_a, *kn_a,
      *qn_b, *kn_b, *relb, *w_up_a, *w_up_b, *w_out, *g_ffn, *peer_wq, *peer_sk, *peer_u, *peer_v, *g_ple,
      *w_gate, *w_proj;
  float* out;
  char* ws;
};

constexpr int SMEM_BYTES = 128 * 129 * 4 + 2 * 64 * 17 * 4 + 256;

DI u16 f2bf(float x) { u32 u = __float_as_uint(x); u += 0x7fffu + ((u >> 16) & 1u); return (u16)(u >> 16); }
DI float bf2f(u16 h) { return __uint_as_float(((u32)h) << 16); }
DI u32 pack2(float a, float b) { return (u32)f2bf(a) | ((u32)f2bf(b) << 16); }
DI float wave_sum(float v) {
#pragma unroll
  for (int o = 32; o; o >>= 1) v += __shfl_xor(v, o);
  return v;
}
DI f32x4 mfma16(bf16x8 a, bf16x8 b, f32x4 c) { return __builtin_amdgcn_mfma_f32_16x16x32_bf16(a, b, c, 0, 0, 0); }
DI float sigmoidf_(float x) { return 1.f / (1.f + __expf(-x)); }
DI u32 mono(float x) { u32 u = __float_as_uint(x); u32 m = (u32)((int)u >> 31) | 0x80000000u; return u ^ m; }
DI float unmono(u32 k) { u32 m = ((k >> 31) - 1u) | 0x80000000u; return __uint_as_float(k ^ m); }
DI void insert16(u32 (&L)[16], u32 x) {
#pragma unroll
  for (int s = 0; s < 16; s++) { u32 mx = max(L[s], x); x = min(L[s], x); L[s] = mx; }
}
DI float gelu_tanh(float x) {
  float u = 0.7978845608028654f * (x + 0.044715f * x * x * x);
  float t = 1.f - 2.f / (1.f + __expf(2.f * u));
  return 0.5f * x * (1.f + t);
}

constexpr int GSTR = 72;
DI void gemm_mainloop(const u16* __restrict__ A, int lda, const u16* __restrict__ B, int ldb, int K, u16* smem,
                      f32x4 (&acc)[4][4]) {
  const int tid = threadIdx.x, lane = tid & 63, w = tid >> 6, wm = w >> 1, wn = w & 1, r = lane & 15, quad = lane >> 4;
  u16* As = smem;
  u16* Bs = smem + 128 * GSTR;
  u32x4 ra[4], rb[4];
  const int lrow = tid >> 3, lch = tid & 7;
  const u16* ap = A + (size_t)lrow * lda + lch * 8;
  const u16* bp = B + (size_t)lrow * ldb + lch * 8;
#pragma unroll
  for (int i = 0; i < 4; i++) {
    ra[i] = *(const u32x4*)(ap + (size_t)i * 32 * lda);
    rb[i] = *(const u32x4*)(bp + (size_t)i * 32 * ldb);
  }
  const int nk = K >> 6;
#pragma unroll 1
  for (int kt = 0; kt < nk; kt++) {
    __syncthreads();
#pragma unroll
    for (int i = 0; i < 4; i++) {
      *(u32x4*)(As + (lrow + i * 32) * GSTR + lch * 8) = ra[i];
      *(u32x4*)(Bs + (lrow + i * 32) * GSTR + lch * 8) = rb[i];
    }
    __syncthreads();
    if (kt + 1 < nk) {
#pragma unroll
      for (int i = 0; i < 4; i++) {
        ra[i] = *(const u32x4*)(ap + (size_t)i * 32 * lda + (kt + 1) * 64);
        rb[i] = *(const u32x4*)(bp + (size_t)i * 32 * ldb + (kt + 1) * 64);
      }
    }
#pragma unroll
    for (int ks = 0; ks < 2; ks++) {
      bf16x8 af[4], bfr[4];
#pragma unroll
      for (int mi = 0; mi < 4; mi++) af[mi] = *(const bf16x8*)(As + (wm * 64 + mi * 16 + r) * GSTR + ks * 32 + quad * 8);
#pragma unroll
      for (int ni = 0; ni < 4; ni++) bfr[ni] = *(const bf16x8*)(Bs + (wn * 64 + ni * 16 + r) * GSTR + ks * 32 + quad * 8);
#pragma unroll
      for (int mi = 0; mi < 4; mi++)
#pragma unroll
        for (int ni = 0; ni < 4; ni++) acc[mi][ni] = mfma16(af[mi], bfr[ni], acc[mi][ni]);
    }
  }
}

DI void zero_acc(f32x4 (&acc)[4][4]) {
#pragma unroll
  for (int i = 0; i < 4; i++)
#pragma unroll
    for (int j = 0; j < 4; j++) acc[i][j] = (f32x4){0.f, 0.f, 0.f, 0.f};
}

DI void transpose_tile(const float* __restrict__ W, int ldw, int K, const float* __restrict__ g, u16* __restrict__ dst,
                       int k0, int n0, int nsrc0, float* tile) {
  const int tid = threadIdx.x;
  __syncthreads();
  {
    const int ty = tid >> 4, tx = tid & 15;
#pragma unroll
    for (int i = 0; i < 4; i++) {
      int k = ty + i * 16;
      f32x4 v = *(const f32x4*)(W + (size_t)(k0 + k) * ldw + nsrc0 + tx * 4);
      float s = g ? g[k0 + k] : 1.f;
      tile[k * 65 + tx * 4 + 0] = v[0] * s;
      tile[k * 65 + tx * 4 + 1] = v[1] * s;
      tile[k * 65 + tx * 4 + 2] = v[2] * s;
      tile[k * 65 + tx * 4 + 3] = v[3] * s;
    }
  }
  __syncthreads();
  {
    const int n = tid >> 2, kc = (tid & 3) * 16;
    u32 pk[8];
#pragma unroll
    for (int i = 0; i < 8; i++) pk[i] = pack2(tile[(kc + 2 * i) * 65 + n], tile[(kc + 2 * i + 1) * 65 + n]);
    u16* d = dst + (size_t)(n0 + n) * K + k0 + kc;
    *(u32x4*)d = (u32x4){pk[0], pk[1], pk[2], pk[3]};
    *(u32x4*)(d + 8) = (u32x4){pk[4], pk[5], pk[6], pk[7]};
  }
}

DI void conv_unit(const float* __restrict__ src, u16* __restrict__ dst, size_t base, const float* __restrict__ colscale) {
  const int tid = threadIdx.x;
#pragma unroll
  for (int i = 0; i < 4; i++) {
    size_t e = base + (size_t)i * 1024 + tid * 4;
    f32x4 v = *(const f32x4*)(src + e);
    if (colscale) {
      f32x4 gg = *(const f32x4*)(colscale + (e & 1023));
      v = v * gg;
    }
    *(u32x2*)(dst + e) = (u32x2){pack2(v[0], v[1]), pack2(v[2], v[3])};
  }
}

DI void phase0(const Params& P, char* smem) {
  const int tid = threadIdx.x, lane = tid & 63, w = tid >> 6;
  char* ws = P.ws;
  {
    float* tile = (float*)smem;
    constexpr int T_WIN = 16 * 80, T_UP = 8 * 16, T_SQ = 256, T_PP = 4 * 16;
    constexpr int NT = T_WIN + 2 * T_UP + 3 * T_SQ + T_PP;
    for (int t = blockIdx.x; t < NT; t += gridDim.x) {
      int u = t;
      if (u < T_WIN) {
        int kt = u / 80, nt = u % 80;
        int n0 = nt * 64;
        int ns = n0 < 1536 ? n0 : n0 + 8;
        transpose_tile(P.w_in, 5128, 1024, P.g_mix, (u16*)(ws + W_WIN), kt * 64, n0, ns, tile);
        continue;
      }
      u -= T_WIN;
      if (u < T_UP) { transpose_tile(P.w_up_a, 1024, 512, nullptr, (u16*)(ws + W_WUPA), (u / 16) * 64, (u % 16) * 64, (u % 16) * 64, tile); continue; }
      u -= T_UP;
      if (u < T_UP) { transpose_tile(P.w_up_b, 1024, 512, nullptr, (u16*)(ws + W_WUPB), (u / 16) * 64, (u % 16) * 64, (u % 16) * 64, tile); continue; }
      u -= T_UP;
      if (u < T_SQ) { transpose_tile(P.w_out, 1024, 1024, nullptr, (u16*)(ws + W_WOUT), (u / 16) * 64, (u % 16) * 64, (u % 16) * 64, tile); continue; }
      u -= T_SQ;
      if (u < T_SQ) { transpose_tile(P.peer_wq, 1024, 1024, P.g_ffn, (u16*)(ws + W_WQ), (u / 16) * 64, (u % 16) * 64, (u % 16) * 64, tile); continue; }
      u -= T_SQ;
      if (u < T_SQ) { transpose_tile(P.w_gate, 1024, 1024, P.g_ple, (u16*)(ws + W_WG), (u / 16) * 64, (u % 16) * 64, (u % 16) * 64, tile); continue; }
      u -= T_SQ;
      transpose_tile(P.w_proj, 1024, 256, nullptr, (u16*)(ws + W_WPP), (u / 16) * 64, (u % 16) * 64, (u % 16) * 64, tile);
    }
  }
  {
    constexpr int U_UB = 4096, U_VB = 4096, U_SK = 32, U_PP = 4096, U_PS = 16;
    constexpr int NU = U_UB + U_VB + U_SK + U_PP + U_PS;
    for (int t = blockIdx.x; t < NU; t += gridDim.x) {
      int u = t;
      if (u < U_UB) { conv_unit(P.peer_u, (u16*)(ws + W_UB), (size_t)u * 4096, P.g_ffn); continue; }
      u -= U_UB;
      if (u < U_VB) { conv_unit(P.peer_v, (u16*)(ws + W_VB), (size_t)u * 4096, nullptr); continue; }
      u -= U_VB;
      if (u < U_SK) { conv_unit(P.peer_sk, (u16*)(ws + W_SK), (size_t)u * 4096, nullptr); continue; }
      u -= U_SK;
      if (u < U_PP) { conv_unit(P.p_p, (u16*)(ws + W_PB), (size_t)u * 4096, nullptr); continue; }
      u -= U_PP;
      conv_unit(P.p_s, (u16*)(ws + W_PB) + (size_t)TP * 256, (size_t)u * 4096, nullptr);
    }
  }
  {
    float* wfl = (float*)smem;
    __syncthreads();
    for (int i = tid; i < 8192; i += 256) {
      int k = i >> 3, h = i & 7;
      wfl[h * 1024 + k] = P.g_mix[k] * P.w_in[(size_t)k * 5128 + 1536 + h];
    }
    __syncthreads();
    u16* XB = (u16*)(ws + W_XB);
    float* RS1 = (float*)(ws + W_RS1);
    for (int t = blockIdx.x * 4 + w; t < TT; t += gridDim.x * 4) {
      const float* xr = t < TP ? P.x_p + (size_t)t * 1024 : P.x_s + (size_t)(t - TP) * 1024;
      f32x4 v[4];
#pragma unroll
      for (int i = 0; i < 4; i++) v[i] = *(const f32x4*)(xr + i * 256 + lane * 4);
      float ss = 0.f;
#pragma unroll
      for (int i = 0; i < 4; i++) ss += v[i][0] * v[i][0] + v[i][1] * v[i][1] + v[i][2] * v[i][2] + v[i][3] * v[i][3];
      float dots[8];
#pragma unroll
      for (int h = 0; h < 8; h++) {
        float d = 0.f;
#pragma unroll
        for (int i = 0; i < 4; i++) {
          f32x4 wv = *(const f32x4*)(wfl + h * 1024 + i * 256 + lane * 4);
          d += v[i][0] * wv[0] + v[i][1] * wv[1] + v[i][2] * wv[2] + v[i][3] * wv[3];
        }
        dots[h] = d;
      }
      ss = wave_sum(ss);
#pragma unroll
      for (int h = 0; h < 8; h++) dots[h] = wave_sum(dots[h]);
      float rs = rsqrtf(ss * (1.f / 1024.f) + EPS);
#pragma unroll
      for (int i = 0; i < 4; i++)
        *(u32x2*)(XB + (size_t)t * 1024 + i * 256 + lane * 4) = (u32x2){pack2(v[i][0], v[i][1]), pack2(v[i][2], v[i][3])};
      if (lane == 0) RS1[t] = rs;
      float myd = dots[0];
#pragma unroll
      for (int h = 1; h < 8; h++) myd = (lane == h) ? dots[h] : myd;
      if (lane < 8) {
        float z = rs * myd + P.b_f[lane];
        float lf = fminf(z, 0.f) - log1pf(expf(-fabsf(z)));
        float* o = t < TP ? P.out + O_AF_P + (size_t)t * 8 : P.out + O_AF_S + (size_t)(t - TP) * 8;
        o[lane] = lf;
      }
    }
  }
}

DI void phase1_scans(const Params& P) {
  const int lane = threadIdx.x & 63;
  const int gw = blockIdx.x * 4 + (threadIdx.x >> 6), nw = gridDim.x * 4;
  float* CUMP = (float*)(P.ws + W_CUMP);
  float* CUMS = (float*)(P.ws + W_CUMS);
  for (int row = gw; row < 384; row += nw) {
    float carry = 0.f;
    if (row < 256) {
      int b = row >> 3, h = row & 7;
      const float* src = P.out + O_AF_P + (size_t)b * 2048 * 8 + h;
      for (int p0 = 0; p0 < 2048; p0 += 64) {
        float v = src[(size_t)(p0 + lane) * 8];
#pragma unroll
        for (int o = 1; o < 64; o <<= 1) { float n = __shfl_up(v, o); if (lane >= o) v += n; }
        v += carry;
        CUMP[(size_t)row * 2048 + p0 + lane] = v * LOG2E;
        carry = __shfl(v, 63);
      }
    } else {
      int rr = row - 256;
      int b = rr >> 3, h = rr & 7;
      const float* src = P.caf + (size_t)b * 4096 * 8 + h;
      for (int p0 = 0; p0 < 4096; p0 += 64) {
        float v = src[(size_t)(p0 + lane) * 8];
#pragma unroll
        for (int o = 1; o < 64; o <<= 1) { float n = __shfl_up(v, o); if (lane >= o) v += n; }
        v += carry;
        CUMS[(size_t)rr * 4112 + p0 + lane] = v * LOG2E;
        carry = __shfl(v, 63);
      }
      {
        float v = lane < 16 ? P.out[O_AF_S + (size_t)(b * 16 + lane) * 8 + h] : 0.f;
#pragma unroll
        for (int o = 1; o < 64; o <<= 1) { float n = __shfl_up(v, o); if (lane >= o) v += n; }
        v += carry;
        if (lane < 16) CUMS[(size_t)rr * 4112 + 4096 + lane] = v * LOG2E;
      }
    }
  }
}

DI void phase1_tile(const Params& P, int tile, char* smem) {
  const int tid = threadIdx.x, lane = tid & 63, w = tid >> 6, wm = w >> 1, wn = w & 1, r = lane & 15, quad = lane >> 4;
  const int mt = tile / 40, nt = tile % 40;
  const int m0 = mt * 128, n0 = nt * 128;
  char* ws = P.ws;
  f32x4 acc[4][4];
  zero_acc(acc);
  gemm_mainloop((const u16*)(ws + W_XB) + (size_t)m0 * 1024, 1024, (const u16*)(ws + W_WIN) + (size_t)n0 * 1024, 1024, 1024,
                (u16*)smem, acc);
  const int ncol0 = n0 + wn * 64;
  const bool sample = m0 >= TP;
  size_t rbase = (size_t)(m0 + wm * 64 + quad * 4);
  LAUNDER(rbase);
  const float* rsp = (const float*)(ws + W_RS1) + rbase;
  if (ncol0 < 3072) {
    const int seg = ncol0 >> 9, hc = ncol0 & 511;
    const bool normed = (seg != 2 && seg != 5);
    const float* gain = seg == 0 ? P.qn_a : seg == 1 ? P.kn_a : seg == 3 ? P.qn_b : P.kn_b;
    const float qs = (seg == 0 || seg == 3) ? 0.125f * LOG2E : 1.f;
    float gn[4];
#pragma unroll
    for (int ni = 0; ni < 4; ni++) gn[ni] = normed ? gain[ni * 16 + r] * qs : 1.f;
    u16* dp = (u16*)(ws + W_QKV + (size_t)seg * SZ_HALF) + rbase * 512 + hc + r;
    float* op = nullptr;
    if (seg == 1 || seg == 2) {
      op = sample ? P.out + (seg == 1 ? O_AK_S : O_AV_S) + (rbase - TP) * 512 : P.out + (seg == 1 ? O_AK_P : O_AV_P) + rbase * 512;
    } else if (seg == 4 || seg == 5) {
      if (sample) op = P.out + (seg == 4 ? O_BK_S : O_BV_S) + (rbase - TP) * 512;
      else if ((m0 & 2047) >= 1536) op = P.out + (seg == 4 ? O_BK_P : O_BV_P) + ((size_t)(m0 >> 11) * 512 + ((rbase & 2047) - 1536)) * 512;
    }
    if (op) op += hc + r;
#pragma unroll
    for (int mi = 0; mi < 4; mi++) {
#pragma unroll
      for (int j = 0; j < 4; j++) {
        const float rs = rsp[mi * 16 + j];
        float v[4];
#pragma unroll
        for (int ni = 0; ni < 4; ni++) v[ni] = acc[mi][ni][j] * rs;
        if (normed) {
          float ss = v[0] * v[0] + v[1] * v[1] + v[2] * v[2] + v[3] * v[3];
          ss += __shfl_xor(ss, 1);
          ss += __shfl_xor(ss, 2);
          ss += __shfl_xor(ss, 4);
          ss += __shfl_xor(ss, 8);
          float inv = rsqrtf(ss * (1.f / 64.f) + EPS);
#pragma unroll
          for (int ni = 0; ni < 4; ni++) v[ni] *= inv * gn[ni];
        }
#pragma unroll
        for (int ni = 0; ni < 4; ni++) dp[(mi * 16 + j) * 512 + ni * 16] = f2bf(v[ni]);
        if (op) {
#pragma unroll
          for (int ni = 0; ni < 4; ni++) op[(mi * 16 + j) * 512 + ni * 16] = v[ni];
        }
      }
    }
  } else {
    u16* dp = (ncol0 < 4096 ? (u16*)(ws + W_GA) + (ncol0 - 3072) : (u16*)(ws + W_GB) + (ncol0 - 4096)) + rbase * 1024 + r;
#pragma unroll
    for (int mi = 0; mi < 4; mi++) {
#pragma unroll
      for (int j = 0; j < 4; j++) {
        const float rs = rsp[mi * 16 + j];
#pragma unroll
        for (int ni = 0; ni < 4; ni++) dp[(mi * 16 + j) * 1024 + ni * 16] = f2bf(sigmoidf_(acc[mi][ni][j] * rs));
      }
    }
  }
}

constexpr int ASTR = 72;
constexpr int TAB_OFF = 36864;
struct AttnState { f32x4 o[4]; float m, l; };

DI s16x4 tr_read(const u16* p) {
  return __builtin_amdgcn_ds_read_tr16_b64_v4i16((__attribute__((address_space(3))) s16x4*)(p));
}

template <int MODE>
DI void attn_step(const u16* Ks, const u16* Vs, const bf16x8 (&qf)[2], AttnState& st, int kpos0, int qpos, int qlim,
                  float cq, const float* cum, const float* tab, bool domask) {
  const int lane = threadIdx.x & 63, r = lane & 15, quad = lane >> 4;
  f32x4 s[2];
#pragma unroll
  for (int t = 0; t < 2; t++) {
    f32x4 a4 = (f32x4){0.f, 0.f, 0.f, 0.f};
#pragma unroll
    for (int ks = 0; ks < 2; ks++) {
      bf16x8 kf = *(const bf16x8*)(Ks + (t * 16 + r) * ASTR + ks * 32 + quad * 8);
      a4 = mfma16(kf, qf[ks], a4);
    }
    s[t] = a4;
  }
#pragma unroll
  for (int t = 0; t < 2; t++) {
    const int kb = kpos0 + t * 16 + quad * 4;
    if (MODE == 0) {
      f32x4 c4 = *(const f32x4*)(cum + kb);
#pragma unroll
      for (int j = 0; j < 4; j++) s[t][j] += cq - c4[j];
    } else {
#pragma unroll
      for (int j = 0; j < 4; j++) {
        int rel = kb + j - qpos;
        rel = min(max(rel, -128), 128) + 128;
        s[t][j] += tab[rel];
      }
    }
    if (domask) {
#pragma unroll
      for (int j = 0; j < 4; j++)
        if (kb + j > qlim) s[t][j] = -1e30f;
    }
  }
  float mx = fmaxf(fmaxf(fmaxf(s[0][0], s[0][1]), fmaxf(s[0][2], s[0][3])), fmaxf(fmaxf(s[1][0], s[1][1]), fmaxf(s[1][2], s[1][3])));
  mx = fmaxf(mx, __shfl_xor(mx, 16));
  mx = fmaxf(mx, __shfl_xor(mx, 32));
  const float mn = fmaxf(st.m, mx);
  const float alpha = __builtin_amdgcn_exp2f(st.m - mn);
  float p[8];
  float ls = 0.f;
#pragma unroll
  for (int t = 0; t < 2; t++)
#pragma unroll
    for (int j = 0; j < 4; j++) { p[t * 4 + j] = __builtin_amdgcn_exp2f(s[t][j] - mn); ls += p[t * 4 + j]; }
  st.l = st.l * alpha + ls;
  st.m = mn;
#pragma unroll
  for (int dt = 0; dt < 4; dt++) st.o[dt] = st.o[dt] * alpha;
  u32x4 pk = (u32x4){pack2(p[0], p[1]), pack2(p[2], p[3]), pack2(p[4], p[5]), pack2(p[6], p[7])};
  bf16x8 pf = __builtin_bit_cast(bf16x8, pk);
  const int qq = (lane & 15) >> 2, pp = lane & 3;
#pragma unroll
  for (int dt = 0; dt < 4; dt++) {
    s16x4 lo = tr_read(Vs + (quad * 4 + qq) * ASTR + dt * 16 + pp * 4);
    s16x4 hi = tr_read(Vs + (16 + quad * 4 + qq) * ASTR + dt * 16 + pp * 4);
    bf16x8 vf = __builtin_shufflevector(lo, hi, 0, 1, 2, 3, 4, 5, 6, 7);
    st.o[dt] = mfma16(vf, pf, st.o[dt]);
  }
}

template <int MODE>
DI void attn_prompt_item(const Params& P, char* smem, int b, int h, int qt) {
  const int tid = threadIdx.x, lane = tid & 63, w = tid >> 6, r = lane & 15, quad = lane >> 4;
  char* ws = P.ws;
  const u16* Q = (const u16*)(ws + W_QKV + (size_t)(MODE == 0 ? 0 : 3) * SZ_HALF);
  const u16* Kg = (const u16*)(ws + W_QKV + (size_t)(MODE == 0 ? 1 : 4) * SZ_HALF);
  const u16* Vg = (const u16*)(ws + W_QKV + (size_t)(MODE == 0 ? 2 : 5) * SZ_HALF);
  u16* Y = (u16*)(ws + W_XB + (size_t)(MODE == 0 ? 0 : 1) * SZ_HALF);
  u16* Ks = (u16*)smem;
  u16* Vs = Ks + 64 * ASTR;
  float* tab = (float*)(smem + TAB_OFF);
  __syncthreads();
  if (MODE == 1) {
    for (int i = tid; i < 257; i += 256) tab[i] = P.relb[h * 257 + i] * LOG2E;
  }
  const int q0 = qt * 64;
  const int qpos = q0 + w * 16 + r;
  const size_t tokq = (size_t)b * 2048 + qpos;
  bf16x8 qf[2];
#pragma unroll
  for (int ks = 0; ks < 2; ks++) qf[ks] = *(const bf16x8*)(Q + tokq * 512 + h * 64 + ks * 32 + quad * 8);
  const float* cum = (const float*)(ws + W_CUMP) + (size_t)(b * 8 + h) * 2048;
  const float cq = MODE == 0 ? cum[qpos] : 0.f;
  AttnState st;
#pragma unroll
  for (int dt = 0; dt < 4; dt++) st.o[dt] = (f32x4){0.f, 0.f, 0.f, 0.f};
  st.m = -1e30f;
  st.l = 0.f;
  const int kt_lo = MODE == 0 ? 0 : max(0, qt - 8), kt_hi = qt;
  u32x4 rk[2], rv[2];
  const int lkey = tid >> 3, lch = tid & 7;
  const u16* kp = Kg + ((size_t)b * 2048 + lkey) * 512 + h * 64 + lch * 8;
  const u16* vp = Vg + ((size_t)b * 2048 + lkey) * 512 + h * 64 + lch * 8;
#pragma unroll
  for (int i = 0; i < 2; i++) {
    rk[i] = *(const u32x4*)(kp + (size_t)(kt_lo * 64 + i * 32) * 512);
    rv[i] = *(const u32x4*)(vp + (size_t)(kt_lo * 64 + i * 32) * 512);
  }
  for (int kt = kt_lo; kt <= kt_hi; kt++) {
    __syncthreads();
#pragma unroll
    for (int i = 0; i < 2; i++) {
      *(u32x4*)(Ks + (lkey + i * 32) * ASTR + lch * 8) = rk[i];
      *(u32x4*)(Vs + (lkey + i * 32) * ASTR + lch * 8) = rv[i];
    }
    __syncthreads();
    if (kt < kt_hi) {
#pragma unroll
      for (int i = 0; i < 2; i++) {
        rk[i] = *(const u32x4*)(kp + (size_t)((kt + 1) * 64 + i * 32) * 512);
        rv[i] = *(const u32x4*)(vp + (size_t)((kt + 1) * 64 + i * 32) * 512);
      }
    }
    const bool diag = (MODE == 0) && (kt == qt);
#pragma unroll
    for (int half = 0; half < 2; half++) {
      const int kpos0 = kt * 64 + half * 32;
      if (diag && kpos0 > q0 + w * 16 + 15) continue;
      attn_step<MODE>(Ks + half * 32 * ASTR, Vs + half * 32 * ASTR, qf, st, kpos0, qpos, qpos, cq, cum, tab, diag);
    }
  }
  float lt = st.l;
  lt += __shfl_xor(lt, 16);
  lt += __shfl_xor(lt, 32);
  const float inv = 1.f / lt;
#pragma unroll
  for (int dt = 0; dt < 4; dt++) {
    u32x2 o2 = (u32x2){pack2(st.o[dt][0] * inv, st.o[dt][1] * inv), pack2(st.o[dt][2] * inv, st.o[dt][3] * inv)};
    *(u32x2*)(Y + tokq * 512 + h * 64 + dt * 16 + quad * 4) = o2;
  }
}

template <int MODE>
DI void attn_sample_item(const Params& P, char* smem, int b, int h) {
  const int tid = threadIdx.x, lane = tid & 63, w = tid >> 6, r = lane & 15, quad = lane >> 4;
  constexpr int L = MODE == 0 ? 4096 : 512;
  char* ws = P.ws;
  const u16* Q = (const u16*)(ws + W_QKV + (size_t)(MODE == 0 ? 0 : 3) * SZ_HALF);
  const u16* Kn = (const u16*)(ws + W_QKV + (size_t)(MODE == 0 ? 1 : 4) * SZ_HALF);
  const u16* Vn = (const u16*)(ws + W_QKV + (size_t)(MODE == 0 ? 2 : 5) * SZ_HALF);
  u16* Y = (u16*)(ws + W_XB + (size_t)(MODE == 0 ? 0 : 1) * SZ_HALF);
  u16* Kw = (u16*)smem + w * (2 * 32 * ASTR);
  u16* Vw = Kw + 32 * ASTR;
  float* tab = (float*)(smem + TAB_OFF);
  __syncthreads();
  if (MODE == 1) {
    for (int i = tid; i < 257; i += 256) tab[i] = P.relb[h * 257 + i] * LOG2E;
  }
  __syncthreads();
  const float* ck = (MODE == 0 ? P.cak : P.cbk) + ((size_t)b * L * 8 + h) * 64;
  const float* cv = (MODE == 0 ? P.cav : P.cbv) + ((size_t)b * L * 8 + h) * 64;
  const size_t tokbase = (size_t)TP + b * 16;
  bf16x8 qf[2];
#pragma unroll
  for (int ks = 0; ks < 2; ks++) qf[ks] = *(const bf16x8*)(Q + (tokbase + r) * 512 + h * 64 + ks * 32 + quad * 8);
  const int qpos = L + r;
  const float* cum = (const float*)(ws + W_CUMS) + (size_t)(b * 8 + h) * 4112;
  const float cq = MODE == 0 ? cum[qpos] : 0.f;
  AttnState st;
#pragma unroll
  for (int dt = 0; dt < 4; dt++) st.o[dt] = (f32x4){0.f, 0.f, 0.f, 0.f};
  st.m = -1e30f;
  st.l = 0.f;
  const int kbeg = w * (L / 4), kend = kbeg + L / 4;
  for (int k0 = kbeg; k0 < kend; k0 += 32) {
    {
      f32x4 kr[8];
#pragma unroll
      for (int i = 0; i < 8; i++) kr[i] = *(const f32x4*)(ck + (size_t)(k0 + i * 4 + quad) * 512 + r * 4);
#pragma unroll
      for (int i = 0; i < 8; i++)
        *(u32x2*)(Kw + (i * 4 + quad) * ASTR + r * 4) = (u32x2){pack2(kr[i][0], kr[i][1]), pack2(kr[i][2], kr[i][3])};
    }
    {
      f32x4 vr[8];
#pragma unroll
      for (int i = 0; i < 8; i++) vr[i] = *(const f32x4*)(cv + (size_t)(k0 + i * 4 + quad) * 512 + r * 4);
#pragma unroll
      for (int i = 0; i < 8; i++)
        *(u32x2*)(Vw + (i * 4 + quad) * ASTR + r * 4) = (u32x2){pack2(vr[i][0], vr[i][1]), pack2(vr[i][2], vr[i][3])};
    }
    asm volatile("s_waitcnt lgkmcnt(0)" ::: "memory");
    __builtin_amdgcn_wave_barrier();
    attn_step<MODE>(Kw, Vw, qf, st, k0, qpos, qpos, cq, cum, tab, false);
    __builtin_amdgcn_wave_barrier();
  }
  if (w == 0) {
#pragma unroll
    for (int i = 0; i < 2; i++) {
      int c = lane + i * 64;
      int key = c >> 3, ch = c & 7;
      u32x4 kk = *(const u32x4*)(Kn + (tokbase + key) * 512 + h * 64 + ch * 8);
      u32x4 vv = *(const u32x4*)(Vn + (tokbase + key) * 512 + h * 64 + ch * 8);
      *(u32x4*)(Kw + key * ASTR + ch * 8) = kk;
      *(u32x4*)(Vw + key * ASTR + ch * 8) = vv;
      *(u32x4*)(Kw + (16 + key) * ASTR + ch * 8) = (u32x4){0u, 0u, 0u, 0u};
      *(u32x4*)(Vw + (16 + key) * ASTR + ch * 8) = (u32x4){0u, 0u, 0u, 0u};
    }
    asm volatile("s_waitcnt lgkmcnt(0)" ::: "memory");
    __builtin_amdgcn_wave_barrier();
    attn_step<MODE>(Kw, Vw, qf, st, L, qpos, MODE == 0 ? qpos : L + 15, cq, cum, tab, true);
  }
  __syncthreads();
  float* comb = (float*)smem;
  float lt = st.l;
  lt += __shfl_xor(lt, 16);
  lt += __shfl_xor(lt, 32);
#pragma unroll
  for (int dt = 0; dt < 4; dt++)
#pragma unroll
    for (int j = 0; j < 4; j++) comb[(w * 16 + r) * 68 + dt * 16 + quad * 4 + j] = st.o[dt][j];
  if (quad == 0) {
    comb[(w * 16 + r) * 68 + 64] = st.m;
    comb[(w * 16 + r) * 68 + 65] = lt;
  }
  __syncthreads();
  if (w == 0) {
    float mw[4], M = -1e30f;
#pragma unroll
    for (int i = 0; i < 4; i++) { mw[i] = comb[(i * 16 + r) * 68 + 64]; M = fmaxf(M, mw[i]); }
    float Ls = 0.f, scl[4];
#pragma unroll
    for (int i = 0; i < 4; i++) { scl[i] = __builtin_amdgcn_exp2f(mw[i] - M); Ls += scl[i] * comb[(i * 16 + r) * 68 + 65]; }
    const float inv = 1.f / Ls;
#pragma unroll
    for (int dt = 0; dt < 4; dt++) {
      float ov[4];
#pragma unroll
      for (int j = 0; j < 4; j++) {
        float a = 0.f;
#pragma unroll
        for (int i = 0; i < 4; i++) a += scl[i] * comb[(i * 16 + r) * 68 + dt * 16 + quad * 4 + j];
        ov[j] = a * inv;
      }
      *(u32x2*)(Y + (tokbase + r) * 512 + h * 64 + dt * 16 + quad * 4) = (u32x2){pack2(ov[0], ov[1]), pack2(ov[2], ov[3])};
    }
  }
}

DI void phase2(const Params& P, char* smem) {
  constexpr int N_SA = 128, N_PA = 8192, N_PB = 8192, N_SB = 128;
  for (int it = blockIdx.x; it < N_SA + N_PA + N_PB + N_SB; it += gridDim.x) {
    int u = it;
    if (u < N_SA) { attn_sample_item<0>(P, smem, u >> 3, u & 7); continue; }
    u -= N_SA;
    if (u < N_PA) { int qt = 31 - (u >> 8), bh = u & 255; attn_prompt_item<0>(P, smem, bh >> 3, bh & 7, qt); continue; }
    u -= N_PA;
    if (u < N_PB) { int qt = 31 - (u >> 8), bh = u & 255; attn_prompt_item<1>(P, smem, bh >> 3, bh & 7, qt); continue; }
    u -= N_PB;
    attn_sample_item<1>(P, smem, u >> 3, u & 7);
  }
}

DI void phase3_tile(const Params& P, int tile, char* smem) {
  const int tid = threadIdx.x, lane = tid & 63, w = tid >> 6, wm = w >> 1, wn = w & 1, r = lane & 15, quad = lane >> 4;
  const int mt = tile >> 3, nt = tile & 7;
  const int m0 = mt * 128, n0 = nt * 128;
  char* ws = P.ws;
  const u16* YA = (const u16*)(ws + W_XB);
  const u16* YB = YA + (size_t)TT * 512;
  const u16* GA = (const u16*)(ws + W_GA);
  const u16* GB = (const u16*)(ws + W_GB);
  u16* MRG = (u16*)(ws + W_QKV);
  f32x4 acc[4][4];
  zero_acc(acc);
  gemm_mainloop(YA + (size_t)m0 * 512, 512, (const u16*)(ws + W_WUPA) + (size_t)n0 * 512, 512, 512, (u16*)smem, acc);
  size_t lofs = (size_t)(m0 + wm * 64 + quad * 4) * 1024 + n0 + wn * 64 + r;
  LAUNDER(lofs);
  {
    const u16* gp = GA + lofs;
    u16* mp = MRG + lofs;
#pragma unroll
    for (int mi = 0; mi < 4; mi++) {
#pragma unroll
      for (int j = 0; j < 4; j++)
#pragma unroll
        for (int ni = 0; ni < 4; ni++)
          mp[(mi * 16 + j) * 1024 + ni * 16] = f2bf(acc[mi][ni][j] * bf2f(gp[(mi * 16 + j) * 1024 + ni * 16]));
      __builtin_amdgcn_sched_barrier(0);
    }
  }
  zero_acc(acc);
  gemm_mainloop(YB + (size_t)m0 * 512, 512, (const u16*)(ws + W_WUPB) + (size_t)n0 * 512, 512, 512, (u16*)smem, acc);
  {
    LAUNDER(lofs);
    const u16* gp = GB + lofs;
    u16* mp = MRG + lofs;
#pragma unroll
    for (int mi = 0; mi < 4; mi++) {
#pragma unroll
      for (int j = 0; j < 4; j++)
#pragma unroll
        for (int ni = 0; ni < 4; ni++) {
          float m = bf2f(mp[(mi * 16 + j) * 1024 + ni * 16]) + acc[mi][ni][j] * bf2f(gp[(mi * 16 + j) * 1024 + ni * 16]);
          mp[(mi * 16 + j) * 1024 + ni * 16] = f2bf(m);
        }
      __builtin_amdgcn_sched_barrier(0);
    }
  }
}

DI void phase4_tile(const Params& P, int tile, char* smem) {
  const int tid = threadIdx.x, lane = tid & 63, w = tid >> 6, wm = w >> 1, wn = w & 1, r = lane & 15, quad = lane >> 4;
  const int mt = tile >> 3, nt = tile & 7;
  const int m0 = mt * 128, n0 = nt * 128;
  char* ws = P.ws;
  const u16* MRG = (const u16*)(ws + W_QKV);
  u16* H1B = (u16*)(ws + W_QKV + SZ_ACT);
  float* SSQ2 = (float*)(ws + W_SSQ2);
  f32x4 acc[4][4];
  zero_acc(acc);
  gemm_mainloop(MRG + (size_t)m0 * 1024, 1024, (const u16*)(ws + W_WOUT) + (size_t)n0 * 1024, 1024, 1024, (u16*)smem, acc);
  const float* xb = m0 < TP ? P.x_p : P.x_s - (size_t)TP * 1024;
  size_t rbase = (size_t)(m0 + wm * 64 + quad * 4);
  LAUNDER(rbase);
  const size_t lofs = rbase * 1024 + n0 + wn * 64 + r;
  const float* xp = xb + lofs;
  float* op = P.out + lofs;
  u16* hp = H1B + lofs;
  float* sp = SSQ2 + rbase * 16 + nt * 2 + wn;
#pragma unroll
  for (int mi = 0; mi < 4; mi++) {
#pragma unroll
    for (int j = 0; j < 4; j++) {
      float ss = 0.f;
#pragma unroll
      for (int ni = 0; ni < 4; ni++) {
        const int o = (mi * 16 + j) * 1024 + ni * 16;
        float h1 = xp[o] + acc[mi][ni][j];
        op[o] = h1;
        hp[o] = f2bf(h1);
        ss += h1 * h1;
      }
      ss += __shfl_xor(ss, 1);
      ss += __shfl_xor(ss, 2);
      ss += __shfl_xor(ss, 4);
      ss += __shfl_xor(ss, 8);
      if (r == 0) sp[(mi * 16 + j) * 16] = ss;
    }
    __builtin_amdgcn_sched_barrier(0);
  }
}

DI void phase5_tile(const Params& P, int tile, char* smem) {
  const int tid = threadIdx.x, lane = tid & 63, w = tid >> 6, wm = w >> 1, wn = w & 1, r = lane & 15, quad = lane >> 4;
  const int mt = tile >> 3, nt = tile & 7;
  const int m0 = mt * 128, n0 = nt * 128;
  char* ws = P.ws;
  const u16* H1B = (const u16*)(ws + W_QKV + SZ_ACT);
  u16* QP = (u16*)(ws + W_QKV + 2 * SZ_ACT);
  const float* SSQ2 = (const float*)(ws + W_SSQ2);
  float* rs_s = (float*)(smem + 2 * 128 * GSTR * 2);
  __syncthreads();
  if (tid < 128) {
    float s = 0.f;
#pragma unroll
    for (int i = 0; i < 16; i++) s += SSQ2[(size_t)(m0 + tid) * 16 + i];
    rs_s[tid] = rsqrtf(s * (1.f / 1024.f) + EPS);
  }
  f32x4 acc[4][4];
  zero_acc(acc);
  gemm_mainloop(H1B + (size_t)m0 * 1024, 1024, (const u16*)(ws + W_WQ) + (size_t)n0 * 1024, 1024, 1024, (u16*)smem, acc);
  size_t lofs = (size_t)(m0 + wm * 64 + quad * 4) * 1024 + n0 + wn * 64 + r;
  LAUNDER(lofs);
  u16* qp = QP + lofs;
#pragma unroll
  for (int mi = 0; mi < 4; mi++)
#pragma unroll
    for (int j = 0; j < 4; j++) {
      const float rs = rs_s[wm * 64 + mi * 16 + quad * 4 + j];
#pragma unroll
      for (int ni = 0; ni < 4; ni++) qp[(mi * 16 + j) * 1024 + ni * 16] = f2bf(acc[mi][ni][j] * rs);
    }
}

DI void phase6a_unit(const Params& P, int unit, char* smem) {
  const int tid = threadIdx.x, lane = tid & 63, w = tid >> 6, r = lane & 15, quad = lane >> 4;
  char* ws = P.ws;
  const u16* QP = (const u16*)(ws + W_QKV + 2 * SZ_ACT);
  const u16* SK = (const u16*)(ws + W_SK);
  u32x2* SEL = (u32x2*)(ws + W_GA);
  float* sc = (float*)smem;
  u32* lists = (u32*)(smem + 128 * 129 * 4);
  unsigned char* tabi = (unsigned char*)(smem + 128 * 129 * 4 + 128 * 17 * 4);
  unsigned char* tabj = tabi + 64;
  const int tok0 = unit * 64;
  __syncthreads();
  if (tid == 0) {
    int s = 0;
    for (int i = 0; i < 16; i++)
      for (int j = 0; j < 16; j++)
        if ((i + 1) * (j + 1) <= 16) { tabi[s] = (unsigned char)i; tabj[s] = (unsigned char)j; s++; }
  }
  for (int h = 0; h < 8; h++) {
#pragma unroll
    for (int p = 0; p < 2; p++) {
      const int hp = h * 2 + p;
      bf16x8 qf[2];
#pragma unroll
      for (int ks = 0; ks < 2; ks++)
        qf[ks] = *(const bf16x8*)(QP + (size_t)(tok0 + w * 16 + r) * 1024 + hp * 64 + ks * 32 + quad * 8);
#pragma unroll
      for (int nt = 0; nt < 8; nt++) {
        f32x4 a4 = (f32x4){0.f, 0.f, 0.f, 0.f};
#pragma unroll
        for (int ks = 0; ks < 2; ks++) {
          bf16x8 kf = *(const bf16x8*)(SK + (size_t)(hp * 128 + nt * 16 + r) * 64 + ks * 32 + quad * 8);
          a4 = mfma16(kf, qf[ks], a4);
        }
        float* d = sc + (p * 64 + w * 16 + r) * 129 + nt * 16 + quad * 4;
        d[0] = a4[0]; d[1] = a4[1]; d[2] = a4[2]; d[3] = a4[3];
      }
    }
    __syncthreads();
    if (tid < 128) {
      u32 L[16];
#pragma unroll
      for (int s = 0; s < 16; s++) L[s] = 0u;
      const float* row = sc + tid * 129;
#pragma unroll 4
      for (int i = 0; i < 128; i++) {
        u32 k = (mono(row[i]) & ~127u) | (u32)i;
        insert16(L, k);
      }
#pragma unroll
      for (int s = 0; s < 16; s++) lists[tid * 17 + s] = L[s];
    }
    __syncthreads();
    if (tid < 64) {
      u32 a[16], bq[16];
      float fa[16], fb[16];
#pragma unroll
      for (int s = 0; s < 16; s++) {
        a[s] = lists[tid * 17 + s];
        bq[s] = lists[(64 + tid) * 17 + s];
        fa[s] = unmono(a[s] & ~127u);
        fb[s] = unmono(bq[s] & ~127u);
      }
      u32 L2[16];
#pragma unroll
      for (int s = 0; s < 16; s++) L2[s] = 0u;
      {
        int slot = 0;
#pragma unroll
        for (int i = 0; i < 16; i++)
#pragma unroll
          for (int j = 0; j < 16; j++)
            if ((i + 1) * (j + 1) <= 16) {
              float sum = fa[i] + fb[j];
              u32 key = (mono(sum) & ~63u) | (u32)slot;
              slot++;
              insert16(L2, key);
            }
      }
      float val[16];
      u32 idx[16];
      float mx = -1e30f;
#pragma unroll
      for (int s = 0; s < 16; s++) {
        u32 sl = L2[s] & 63u;
        int i = tabi[sl], j = tabj[sl];
        u32 au = lists[tid * 17 + i], bu = lists[(64 + tid) * 17 + j];
        val[s] = unmono(au & ~127u) + unmono(bu & ~127u);
        idx[s] = (au & 127u) * 128u + (bu & 127u);
        mx = fmaxf(mx, val[s]);
      }
      float sum = 0.f;
#pragma unroll
      for (int s = 0; s < 16; s++) { val[s] = __expf(val[s] - mx); sum += val[s]; }
      const float inv = 1.f / sum;
      u32x2* dst = SEL + ((size_t)(tok0 + tid) * 8 + h) * 16;
#pragma unroll
      for (int s = 0; s < 16; s++) dst[s] = (u32x2){idx[s], __float_as_uint(val[s] * inv)};
    }
  }
}

DI float dot2bf(u32 a, u32 b, float c) {
  return __builtin_amdgcn_fdot2_f32_bf16(__builtin_bit_cast(bf16x2_t, a), __builtin_bit_cast(bf16x2_t, b), c, false);
}
DI float dot8(u32x4 a, u32x4 b, float acc) {
  acc = dot2bf(a.x, b.x, acc);
  acc = dot2bf(a.y, b.y, acc);
  acc = dot2bf(a.z, b.z, acc);
  acc = dot2bf(a.w, b.w, acc);
  return acc;
}

DI void phase6b(const Params& P) {
  const int lane = threadIdx.x & 63;
  const int gw = blockIdx.x * 4 + (threadIdx.x >> 6), nw = gridDim.x * 4;
  char* ws = P.ws;
  u16* H1B = (u16*)(ws + W_QKV + SZ_ACT);
  const u16* UB = (const u16*)(ws + W_UB);
  const u16* VB = (const u16*)(ws + W_VB);
  const u32x2* SEL = (const u32x2*)(ws + W_GA);
  const float* SSQ2 = (const float*)(ws + W_SSQ2);
  float* RS3 = (float*)(ws + W_RS3);
  for (int t = gw; t < TT; t += nw) {
    float ssq = lane < 16 ? SSQ2[(size_t)t * 16 + lane] : 0.f;
    ssq = wave_sum(ssq);
    const float rs2 = rsqrtf(ssq * (1.f / 1024.f) + EPS);
    const u32x4 xa = *(const u32x4*)(H1B + (size_t)t * 1024 + lane * 16);
    const u32x4 xb = *(const u32x4*)(H1B + (size_t)t * 1024 + lane * 16 + 8);
    const u32x2 e0 = SEL[(size_t)t * 128 + lane];
    const u32x2 e1 = SEL[(size_t)t * 128 + 64 + lane];
    float wv[2];
#pragma unroll
    for (int rd = 0; rd < 2; rd++) {
      const int idxv = (int)(rd ? e1[0] : e0[0]);
      float p[64];
#pragma unroll
      for (int c = 0; c < 8; c++) {
        u32x4 ua[8], ub[8];
#pragma unroll
        for (int i = 0; i < 8; i++) {
          int e = __builtin_amdgcn_readlane(idxv, c * 8 + i);
          const u16* up = UB + (size_t)e * 1024 + lane * 16;
          ua[i] = *(const u32x4*)up;
          ub[i] = *(const u32x4*)(up + 8);
        }
#pragma unroll
        for (int i = 0; i < 8; i++) p[c * 8 + i] = dot8(ub[i], xb, dot8(ua[i], xa, 0.f));
      }
#pragma unroll
      for (int i = 0; i < 32; i++) { float keep = (lane & 32) ? p[i + 32] : p[i]; float send = (lane & 32) ? p[i] : p[i + 32]; p[i] = keep + __shfl_xor(send, 32); }
#pragma unroll
      for (int i = 0; i < 16; i++) { float keep = (lane & 16) ? p[i + 16] : p[i]; float send = (lane & 16) ? p[i] : p[i + 16]; p[i] = keep + __shfl_xor(send, 16); }
#pragma unroll
      for (int i = 0; i < 8; i++) { float keep = (lane & 8) ? p[i + 8] : p[i]; float send = (lane & 8) ? p[i] : p[i + 8]; p[i] = keep + __shfl_xor(send, 8); }
#pragma unroll
      for (int i = 0; i < 4; i++) { float keep = (lane & 4) ? p[i + 4] : p[i]; float send = (lane & 4) ? p[i] : p[i + 4]; p[i] = keep + __shfl_xor(send, 4); }
#pragma unroll
      for (int i = 0; i < 2; i++) { float keep = (lane & 2) ? p[i + 2] : p[i]; float send = (lane & 2) ? p[i] : p[i + 2]; p[i] = keep + __shfl_xor(send, 2); }
      { float keep = (lane & 1) ? p[1] : p[0]; float send = (lane & 1) ? p[0] : p[1]; p[0] = keep + __shfl_xor(send, 1); }
      const float g = __uint_as_float(rd ? e1[1] : e0[1]);
      wv[rd] = g * gelu_tanh(rs2 * p[0]);
    }
    float oacc[16];
#pragma unroll
    for (int i = 0; i < 16; i++) oacc[i] = 0.f;
#pragma unroll
    for (int rd = 0; rd < 2; rd++) {
      const int idxv = (int)(rd ? e1[0] : e0[0]);
      const int wbits = (int)__float_as_uint(wv[rd]);
#pragma unroll
      for (int c = 0; c < 8; c++) {
        u32x4 va[8], vb[8];
#pragma unroll
        for (int i = 0; i < 8; i++) {
          int e = __builtin_amdgcn_readlane(idxv, c * 8 + i);
          const u16* vp = VB + (size_t)e * 1024 + lane * 16;
          va[i] = *(const u32x4*)vp;
          vb[i] = *(const u32x4*)(vp + 8);
        }
#pragma unroll
        for (int i = 0; i < 8; i++) {
          const float wgt = __uint_as_float((u32)__builtin_amdgcn_readlane(wbits, c * 8 + i));
#pragma unroll
          for (int q = 0; q < 4; q++) {
            oacc[2 * q] += wgt * __uint_as_float(va[i][q] << 16);
            oacc[2 * q + 1] += wgt * __uint_as_float(va[i][q] & 0xffff0000u);
            oacc[8 + 2 * q] += wgt * __uint_as_float(vb[i][q] << 16);
            oacc[8 + 2 * q + 1] += wgt * __uint_as_float(vb[i][q] & 0xffff0000u);
          }
        }
      }
    }
    float* hrow = P.out + (size_t)t * 1024 + lane * 16;
    float ss = 0.f;
    float h2[16];
#pragma unroll
    for (int i = 0; i < 4; i++) {
      f32x4 hv = *(const f32x4*)(hrow + i * 4);
#pragma unroll
      for (int c = 0; c < 4; c++) { h2[i * 4 + c] = hv[c] + oacc[i * 4 + c]; ss += h2[i * 4 + c] * h2[i * 4 + c]; }
      *(f32x4*)(hrow + i * 4) = (f32x4){h2[i * 4], h2[i * 4 + 1], h2[i * 4 + 2], h2[i * 4 + 3]};
    }
    *(u32x4*)(H1B + (size_t)t * 1024 + lane * 16) = (u32x4){pack2(h2[0], h2[1]), pack2(h2[2], h2[3]), pack2(h2[4], h2[5]), pack2(h2[6], h2[7])};
    *(u32x4*)(H1B + (size_t)t * 1024 + lane * 16 + 8) = (u32x4){pack2(h2[8], h2[9]), pack2(h2[10], h2[11]), pack2(h2[12], h2[13]), pack2(h2[14], h2[15])};
    ss = wave_sum(ss);
    if (lane == 0) RS3[t] = rsqrtf(ss * (1.f / 1024.f) + EPS);
  }
}

DI void phase7_tile(const Params& P, int tile, char* smem) {
  const int tid = threadIdx.x, lane = tid & 63, w = tid >> 6, wm = w >> 1, wn = w & 1, r = lane & 15, quad = lane >> 4;
  const int mt = tile >> 3, nt = tile & 7;
  const int m0 = mt * 128, n0 = nt * 128;
  char* ws = P.ws;
  const u16* H2B = (const u16*)(ws + W_QKV + SZ_ACT);
  const u16* PB = (const u16*)(ws + W_PB);
  const float* RS3 = (const float*)(ws + W_RS3);
  u16* PJ = (u16*)(ws + W_QKV);
  f32x4 acc[4][4];
  zero_acc(acc);
  gemm_mainloop(PB + (size_t)m0 * 256, 256, (const u16*)(ws + W_WPP) + (size_t)n0 * 256, 256, 256, (u16*)smem, acc);
  size_t rbase7 = (size_t)(m0 + wm * 64 + quad * 4);
  LAUNDER(rbase7);
  {
    u16* pj = PJ + rbase7 * 1024 + n0 + wn * 64 + r;
#pragma unroll
    for (int mi = 0; mi < 4; mi++)
#pragma unroll
      for (int j = 0; j < 4; j++)
#pragma unroll
        for (int ni = 0; ni < 4; ni++) pj[(mi * 16 + j) * 1024 + ni * 16] = f2bf(acc[mi][ni][j]);
  }
  zero_acc(acc);
  gemm_mainloop(H2B + (size_t)m0 * 1024, 1024, (const u16*)(ws + W_WG) + (size_t)n0 * 1024, 1024, 1024, (u16*)smem, acc);
  LAUNDER(rbase7);
  float* op = P.out + rbase7 * 1024 + n0 + wn * 64 + r;
  const u16* pj = PJ + rbase7 * 1024 + n0 + wn * 64 + r;
  const float* rp = RS3 + rbase7;
#pragma unroll
  for (int mi = 0; mi < 4; mi++) {
#pragma unroll
    for (int j = 0; j < 4; j++) {
      const float rs = rp[mi * 16 + j];
#pragma unroll
      for (int ni = 0; ni < 4; ni++) {
        const int o = (mi * 16 + j) * 1024 + ni * 16;
        float h2 = op[o];
        op[o] = h2 + sigmoidf_(rs * acc[mi][ni][j]) * bf2f(pj[o]);
      }
    }
    __builtin_amdgcn_sched_barrier(0);
  }
}

__global__ void __launch_bounds__(256, 2) fwd_megakernel(Params P) {
  __shared__ __attribute__((aligned(16))) char smem[SMEM_BYTES];
  cg::grid_group grid = cg::this_grid();
  phase0(P, smem);
  grid.sync();
  phase1_scans(P);
  for (int t = blockIdx.x; t < 514 * 40; t += gridDim.x) phase1_tile(P, t, smem);
  grid.sync();
  phase2(P, smem);
  grid.sync();
  for (int t = blockIdx.x; t < 514 * 8; t += gridDim.x) phase3_tile(P, t, smem);
  grid.sync();
  for (int t = blockIdx.x; t < 514 * 8; t += gridDim.x) phase4_tile(P, t, smem);
  grid.sync();
  for (int t = blockIdx.x; t < 514 * 8; t += gridDim.x) phase5_tile(P, t, smem);
  grid.sync();
  for (int t = blockIdx.x; t < TT / 64; t += gridDim.x) phase6a_unit(P, t, smem);
  grid.sync();
  phase6b(P);
  grid.sync();
  for (int t = blockIdx.x; t < 514 * 8; t += gridDim.x) phase7_tile(P, t, smem);
}

extern "C" void kernel_launch(void* const* d_in, const int* in_sizes, int n_in, void* d_out, int out_size, void* d_ws,
                              size_t ws_size, hipStream_t stream) {
  static int grid_blocks = 0;
  if (!grid_blocks) {
    int dev = 0, cus = 0, per_cu = 0;
    hipGetDevice(&dev);
    hipDeviceGetAttribute(&cus, hipDeviceAttributeMultiprocessorCount, dev);
    hipOccupancyMaxActiveBlocksPerMultiprocessor(&per_cu, fwd_megakernel, 256, 0);
    if (per_cu > 2) per_cu = 2;
    if (per_cu < 1) per_cu = 1;
    grid_blocks = cus * per_cu;
  }
  if (ws_size < W_END) { fprintf(stderr, "workspace too small: %zu < %zu\n", ws_size, (size_t)W_END); return; }
  Params p{};
  const float** pf = (const float**)&p;
  for (int i = 0; i < 28; i++) pf[i] = (const float*)d_in[i];
  p.out = (float*)d_out;
  p.ws = (char*)d_ws;
  void* args[] = {&p};
  hipError_t e = hipLaunchCooperativeKernel((void*)fwd_megakernel, dim3(grid_blocks), dim3(256), args, 0, stream);
  if (e != hipSuccess) fprintf(stderr, "cooperative launch failed: %s (grid %d)\n", hipGetErrorString(e), grid_blocks);
}
```

```cpp
#include <hip/hip_runtime.h>
#include <hip/hip_cooperative_groups.h>
#include <cstdio>
namespace cg = cooperative_groups;

typedef unsigned short u16;
typedef unsigned int u32;
typedef short bf16x8 __attribute__((ext_vector_type(8)));
typedef short s16x4 __attribute__((ext_vector_type(4)));
typedef float f32x4 __attribute__((ext_vector_type(4)));
typedef unsigned int u32x4 __attribute__((ext_vector_type(4)));
typedef unsigned int u32x2 __attribute__((ext_vector_type(2)));
typedef __bf16 bf16x2_t __attribute__((ext_vector_type(2)));

#define DI __device__ __forceinline__
#define LAUNDER(x) asm volatile("" : "+v"(x))

constexpr int TP = 65536, TS = 256, TT = TP + TS;
constexpr float LOG2E = 1.4426950408889634f;
constexpr float EPS = 1e-6f;
constexpr float U_SCALE = 1024.f, V_SCALE = 128.f;

constexpr size_t O_AK_P = 67371008, O_AV_P = 100925440, O_AF_P = 134479872, O_BK_P = 135004160,
                 O_BV_P = 143392768, O_AK_S = 151781376, O_AV_S = 151912448, O_AF_S = 152043520,
                 O_BK_S = 152045568, O_BV_S = 152176640;

constexpr size_t SZ_ACT = (size_t)TT * 1024 * 2;
constexpr size_t SZ_HALF = (size_t)TT * 512 * 2;
constexpr size_t W_XB = 0;
constexpr size_t W_QKV = SZ_ACT;
constexpr size_t W_GA = W_QKV + 6 * SZ_HALF;
constexpr size_t W_GB = W_GA + SZ_ACT;
constexpr size_t W_PB = W_GB + SZ_ACT;
constexpr size_t W_WIN = W_PB + (size_t)TT * 256 * 2;
constexpr size_t W_WUPA = W_WIN + (size_t)5120 * 1024 * 2;
constexpr size_t W_WUPB = W_WUPA + 1024 * 512 * 2;
constexpr size_t W_WOUT = W_WUPB + 1024 * 512 * 2;
constexpr size_t W_WQ = W_WOUT + 1024 * 1024 * 2;
constexpr size_t W_WG = W_WQ + 1024 * 1024 * 2;
constexpr size_t W_WPP = W_WG + 1024 * 1024 * 2;
constexpr size_t W_UB = W_WPP + 1024 * 256 * 2;
constexpr size_t W_VB = W_UB + (size_t)16384 * 1024 * 2;
constexpr size_t W_SK = W_VB + (size_t)16384 * 1024 * 2;
constexpr size_t W_RS1 = W_SK + 131072 * 2;
constexpr size_t W_SSQ2 = W_RS1 + (size_t)TT * 4;
constexpr size_t W_RS3 = W_SSQ2 + (size_t)TT * 64;
constexpr size_t W_CUMP = W_RS3 + (size_t)TT * 4;
constexpr size_t W_CUMS = W_CUMP + (size_t)256 * 2048 * 4;
constexpr size_t W_END = W_CUMS + (size_t)128 * 4112 * 4 + 1024;

struct Params {
  const float *x_p, *x_s, *cak, *cav, *caf, *cbk, *cbv, *p_p, *p_s, *g_mix, *w_in, *b_f, *qn_a, *kn_a,
      *qn_b, *kn_b, *relb, *w_up_a, *w_up_b, *w_out, *g_ffn, *peer_wq, *peer_sk, *peer_u, *peer_v, *g_ple,
      *w_gate, *w_proj;
  float* out;
  char* ws;
};

constexpr int SMEM_BYTES = 128 * 129 * 4 + 2 * 64 * 17 * 4 + 256;

DI u16 f2bf(float x) { u32 u = __float_as_uint(x); u += 0x7fffu + ((u >> 16) & 1u); return (u16)(u >> 16); }
DI float bf2f(u16 h) { return __uint_as_float(((u32)h) << 16); }
DI u32 pack2(float a, float b) { return (u32)f2bf(a) | ((u32)f2bf(b) << 16); }
DI float wave_sum(float v) {
#pragma unroll
  for (int o = 32; o; o >>= 1) v += __shfl_xor(v, o);
  return v;
}
DI f32x4 mfma16(bf16x8 a, bf16x8 b, f32x4 c) { return __builtin_amdgcn_mfma_f32_16x16x32_bf16(a, b, c, 0, 0, 0); }
DI float sigmoidf_(float x) { return 1.f / (1.f + __expf(-x)); }
DI u32 mono(float x) { u32 u = __float_as_uint(x); u32 m = (u32)((int)u >> 31) | 0x80000000u; return u ^ m; }
DI float unmono(u32 k) { u32 m = ((k >> 31) - 1u) | 0x80000000u; return __uint_as_float(k ^ m); }
DI void insert16(u32 (&L)[16], u32 x) {
#pragma unroll
  for (int s = 0; s < 16; s++) { u32 mx = max(L[s], x); x = min(L[s], x); L[s] = mx; }
}
DI float gelu_tanh(float x) {
  float u = 0.7978845608028654f * (x + 0.044715f * x * x * x);
  float t = 1.f - 2.f / (1.f + __expf(2.f * u));
  return 0.5f * x * (1.f + t);
}

constexpr int GSTR = 72;
DI void gemm_mainloop(const u16* __restrict__ A, int lda, const u16* __restrict__ B, int ldb, int K, u16* smem,
                      f32x4 (&acc)[4][4]) {
  const int tid = threadIdx.x, lane = tid & 63, w = tid >> 6, wm = w >> 1, wn = w & 1, r = lane & 15, quad = lane >> 4;
  u16* As = smem;
  u16* Bs = smem + 128 * GSTR;
  u32x4 ra[4], rb[4];
  const int lrow = tid >> 3, lch = tid & 7;
  const u16* ap = A + (size_t)lrow * lda + lch * 8;
  const u16* bp = B + (size_t)lrow * ldb + lch * 8;
#pragma unroll
  for (int i = 0; i < 4; i++) {
    ra[i] = *(const u32x4*)(ap + (size_t)i * 32 * lda);
    rb[i] = *(const u32x4*)(bp + (size_t)i * 32 * ldb);
  }
  const int nk = K >> 6;
#pragma unroll 1
  for (int kt = 0; kt < nk; kt++) {
    __syncthreads();
#pragma unroll
    for (int i = 0; i < 4; i++) {
      *(u32x4*)(As + (lrow + i * 32) * GSTR + lch * 8) = ra[i];
      *(u32x4*)(Bs + (lrow + i * 32) * GSTR + lch * 8) = rb[i];
    }
    __syncthreads();
    if (kt + 1 < nk) {
#pragma unroll
      for (int i = 0; i < 4; i++) {
        ra[i] = *(const u32x4*)(ap + (size_t)i * 32 * lda + (kt + 1) * 64);
        rb[i] = *(const u32x4*)(bp + (size_t)i * 32 * ldb + (kt + 1) * 64);
      }
    }
#pragma unroll
    for (int ks = 0; ks < 2; ks++) {
      bf16x8 af[4], bfr[4];
#pragma unroll
      for (int mi = 0; mi < 4; mi++) af[mi] = *(const bf16x8*)(As + (wm * 64 + mi * 16 + r) * GSTR + ks * 32 + quad * 8);
#pragma unroll
      for (int ni = 0; ni < 4; ni++) bfr[ni] = *(const bf16x8*)(Bs + (wn * 64 + ni * 16 + r) * GSTR + ks * 32 + quad * 8);
#pragma unroll
      for (int mi = 0; mi < 4; mi++)
#pragma unroll
        for (int ni = 0; ni < 4; ni++) acc[mi][ni] = mfma16(af[mi], bfr[ni], acc[mi][ni]);
    }
  }
}

DI void zero_acc(f32x4 (&acc)[4][4]) {
#pragma unroll
  for (int i = 0; i < 4; i++)
#pragma unroll
    for (int j = 0; j < 4; j++) acc[i][j] = (f32x4){0.f, 0.f, 0.f, 0.f};
}

DI void transpose_tile(const float* __restrict__ W, int ldw, int K, const float* __restrict__ g, u16* __restrict__ dst,
                       int k0, int n0, int nsrc0, float* tile) {
  const int tid = threadIdx.x;
  __syncthreads();
  {
    const int ty = tid >> 4, tx = tid & 15;
#pragma unroll
    for (int i = 0; i < 4; i++) {
      int k = ty + i * 16;
      f32x4 v = *(const f32x4*)(W + (size_t)(k0 + k) * ldw + nsrc0 + tx * 4);
      float s = g ? g[k0 + k] : 1.f;
      tile[k * 65 + tx * 4 + 0] = v[0] * s;
      tile[k * 65 + tx * 4 + 1] = v[1] * s;
      tile[k * 65 + tx * 4 + 2] = v[2] * s;
      tile[k * 65 + tx * 4 + 3] = v[3] * s;
    }
  }
  __syncthreads();
  {
    const int n = tid >> 2, kc = (tid & 3) * 16;
    u32 pk[8];
#pragma unroll
    for (int i = 0; i < 8; i++) pk[i] = pack2(tile[(kc + 2 * i) * 65 + n], tile[(kc + 2 * i + 1) * 65 + n]);
    u16* d = dst + (size_t)(n0 + n) * K + k0 + kc;
    *(u32x4*)d = (u32x4){pk[0], pk[1], pk[2], pk[3]};
    *(u32x4*)(d + 8) = (u32x4){pk[4], pk[5], pk[6], pk[7]};
  }
}

DI void conv_unit(const float* __restrict__ src, u16* __restrict__ dst, size_t base, const float* __restrict__ colscale) {
  const int tid = threadIdx.x;
#pragma unroll
  for (int i = 0; i < 4; i++) {
    size_t e = base + (size_t)i * 1024 + tid * 4;
    f32x4 v = *(const f32x4*)(src + e);
    if (colscale) {
      f32x4 gg = *(const f32x4*)(colscale + (e & 1023));
      v = v * gg;
    }
    *(u32x2*)(dst + e) = (u32x2){pack2(v[0], v[1]), pack2(v[2], v[3])};
  }
}

DI void conv_unit_fp8(const float* __restrict__ src, unsigned char* __restrict__ dst, size_t base,
                      const float* __restrict__ colscale, float scale) {
  const int tid = threadIdx.x;
#pragma unroll
  for (int i = 0; i < 4; i++) {
    size_t e = base + (size_t)i * 1024 + tid * 4;
    f32x4 v = *(const f32x4*)(src + e);
    if (colscale) {
      f32x4 gg = *(const f32x4*)(colscale + (e & 1023));
      v = v * gg;
    }
    int w = __builtin_amdgcn_cvt_pk_fp8_f32(v[0] * scale, v[1] * scale, 0, false);
    w = __builtin_amdgcn_cvt_pk_fp8_f32(v[2] * scale, v[3] * scale, w, true);
    *(int*)(dst + e) = w;
  }
}

DI void phase0(const Params& P, char* smem) {
  const int tid = threadIdx.x, lane = tid & 63, w = tid >> 6;
  char* ws = P.ws;
  {
    float* tile = (float*)smem;
    constexpr int T_WIN = 16 * 80, T_UP = 8 * 16, T_SQ = 256, T_PP = 4 * 16;
    constexpr int NT = T_WIN + 2 * T_UP + 3 * T_SQ + T_PP;
    for (int t = blockIdx.x; t < NT; t += gridDim.x) {
      int u = t;
      if (u < T_WIN) {
        int kt = u / 80, nt = u % 80;
        int n0 = nt * 64;
        int ns = n0 < 1536 ? n0 : n0 + 8;
        transpose_tile(P.w_in, 5128, 1024, P.g_mix, (u16*)(ws + W_WIN), kt * 64, n0, ns, tile);
        continue;
      }
      u -= T_WIN;
      if (u < T_UP) { transpose_tile(P.w_up_a, 1024, 512, nullptr, (u16*)(ws + W_WUPA), (u / 16) * 64, (u % 16) * 64, (u % 16) * 64, tile); continue; }
      u -= T_UP;
      if (u < T_UP) { transpose_tile(P.w_up_b, 1024, 512, nullptr, (u16*)(ws + W_WUPB), (u / 16) * 64, (u % 16) * 64, (u % 16) * 64, tile); continue; }
      u -= T_UP;
      if (u < T_SQ) { transpose_tile(P.w_out, 1024, 1024, nullptr, (u16*)(ws + W_WOUT), (u / 16) * 64, (u % 16) * 64, (u % 16) * 64, tile); continue; }
      u -= T_SQ;
      if (u < T_SQ) { transpose_tile(P.peer_wq, 1024, 1024, P.g_ffn, (u16*)(ws + W_WQ), (u / 16) * 64, (u % 16) * 64, (u % 16) * 64, tile); continue; }
      u -= T_SQ;
      if (u < T_SQ) { transpose_tile(P.w_gate, 1024, 1024, P.g_ple, (u16*)(ws + W_WG), (u / 16) * 64, (u % 16) * 64, (u % 16) * 64, tile); continue; }
      u -= T_SQ;
      transpose_tile(P.w_proj, 1024, 256, nullptr, (u16*)(ws + W_WPP), (u / 16) * 64, (u % 16) * 64, (u % 16) * 64, tile);
    }
  }
  {
    constexpr int U_UB = 4096, U_VB = 4096, U_SK = 32, U_PP = 4096, U_PS = 16;
    constexpr int NU = U_UB + U_VB + U_SK + U_PP + U_PS;
    for (int t = blockIdx.x; t < NU; t += gridDim.x) {
      int u = t;
      if (u < U_UB) { conv_unit_fp8(P.peer_u, (unsigned char*)(ws + W_UB), (size_t)u * 4096, P.g_ffn, U_SCALE); continue; }
      u -= U_UB;
      if (u < U_VB) { conv_unit_fp8(P.peer_v, (unsigned char*)(ws + W_VB), (size_t)u * 4096, nullptr, V_SCALE); continue; }
      u -= U_VB;
      if (u < U_SK) { conv_unit(P.peer_sk, (u16*)(ws + W_SK), (size_t)u * 4096, nullptr); continue; }
      u -= U_SK;
      if (u < U_PP) { conv_unit(P.p_p, (u16*)(ws + W_PB), (size_t)u * 4096, nullptr); continue; }
      u -= U_PP;
      conv_unit(P.p_s, (u16*)(ws + W_PB) + (size_t)TP * 256, (size_t)u * 4096, nullptr);
    }
  }
  {
    float* wfl = (float*)smem;
    __syncthreads();
    for (int i = tid; i < 8192; i += 256) {
      int k = i >> 3, h = i & 7;
      wfl[h * 1024 + k] = P.g_mix[k] * P.w_in[(size_t)k * 5128 + 1536 + h];
    }
    __syncthreads();
    u16* XB = (u16*)(ws + W_XB);
    float* RS1 = (float*)(ws + W_RS1);
    for (int t = blockIdx.x * 4 + w; t < TT; t += gridDim.x * 4) {
      const float* xr = t < TP ? P.x_p + (size_t)t * 1024 : P.x_s + (size_t)(t - TP) * 1024;
      f32x4 v[4];
#pragma unroll
      for (int i = 0; i < 4; i++) v[i] = *(const f32x4*)(xr + i * 256 + lane * 4);
      float ss = 0.f;
#pragma unroll
      for (int i = 0; i < 4; i++) ss += v[i][0] * v[i][0] + v[i][1] * v[i][1] + v[i][2] * v[i][2] + v[i][3] * v[i][3];
      float dots[8];
#pragma unroll
      for (int h = 0; h < 8; h++) {
        float d = 0.f;
#pragma unroll
        for (int i = 0; i < 4; i++) {
          f32x4 wv = *(const f32x4*)(wfl + h * 1024 + i * 256 + lane * 4);
          d += v[i][0] * wv[0] + v[i][1] * wv[1] + v[i][2] * wv[2] + v[i][3] * wv[3];
        }
        dots[h] = d;
      }
      ss = wave_sum(ss);
#pragma unroll
      for (int h = 0; h < 8; h++) dots[h] = wave_sum(dots[h]);
      float rs = rsqrtf(ss * (1.f / 1024.f) + EPS);
#pragma unroll
      for (int i = 0; i < 4; i++)
        *(u32x2*)(XB + (size_t)t * 1024 + i * 256 + lane * 4) = (u32x2){pack2(v[i][0], v[i][1]), pack2(v[i][2], v[i][3])};
      if (lane == 0) RS1[t] = rs;
      float myd = dots[0];
#pragma unroll
      for (int h = 1; h < 8; h++) myd = (lane == h) ? dots[h] : myd;
      if (lane < 8) {
        float z = rs * myd + P.b_f[lane];
        float lf = fminf(z, 0.f) - log1pf(expf(-fabsf(z)));
        float* o = t < TP ? P.out + O_AF_P + (size_t)t * 8 : P.out + O_AF_S + (size_t)(t - TP) * 8;
        o[lane] = lf;
      }
    }
  }
}

DI void phase1_scans(const Params& P) {
  const int lane = threadIdx.x & 63;
  const int gw = blockIdx.x * 4 + (threadIdx.x >> 6), nw = gridDim.x * 4;
  float* CUMP = (float*)(P.ws + W_CUMP);
  float* CUMS = (float*)(P.ws + W_CUMS);
  for (int row = gw; row < 384; row += nw) {
    float carry = 0.f;
    if (row < 256) {
      int b = row >> 3, h = row & 7;
      const float* src = P.out + O_AF_P + (size_t)b * 2048 * 8 + h;
      for (int p0 = 0; p0 < 2048; p0 += 64) {
        float v = src[(size_t)(p0 + lane) * 8];
#pragma unroll
        for (int o = 1; o < 64; o <<= 1) { float n = __shfl_up(v, o); if (lane >= o) v += n; }
        v += carry;
        CUMP[(size_t)row * 2048 + p0 + lane] = v * LOG2E;
        carry = __shfl(v, 63);
      }
    } else {
      int rr = row - 256;
      int b = rr >> 3, h = rr & 7;
      const float* src = P.caf + (size_t)b * 4096 * 8 + h;
      for (int p0 = 0; p0 < 4096; p0 += 64) {
        float v = src[(size_t)(p0 + lane) * 8];
#pragma unroll
        for (int o = 1; o < 64; o <<= 1) { float n = __shfl_up(v, o); if (lane >= o) v += n; }
        v += carry;
        CUMS[(size_t)rr * 4112 + p0 + lane] = v * LOG2E;
        carry = __shfl(v, 63);
      }
      {
        float v = lane < 16 ? P.out[O_AF_S + (size_t)(b * 16 + lane) * 8 + h] : 0.f;
#pragma unroll
        for (int o = 1; o < 64; o <<= 1) { float n = __shfl_up(v, o); if (lane >= o) v += n; }
        v += carry;
        if (lane < 16) CUMS[(size_t)rr * 4112 + 4096 + lane] = v * LOG2E;
      }
    }
  }
}

DI void phase1_tile(const Params& P, int tile, char* smem) {
  const int tid = threadIdx.x, lane = tid & 63, w = tid >> 6, wm = w >> 1, wn = w & 1, r = lane & 15, quad = lane >> 4;
  const int mt = tile / 40, nt = tile % 40;
  const int m0 = mt * 128, n0 = nt * 128;
  char* ws = P.ws;
  f32x4 acc[4][4];
  zero_acc(acc);
  gemm_mainloop((const u16*)(ws + W_XB) + (size_t)m0 * 1024, 1024, (const u16*)(ws + W_WIN) + (size_t)n0 * 1024, 1024, 1024,
                (u16*)smem, acc);
  const int ncol0 = n0 + wn * 64;
  const bool sample = m0 >= TP;
  size_t rbase = (size_t)(m0 + wm * 64 + quad * 4);
  LAUNDER(rbase);
  const float* rsp = (const float*)(ws + W_RS1) + rbase;
  if (ncol0 < 3072) {
    const int seg = ncol0 >> 9, hc = ncol0 & 511;
    const bool normed = (seg != 2 && seg != 5);
    const float* gain = seg == 0 ? P.qn_a : seg == 1 ? P.kn_a : seg == 3 ? P.qn_b : P.kn_b;
    const float qs = (seg == 0 || seg == 3) ? 0.125f * LOG2E : 1.f;
    float gn[4];
#pragma unroll
    for (int ni = 0; ni < 4; ni++) gn[ni] = normed ? gain[ni * 16 + r] * qs : 1.f;
    u16* dp = (u16*)(ws + W_QKV + (size_t)seg * SZ_HALF) + rbase * 512 + hc + r;
    float* op = nullptr;
    if (seg == 1 || seg == 2) {
      op = sample ? P.out + (seg == 1 ? O_AK_S : O_AV_S) + (rbase - TP) * 512 : P.out + (seg == 1 ? O_AK_P : O_AV_P) + rbase * 512;
    } else if (seg == 4 || seg == 5) {
      if (sample) op = P.out + (seg == 4 ? O_BK_S : O_BV_S) + (rbase - TP) * 512;
      else if ((m0 & 2047) >= 1536) op = P.out + (seg == 4 ? O_BK_P : O_BV_P) + ((size_t)(m0 >> 11) * 512 + ((rbase & 2047) - 1536)) * 512;
    }
    if (op) op += hc + r;
#pragma unroll
    for (int mi = 0; mi < 4; mi++) {
#pragma unroll
      for (int j = 0; j < 4; j++) {
        const float rs = rsp[mi * 16 + j];
        float v[4];
#pragma unroll
        for (int ni = 0; ni < 4; ni++) v[ni] = acc[mi][ni][j] * rs;
        if (normed) {
          float ss = v[0] * v[0] + v[1] * v[1] + v[2] * v[2] + v[3] * v[3];
          ss += __shfl_xor(ss, 1);
          ss += __shfl_xor(ss, 2);
          ss += __shfl_xor(ss, 4);
          ss += __shfl_xor(ss, 8);
          float inv = rsqrtf(ss * (1.f / 64.f) + EPS);
#pragma unroll
          for (int ni = 0; ni < 4; ni++) v[ni] *= inv * gn[ni];
        }
#pragma unroll
        for (int ni = 0; ni < 4; ni++) dp[(mi * 16 + j) * 512 + ni * 16] = f2bf(v[ni]);
        if (op) {
#pragma unroll
          for (int ni = 0; ni < 4; ni++) op[(mi * 16 + j) * 512 + ni * 16] = v[ni];
        }
      }
    }
  } else {
    u16* dp = (ncol0 < 4096 ? (u16*)(ws + W_GA) + (ncol0 - 3072) : (u16*)(ws + W_GB) + (ncol0 - 4096)) + rbase * 1024 + r;
#pragma unroll
    for (int mi = 0; mi < 4; mi++) {
#pragma unroll
      for (int j = 0; j < 4; j++) {
        const float rs = rsp[mi * 16 + j];
#pragma unroll
        for (int ni = 0; ni < 4; ni++) dp[(mi * 16 + j) * 1024 + ni * 16] = f2bf(sigmoidf_(acc[mi][ni][j] * rs));
      }
    }
  }
}

constexpr int ASTR = 72;
constexpr int TAB_OFF = 36864;
struct AttnState { f32x4 o[4]; float m, l; };

DI s16x4 tr_read(const u16* p) {
  return __builtin_amdgcn_ds_read_tr16_b64_v4i16((__attribute__((address_space(3))) s16x4*)(p));
}

template <int MODE>
DI void attn_step(const u16* Ks, const u16* Vs, const bf16x8 (&qf)[2], AttnState& st, int kpos0, int qpos, int qlim,
                  float cq, const float* cum, const float* tab, bool domask) {
  const int lane = threadIdx.x & 63, r = lane & 15, quad = lane >> 4;
  f32x4 s[2];
#pragma unroll
  for (int t = 0; t < 2; t++) {
    f32x4 a4 = (f32x4){0.f, 0.f, 0.f, 0.f};
#pragma unroll
    for (int ks = 0; ks < 2; ks++) {
      bf16x8 kf = *(const bf16x8*)(Ks + (t * 16 + r) * ASTR + ks * 32 + quad * 8);
      a4 = mfma16(kf, qf[ks], a4);
    }
    s[t] = a4;
  }
#pragma unroll
  for (int t = 0; t < 2; t++) {
    const int kb = kpos0 + t * 16 + quad * 4;
    if (MODE == 0) {
      f32x4 c4 = *(const f32x4*)(cum + kb);
#pragma unroll
      for (int j = 0; j < 4; j++) s[t][j] += cq - c4[j];
    } else {
#pragma unroll
      for (int j = 0; j < 4; j++) {
        int rel = kb + j - qpos;
        rel = min(max(rel, -128), 128) + 128;
        s[t][j] += tab[rel];
      }
    }
    if (domask) {
#pragma unroll
      for (int j = 0; j < 4; j++)
        if (kb + j > qlim) s[t][j] = -1e30f;
    }
  }
  float mx = fmaxf(fmaxf(fmaxf(s[0][0], s[0][1]), fmaxf(s[0][2], s[0][3])), fmaxf(fmaxf(s[1][0], s[1][1]), fmaxf(s[1][2], s[1][3])));
  mx = fmaxf(mx, __shfl_xor(mx, 16));
  mx = fmaxf(mx, __shfl_xor(mx, 32));
  const float mn = fmaxf(st.m, mx);
  const float alpha = __builtin_amdgcn_exp2f(st.m - mn);
  float p[8];
  float ls = 0.f;
#pragma unroll
  for (int t = 0; t < 2; t++)
#pragma unroll
    for (int j = 0; j < 4; j++) { p[t * 4 + j] = __builtin_amdgcn_exp2f(s[t][j] - mn); ls += p[t * 4 + j]; }
  st.l = st.l * alpha + ls;
  st.m = mn;
#pragma unroll
  for (int dt = 0; dt < 4; dt++) st.o[dt] = st.o[dt] * alpha;
  u32x4 pk = (u32x4){pack2(p[0], p[1]), pack2(p[2], p[3]), pack2(p[4], p[5]), pack2(p[6], p[7])};
  bf16x8 pf = __builtin_bit_cast(bf16x8, pk);
  const int qq = (lane & 15) >> 2, pp = lane & 3;
#pragma unroll
  for (int dt = 0; dt < 4; dt++) {
    s16x4 lo = tr_read(Vs + (quad * 4 + qq) * ASTR + dt * 16 + pp * 4);
    s16x4 hi = tr_read(Vs + (16 + quad * 4 + qq) * ASTR + dt * 16 + pp * 4);
    bf16x8 vf = __builtin_shufflevector(lo, hi, 0, 1, 2, 3, 4, 5, 6, 7);
    st.o[dt] = mfma16(vf, pf, st.o[dt]);
  }
}

template <int MODE>
DI void attn_prompt_item(const Params& P, char* smem, int b, int h, int qt) {
  const int tid = threadIdx.x, lane = tid & 63, w = tid >> 6, r = lane & 15, quad = lane >> 4;
  char* ws = P.ws;
  const u16* Q = (const u16*)(ws + W_QKV + (size_t)(MODE == 0 ? 0 : 3) * SZ_HALF);
  const u16* Kg = (const u16*)(ws + W_QKV + (size_t)(MODE == 0 ? 1 : 4) * SZ_HALF);
  const u16* Vg = (const u16*)(ws + W_QKV + (size_t)(MODE == 0 ? 2 : 5) * SZ_HALF);
  u16* Y = (u16*)(ws + W_XB + (size_t)(MODE == 0 ? 0 : 1) * SZ_HALF);
  u16* Ks = (u16*)smem;
  u16* Vs = Ks + 64 * ASTR;
  float* tab = (float*)(smem + TAB_OFF);
  __syncthreads();
  if (MODE == 1) {
    for (int i = tid; i < 257; i += 256) tab[i] = P.relb[h * 257 + i] * LOG2E;
  }
  const int q0 = qt * 64;
  const int qpos = q0 + w * 16 + r;
  const size_t tokq = (size_t)b * 2048 + qpos;
  bf16x8 qf[2];
#pragma unroll
  for (int ks = 0; ks < 2; ks++) qf[ks] = *(const bf16x8*)(Q + tokq * 512 + h * 64 + ks * 32 + quad * 8);
  const float* cum = (const float*)(ws + W_CUMP) + (size_t)(b * 8 + h) * 2048;
  const float cq = MODE == 0 ? cum[qpos] : 0.f;
  AttnState st;
#pragma unroll
  for (int dt = 0; dt < 4; dt++) st.o[dt] = (f32x4){0.f, 0.f, 0.f, 0.f};
  st.m = -1e30f;
  st.l = 0.f;
  const int kt_lo = MODE == 0 ? 0 : max(0, qt - 8), kt_hi = qt;
  u32x4 rk[2], rv[2];
  const int lkey = tid >> 3, lch = tid & 7;
  const u16* kp = Kg + ((size_t)b * 2048 + lkey) * 512 + h * 64 + lch * 8;
  const u16* vp = Vg + ((size_t)b * 2048 + lkey) * 512 + h * 64 + lch * 8;
#pragma unroll
  for (int i = 0; i < 2; i++) {
    rk[i] = *(const u32x4*)(kp + (size_t)(kt_lo * 64 + i * 32) * 512);
    rv[i] = *(const u32x4*)(vp + (size_t)(kt_lo * 64 + i * 32) * 512);
  }
  for (int kt = kt_lo; kt <= kt_hi; kt++) {
    __syncthreads();
#pragma unroll
    for (int i = 0; i < 2; i++) {
      *(u32x4*)(Ks + (lkey + i * 32) * ASTR + lch * 8) = rk[i];
      *(u32x4*)(Vs + (lkey + i * 32) * ASTR + lch * 8) = rv[i];
    }
    __syncthreads();
    if (kt < kt_hi) {
#pragma unroll
      for (int i = 0; i < 2; i++) {
        rk[i] = *(const u32x4*)(kp + (size_t)((kt + 1) * 64 + i * 32) * 512);
        rv[i] = *(const u32x4*)(vp + (size_t)((kt + 1) * 64 + i * 32) * 512);
      }
    }
    const bool diag = (MODE == 0) && (kt == qt);
#pragma unroll
    for (int half = 0; half < 2; half++) {
      const int kpos0 = kt * 64 + half * 32;
      if (diag && kpos0 > q0 + w * 16 + 15) continue;
      attn_step<MODE>(Ks + half * 32 * ASTR, Vs + half * 32 * ASTR, qf, st, kpos0, qpos, qpos, cq, cum, tab, diag);
    }
  }
  float lt = st.l;
  lt += __shfl_xor(lt, 16);
  lt += __shfl_xor(lt, 32);
  const float inv = 1.f / lt;
#pragma unroll
  for (int dt = 0; dt < 4; dt++) {
    u32x2 o2 = (u32x2){pack2(st.o[dt][0] * inv, st.o[dt][1] * inv), pack2(st.o[dt][2] * inv, st.o[dt][3] * inv)};
    *(u32x2*)(Y + tokq * 512 + h * 64 + dt * 16 + quad * 4) = o2;
  }
}

template <int MODE>
DI void attn_sample_item(const Params& P, char* smem, int b, int h) {
  const int tid = threadIdx.x, lane = tid & 63, w = tid >> 6, r = lane & 15, quad = lane >> 4;
  constexpr int L = MODE == 0 ? 4096 : 512;
  char* ws = P.ws;
  const u16* Q = (const u16*)(ws + W_QKV + (size_t)(MODE == 0 ? 0 : 3) * SZ_HALF);
  const u16* Kn = (const u16*)(ws + W_QKV + (size_t)(MODE == 0 ? 1 : 4) * SZ_HALF);
  const u16* Vn = (const u16*)(ws + W_QKV + (size_t)(MODE == 0 ? 2 : 5) * SZ_HALF);
  u16* Y = (u16*)(ws + W_XB + (size_t)(MODE == 0 ? 0 : 1) * SZ_HALF);
  u16* Kw = (u16*)smem + w * (2 * 32 * ASTR);
  u16* Vw = Kw + 32 * ASTR;
  float* tab = (float*)(smem + TAB_OFF);
  __syncthreads();
  if (MODE == 1) {
    for (int i = tid; i < 257; i += 256) tab[i] = P.relb[h * 257 + i] * LOG2E;
  }
  __syncthreads();
  const float* ck = (MODE == 0 ? P.cak : P.cbk) + ((size_t)b * L * 8 + h) * 64;
  const float* cv = (MODE == 0 ? P.cav : P.cbv) + ((size_t)b * L * 8 + h) * 64;
  const size_t tokbase = (size_t)TP + b * 16;
  bf16x8 qf[2];
#pragma unroll
  for (int ks = 0; ks < 2; ks++) qf[ks] = *(const bf16x8*)(Q + (tokbase + r) * 512 + h * 64 + ks * 32 + quad * 8);
  const int qpos = L + r;
  const float* cum = (const float*)(ws + W_CUMS) + (size_t)(b * 8 + h) * 4112;
  const float cq = MODE == 0 ? cum[qpos] : 0.f;
  AttnState st;
#pragma unroll
  for (int dt = 0; dt < 4; dt++) st.o[dt] = (f32x4){0.f, 0.f, 0.f, 0.f};
  st.m = -1e30f;
  st.l = 0.f;
  const int kbeg = w * (L / 4), kend = kbeg + L / 4;
  for (int k0 = kbeg; k0 < kend; k0 += 32) {
    {
      f32x4 kr[8];
#pragma unroll
      for (int i = 0; i < 8; i++) kr[i] = *(const f32x4*)(ck + (size_t)(k0 + i * 4 + quad) * 512 + r * 4);
#pragma unroll
      for (int i = 0; i < 8; i++)
        *(u32x2*)(Kw + (i * 4 + quad) * ASTR + r * 4) = (u32x2){pack2(kr[i][0], kr[i][1]), pack2(kr[i][2], kr[i][3])};
    }
    {
      f32x4 vr[8];
#pragma unroll
      for (int i = 0; i < 8; i++) vr[i] = *(const f32x4*)(cv + (size_t)(k0 + i * 4 + quad) * 512 + r * 4);
#pragma unroll
      for (int i = 0; i < 8; i++)
        *(u32x2*)(Vw + (i * 4 + quad) * ASTR + r * 4) = (u32x2){pack2(vr[i][0], vr[i][1]), pack2(vr[i][2], vr[i][3])};
    }
    asm volatile("s_waitcnt lgkmcnt(0)" ::: "memory");
    __builtin_amdgcn_wave_barrier();
    attn_step<MODE>(Kw, Vw, qf, st, k0, qpos, qpos, cq, cum, tab, false);
    __builtin_amdgcn_wave_barrier();
  }
  if (w == 0) {
#pragma unroll
    for (int i = 0; i < 2; i++) {
      int c = lane + i * 64;
      int key = c >> 3, ch = c & 7;
      u32x4 kk = *(const u32x4*)(Kn + (tokbase + key) * 512 + h * 64 + ch * 8);
      u32x4 vv = *(const u32x4*)(Vn + (tokbase + key) * 512 + h * 64 + ch * 8);
      *(u32x4*)(Kw + key * ASTR + ch * 8) = kk;
      *(u32x4*)(Vw + key * ASTR + ch * 8) = vv;
      *(u32x4*)(Kw + (16 + key) * ASTR + ch * 8) = (u32x4){0u, 0u, 0u, 0u};
      *(u32x4*)(Vw + (16 + key) * ASTR + ch * 8) = (u32x4){0u, 0u, 0u, 0u};
    }
    asm volatile("s_waitcnt lgkmcnt(0)" ::: "memory");
    __builtin_amdgcn_wave_barrier();
    attn_step<MODE>(Kw, Vw, qf, st, L, qpos, MODE == 0 ? qpos : L + 15, cq, cum, tab, true);
  }
  __syncthreads();
  float* comb = (float*)smem;
  float lt = st.l;
  lt += __shfl_xor(lt, 16);
  lt += __shfl_xor(lt, 32);
#pragma unroll
  for (int dt = 0; dt < 4; dt++)
#pragma unroll
    for (int j = 0; j < 4; j++) comb[(w * 16 + r) * 68 + dt * 16 + quad * 4 + j] = st.o[dt][j];
  if (quad == 0) {
    comb[(w * 16 + r) * 68 + 64] = st.m;
    comb[(w * 16 + r) * 68 + 65] = lt;
  }
  __syncthreads();
  if (w == 0) {
    float mw[4], M = -1e30f;
#pragma unroll
    for (int i = 0; i < 4; i++) { mw[i] = comb[(i * 16 + r) * 68 + 64]; M = fmaxf(M, mw[i]); }
    float Ls = 0.f, scl[4];
#pragma unroll
    for (int i = 0; i < 4; i++) { scl[i] = __builtin_amdgcn_exp2f(mw[i] - M); Ls += scl[i] * comb[(i * 16 + r) * 68 + 65]; }
    const float inv = 1.f / Ls;
#pragma unroll
    for (int dt = 0; dt < 4; dt++) {
      float ov[4];
#pragma unroll
      for (int j = 0; j < 4; j++) {
        float a = 0.f;
#pragma unroll
        for (int i = 0; i < 4; i++) a += scl[i] * comb[(i * 16 + r) * 68 + dt * 16 + quad * 4 + j];
        ov[j] = a * inv;
      }
      *(u32x2*)(Y + (tokbase + r) * 512 + h * 64 + dt * 16 + quad * 4) = (u32x2){pack2(ov[0], ov[1]), pack2(ov[2], ov[3])};
    }
  }
}

DI void phase2(const Params& P, char* smem) {
  constexpr int N_SA = 128, N_PA = 8192, N_PB = 8192, N_SB = 128;
  for (int it = blockIdx.x; it < N_SA + N_PA + N_PB + N_SB; it += gridDim.x) {
    int u = it;
    if (u < N_SA) { attn_sample_item<0>(P, smem, u >> 3, u & 7); continue; }
    u -= N_SA;
    if (u < N_PA) { int qt = 31 - (u >> 8), bh = u & 255; attn_prompt_item<0>(P, smem, bh >> 3, bh & 7, qt); continue; }
    u -= N_PA;
    if (u < N_PB) { int qt = 31 - (u >> 8), bh = u & 255; attn_prompt_item<1>(P, smem, bh >> 3, bh & 7, qt); continue; }
    u -= N_PB;
    attn_sample_item<1>(P, smem, u >> 3, u & 7);
  }
}

DI void phase3_tile(const Params& P, int tile, char* smem) {
  const int tid = threadIdx.x, lane = tid & 63, w = tid >> 6, wm = w >> 1, wn = w & 1, r = lane & 15, quad = lane >> 4;
  const int mt = tile >> 3, nt = tile & 7;
  const int m0 = mt * 128, n0 = nt * 128;
  char* ws = P.ws;
  const u16* YA = (const u16*)(ws + W_XB);
  const u16* YB = YA + (size_t)TT * 512;
  const u16* GA = (const u16*)(ws + W_GA);
  const u16* GB = (const u16*)(ws + W_GB);
  u16* MRG = (u16*)(ws + W_QKV);
  f32x4 acc[4][4];
  zero_acc(acc);
  gemm_mainloop(YA + (size_t)m0 * 512, 512, (const u16*)(ws + W_WUPA) + (size_t)n0 * 512, 512, 512, (u16*)smem, acc);
  size_t lofs = (size_t)(m0 + wm * 64 + quad * 4) * 1024 + n0 + wn * 64 + r;
  LAUNDER(lofs);
  {
    const u16* gp = GA + lofs;
    u16* mp = MRG + lofs;
#pragma unroll
    for (int mi = 0; mi < 4; mi++) {
#pragma unroll
      for (int j = 0; j < 4; j++)
#pragma unroll
        for (int ni = 0; ni < 4; ni++)
          mp[(mi * 16 + j) * 1024 + ni * 16] = f2bf(acc[mi][ni][j] * bf2f(gp[(mi * 16 + j) * 1024 + ni * 16]));
      __builtin_amdgcn_sched_barrier(0);
    }
  }
  zero_acc(acc);
  gemm_mainloop(YB + (size_t)m0 * 512, 512, (const u16*)(ws + W_WUPB) + (size_t)n0 * 512, 512, 512, (u16*)smem, acc);
  {
    LAUNDER(lofs);
    const u16* gp = GB + lofs;
    u16* mp = MRG + lofs;
#pragma unroll
    for (int mi = 0; mi < 4; mi++) {
#pragma unroll
      for (int j = 0; j < 4; j++)
#pragma unroll
        for (int ni = 0; ni < 4; ni++) {
          float m = bf2f(mp[(mi * 16 + j) * 1024 + ni * 16]) + acc[mi][ni][j] * bf2f(gp[(mi * 16 + j) * 1024 + ni * 16]);
          mp[(mi * 16 + j) * 1024 + ni * 16] = f2bf(m);
        }
      __builtin_amdgcn_sched_barrier(0);
    }
  }
}

DI void phase4_tile(const Params& P, int tile, char* smem) {
  const int tid = threadIdx.x, lane = tid & 63, w = tid >> 6, wm = w >> 1, wn = w & 1, r = lane & 15, quad = lane >> 4;
  const int mt = tile >> 3, nt = tile & 7;
  const int m0 = mt * 128, n0 = nt * 128;
  char* ws = P.ws;
  const u16* MRG = (const u16*)(ws + W_QKV);
  u16* H1B = (u16*)(ws + W_QKV + SZ_ACT);
  float* SSQ2 = (float*)(ws + W_SSQ2);
  f32x4 acc[4][4];
  zero_acc(acc);
  gemm_mainloop(MRG + (size_t)m0 * 1024, 1024, (const u16*)(ws + W_WOUT) + (size_t)n0 * 1024, 1024, 1024, (u16*)smem, acc);
  const float* xb = m0 < TP ? P.x_p : P.x_s - (size_t)TP * 1024;
  size_t rbase = (size_t)(m0 + wm * 64 + quad * 4);
  LAUNDER(rbase);
  const size_t lofs = rbase * 1024 + n0 + wn * 64 + r;
  const float* xp = xb + lofs;
  float* op = P.out + lofs;
  u16* hp = H1B + lofs;
  float* sp = SSQ2 + rbase * 16 + nt * 2 + wn;
#pragma unroll
  for (int mi = 0; mi < 4; mi++) {
#pragma unroll
    for (int j = 0; j < 4; j++) {
      float ss = 0.f;
#pragma unroll
      for (int ni = 0; ni < 4; ni++) {
        const int o = (mi * 16 + j) * 1024 + ni * 16;
        float h1 = xp[o] + acc[mi][ni][j];
        op[o] = h1;
        hp[o] = f2bf(h1);
        ss += h1 * h1;
      }
      ss += __shfl_xor(ss, 1);
      ss += __shfl_xor(ss, 2);
      ss += __shfl_xor(ss, 4);
      ss += __shfl_xor(ss, 8);
      if (r == 0) sp[(mi * 16 + j) * 16] = ss;
    }
    __builtin_amdgcn_sched_barrier(0);
  }
}

DI void phase5_tile(const Params& P, int tile, char* smem) {
  const int tid = threadIdx.x, lane = tid & 63, w = tid >> 6, wm = w >> 1, wn = w & 1, r = lane & 15, quad = lane >> 4;
  const int mt = tile >> 3, nt = tile & 7;
  const int m0 = mt * 128, n0 = nt * 128;
  char* ws = P.ws;
  const u16* H1B = (const u16*)(ws + W_QKV + SZ_ACT);
  u16* QP = (u16*)(ws + W_QKV + 2 * SZ_ACT);
  const float* SSQ2 = (const float*)(ws + W_SSQ2);
  float* rs_s = (float*)(smem + 2 * 128 * GSTR * 2);
  __syncthreads();
  if (tid < 128) {
    float s = 0.f;
#pragma unroll
    for (int i = 0; i < 16; i++) s += SSQ2[(size_t)(m0 + tid) * 16 + i];
    rs_s[tid] = rsqrtf(s * (1.f / 1024.f) + EPS);
  }
  f32x4 acc[4][4];
  zero_acc(acc);
  gemm_mainloop(H1B + (size_t)m0 * 1024, 1024, (const u16*)(ws + W_WQ) + (size_t)n0 * 1024, 1024, 1024, (u16*)smem, acc);
  size_t lofs = (size_t)(m0 + wm * 64 + quad * 4) * 1024 + n0 + wn * 64 + r;
  LAUNDER(lofs);
  u16* qp = QP + lofs;
#pragma unroll
  for (int mi = 0; mi < 4; mi++)
#pragma unroll
    for (int j = 0; j < 4; j++) {
      const float rs = rs_s[wm * 64 + mi * 16 + quad * 4 + j];
#pragma unroll
      for (int ni = 0; ni < 4; ni++) qp[(mi * 16 + j) * 1024 + ni * 16] = f2bf(acc[mi][ni][j] * rs);
    }
}

DI void phase6a_unit(const Params& P, int unit, char* smem) {
  const int tid = threadIdx.x, lane = tid & 63, w = tid >> 6, r = lane & 15, quad = lane >> 4;
  char* ws = P.ws;
  const u16* QP = (const u16*)(ws + W_QKV + 2 * SZ_ACT);
  const u16* SK = (const u16*)(ws + W_SK);
  u32x2* SEL = (u32x2*)(ws + W_GA);
  float* sc = (float*)smem;
  u32* lists = (u32*)(smem + 128 * 129 * 4);
  unsigned char* tabi = (unsigned char*)(smem + 128 * 129 * 4 + 128 * 17 * 4);
  unsigned char* tabj = tabi + 64;
  const int tok0 = unit * 64;
  __syncthreads();
  if (tid == 0) {
    int s = 0;
    for (int i = 0; i < 16; i++)
      for (int j = 0; j < 16; j++)
        if ((i + 1) * (j + 1) <= 16) { tabi[s] = (unsigned char)i; tabj[s] = (unsigned char)j; s++; }
  }
  for (int h = 0; h < 8; h++) {
#pragma unroll
    for (int p = 0; p < 2; p++) {
      const int hp = h * 2 + p;
      bf16x8 qf[2];
#pragma unroll
      for (int ks = 0; ks < 2; ks++)
        qf[ks] = *(const bf16x8*)(QP + (size_t)(tok0 + w * 16 + r) * 1024 + hp * 64 + ks * 32 + quad * 8);
#pragma unroll
      for (int nt = 0; nt < 8; nt++) {
        f32x4 a4 = (f32x4){0.f, 0.f, 0.f, 0.f};
#pragma unroll
        for (int ks = 0; ks < 2; ks++) {
          bf16x8 kf = *(const bf16x8*)(SK + (size_t)(hp * 128 + nt * 16 + r) * 64 + ks * 32 + quad * 8);
          a4 = mfma16(kf, qf[ks], a4);
        }
        float* d = sc + (p * 64 + w * 16 + r) * 129 + nt * 16 + quad * 4;
        d[0] = a4[0]; d[1] = a4[1]; d[2] = a4[2]; d[3] = a4[3];
      }
    }
    __syncthreads();
    if (tid < 128) {
      u32 L[16];
#pragma unroll
      for (int s = 0; s < 16; s++) L[s] = 0u;
      const float* row = sc + tid * 129;
#pragma unroll 4
      for (int i = 0; i < 128; i++) {
        u32 k = (mono(row[i]) & ~127u) | (u32)i;
        insert16(L, k);
      }
#pragma unroll
      for (int s = 0; s < 16; s++) lists[tid * 17 + s] = L[s];
    }
    __syncthreads();
    if (tid < 64) {
      u32 a[16], bq[16];
      float fa[16], fb[16];
#pragma unroll
      for (int s = 0; s < 16; s++) {
        a[s] = lists[tid * 17 + s];
        bq[s] = lists[(64 + tid) * 17 + s];
        fa[s] = unmono(a[s] & ~127u);
        fb[s] = unmono(bq[s] & ~127u);
      }
      u32 L2[16];
#pragma unroll
      for (int s = 0; s < 16; s++) L2[s] = 0u;
      {
        int slot = 0;
#pragma unroll
        for (int i = 0; i < 16; i++)
#pragma unroll
          for (int j = 0; j < 16; j++)
            if ((i + 1) * (j + 1) <= 16) {
              float sum = fa[i] + fb[j];
              u32 key = (mono(sum) & ~63u) | (u32)slot;
              slot++;
              insert16(L2, key);
            }
      }
      float val[16];
      u32 idx[16];
      float mx = -1e30f;
#pragma unroll
      for (int s = 0; s < 16; s++) {
        u32 sl = L2[s] & 63u;
        int i = tabi[sl], j = tabj[sl];
        u32 au = lists[tid * 17 + i], bu = lists[(64 + tid) * 17 + j];
        val[s] = unmono(au & ~127u) + unmono(bu & ~127u);
        idx[s] = (au & 127u) * 128u + (bu & 127u);
        mx = fmaxf(mx, val[s]);
      }
      float sum = 0.f;
#pragma unroll
      for (int s = 0; s < 16; s++) { val[s] = __expf(val[s] - mx); sum += val[s]; }
      const float inv = 1.f / sum;
      u32x2* dst = SEL + ((size_t)(tok0 + tid) * 8 + h) * 16;
#pragma unroll
      for (int s = 0; s < 16; s++) dst[s] = (u32x2){idx[s], __float_as_uint(val[s] * inv)};
    }
  }
}

typedef float f32x2 __attribute__((ext_vector_type(2)));
DI float dot4_fp8(u32 w, float x0, float x1, float x2, float x3, float acc) {
  f32x2 lo = __builtin_amdgcn_cvt_pk_f32_fp8((int)w, false);
  f32x2 hi = __builtin_amdgcn_cvt_pk_f32_fp8((int)w, true);
  acc = fmaf(lo[0], x0, acc);
  acc = fmaf(lo[1], x1, acc);
  acc = fmaf(hi[0], x2, acc);
  acc = fmaf(hi[1], x3, acc);
  return acc;
}
DI void axpy4_fp8(u32 w, float wgt, float& o0, float& o1, float& o2, float& o3) {
  f32x2 lo = __builtin_amdgcn_cvt_pk_f32_fp8((int)w, false);
  f32x2 hi = __builtin_amdgcn_cvt_pk_f32_fp8((int)w, true);
  o0 = fmaf(wgt, lo[0], o0);
  o1 = fmaf(wgt, lo[1], o1);
  o2 = fmaf(wgt, hi[0], o2);
  o3 = fmaf(wgt, hi[1], o3);
}

DI void phase6b(const Params& P) {
  const int lane = threadIdx.x & 63;
  const int gw = blockIdx.x * 4 + (threadIdx.x >> 6), nw = gridDim.x * 4;
  char* ws = P.ws;
  u16* H1B = (u16*)(ws + W_QKV + SZ_ACT);
  const unsigned char* U8 = (const unsigned char*)(ws + W_UB);
  const unsigned char* V8 = (const unsigned char*)(ws + W_VB);
  const u32x2* SEL = (const u32x2*)(ws + W_GA);
  const float* SSQ2 = (const float*)(ws + W_SSQ2);
  float* RS3 = (float*)(ws + W_RS3);
  for (int t = gw; t < TT; t += nw) {
    float ssq = lane < 16 ? SSQ2[(size_t)t * 16 + lane] : 0.f;
    ssq = wave_sum(ssq);
    const float rs2 = rsqrtf(ssq * (1.f / 1024.f) + EPS);
    float xf[16];
    {
      const u32x4 xa = *(const u32x4*)(H1B + (size_t)t * 1024 + lane * 16);
      const u32x4 xb = *(const u32x4*)(H1B + (size_t)t * 1024 + lane * 16 + 8);
      xf[0] = __uint_as_float(xa.x << 16); xf[1] = __uint_as_float(xa.x & 0xffff0000u);
      xf[2] = __uint_as_float(xa.y << 16); xf[3] = __uint_as_float(xa.y & 0xffff0000u);
      xf[4] = __uint_as_float(xa.z << 16); xf[5] = __uint_as_float(xa.z & 0xffff0000u);
      xf[6] = __uint_as_float(xa.w << 16); xf[7] = __uint_as_float(xa.w & 0xffff0000u);
      xf[8] = __uint_as_float(xb.x << 16); xf[9] = __uint_as_float(xb.x & 0xffff0000u);
      xf[10] = __uint_as_float(xb.y << 16); xf[11] = __uint_as_float(xb.y & 0xffff0000u);
      xf[12] = __uint_as_float(xb.z << 16); xf[13] = __uint_as_float(xb.z & 0xffff0000u);
      xf[14] = __uint_as_float(xb.w << 16); xf[15] = __uint_as_float(xb.w & 0xffff0000u);
    }
    const u32x2 e0 = SEL[(size_t)t * 128 + lane];
    const u32x2 e1 = SEL[(size_t)t * 128 + 64 + lane];
    float wv[2];
#pragma unroll
    for (int rd = 0; rd < 2; rd++) {
      const int idxv = (int)(rd ? e1.x : e0.x);
      float p[64];
#pragma unroll
      for (int c = 0; c < 8; c++) {
        u32x4 ua[8];
#pragma unroll
        for (int i = 0; i < 8; i++) {
          int e = __builtin_amdgcn_readlane(idxv, c * 8 + i);
          ua[i] = *(const u32x4*)(U8 + (size_t)e * 1024 + lane * 16);
        }
#pragma unroll
        for (int i = 0; i < 8; i++) {
          float a = dot4_fp8(ua[i].x, xf[0], xf[1], xf[2], xf[3], 0.f);
          a = dot4_fp8(ua[i].y, xf[4], xf[5], xf[6], xf[7], a);
          a = dot4_fp8(ua[i].z, xf[8], xf[9], xf[10], xf[11], a);
          a = dot4_fp8(ua[i].w, xf[12], xf[13], xf[14], xf[15], a);
          p[c * 8 + i] = a;
        }
      }
#pragma unroll
      for (int i = 0; i < 32; i++) { float keep = (lane & 32) ? p[i + 32] : p[i]; float send = (lane & 32) ? p[i] : p[i + 32]; p[i] = keep + __shfl_xor(send, 32); }
#pragma unroll
      for (int i = 0; i < 16; i++) { float keep = (lane & 16) ? p[i + 16] : p[i]; float send = (lane & 16) ? p[i] : p[i + 16]; p[i] = keep + __shfl_xor(send, 16); }
#pragma unroll
      for (int i = 0; i < 8; i++) { float keep = (lane & 8) ? p[i + 8] : p[i]; float send = (lane & 8) ? p[i] : p[i + 8]; p[i] = keep + __shfl_xor(send, 8); }
#pragma unroll
      for (int i = 0; i < 4; i++) { float keep = (lane & 4) ? p[i + 4] : p[i]; float send = (lane & 4) ? p[i] : p[i + 4]; p[i] = keep + __shfl_xor(send, 4); }
#pragma unroll
      for (int i = 0; i < 2; i++) { float keep = (lane & 2) ? p[i + 2] : p[i]; float send = (lane & 2) ? p[i] : p[i + 2]; p[i] = keep + __shfl_xor(send, 2); }
      { float keep = (lane & 1) ? p[1] : p[0]; float send = (lane & 1) ? p[0] : p[1]; p[0] = keep + __shfl_xor(send, 1); }
      const float g = __uint_as_float(rd ? e1.y : e0.y);
      wv[rd] = g * gelu_tanh(rs2 * (1.f / U_SCALE) * p[0]) * (1.f / V_SCALE);
    }
    float oacc[16];
#pragma unroll
    for (int i = 0; i < 16; i++) oacc[i] = 0.f;
#pragma unroll
    for (int rd = 0; rd < 2; rd++) {
      const int idxv = (int)(rd ? e1.x : e0.x);
      const int wbits = (int)__float_as_uint(wv[rd]);
#pragma unroll
      for (int c = 0; c < 8; c++) {
        u32x4 va[8];
#pragma unroll
        for (int i = 0; i < 8; i++) {
          int e = __builtin_amdgcn_readlane(idxv, c * 8 + i);
          va[i] = *(const u32x4*)(V8 + (size_t)e * 1024 + lane * 16);
        }
#pragma unroll
        for (int i = 0; i < 8; i++) {
          const float wgt = __uint_as_float((u32)__builtin_amdgcn_readlane(wbits, c * 8 + i));
          axpy4_fp8(va[i].x, wgt, oacc[0], oacc[1], oacc[2], oacc[3]);
          axpy4_fp8(va[i].y, wgt, oacc[4], oacc[5], oacc[6], oacc[7]);
          axpy4_fp8(va[i].z, wgt, oacc[8], oacc[9], oacc[10], oacc[11]);
          axpy4_fp8(va[i].w, wgt, oacc[12], oacc[13], oacc[14], oacc[15]);
        }
      }
    }
    float* hrow = P.out + (size_t)t * 1024 + lane * 16;
    float ss = 0.f;
    float h2[16];
#pragma unroll
    for (int i = 0; i < 4; i++) {
      f32x4 hv = *(const f32x4*)(hrow + i * 4);
      h2[i * 4 + 0] = hv.x + oacc[i * 4 + 0];
      h2[i * 4 + 1] = hv.y + oacc[i * 4 + 1];
      h2[i * 4 + 2] = hv.z + oacc[i * 4 + 2];
      h2[i * 4 + 3] = hv.w + oacc[i * 4 + 3];
#pragma unroll
      for (int c = 0; c < 4; c++) ss += h2[i * 4 + c] * h2[i * 4 + c];
      *(f32x4*)(hrow + i * 4) = (f32x4){h2[i * 4], h2[i * 4 + 1], h2[i * 4 + 2], h2[i * 4 + 3]};
    }
    *(u32x4*)(H1B + (size_t)t * 1024 + lane * 16) = (u32x4){pack2(h2[0], h2[1]), pack2(h2[2], h2[3]), pack2(h2[4], h2[5]), pack2(h2[6], h2[7])};
    *(u32x4*)(H1B + (size_t)t * 1024 + lane * 16 + 8) = (u32x4){pack2(h2[8], h2[9]), pack2(h2[10], h2[11]), pack2(h2[12], h2[13]), pack2(h2[14], h2[15])};
    ss = wave_sum(ss);
    if (lane == 0) RS3[t] = rsqrtf(ss * (1.f / 1024.f) + EPS);
  }
}

DI void phase7_tile(const Params& P, int tile, char* smem) {
  const int tid = threadIdx.x, lane = tid & 63, w = tid >> 6, wm = w >> 1, wn = w & 1, r = lane & 15, quad = lane >> 4;
  const int mt = tile >> 3, nt = tile & 7;
  const int m0 = mt * 128, n0 = nt * 128;
  char* ws = P.ws;
  const u16* H2B = (const u16*)(ws + W_QKV + SZ_ACT);
  const u16* PB = (const u16*)(ws + W_PB);
  const float* RS3 = (const float*)(ws + W_RS3);
  u16* PJ = (u16*)(ws + W_QKV);
  f32x4 acc[4][4];
  zero_acc(acc);
  gemm_mainloop(PB + (size_t)m0 * 256, 256, (const u16*)(ws + W_WPP) + (size_t)n0 * 256, 256, 256, (u16*)smem, acc);
  size_t rbase7 = (size_t)(m0 + wm * 64 + quad * 4);
  LAUNDER(rbase7);
  {
    u16* pj = PJ + rbase7 * 1024 + n0 + wn * 64 + r;
#pragma unroll
    for (int mi = 0; mi < 4; mi++)
#pragma unroll
      for (int j = 0; j < 4; j++)
#pragma unroll
        for (int ni = 0; ni < 4; ni++) pj[(mi * 16 + j) * 1024 + ni * 16] = f2bf(acc[mi][ni][j]);
  }
  zero_acc(acc);
  gemm_mainloop(H2B + (size_t)m0 * 1024, 1024, (const u16*)(ws + W_WG) + (size_t)n0 * 1024, 1024, 1024, (u16*)smem, acc);
  LAUNDER(rbase7);
  float* op = P.out + rbase7 * 1024 + n0 + wn * 64 + r;
  const u16* pj = PJ + rbase7 * 1024 + n0 + wn * 64 + r;
  const float* rp = RS3 + rbase7;
#pragma unroll
  for (int mi = 0; mi < 4; mi++) {
#pragma unroll
    for (int j = 0; j < 4; j++) {
      const float rs = rp[mi * 16 + j];
#pragma unroll
      for (int ni = 0; ni < 4; ni++) {
        const int o = (mi * 16 + j) * 1024 + ni * 16;
        float h2 = op[o];
        op[o] = h2 + sigmoidf_(rs * acc[mi][ni][j]) * bf2f(pj[o]);
      }
    }
    __builtin_amdgcn_sched_barrier(0);
  }
}

__global__ void __launch_bounds__(256, 2) fwd_megakernel(Params P) {
  __shared__ __attribute__((aligned(16))) char smem[SMEM_BYTES];
  cg::grid_group grid = cg::this_grid();
  phase0(P, smem);
  grid.sync();
  phase1_scans(P);
  for (int t = blockIdx.x; t < 514 * 40; t += gridDim.x) phase1_tile(P, t, smem);
  grid.sync();
  phase2(P, smem);
  grid.sync();
  for (int t = blockIdx.x; t < 514 * 8; t += gridDim.x) phase3_tile(P, t, smem);
  grid.sync();
  for (int t = blockIdx.x; t < 514 * 8; t += gridDim.x) phase4_tile(P, t, smem);
  grid.sync();
  for (int t = blockIdx.x; t < 514 * 8; t += gridDim.x) phase5_tile(P, t, smem);
  grid.sync();
  for (int t = blockIdx.x; t < TT / 64; t += gridDim.x) phase6a_unit(P, t, smem);
  grid.sync();
  phase6b(P);
  grid.sync();
  for (int t = blockIdx.x; t < 514 * 8; t += gridDim.x) phase7_tile(P, t, smem);
}

extern "C" void kernel_launch(void* const* d_in, const int* in_sizes, int n_in, void* d_out, int out_size, void* d_ws,
                              size_t ws_size, hipStream_t stream) {
  static int grid_blocks = 0;
  if (!grid_blocks) {
    int dev = 0, cus = 0, per_cu = 0;
    hipGetDevice(&dev);
    hipDeviceGetAttribute(&cus, hipDeviceAttributeMultiprocessorCount, dev);
    hipOccupancyMaxActiveBlocksPerMultiprocessor(&per_cu, fwd_megakernel, 256, 0);
    if (per_cu > 2) per_cu = 2;
    if (per_cu < 1) per_cu = 1;
    grid_blocks = cus * per_cu;
  }
  if (ws_size < W_END) { fprintf(stderr, "workspace too small: %zu < %zu\n", ws_size, (size_t)W_END); return; }
  Params p{};
  const float** pf = (const float**)&p;
  for (int i = 0; i < 28; i++) pf[i] = (const float*)d_in[i];
  p.out = (float*)d_out;
  p.ws = (char*)d_ws;
  void* args[] = {&p};
  hipError_t e = hipLaunchCooperativeKernel((void*)fwd_megakernel, dim3(grid_blocks), dim3(256), args, 0, stream);
  if (e != hipSuccess) fprintf(stderr, "cooperative launch failed: %s (grid %d)\n", hipGetErrorString(e), grid_blocks);
}
```

```cpp
#include <hip/hip_runtime.h>
#include <hip/hip_cooperative_groups.h>
#include <cstdio>
namespace cg = cooperative_groups;

typedef unsigned short u16;
typedef unsigned int u32;
typedef short bf16x8 __attribute__((ext_vector_type(8)));
typedef short s16x4 __attribute__((ext_vector_type(4)));
typedef float f32x4 __attribute__((ext_vector_type(4)));
typedef unsigned int u32x4 __attribute__((ext_vector_type(4)));
typedef unsigned int u32x2 __attribute__((ext_vector_type(2)));
typedef __bf16 bf16x2_t __attribute__((ext_vector_type(2)));

#define DI __device__ __forceinline__
#define LAUNDER(x) asm volatile("" : "+v"(x))

constexpr int TP = 65536, TS = 256, TT = TP + TS;
constexpr float LOG2E = 1.4426950408889634f;
constexpr float EPS = 1e-6f;
constexpr float U_SCALE = 1024.f, V_SCALE = 128.f;

constexpr size_t O_AK_P = 67371008, O_AV_P = 100925440, O_AF_P = 134479872, O_BK_P = 135004160,
                 O_BV_P = 143392768, O_AK_S = 151781376, O_AV_S = 151912448, O_AF_S = 152043520,
                 O_BK_S = 152045568, O_BV_S = 152176640;

constexpr size_t SZ_ACT = (size_t)TT * 1024 * 2;
constexpr size_t SZ_HALF = (size_t)TT * 512 * 2;
constexpr size_t W_XB = 0;
constexpr size_t W_QKV = SZ_ACT;
constexpr size_t W_GA = W_QKV + 6 * SZ_HALF;
constexpr size_t W_GB = W_GA + SZ_ACT;
constexpr size_t W_PB = W_GB + SZ_ACT;
constexpr size_t W_WIN = W_PB + (size_t)TT * 256 * 2;
constexpr size_t W_WUPA = W_WIN + (size_t)5120 * 1024 * 2;
constexpr size_t W_WUPB = W_WUPA + 1024 * 512 * 2;
constexpr size_t W_WOUT = W_WUPB + 1024 * 512 * 2;
constexpr size_t W_WQ = W_WOUT + 1024 * 1024 * 2;
constexpr size_t W_WG = W_WQ + 1024 * 1024 * 2;
constexpr size_t W_WPP = W_WG + 1024 * 1024 * 2;
constexpr size_t W_UB = W_WPP + 1024 * 256 * 2;
constexpr size_t W_VB = W_UB + (size_t)16384 * 1024 * 2;
constexpr size_t W_SK = W_VB + (size_t)16384 * 1024 * 2;
constexpr size_t W_RS1 = W_SK + 131072 * 2;
constexpr size_t W_SSQ2 = W_RS1 + (size_t)TT * 4;
constexpr size_t W_RS3 = W_SSQ2 + (size_t)TT * 64;
constexpr size_t W_CUMP = W_RS3 + (size_t)TT * 4;
constexpr size_t W_CUMS = W_CUMP + (size_t)256 * 2048 * 4;
constexpr size_t W_SSQ3 = W_CUMS + (size_t)128 * 4112 * 4 + 1024;
constexpr size_t W_END = W_SSQ3 + (size_t)TT * 8 * 4;
constexpr size_t W_IDX = W_GA;
constexpr size_t W_G = W_GA + (size_t)32 * 1024 * 1024;
constexpr size_t SZ_PH = (size_t)TT * 128 * 4;


struct Params {
  const float *x_p, *x_s, *cak, *cav, *caf, *cbk, *cbv, *p_p, *p_s, *g_mix, *w_in, *b_f, *qn_a, *kn_a,
      *qn_b, *kn_b, *relb, *w_up_a, *w_up_b, *w_out, *g_ffn, *peer_wq, *peer_sk, *peer_u, *peer_v, *g_ple,
      *w_gate, *w_proj;
  float* out;
  char* ws;
};

constexpr int SMEM_BYTES = 128 * 129 * 4 + 2 * 64 * 17 * 4 + 256;

DI float* ph_slice(char* ws, int x) { return (float*)(ws + (x < 4 ? W_XB + (size_t)x * SZ_PH : W_GB + (size_t)(x - 4) * SZ_PH)); }
DI u16 f2bf(float x) { u32 u = __float_as_uint(x); u += 0x7fffu + ((u >> 16) & 1u); return (u16)(u >> 16); }
DI float bf2f(u16 h) { return __uint_as_float(((u32)h) << 16); }
DI u32 pack2(float a, float b) { return (u32)f2bf(a) | ((u32)f2bf(b) << 16); }
DI float wave_sum(float v) {
#pragma unroll
  for (int o = 32; o; o >>= 1) v += __shfl_xor(v, o);
  return v;
}
DI f32x4 mfma16(bf16x8 a, bf16x8 b, f32x4 c) { return __builtin_amdgcn_mfma_f32_16x16x32_bf16(a, b, c, 0, 0, 0); }
DI float sigmoidf_(float x) { return 1.f / (1.f + __expf(-x)); }
DI u32 mono(float x) { u32 u = __float_as_uint(x); u32 m = (u32)((int)u >> 31) | 0x80000000u; return u ^ m; }
DI float unmono(u32 k) { u32 m = ((k >> 31) - 1u) | 0x80000000u; return __uint_as_float(k ^ m); }
DI void insert16(u32 (&L)[16], u32 x) {
#pragma unroll
  for (int s = 0; s < 16; s++) { u32 mx = max(L[s], x); x = min(L[s], x); L[s] = mx; }
}
DI float gelu_tanh(float x) {
  float u = 0.7978845608028654f * (x + 0.044715f * x * x * x);
  float t = 1.f - 2.f / (1.f + __expf(2.f * u));
  return 0.5f * x * (1.f + t);
}

constexpr int GSTR = 72;
constexpr int GBUF = 2 * 128 * GSTR;
constexpr int RS_OFF = 2 * GBUF * 2;
DI void gemm_compute(const u16* As, const u16* Bs, f32x4 (&acc)[4][4], int wm, int wn, int r, int quad) {
#pragma unroll
  for (int ks = 0; ks < 2; ks++) {
    bf16x8 af[4], bfr[4];
#pragma unroll
    for (int mi = 0; mi < 4; mi++) af[mi] = *(const bf16x8*)(As + (wm * 64 + mi * 16 + r) * GSTR + ks * 32 + quad * 8);
#pragma unroll
    for (int ni = 0; ni < 4; ni++) bfr[ni] = *(const bf16x8*)(Bs + (wn * 64 + ni * 16 + r) * GSTR + ks * 32 + quad * 8);
#pragma unroll
    for (int mi = 0; mi < 4; mi++)
#pragma unroll
      for (int ni = 0; ni < 4; ni++) acc[mi][ni] = mfma16(af[mi], bfr[ni], acc[mi][ni]);
    if (ks == 0) __builtin_amdgcn_sched_barrier(0);
  }
}
DI void gemm_mainloop(const u16* __restrict__ A, int lda, const u16* __restrict__ B, int ldb, int K, u16* smem,
                      f32x4 (&acc)[4][4]) {
  const int tid = threadIdx.x, lane = tid & 63, w = tid >> 6, wm = w >> 1, wn = w & 1, r = lane & 15, quad = lane >> 4;
  u16* As0 = smem;
  u16* Bs0 = smem + 128 * GSTR;
  u16* As1 = smem + GBUF;
  u16* Bs1 = As1 + 128 * GSTR;
  u32x4 r0a[4], r0b[4], r1a[4], r1b[4];
  const int lrow = tid >> 3, lch = tid & 7;
  const u16* ap = A + (size_t)lrow * lda + lch * 8;
  const u16* bp = B + (size_t)lrow * ldb + lch * 8;
  const int lo = lrow * GSTR + lch * 8;
#pragma unroll
  for (int i = 0; i < 4; i++) {
    r0a[i] = *(const u32x4*)(ap + (size_t)i * 32 * lda);
    r0b[i] = *(const u32x4*)(bp + (size_t)i * 32 * ldb);
  }
#pragma unroll
  for (int i = 0; i < 4; i++) {
    r1a[i] = *(const u32x4*)(ap + (size_t)i * 32 * lda + 64);
    r1b[i] = *(const u32x4*)(bp + (size_t)i * 32 * ldb + 64);
  }
  const int nk = K >> 6;
  __syncthreads();
#pragma unroll 1
  for (int kt = 0; kt < nk; kt += 2) {
#pragma unroll
    for (int i = 0; i < 4; i++) {
      *(u32x4*)(As0 + lo + i * 32 * GSTR) = r0a[i];
      *(u32x4*)(Bs0 + lo + i * 32 * GSTR) = r0b[i];
    }
    __syncthreads();
    if (kt + 2 < nk) {
#pragma unroll
      for (int i = 0; i < 4; i++) {
        r0a[i] = *(const u32x4*)(ap + (size_t)i * 32 * lda + (kt + 2) * 64);
        r0b[i] = *(const u32x4*)(bp + (size_t)i * 32 * ldb + (kt + 2) * 64);
      }
    }
    gemm_compute(As0, Bs0, acc, wm, wn, r, quad);
#pragma unroll
    for (int i = 0; i < 4; i++) {
      *(u32x4*)(As1 + lo + i * 32 * GSTR) = r1a[i];
      *(u32x4*)(Bs1 + lo + i * 32 * GSTR) = r1b[i];
    }
    __syncthreads();
    if (kt + 3 < nk) {
#pragma unroll
      for (int i = 0; i < 4; i++) {
        r1a[i] = *(const u32x4*)(ap + (size_t)i * 32 * lda + (kt + 3) * 64);
        r1b[i] = *(const u32x4*)(bp + (size_t)i * 32 * ldb + (kt + 3) * 64);
      }
    }
    gemm_compute(As1, Bs1, acc, wm, wn, r, quad);
  }
}

DI void zero_acc(f32x4 (&acc)[4][4]) {
#pragma unroll
  for (int i = 0; i < 4; i++)
#pragma unroll
    for (int j = 0; j < 4; j++) acc[i][j] = (f32x4){0.f, 0.f, 0.f, 0.f};
}

constexpr int CSTR = 132;
DI void stage_acc(const f32x4 (&acc)[4][4], float* Cs) {
  const int tid = threadIdx.x, lane = tid & 63, w = tid >> 6, wm = w >> 1, wn = w & 1, r = lane & 15, quad = lane >> 4;
  __syncthreads();
#pragma unroll
  for (int mi = 0; mi < 4; mi++)
#pragma unroll
    for (int ni = 0; ni < 4; ni++)
#pragma unroll
      for (int j = 0; j < 4; j++) Cs[(wm * 64 + mi * 16 + quad * 4 + j) * CSTR + wn * 64 + ni * 16 + r] = acc[mi][ni][j];
  __syncthreads();
}
DI u32x2 pack4(f32x4 v) { return (u32x2){pack2(v.x, v.y), pack2(v.z, v.w)}; }
DI f32x4 unpack4(u32x2 p) {
  return (f32x4){__uint_as_float(p.x << 16), __uint_as_float(p.x & 0xffff0000u), __uint_as_float(p.y << 16), __uint_as_float(p.y & 0xffff0000u)};
}

DI void transpose_tile(const float* __restrict__ W, int ldw, int K, const float* __restrict__ g, u16* __restrict__ dst,
                       int k0, int n0, int nsrc0, float* tile) {
  const int tid = threadIdx.x;
  __syncthreads();
  {
    const int ty = tid >> 4, tx = tid & 15;
#pragma unroll
    for (int i = 0; i < 4; i++) {
      int k = ty + i * 16;
      f32x4 v = *(const f32x4*)(W + (size_t)(k0 + k) * ldw + nsrc0 + tx * 4);
      float s = g ? g[k0 + k] : 1.f;
      tile[k * 65 + tx * 4 + 0] = v[0] * s;
      tile[k * 65 + tx * 4 + 1] = v[1] * s;
      tile[k * 65 + tx * 4 + 2] = v[2] * s;
      tile[k * 65 + tx * 4 + 3] = v[3] * s;
    }
  }
  __syncthreads();
  {
    const int n = tid >> 2, kc = (tid & 3) * 16;
    u32 pk[8];
#pragma unroll
    for (int i = 0; i < 8; i++) pk[i] = pack2(tile[(kc + 2 * i) * 65 + n], tile[(kc + 2 * i + 1) * 65 + n]);
    u16* d = dst + (size_t)(n0 + n) * K + k0 + kc;
    *(u32x4*)d = (u32x4){pk[0], pk[1], pk[2], pk[3]};
    *(u32x4*)(d + 8) = (u32x4){pk[4], pk[5], pk[6], pk[7]};
  }
}

DI void conv_unit(const float* __restrict__ src, u16* __restrict__ dst, size_t base, const float* __restrict__ colscale) {
  const int tid = threadIdx.x;
#pragma unroll
  for (int i = 0; i < 4; i++) {
    size_t e = base + (size_t)i * 1024 + tid * 4;
    f32x4 v = *(const f32x4*)(src + e);
    if (colscale) {
      f32x4 gg = *(const f32x4*)(colscale + (e & 1023));
      v = v * gg;
    }
    *(u32x2*)(dst + e) = (u32x2){pack2(v[0], v[1]), pack2(v[2], v[3])};
  }
}

DI void conv_unit_fp8(const float* __restrict__ src, unsigned char* __restrict__ dst, size_t base,
                      const float* __restrict__ colscale, float scale) {
  const int tid = threadIdx.x;
#pragma unroll
  for (int i = 0; i < 4; i++) {
    size_t e = base + (size_t)i * 1024 + tid * 4;
    f32x4 v = *(const f32x4*)(src + e);
    if (colscale) {
      f32x4 gg = *(const f32x4*)(colscale + (e & 1023));
      v = v * gg;
    }
    int w = __builtin_amdgcn_cvt_pk_fp8_f32(v[0] * scale, v[1] * scale, 0, false);
    w = __builtin_amdgcn_cvt_pk_fp8_f32(v[2] * scale, v[3] * scale, w, true);
    *(int*)(dst + (((e & 1023) >> 7) << 21) + ((e >> 10) << 7) + (e & 127)) = w;
  }
}

DI void phase0(const Params& P, char* smem) {
  const int tid = threadIdx.x, lane = tid & 63, w = tid >> 6;
  char* ws = P.ws;
  {
    float* tile = (float*)smem;
    constexpr int T_WIN = 16 * 80, T_UP = 8 * 16, T_SQ = 256, T_PP = 4 * 16;
    constexpr int NT = T_WIN + 2 * T_UP + 3 * T_SQ + T_PP;
    for (int t = blockIdx.x; t < NT; t += gridDim.x) {
      int u = t;
      if (u < T_WIN) {
        int kt = u / 80, nt = u % 80;
        int n0 = nt * 64;
        int ns = n0 < 1536 ? n0 : n0 + 8;
        transpose_tile(P.w_in, 5128, 1024, P.g_mix, (u16*)(ws + W_WIN), kt * 64, n0, ns, tile);
        continue;
      }
      u -= T_WIN;
      if (u < T_UP) { transpose_tile(P.w_up_a, 1024, 512, nullptr, (u16*)(ws + W_WUPA), (u / 16) * 64, (u % 16) * 64, (u % 16) * 64, tile); continue; }
      u -= T_UP;
      if (u < T_UP) { transpose_tile(P.w_up_b, 1024, 512, nullptr, (u16*)(ws + W_WUPB), (u / 16) * 64, (u % 16) * 64, (u % 16) * 64, tile); continue; }
      u -= T_UP;
      if (u < T_SQ) { transpose_tile(P.w_out, 1024, 1024, nullptr, (u16*)(ws + W_WOUT), (u / 16) * 64, (u % 16) * 64, (u % 16) * 64, tile); continue; }
      u -= T_SQ;
      if (u < T_SQ) { transpose_tile(P.peer_wq, 1024, 1024, P.g_ffn, (u16*)(ws + W_WQ), (u / 16) * 64, (u % 16) * 64, (u % 16) * 64, tile); continue; }
      u -= T_SQ;
      if (u < T_SQ) { transpose_tile(P.w_gate, 1024, 1024, P.g_ple, (u16*)(ws + W_WG), (u / 16) * 64, (u % 16) * 64, (u % 16) * 64, tile); continue; }
      u -= T_SQ;
      transpose_tile(P.w_proj, 1024, 256, nullptr, (u16*)(ws + W_WPP), (u / 16) * 64, (u % 16) * 64, (u % 16) * 64, tile);
    }
  }
  {
    constexpr int U_UB = 4096, U_VB = 4096, U_SK = 32, U_PP = 4096, U_PS = 16;
    constexpr int NU = U_UB + U_VB + U_SK + U_PP + U_PS;
    for (int t = blockIdx.x; t < NU; t += gridDim.x) {
      int u = t;
      if (u < U_UB) { conv_unit_fp8(P.peer_u, (unsigned char*)(ws + W_UB), (size_t)u * 4096, P.g_ffn, U_SCALE); continue; }
      u -= U_UB;
      if (u < U_VB) { conv_unit_fp8(P.peer_v, (unsigned char*)(ws + W_VB), (size_t)u * 4096, nullptr, V_SCALE); continue; }
      u -= U_VB;
      if (u < U_SK) { conv_unit(P.peer_sk, (u16*)(ws + W_SK), (size_t)u * 4096, nullptr); continue; }
      u -= U_SK;
      if (u < U_PP) { conv_unit(P.p_p, (u16*)(ws + W_PB), (size_t)u * 4096, nullptr); continue; }
      u -= U_PP;
      conv_unit(P.p_s, (u16*)(ws + W_PB) + (size_t)TP * 256, (size_t)u * 4096, nullptr);
    }
  }
  {
    float* wfl = (float*)smem;
    __syncthreads();
    for (int i = tid; i < 8192; i += 256) {
      int k = i >> 3, h = i & 7;
      wfl[h * 1024 + k] = P.g_mix[k] * P.w_in[(size_t)k * 5128 + 1536 + h];
    }
    __syncthreads();
    u16* XB = (u16*)(ws + W_XB);
    float* RS1 = (float*)(ws + W_RS1);
    for (int t = blockIdx.x * 4 + w; t < TT; t += gridDim.x * 4) {
      const float* xr = t < TP ? P.x_p + (size_t)t * 1024 : P.x_s + (size_t)(t - TP) * 1024;
      f32x4 v[4];
#pragma unroll
      for (int i = 0; i < 4; i++) v[i] = *(const f32x4*)(xr + i * 256 + lane * 4);
      float ss = 0.f;
#pragma unroll
      for (int i = 0; i < 4; i++) ss += v[i][0] * v[i][0] + v[i][1] * v[i][1] + v[i][2] * v[i][2] + v[i][3] * v[i][3];
      float dots[8];
#pragma unroll
      for (int h = 0; h < 8; h++) {
        float d = 0.f;
#pragma unroll
        for (int i = 0; i < 4; i++) {
          f32x4 wv = *(const f32x4*)(wfl + h * 1024 + i * 256 + lane * 4);
          d += v[i][0] * wv[0] + v[i][1] * wv[1] + v[i][2] * wv[2] + v[i][3] * wv[3];
        }
        dots[h] = d;
      }
      ss = wave_sum(ss);
#pragma unroll
      for (int h = 0; h < 8; h++) dots[h] = wave_sum(dots[h]);
      float rs = rsqrtf(ss * (1.f / 1024.f) + EPS);
#pragma unroll
      for (int i = 0; i < 4; i++)
        *(u32x2*)(XB + (size_t)t * 1024 + i * 256 + lane * 4) = (u32x2){pack2(v[i][0], v[i][1]), pack2(v[i][2], v[i][3])};
      if (lane == 0) RS1[t] = rs;
      float myd = dots[0];
#pragma unroll
      for (int h = 1; h < 8; h++) myd = (lane == h) ? dots[h] : myd;
      if (lane < 8) {
        float z = rs * myd + P.b_f[lane];
        float lf = fminf(z, 0.f) - log1pf(expf(-fabsf(z)));
        float* o = t < TP ? P.out + O_AF_P + (size_t)t * 8 : P.out + O_AF_S + (size_t)(t - TP) * 8;
        o[lane] = lf;
      }
    }
  }
}

DI void phase1_scans(const Params& P) {
  const int lane = threadIdx.x & 63;
  const int gw = blockIdx.x * 4 + (threadIdx.x >> 6), nw = gridDim.x * 4;
  float* CUMP = (float*)(P.ws + W_CUMP);
  float* CUMS = (float*)(P.ws + W_CUMS);
  for (int row = gw; row < 384; row += nw) {
    float carry = 0.f;
    if (row < 256) {
      int b = row >> 3, h = row & 7;
      const float* src = P.out + O_AF_P + (size_t)b * 2048 * 8 + h;
      for (int p0 = 0; p0 < 2048; p0 += 64) {
        float v = src[(size_t)(p0 + lane) * 8];
#pragma unroll
        for (int o = 1; o < 64; o <<= 1) { float n = __shfl_up(v, o); if (lane >= o) v += n; }
        v += carry;
        CUMP[(size_t)row * 2048 + p0 + lane] = v * LOG2E;
        carry = __shfl(v, 63);
      }
    } else {
      int rr = row - 256;
      int b = rr >> 3, h = rr & 7;
      const float* src = P.caf + (size_t)b * 4096 * 8 + h;
      for (int p0 = 0; p0 < 4096; p0 += 64) {
        float v = src[(size_t)(p0 + lane) * 8];
#pragma unroll
        for (int o = 1; o < 64; o <<= 1) { float n = __shfl_up(v, o); if (lane >= o) v += n; }
        v += carry;
        CUMS[(size_t)rr * 4112 + p0 + lane] = v * LOG2E;
        carry = __shfl(v, 63);
      }
      {
        float v = lane < 16 ? P.out[O_AF_S + (size_t)(b * 16 + lane) * 8 + h] : 0.f;
#pragma unroll
        for (int o = 1; o < 64; o <<= 1) { float n = __shfl_up(v, o); if (lane >= o) v += n; }
        v += carry;
        if (lane < 16) CUMS[(size_t)rr * 4112 + 4096 + lane] = v * LOG2E;
      }
    }
  }
}

DI void phase1_tile(const Params& P, int mt, int nt, char* smem) {
  const int tid = threadIdx.x, lane = tid & 63, w = tid >> 6, wm = w >> 1, wn = w & 1, r = lane & 15, quad = lane >> 4;
  const int m0 = mt * 128, n0 = nt * 128;
  char* ws = P.ws;
  f32x4 acc[4][4];
  zero_acc(acc);
  gemm_mainloop((const u16*)(ws + W_XB) + (size_t)m0 * 1024, 1024, (const u16*)(ws + W_WIN) + (size_t)n0 * 1024, 1024, 1024,
                (u16*)smem, acc);
  float* Cs = (float*)smem;
  stage_acc(acc, Cs);
  const bool sample = m0 >= TP;
  const int c4 = tid & 31, rsub = tid >> 5;
  const float* RS1 = (const float*)(ws + W_RS1) + m0;
  if (n0 < 3072) {
    const int seg = n0 >> 9, hc = n0 & 511;
    const bool normed = (seg != 2 && seg != 5);
    const float* gain = seg == 0 ? P.qn_a : seg == 1 ? P.kn_a : seg == 3 ? P.qn_b : P.kn_b;
    const float qs = (seg == 0 || seg == 3) ? 0.125f * LOG2E : 1.f;
    f32x4 gn = (f32x4){1.f, 1.f, 1.f, 1.f};
    if (normed) gn = *(const f32x4*)(gain + (c4 & 15) * 4) * qs;
    u16* dp = (u16*)(ws + W_QKV + (size_t)seg * SZ_HALF) + (size_t)m0 * 512 + hc + c4 * 4;
    float* op = nullptr;
    if (seg == 1 || seg == 2) {
      op = sample ? P.out + (seg == 1 ? O_AK_S : O_AV_S) + (size_t)(m0 - TP) * 512 : P.out + (seg == 1 ? O_AK_P : O_AV_P) + (size_t)m0 * 512;
    } else if (seg == 4 || seg == 5) {
      if (sample) op = P.out + (seg == 4 ? O_BK_S : O_BV_S) + (size_t)(m0 - TP) * 512;
      else if ((m0 & 2047) >= 1536) op = P.out + (seg == 4 ? O_BK_P : O_BV_P) + ((size_t)(m0 >> 11) * 512 + ((m0 & 2047) - 1536)) * 512;
    }
    if (op) op += hc + c4 * 4;
#pragma unroll 4
    for (int p = 0; p < 16; p++) {
      const int row = p * 8 + rsub;
      f32x4 v = *(const f32x4*)(Cs + row * CSTR + c4 * 4) * RS1[row];
      if (normed) {
        float ss = v.x * v.x + v.y * v.y + v.z * v.z + v.w * v.w;
        ss += __shfl_xor(ss, 1);
        ss += __shfl_xor(ss, 2);
        ss += __shfl_xor(ss, 4);
        ss += __shfl_xor(ss, 8);
        v = v * gn * rsqrtf(ss * (1.f / 64.f) + EPS);
      }
      *(u32x2*)(dp + (size_t)row * 512) = pack4(v);
      if (op) *(f32x4*)(op + (size_t)row * 512) = v;
    }
  } else {
    u16* dp = (n0 < 4096 ? (u16*)(ws + W_GA) + (n0 - 3072) : (u16*)(ws + W_GB) + (n0 - 4096)) + (size_t)m0 * 1024 + c4 * 4;
#pragma unroll 4
    for (int p = 0; p < 16; p++) {
      const int row = p * 8 + rsub;
      f32x4 v = *(const f32x4*)(Cs + row * CSTR + c4 * 4) * RS1[row];
      v = (f32x4){sigmoidf_(v.x), sigmoidf_(v.y), sigmoidf_(v.z), sigmoidf_(v.w)};
      *(u32x2*)(dp + (size_t)row * 1024) = pack4(v);
    }
  }
}

constexpr int ASTR = 72;
constexpr int TAB_OFF = 36864;
struct AttnState { f32x4 o[4]; float m, l; };

DI s16x4 tr_read(const u16* p) {
  return __builtin_amdgcn_ds_read_tr16_b64_v4i16((__attribute__((address_space(3))) s16x4*)(p));
}

template <int MODE>
DI void attn_step(const u16* Ks, const u16* Vs, const bf16x8 (&qf)[2], AttnState& st, int kpos0, int qpos, int qlim,
                  float cq, const float* cum, const float* tab, bool domask) {
  const int lane = threadIdx.x & 63, r = lane & 15, quad = lane >> 4;
  f32x4 s[2];
#pragma unroll
  for (int t = 0; t < 2; t++) {
    f32x4 a4 = (f32x4){0.f, 0.f, 0.f, 0.f};
#pragma unroll
    for (int ks = 0; ks < 2; ks++) {
      bf16x8 kf = *(const bf16x8*)(Ks + (t * 16 + r) * ASTR + ks * 32 + quad * 8);
      a4 = mfma16(kf, qf[ks], a4);
    }
    s[t] = a4;
  }
#pragma unroll
  for (int t = 0; t < 2; t++) {
    const int kb = kpos0 + t * 16 + quad * 4;
    if (MODE == 0) {
      f32x4 c4 = *(const f32x4*)(cum + kb);
#pragma unroll
      for (int j = 0; j < 4; j++) s[t][j] += cq - c4[j];
    } else {
#pragma unroll
      for (int j = 0; j < 4; j++) {
        int rel = kb + j - qpos;
        rel = min(max(rel, -128), 128) + 128;
        s[t][j] += tab[rel];
      }
    }
    if (domask) {
#pragma unroll
      for (int j = 0; j < 4; j++)
        if (kb + j > qlim) s[t][j] = -1e30f;
    }
  }
  float mx = fmaxf(fmaxf(fmaxf(s[0][0], s[0][1]), fmaxf(s[0][2], s[0][3])), fmaxf(fmaxf(s[1][0], s[1][1]), fmaxf(s[1][2], s[1][3])));
  mx = fmaxf(mx, __shfl_xor(mx, 16));
  mx = fmaxf(mx, __shfl_xor(mx, 32));
  const float mn = fmaxf(st.m, mx);
  const float alpha = __builtin_amdgcn_exp2f(st.m - mn);
  float p[8];
  float ls = 0.f;
#pragma unroll
  for (int t = 0; t < 2; t++)
#pragma unroll
    for (int j = 0; j < 4; j++) { p[t * 4 + j] = __builtin_amdgcn_exp2f(s[t][j] - mn); ls += p[t * 4 + j]; }
  st.l = st.l * alpha + ls;
  st.m = mn;
#pragma unroll
  for (int dt = 0; dt < 4; dt++) st.o[dt] = st.o[dt] * alpha;
  u32x4 pk = (u32x4){pack2(p[0], p[1]), pack2(p[2], p[3]), pack2(p[4], p[5]), pack2(p[6], p[7])};
  bf16x8 pf = __builtin_bit_cast(bf16x8, pk);
  const int qq = (lane & 15) >> 2, pp = lane & 3;
#pragma unroll
  for (int dt = 0; dt < 4; dt++) {
    s16x4 lo = tr_read(Vs + (quad * 4 + qq) * ASTR + dt * 16 + pp * 4);
    s16x4 hi = tr_read(Vs + (16 + quad * 4 + qq) * ASTR + dt * 16 + pp * 4);
    bf16x8 vf = __builtin_shufflevector(lo, hi, 0, 1, 2, 3, 4, 5, 6, 7);
    st.o[dt] = mfma16(vf, pf, st.o[dt]);
  }
}

template <int MODE>
DI void attn_prompt_item(const Params& P, char* smem, int b, int h, int qt) {
  const int tid = threadIdx.x, lane = tid & 63, w = tid >> 6, r = lane & 15, quad = lane >> 4;
  char* ws = P.ws;
  const u16* Q = (const u16*)(ws + W_QKV + (size_t)(MODE == 0 ? 0 : 3) * SZ_HALF);
  const u16* Kg = (const u16*)(ws + W_QKV + (size_t)(MODE == 0 ? 1 : 4) * SZ_HALF);
  const u16* Vg = (const u16*)(ws + W_QKV + (size_t)(MODE == 0 ? 2 : 5) * SZ_HALF);
  u16* Y = (u16*)(ws + W_XB + (size_t)(MODE == 0 ? 0 : 1) * SZ_HALF);
  u16* Ks = (u16*)smem;
  u16* Vs = Ks + 64 * ASTR;
  float* tab = (float*)(smem + TAB_OFF);
  __syncthreads();
  if (MODE == 1) {
    for (int i = tid; i < 257; i += 256) tab[i] = P.relb[h * 257 + i] * LOG2E;
  }
  const int q0 = qt * 64;
  const int qpos = q0 + w * 16 + r;
  const size_t tokq = (size_t)b * 2048 + qpos;
  bf16x8 qf[2];
#pragma unroll
  for (int ks = 0; ks < 2; ks++) qf[ks] = *(const bf16x8*)(Q + tokq * 512 + h * 64 + ks * 32 + quad * 8);
  const float* cum = (const float*)(ws + W_CUMP) + (size_t)(b * 8 + h) * 2048;
  const float cq = MODE == 0 ? cum[qpos] : 0.f;
  AttnState st;
#pragma unroll
  for (int dt = 0; dt < 4; dt++) st.o[dt] = (f32x4){0.f, 0.f, 0.f, 0.f};
  st.m = -1e30f;
  st.l = 0.f;
  const int kt_lo = MODE == 0 ? 0 : max(0, qt - 8), kt_hi = qt;
  u32x4 rk[2], rv[2];
  const int lkey = tid >> 3, lch = tid & 7;
  const u16* kp = Kg + ((size_t)b * 2048 + lkey) * 512 + h * 64 + lch * 8;
  const u16* vp = Vg + ((size_t)b * 2048 + lkey) * 512 + h * 64 + lch * 8;
#pragma unroll
  for (int i = 0; i < 2; i++) {
    rk[i] = *(const u32x4*)(kp + (size_t)(kt_lo * 64 + i * 32) * 512);
    rv[i] = *(const u32x4*)(vp + (size_t)(kt_lo * 64 + i * 32) * 512);
  }
  for (int kt = kt_lo; kt <= kt_hi; kt++) {
    __syncthreads();
#pragma unroll
    for (int i = 0; i < 2; i++) {
      *(u32x4*)(Ks + (lkey + i * 32) * ASTR + lch * 8) = rk[i];
      *(u32x4*)(Vs + (lkey + i * 32) * ASTR + lch * 8) = rv[i];
    }
    __syncthreads();
    if (kt < kt_hi) {
#pragma unroll
      for (int i = 0; i < 2; i++) {
        rk[i] = *(const u32x4*)(kp + (size_t)((kt + 1) * 64 + i * 32) * 512);
        rv[i] = *(const u32x4*)(vp + (size_t)((kt + 1) * 64 + i * 32) * 512);
      }
    }
    const bool diag = (MODE == 0) && (kt == qt);
#pragma unroll
    for (int half = 0; half < 2; half++) {
      const int kpos0 = kt * 64 + half * 32;
      if (diag && kpos0 > q0 + w * 16 + 15) continue;
      attn_step<MODE>(Ks + half * 32 * ASTR, Vs + half * 32 * ASTR, qf, st, kpos0, qpos, qpos, cq, cum, tab, diag);
    }
  }
  float lt = st.l;
  lt += __shfl_xor(lt, 16);
  lt += __shfl_xor(lt, 32);
  const float inv = 1.f / lt;
#pragma unroll
  for (int dt = 0; dt < 4; dt++) {
    u32x2 o2 = (u32x2){pack2(st.o[dt][0] * inv, st.o[dt][1] * inv), pack2(st.o[dt][2] * inv, st.o[dt][3] * inv)};
    *(u32x2*)(Y + tokq * 512 + h * 64 + dt * 16 + quad * 4) = o2;
  }
}

template <int MODE>
DI void attn_sample_item(const Params& P, char* smem, int b, int h) {
  const int tid = threadIdx.x, lane = tid & 63, w = tid >> 6, r = lane & 15, quad = lane >> 4;
  constexpr int L = MODE == 0 ? 4096 : 512;
  char* ws = P.ws;
  const u16* Q = (const u16*)(ws + W_QKV + (size_t)(MODE == 0 ? 0 : 3) * SZ_HALF);
  const u16* Kn = (const u16*)(ws + W_QKV + (size_t)(MODE == 0 ? 1 : 4) * SZ_HALF);
  const u16* Vn = (const u16*)(ws + W_QKV + (size_t)(MODE == 0 ? 2 : 5) * SZ_HALF);
  u16* Y = (u16*)(ws + W_XB + (size_t)(MODE == 0 ? 0 : 1) * SZ_HALF);
  u16* Kw = (u16*)smem + w * (2 * 32 * ASTR);
  u16* Vw = Kw + 32 * ASTR;
  float* tab = (float*)(smem + TAB_OFF);
  __syncthreads();
  if (MODE == 1) {
    for (int i = tid; i < 257; i += 256) tab[i] = P.relb[h * 257 + i] * LOG2E;
  }
  __syncthreads();
  const float* ck = (MODE == 0 ? P.cak : P.cbk) + ((size_t)b * L * 8 + h) * 64;
  const float* cv = (MODE == 0 ? P.cav : P.cbv) + ((size_t)b * L * 8 + h) * 64;
  const size_t tokbase = (size_t)TP + b * 16;
  bf16x8 qf[2];
#pragma unroll
  for (int ks = 0; ks < 2; ks++) qf[ks] = *(const bf16x8*)(Q + (tokbase + r) * 512 + h * 64 + ks * 32 + quad * 8);
  const int qpos = L + r;
  const float* cum = (const float*)(ws + W_CUMS) + (size_t)(b * 8 + h) * 4112;
  const float cq = MODE == 0 ? cum[qpos] : 0.f;
  AttnState st;
#pragma unroll
  for (int dt = 0; dt < 4; dt++) st.o[dt] = (f32x4){0.f, 0.f, 0.f, 0.f};
  st.m = -1e30f;
  st.l = 0.f;
  const int kbeg = w * (L / 4), kend = kbeg + L / 4;
  for (int k0 = kbeg; k0 < kend; k0 += 32) {
    {
      f32x4 kr[8];
#pragma unroll
      for (int i = 0; i < 8; i++) kr[i] = *(const f32x4*)(ck + (size_t)(k0 + i * 4 + quad) * 512 + r * 4);
#pragma unroll
      for (int i = 0; i < 8; i++)
        *(u32x2*)(Kw + (i * 4 + quad) * ASTR + r * 4) = (u32x2){pack2(kr[i][0], kr[i][1]), pack2(kr[i][2], kr[i][3])};
    }
    {
      f32x4 vr[8];
#pragma unroll
      for (int i = 0; i < 8; i++) vr[i] = *(const f32x4*)(cv + (size_t)(k0 + i * 4 + quad) * 512 + r * 4);
#pragma unroll
      for (int i = 0; i < 8; i++)
        *(u32x2*)(Vw + (i * 4 + quad) * ASTR + r * 4) = (u32x2){pack2(vr[i][0], vr[i][1]), pack2(vr[i][2], vr[i][3])};
    }
    asm volatile("s_waitcnt lgkmcnt(0)" ::: "memory");
    __builtin_amdgcn_wave_barrier();
    attn_step<MODE>(Kw, Vw, qf, st, k0, qpos, qpos, cq, cum, tab, false);
    __builtin_amdgcn_wave_barrier();
  }
  if (w == 0) {
#pragma unroll
    for (int i = 0; i < 2; i++) {
      int c = lane + i * 64;
      int key = c >> 3, ch = c & 7;
      u32x4 kk = *(const u32x4*)(Kn + (tokbase + key) * 512 + h * 64 + ch * 8);
      u32x4 vv = *(const u32x4*)(Vn + (tokbase + key) * 512 + h * 64 + ch * 8);
      *(u32x4*)(Kw + key * ASTR + ch * 8) = kk;
      *(u32x4*)(Vw + key * ASTR + ch * 8) = vv;
      *(u32x4*)(Kw + (16 + key) * ASTR + ch * 8) = (u32x4){0u, 0u, 0u, 0u};
      *(u32x4*)(Vw + (16 + key) * ASTR + ch * 8) = (u32x4){0u, 0u, 0u, 0u};
    }
    asm volatile("s_waitcnt lgkmcnt(0)" ::: "memory");
    __builtin_amdgcn_wave_barrier();
    attn_step<MODE>(Kw, Vw, qf, st, L, qpos, MODE == 0 ? qpos : L + 15, cq, cum, tab, true);
  }
  __syncthreads();
  float* comb = (float*)smem;
  float lt = st.l;
  lt += __shfl_xor(lt, 16);
  lt += __shfl_xor(lt, 32);
#pragma unroll
  for (int dt = 0; dt < 4; dt++)
#pragma unroll
    for (int j = 0; j < 4; j++) comb[(w * 16 + r) * 68 + dt * 16 + quad * 4 + j] = st.o[dt][j];
  if (quad == 0) {
    comb[(w * 16 + r) * 68 + 64] = st.m;
    comb[(w * 16 + r) * 68 + 65] = lt;
  }
  __syncthreads();
  if (w == 0) {
    float mw[4], M = -1e30f;
#pragma unroll
    for (int i = 0; i < 4; i++) { mw[i] = comb[(i * 16 + r) * 68 + 64]; M = fmaxf(M, mw[i]); }
    float Ls = 0.f, scl[4];
#pragma unroll
    for (int i = 0; i < 4; i++) { scl[i] = __builtin_amdgcn_exp2f(mw[i] - M); Ls += scl[i] * comb[(i * 16 + r) * 68 + 65]; }
    const float inv = 1.f / Ls;
#pragma unroll
    for (int dt = 0; dt < 4; dt++) {
      float ov[4];
#pragma unroll
      for (int j = 0; j < 4; j++) {
        float a = 0.f;
#pragma unroll
        for (int i = 0; i < 4; i++) a += scl[i] * comb[(i * 16 + r) * 68 + dt * 16 + quad * 4 + j];
        ov[j] = a * inv;
      }
      *(u32x2*)(Y + (tokbase + r) * 512 + h * 64 + dt * 16 + quad * 4) = (u32x2){pack2(ov[0], ov[1]), pack2(ov[2], ov[3])};
    }
  }
}

DI void phase2(const Params& P, char* smem) {
  constexpr int N_SA = 128, N_PA = 8192, N_PB = 8192, N_SB = 128;
  for (int it = blockIdx.x; it < N_SA + N_PA + N_PB + N_SB; it += gridDim.x) {
    int u = it;
    if (u < N_SA) { attn_sample_item<0>(P, smem, u >> 3, u & 7); continue; }
    u -= N_SA;
    if (u < N_PA) { int qt = 31 - (u >> 8), bh = u & 255; attn_prompt_item<0>(P, smem, bh >> 3, bh & 7, qt); continue; }
    u -= N_PA;
    if (u < N_PB) { int qt = 31 - (u >> 8), bh = u & 255; attn_prompt_item<1>(P, smem, bh >> 3, bh & 7, qt); continue; }
    u -= N_PB;
    attn_sample_item<1>(P, smem, u >> 3, u & 7);
  }
}

DI void phase3_tile(const Params& P, int mt, int nt, char* smem) {
  const int tid = threadIdx.x, lane = tid & 63, w = tid >> 6, wm = w >> 1, wn = w & 1, r = lane & 15, quad = lane >> 4;
  const int m0 = mt * 128, n0 = nt * 128;
  char* ws = P.ws;
  const u16* YA = (const u16*)(ws + W_XB);
  const u16* YB = YA + (size_t)TT * 512;
  const u16* GA = (const u16*)(ws + W_GA);
  const u16* GB = (const u16*)(ws + W_GB);
  u16* MRG = (u16*)(ws + W_QKV);
  f32x4 acc[4][4];
  zero_acc(acc);
  gemm_mainloop(YA + (size_t)m0 * 512, 512, (const u16*)(ws + W_WUPA) + (size_t)n0 * 512, 512, 512, (u16*)smem, acc);
  float* Cs = (float*)smem;
  const int c4 = tid & 31, rsub = tid >> 5;
  const size_t tofs = (size_t)m0 * 1024 + n0 + c4 * 4;
  stage_acc(acc, Cs);
#pragma unroll 4
  for (int p = 0; p < 16; p++) {
    const int row = p * 8 + rsub;
    const f32x4 v = *(const f32x4*)(Cs + row * CSTR + c4 * 4);
    const f32x4 gv = unpack4(*(const u32x2*)(GA + tofs + (size_t)row * 1024));
    *(u32x2*)(MRG + tofs + (size_t)row * 1024) = pack4(v * gv);
  }
  zero_acc(acc);
  gemm_mainloop(YB + (size_t)m0 * 512, 512, (const u16*)(ws + W_WUPB) + (size_t)n0 * 512, 512, 512, (u16*)smem, acc);
  stage_acc(acc, Cs);
#pragma unroll 4
  for (int p = 0; p < 16; p++) {
    const int row = p * 8 + rsub;
    const f32x4 v = *(const f32x4*)(Cs + row * CSTR + c4 * 4);
    const f32x4 gv = unpack4(*(const u32x2*)(GB + tofs + (size_t)row * 1024));
    const f32x4 m1 = unpack4(*(const u32x2*)(MRG + tofs + (size_t)row * 1024));
    *(u32x2*)(MRG + tofs + (size_t)row * 1024) = pack4(m1 + v * gv);
  }
}

DI void phase4_tile(const Params& P, int mt, int nt, char* smem) {
  const int tid = threadIdx.x, lane = tid & 63, w = tid >> 6, wm = w >> 1, wn = w & 1, r = lane & 15, quad = lane >> 4;
  const int m0 = mt * 128, n0 = nt * 128;
  char* ws = P.ws;
  const u16* MRG = (const u16*)(ws + W_QKV);
  u16* H1B = (u16*)(ws + W_QKV + SZ_ACT);
  float* SSQ2 = (float*)(ws + W_SSQ2);
  f32x4 acc[4][4];
  zero_acc(acc);
  gemm_mainloop(MRG + (size_t)m0 * 1024, 1024, (const u16*)(ws + W_WOUT) + (size_t)n0 * 1024, 1024, 1024, (u16*)smem, acc);
  const float* xb = m0 < TP ? P.x_p : P.x_s - (size_t)TP * 1024;
  float* Cs = (float*)smem;
  const int c4 = tid & 31, rsub = tid >> 5;
  const size_t tofs = (size_t)m0 * 1024 + n0 + c4 * 4;
  stage_acc(acc, Cs);
#pragma unroll 4
  for (int p = 0; p < 16; p++) {
    const int row = p * 8 + rsub;
    const f32x4 v = *(const f32x4*)(Cs + row * CSTR + c4 * 4);
    const f32x4 h1 = *(const f32x4*)(xb + tofs + (size_t)row * 1024) + v;
    *(f32x4*)(P.out + tofs + (size_t)row * 1024) = h1;
    *(u32x2*)(H1B + tofs + (size_t)row * 1024) = pack4(h1);
    float ss = h1.x * h1.x + h1.y * h1.y + h1.z * h1.z + h1.w * h1.w;
    ss += __shfl_xor(ss, 1);
    ss += __shfl_xor(ss, 2);
    ss += __shfl_xor(ss, 4);
    ss += __shfl_xor(ss, 8);
    ss += __shfl_xor(ss, 16);
    if (c4 == 0) SSQ2[(size_t)(m0 + row) * 16 + nt] = ss;
  }
}

DI void phase5_tile(const Params& P, int mt, int nt, char* smem) {
  const int tid = threadIdx.x, lane = tid & 63, w = tid >> 6, wm = w >> 1, wn = w & 1, r = lane & 15, quad = lane >> 4;
  const int m0 = mt * 128, n0 = nt * 128;
  char* ws = P.ws;
  const u16* H1B = (const u16*)(ws + W_QKV + SZ_ACT);
  u16* QP = (u16*)(ws + W_QKV + 2 * SZ_ACT);
  const float* SSQ2 = (const float*)(ws + W_SSQ2);
  float* rs_s = (float*)(smem + RS_OFF);
  __syncthreads();
  if (tid < 128) {
    float s = 0.f;
#pragma unroll
    for (int i = 0; i < 8; i++) s += SSQ2[(size_t)(m0 + tid) * 16 + i];
    rs_s[tid] = rsqrtf(s * (1.f / 1024.f) + EPS);
  }
  f32x4 acc[4][4];
  zero_acc(acc);
  gemm_mainloop(H1B + (size_t)m0 * 1024, 1024, (const u16*)(ws + W_WQ) + (size_t)n0 * 1024, 1024, 1024, (u16*)smem, acc);
  float* Cs = (float*)smem;
  const int c4 = tid & 31, rsub = tid >> 5;
  const size_t tofs = (size_t)m0 * 1024 + n0 + c4 * 4;
  stage_acc(acc, Cs);
#pragma unroll 4
  for (int p = 0; p < 16; p++) {
    const int row = p * 8 + rsub;
    const f32x4 v = *(const f32x4*)(Cs + row * CSTR + c4 * 4) * rs_s[row];
    *(u32x2*)(QP + tofs + (size_t)row * 1024) = pack4(v);
  }
}

DI void phase6a_unit(const Params& P, int unit, char* smem) {
  const int tid = threadIdx.x, lane = tid & 63, w = tid >> 6, r = lane & 15, quad = lane >> 4;
  char* ws = P.ws;
  const u16* QP = (const u16*)(ws + W_QKV + 2 * SZ_ACT);
  const u16* SK = (const u16*)(ws + W_SK);
  u16* IDXo = (u16*)(ws + W_IDX);
  float* Go = (float*)(ws + W_G);
  float* sc = (float*)smem;
  u32* lists = (u32*)(smem + 128 * 129 * 4);
  unsigned char* tabi = (unsigned char*)(smem + 128 * 129 * 4 + 128 * 17 * 4);
  unsigned char* tabj = tabi + 64;
  const int tok0 = unit * 64;
  __syncthreads();
  if (tid == 0) {
    int s = 0;
    for (int i = 0; i < 16; i++)
      for (int j = 0; j < 16; j++)
        if ((i + 1) * (j + 1) <= 16) { tabi[s] = (unsigned char)i; tabj[s] = (unsigned char)j; s++; }
  }
  for (int h = 0; h < 8; h++) {
#pragma unroll
    for (int p = 0; p < 2; p++) {
      const int hp = h * 2 + p;
      bf16x8 qf[2];
#pragma unroll
      for (int ks = 0; ks < 2; ks++)
        qf[ks] = *(const bf16x8*)(QP + (size_t)(tok0 + w * 16 + r) * 1024 + hp * 64 + ks * 32 + quad * 8);
#pragma unroll
      for (int nt = 0; nt < 8; nt++) {
        f32x4 a4 = (f32x4){0.f, 0.f, 0.f, 0.f};
#pragma unroll
        for (int ks = 0; ks < 2; ks++) {
          bf16x8 kf = *(const bf16x8*)(SK + (size_t)(hp * 128 + nt * 16 + r) * 64 + ks * 32 + quad * 8);
          a4 = mfma16(kf, qf[ks], a4);
        }
        float* d = sc + (p * 64 + w * 16 + r) * 129 + nt * 16 + quad * 4;
        d[0] = a4[0]; d[1] = a4[1]; d[2] = a4[2]; d[3] = a4[3];
      }
    }
    __syncthreads();
    if (tid < 128) {
      u32 L[16];
#pragma unroll
      for (int s = 0; s < 16; s++) L[s] = 0u;
      const float* row = sc + tid * 129;
#pragma unroll 4
      for (int i = 0; i < 128; i++) {
        u32 k = (mono(row[i]) & ~127u) | (u32)i;
        insert16(L, k);
      }
#pragma unroll
      for (int s = 0; s < 16; s++) lists[tid * 17 + s] = L[s];
    }
    __syncthreads();
    if (tid < 64) {
      u32 a[16], bq[16];
      float fa[16], fb[16];
#pragma unroll
      for (int s = 0; s < 16; s++) {
        a[s] = lists[tid * 17 + s];
        bq[s] = lists[(64 + tid) * 17 + s];
        fa[s] = unmono(a[s] & ~127u);
        fb[s] = unmono(bq[s] & ~127u);
      }
      u32 L2[16];
#pragma unroll
      for (int s = 0; s < 16; s++) L2[s] = 0u;
      {
        int slot = 0;
#pragma unroll
        for (int i = 0; i < 16; i++)
#pragma unroll
          for (int j = 0; j < 16; j++)
            if ((i + 1) * (j + 1) <= 16) {
              float sum = fa[i] + fb[j];
              u32 key = (mono(sum) & ~63u) | (u32)slot;
              slot++;
              insert16(L2, key);
            }
      }
      float val[16];
      u32 idx[16];
      float mx = -1e30f;
#pragma unroll
      for (int s = 0; s < 16; s++) {
        u32 sl = L2[s] & 63u;
        int i = tabi[sl], j = tabj[sl];
        u32 au = lists[tid * 17 + i], bu = lists[(64 + tid) * 17 + j];
        val[s] = unmono(au & ~127u) + unmono(bu & ~127u);
        idx[s] = (au & 127u) * 128u + (bu & 127u);
        mx = fmaxf(mx, val[s]);
      }
      float sum = 0.f;
#pragma unroll
      for (int s = 0; s < 16; s++) { val[s] = __expf(val[s] - mx); sum += val[s]; }
      const float inv = 1.f / sum;
      const size_t so = ((size_t)(tok0 + tid) * 8 + h) * 16;
      {
        u32* ib = (u32*)(IDXo + (size_t)(tok0 + tid) * 128 + h * 2);
#pragma unroll
        for (int gg = 0; gg < 8; gg++) ib[gg * 8] = idx[gg] | (idx[gg + 8] << 16);
      }
#pragma unroll
      for (int s = 0; s < 4; s++)
        *(f32x4*)(Go + so + s * 4) = (f32x4){val[s * 4] * inv, val[s * 4 + 1] * inv, val[s * 4 + 2] * inv, val[s * 4 + 3] * inv};
    }
  }
}

typedef float f32x2 __attribute__((ext_vector_type(2)));
DI float dot4_fp8(u32 w, float x0, float x1, float x2, float x3, float acc) {
  f32x2 lo = __builtin_amdgcn_cvt_pk_f32_fp8((int)w, false);
  f32x2 hi = __builtin_amdgcn_cvt_pk_f32_fp8((int)w, true);
  acc = fmaf(lo[0], x0, acc);
  acc = fmaf(lo[1], x1, acc);
  acc = fmaf(hi[0], x2, acc);
  acc = fmaf(hi[1], x3, acc);
  return acc;
}
DI void axpy4_fp8(u32 w, float wgt, float& o0, float& o1, float& o2, float& o3) {
  f32x2 lo = __builtin_amdgcn_cvt_pk_f32_fp8((int)w, false);
  f32x2 hi = __builtin_amdgcn_cvt_pk_f32_fp8((int)w, true);
  o0 = fmaf(wgt, lo[0], o0);
  o1 = fmaf(wgt, lo[1], o1);
  o2 = fmaf(wgt, hi[0], o2);
  o3 = fmaf(wgt, hi[1], o3);
}

DI void phase6b1(const Params& P) {
  const int lane = threadIdx.x & 63, g = lane >> 3, c = lane & 7;
  const int x = blockIdx.x & 7;
  const int wg = (blockIdx.x >> 3) * 4 + (threadIdx.x >> 6), nwg = (gridDim.x >> 3) * 4;
  char* ws = P.ws;
  const u16* H1B = (const u16*)(ws + W_QKV + SZ_ACT);
  const unsigned char* U8 = (const unsigned char*)(ws + W_UB) + ((size_t)x << 21) + c * 16;
  const u16* IDX = (const u16*)(ws + W_IDX) + g * 16;
  float* PH = ph_slice(ws, x) + g;
  int t = wg;
  u32x4 ea = (u32x4){0u, 0u, 0u, 0u}, eb = ea;
  if (t < TT) {
    ea = *(const u32x4*)(IDX + (size_t)t * 128);
    eb = *(const u32x4*)(IDX + (size_t)t * 128 + 8);
  }
  while (t < TT) {
    u32x4 ua[16];
    {
      const u32 ev[8] = {ea.x, ea.y, ea.z, ea.w, eb.x, eb.y, eb.z, eb.w};
#pragma unroll
      for (int i = 0; i < 8; i++) {
        ua[2 * i] = *(const u32x4*)(U8 + (size_t)(ev[i] & 0xffffu) * 128);
        ua[2 * i + 1] = *(const u32x4*)(U8 + (size_t)(ev[i] >> 16) * 128);
      }
    }
    const u32x4 xa = *(const u32x4*)(H1B + (size_t)t * 1024 + x * 128 + c * 16);
    const u32x4 xb = *(const u32x4*)(H1B + (size_t)t * 1024 + x * 128 + c * 16 + 8);
    const int tn = t + nwg;
    if (tn < TT) {
      ea = *(const u32x4*)(IDX + (size_t)tn * 128);
      eb = *(const u32x4*)(IDX + (size_t)tn * 128 + 8);
    }
    float xf[16];
    xf[0] = __uint_as_float(xa.x << 16); xf[1] = __uint_as_float(xa.x & 0xffff0000u);
    xf[2] = __uint_as_float(xa.y << 16); xf[3] = __uint_as_float(xa.y & 0xffff0000u);
    xf[4] = __uint_as_float(xa.z << 16); xf[5] = __uint_as_float(xa.z & 0xffff0000u);
    xf[6] = __uint_as_float(xa.w << 16); xf[7] = __uint_as_float(xa.w & 0xffff0000u);
    xf[8] = __uint_as_float(xb.x << 16); xf[9] = __uint_as_float(xb.x & 0xffff0000u);
    xf[10] = __uint_as_float(xb.y << 16); xf[11] = __uint_as_float(xb.y & 0xffff0000u);
    xf[12] = __uint_as_float(xb.z << 16); xf[13] = __uint_as_float(xb.z & 0xffff0000u);
    xf[14] = __uint_as_float(xb.w << 16); xf[15] = __uint_as_float(xb.w & 0xffff0000u);
    float p[16];
#pragma unroll
    for (int i = 0; i < 16; i++) {
      float a = dot4_fp8(ua[i].x, xf[0], xf[1], xf[2], xf[3], 0.f);
      a = dot4_fp8(ua[i].y, xf[4], xf[5], xf[6], xf[7], a);
      a = dot4_fp8(ua[i].z, xf[8], xf[9], xf[10], xf[11], a);
      a = dot4_fp8(ua[i].w, xf[12], xf[13], xf[14], xf[15], a);
      p[i] = a;
    }
#pragma unroll
    for (int i = 0; i < 8; i++) { float keep = (c & 4) ? p[i + 8] : p[i]; float send = (c & 4) ? p[i] : p[i + 8]; p[i] = keep + __shfl_xor(send, 4); }
#pragma unroll
    for (int i = 0; i < 4; i++) { float keep = (c & 2) ? p[i + 4] : p[i]; float send = (c & 2) ? p[i] : p[i + 4]; p[i] = keep + __shfl_xor(send, 2); }
#pragma unroll
    for (int i = 0; i < 2; i++) { float keep = (c & 1) ? p[i + 2] : p[i]; float send = (c & 1) ? p[i] : p[i + 2]; p[i] = keep + __shfl_xor(send, 1); }
    const int it0 = 2 * (c & 1) + 4 * ((c >> 1) & 1) + 8 * ((c >> 2) & 1);
    float* pr = PH + (size_t)t * 128;
    pr[it0 * 8] = p[0];
    pr[(it0 + 1) * 8] = p[1];
    t = tn;
  }
}

DI void phase6w(const Params& P) {
  const int lane = threadIdx.x & 63;
  const int gw = blockIdx.x * 4 + (threadIdx.x >> 6), nw = gridDim.x * 4;
  char* ws = P.ws;
  float* G = (float*)(ws + W_G);
  const float* SSQ2 = (const float*)(ws + W_SSQ2);
  for (int t = gw; t < TT; t += nw) {
    float ssq = lane < 8 ? SSQ2[(size_t)t * 16 + lane] : 0.f;
    float h0 = 0.f, h1v = 0.f;
    {
      const float* ph = (const float*)(ws + W_XB) + (size_t)t * 128 + lane;
#pragma unroll
      for (int xs = 0; xs < 4; xs++) { h0 += ph[(size_t)xs * (SZ_PH / 4)]; h1v += ph[(size_t)xs * (SZ_PH / 4) + 64]; }
      ph = (const float*)(ws + W_GB) + (size_t)t * 128 + lane;
#pragma unroll
      for (int xs = 0; xs < 4; xs++) { h0 += ph[(size_t)xs * (SZ_PH / 4)]; h1v += ph[(size_t)xs * (SZ_PH / 4) + 64]; }
    }
    const float g0 = G[(size_t)t * 128 + lane];
    const float g1 = G[(size_t)t * 128 + 64 + lane];
    const float rs2 = rsqrtf(wave_sum(ssq) * (1.f / 1024.f) + EPS);
    const float w0 = g0 * gelu_tanh(rs2 * (1.f / U_SCALE) * h0) * (1.f / V_SCALE);
    const float w1 = g1 * gelu_tanh(rs2 * (1.f / U_SCALE) * h1v) * (1.f / V_SCALE);
    G[(size_t)t * 128 + (lane & 7) * 16 + (lane >> 3)] = w0;
    G[(size_t)t * 128 + (lane & 7) * 16 + 8 + (lane >> 3)] = w1;
  }
}

DI void phase6b2(const Params& P) {
  const int lane = threadIdx.x & 63, g = lane >> 3, c = lane & 7, w = threadIdx.x >> 6;
  const int x = blockIdx.x & 7;
  const int wg = (blockIdx.x >> 3) * 4 + w, nwg = (gridDim.x >> 3) * 4;
  char* ws = P.ws;
  u16* H1B = (u16*)(ws + W_QKV + SZ_ACT);
  const unsigned char* V8 = (const unsigned char*)(ws + W_VB) + ((size_t)x << 21) + c * 16;
  const u16* IDX = (const u16*)(ws + W_IDX) + g * 16;
  const float* WG = (const float*)(ws + W_G) + g * 16;
  float* SSQ3 = (float*)(ws + W_SSQ3);
  const int col = x * 128 + c * 16 + 2 * (g & 1) + 4 * ((g >> 1) & 1) + 8 * ((g >> 2) & 1);
  int t = wg;
  u32x4 ea = (u32x4){0u, 0u, 0u, 0u}, eb = ea;
  f32x4 wq[4];
#pragma unroll
  for (int i = 0; i < 4; i++) wq[i] = (f32x4){0.f, 0.f, 0.f, 0.f};
  if (t < TT) {
    ea = *(const u32x4*)(IDX + (size_t)t * 128);
    eb = *(const u32x4*)(IDX + (size_t)t * 128 + 8);
#pragma unroll
    for (int i = 0; i < 4; i++) wq[i] = *(const f32x4*)(WG + (size_t)t * 128 + i * 4);
  }
  while (t < TT) {
    u32x4 va[16];
    {
      const u32 ev[8] = {ea.x, ea.y, ea.z, ea.w, eb.x, eb.y, eb.z, eb.w};
#pragma unroll
      for (int i = 0; i < 8; i++) {
        va[2 * i] = *(const u32x4*)(V8 + (size_t)(ev[i] & 0xffffu) * 128);
        va[2 * i + 1] = *(const u32x4*)(V8 + (size_t)(ev[i] >> 16) * 128);
      }
    }
    const float wgt[16] = {wq[0].x, wq[0].y, wq[0].z, wq[0].w, wq[1].x, wq[1].y, wq[1].z, wq[1].w,
                           wq[2].x, wq[2].y, wq[2].z, wq[2].w, wq[3].x, wq[3].y, wq[3].z, wq[3].w};
    float* hp = P.out + (size_t)t * 1024 + col;
    const f32x2 hv = *(const f32x2*)hp;
    const int tn = t + nwg;
    if (tn < TT) {
      ea = *(const u32x4*)(IDX + (size_t)tn * 128);
      eb = *(const u32x4*)(IDX + (size_t)tn * 128 + 8);
#pragma unroll
      for (int i = 0; i < 4; i++) wq[i] = *(const f32x4*)(WG + (size_t)tn * 128 + i * 4);
    }
    float o[16];
#pragma unroll
    for (int i = 0; i < 16; i++) o[i] = 0.f;
#pragma unroll
    for (int i = 0; i < 16; i++) {
      u32 r0 = va[i].x, r1 = va[i].y, r2 = va[i].z, r3 = va[i].w;
      asm volatile("" : "+v"(r0), "+v"(r1), "+v"(r2), "+v"(r3) : "v"(o[0]), "v"(o[15]));
      axpy4_fp8(r0, wgt[i], o[0], o[1], o[2], o[3]);
      axpy4_fp8(r1, wgt[i], o[4], o[5], o[6], o[7]);
      axpy4_fp8(r2, wgt[i], o[8], o[9], o[10], o[11]);
      axpy4_fp8(r3, wgt[i], o[12], o[13], o[14], o[15]);
    }
#pragma unroll
    for (int i = 0; i < 8; i++) { float keep = (g & 4) ? o[i + 8] : o[i]; float send = (g & 4) ? o[i] : o[i + 8]; o[i] = keep + __shfl_xor(send, 32); }
#pragma unroll
    for (int i = 0; i < 4; i++) { float keep = (g & 2) ? o[i + 4] : o[i]; float send = (g & 2) ? o[i] : o[i + 4]; o[i] = keep + __shfl_xor(send, 16); }
#pragma unroll
    for (int i = 0; i < 2; i++) { float keep = (g & 1) ? o[i + 2] : o[i]; float send = (g & 1) ? o[i] : o[i + 2]; o[i] = keep + __shfl_xor(send, 8); }
    const float a0 = hv.x + o[0], a1 = hv.y + o[1];
    *(f32x2*)hp = (f32x2){a0, a1};
    *(u32*)(H1B + (size_t)t * 1024 + col) = pack2(a0, a1);
    const float ss = wave_sum(a0 * a0 + a1 * a1);
    if (lane == 0) SSQ3[(size_t)t * 8 + x] = ss;
    t = tn;
  }
}

DI void phase7_tile(const Params& P, int mt, int nt, char* smem) {
  const int tid = threadIdx.x, lane = tid & 63, w = tid >> 6, wm = w >> 1, wn = w & 1, r = lane & 15, quad = lane >> 4;
  const int m0 = mt * 128, n0 = nt * 128;
  char* ws = P.ws;
  const u16* H2B = (const u16*)(ws + W_QKV + SZ_ACT);
  const u16* PB = (const u16*)(ws + W_PB);
  const float* SSQ3 = (const float*)(ws + W_SSQ3);
  float* rs_s = (float*)(smem + RS_OFF);
  __syncthreads();
  if (tid < 128) {
    float q = 0.f;
#pragma unroll
    for (int i = 0; i < 8; i++) q += SSQ3[(size_t)(m0 + tid) * 8 + i];
    rs_s[tid] = rsqrtf(q * (1.f / 1024.f) + EPS);
  }
  u16* PJ = (u16*)(ws + W_QKV);
  f32x4 acc[4][4];
  zero_acc(acc);
  gemm_mainloop(PB + (size_t)m0 * 256, 256, (const u16*)(ws + W_WPP) + (size_t)n0 * 256, 256, 256, (u16*)smem, acc);
  float* Cs = (float*)smem;
  const int c4 = tid & 31, rsub = tid >> 5;
  const size_t tofs = (size_t)m0 * 1024 + n0 + c4 * 4;
  stage_acc(acc, Cs);
#pragma unroll 4
  for (int p = 0; p < 16; p++) {
    const int row = p * 8 + rsub;
    *(u32x2*)(PJ + tofs + (size_t)row * 1024) = pack4(*(const f32x4*)(Cs + row * CSTR + c4 * 4));
  }
  zero_acc(acc);
  gemm_mainloop(H2B + (size_t)m0 * 1024, 1024, (const u16*)(ws + W_WG) + (size_t)n0 * 1024, 1024, 1024, (u16*)smem, acc);
  stage_acc(acc, Cs);
#pragma unroll 4
  for (int p = 0; p < 16; p++) {
    const int row = p * 8 + rsub;
    const f32x4 v = *(const f32x4*)(Cs + row * CSTR + c4 * 4) * rs_s[row];
    const f32x4 pj = unpack4(*(const u32x2*)(PJ + tofs + (size_t)row * 1024));
    const f32x4 h2 = *(const f32x4*)(P.out + tofs + (size_t)row * 1024);
    const f32x4 gate = (f32x4){sigmoidf_(v.x), sigmoidf_(v.y), sigmoidf_(v.z), sigmoidf_(v.w)};
    *(f32x4*)(P.out + tofs + (size_t)row * 1024) = h2 + gate * pj;
  }
}

#define GEMM_TILES(NT, FN)                                                              \
  {                                                                                     \
    for (int t = blockIdx.x; t < 2 * (NT); t += gridDim.x) FN(P, 512 + t / (NT), t % (NT), smem); \
    const int x_ = blockIdx.x & 7, bpx_ = gridDim.x >> 3;                               \
    constexpr int NG_ = (NT) / 8;                                                       \
    for (int s_ = blockIdx.x >> 3; s_ < 64 * 8 * NG_; s_ += bpx_) {                     \
      const int R_ = s_ >> 6, q_ = s_ & 63;                                             \
      const int mg_ = R_ / NG_, ng_ = R_ % NG_;                                         \
      FN(P, ((mg_ * 8 + (q_ >> 3)) << 3) + x_, ng_ * 8 + (q_ & 7), smem);               \
    }                                                                                   \
  }

__global__ void __launch_bounds__(256, 2) fwd_megakernel(Params P) {
  __shared__ __attribute__((aligned(16))) char smem[SMEM_BYTES];
  cg::grid_group grid = cg::this_grid();
  phase0(P, smem);
  grid.sync();
  phase1_scans(P);
  GEMM_TILES(40, phase1_tile)
  grid.sync();
  phase2(P, smem);
  grid.sync();
  GEMM_TILES(8, phase3_tile)
  grid.sync();
  GEMM_TILES(8, phase4_tile)
  grid.sync();
  GEMM_TILES(8, phase5_tile)
  grid.sync();
  for (int t = blockIdx.x; t < TT / 64; t += gridDim.x) phase6a_unit(P, t, smem);
  grid.sync();
  phase6b1(P);
  grid.sync();
  phase6w(P);
  grid.sync();
  phase6b2(P);
  grid.sync();
  GEMM_TILES(8, phase7_tile)
}

extern "C" void kernel_launch(void* const* d_in, const int* in_sizes, int n_in, void* d_out, int out_size, void* d_ws,
                              size_t ws_size, hipStream_t stream) {
  static int grid_blocks = 0;
  if (!grid_blocks) {
    int dev = 0, cus = 0, per_cu = 0;
    hipGetDevice(&dev);
    hipDeviceGetAttribute(&cus, hipDeviceAttributeMultiprocessorCount, dev);
    hipOccupancyMaxActiveBlocksPerMultiprocessor(&per_cu, fwd_megakernel, 256, 0);
    if (per_cu > 2) per_cu = 2;
    if (per_cu < 1) per_cu = 1;
    grid_blocks = cus * per_cu;
  }
  if (ws_size < W_END) { fprintf(stderr, "workspace too small: %zu < %zu\n", ws_size, (size_t)W_END); return; }
  Params p{};
  const float** pf = (const float**)&p;
  for (int i = 0; i < 28; i++) pf[i] = (const float*)d_in[i];
  p.out = (float*)d_out;
  p.ws = (char*)d_ws;
  void* args[] = {&p};
  hipError_t e = hipLaunchCooperativeKernel((void*)fwd_megakernel, dim3(grid_blocks), dim3(256), args, 0, stream);
  if (e != hipSuccess) fprintf(stderr, "cooperative launch failed: %s (grid %d)\n", hipGetErrorString(e), grid_blocks);
}
```

```cpp
#include <hip/hip_runtime.h>
#include <hip/hip_cooperative_groups.h>
#include <cstdio>
namespace cg = cooperative_groups;

typedef unsigned short u16;
typedef unsigned int u32;
typedef short bf16x8 __attribute__((ext_vector_type(8)));
typedef short s16x4 __attribute__((ext_vector_type(4)));
typedef float f32x4 __attribute__((ext_vector_type(4)));
typedef unsigned int u32x4 __attribute__((ext_vector_type(4)));
typedef unsigned int u32x2 __attribute__((ext_vector_type(2)));
typedef __bf16 bf16x2_t __attribute__((ext_vector_type(2)));

#define DI __device__ __forceinline__
#define LAUNDER(x) asm volatile("" : "+v"(x))

constexpr int TP = 65536, TS = 256, TT = TP + TS;
constexpr float LOG2E = 1.4426950408889634f;
constexpr float EPS = 1e-6f;
constexpr float U_SCALE = 1024.f, V_SCALE = 128.f;

constexpr size_t O_AK_P = 67371008, O_AV_P = 100925440, O_AF_P = 134479872, O_BK_P = 135004160,
                 O_BV_P = 143392768, O_AK_S = 151781376, O_AV_S = 151912448, O_AF_S = 152043520,
                 O_BK_S = 152045568, O_BV_S = 152176640;

constexpr size_t SZ_ACT = (size_t)TT * 1024 * 2;
constexpr size_t SZ_HALF = (size_t)TT * 512 * 2;
constexpr size_t W_XB = 0;
constexpr size_t W_QKV = SZ_ACT;
constexpr size_t W_GA = W_QKV + 6 * SZ_HALF;
constexpr size_t W_GB = W_GA + SZ_ACT;
constexpr size_t W_PB = W_GB + SZ_ACT;
constexpr size_t W_WIN = W_PB + (size_t)TT * 256 * 2;
constexpr size_t W_WUPA = W_WIN + (size_t)5120 * 1024 * 2;
constexpr size_t W_WUPB = W_WUPA + 1024 * 512 * 2;
constexpr size_t W_WOUT = W_WUPB + 1024 * 512 * 2;
constexpr size_t W_WQ = W_WOUT + 1024 * 1024 * 2;
constexpr size_t W_WG = W_WQ + 1024 * 1024 * 2;
constexpr size_t W_WPP = W_WG + 1024 * 1024 * 2;
constexpr size_t W_UB = W_WPP + 1024 * 256 * 2;
constexpr size_t W_VB = W_UB + (size_t)16384 * 1024 * 2;
constexpr size_t W_SK = W_VB + (size_t)16384 * 1024 * 2;
constexpr size_t W_RS1 = W_SK + 131072 * 2;
constexpr size_t W_SSQ2 = W_RS1 + (size_t)TT * 4;
constexpr size_t W_RS3 = W_SSQ2 + (size_t)TT * 64;
constexpr size_t W_CUMP = W_RS3 + (size_t)TT * 4;
constexpr size_t W_CUMS = W_CUMP + (size_t)256 * 2048 * 4;
constexpr size_t W_SSQ3 = W_CUMS + (size_t)128 * 4112 * 4 + 1024;
constexpr size_t W_END = W_SSQ3 + (size_t)TT * 8 * 4;
constexpr size_t W_IDX = W_GA;
constexpr size_t W_G = W_GA + (size_t)32 * 1024 * 1024;
constexpr size_t SZ_PH = (size_t)TT * 128 * 4;


struct Params {
  const float *x_p, *x_s, *cak, *cav, *caf, *cbk, *cbv, *p_p, *p_s, *g_mix, *w_in, *b_f, *qn_a, *kn_a,
      *qn_b, *kn_b, *relb, *w_up_a, *w_up_b, *w_out, *g_ffn, *peer_wq, *peer_sk, *peer_u, *peer_v, *g_ple,
      *w_gate, *w_proj;
  float* out;
  char* ws;
};

constexpr int SMEM_BYTES = 128 * 129 * 4 + 2 * 64 * 17 * 4 + 256;

DI float* ph_slice(char* ws, int x) { return (float*)(ws + (x < 4 ? W_XB + (size_t)x * SZ_PH : W_GB + (size_t)(x - 4) * SZ_PH)); }
DI u16 f2bf(float x) { u32 u = __float_as_uint(x); u += 0x7fffu + ((u >> 16) & 1u); return (u16)(u >> 16); }
DI float bf2f(u16 h) { return __uint_as_float(((u32)h) << 16); }
DI u32 pack2(float a, float b) { return (u32)f2bf(a) | ((u32)f2bf(b) << 16); }
DI float wave_sum(float v) {
#pragma unroll
  for (int o = 32; o; o >>= 1) v += __shfl_xor(v, o);
  return v;
}
DI f32x4 mfma16(bf16x8 a, bf16x8 b, f32x4 c) { return __builtin_amdgcn_mfma_f32_16x16x32_bf16(a, b, c, 0, 0, 0); }
DI float sigmoidf_(float x) { return 1.f / (1.f + __expf(-x)); }
DI u32 mono(float x) { u32 u = __float_as_uint(x); u32 m = (u32)((int)u >> 31) | 0x80000000u; return u ^ m; }
DI float unmono(u32 k) { u32 m = ((k >> 31) - 1u) | 0x80000000u; return __uint_as_float(k ^ m); }
DI void insert16(u32 (&L)[16], u32 x) {
#pragma unroll
  for (int s = 0; s < 16; s++) { u32 mx = max(L[s], x); x = min(L[s], x); L[s] = mx; }
}
DI float gelu_tanh(float x) {
  float u = 0.7978845608028654f * (x + 0.044715f * x * x * x);
  float t = 1.f - 2.f / (1.f + __expf(2.f * u));
  return 0.5f * x * (1.f + t);
}

constexpr int GSTR = 72;
constexpr int GBUF = 2 * 128 * GSTR;
constexpr int RS_OFF = 2 * GBUF * 2;
DI void gemm_compute(const u16* As, const u16* Bs, f32x4 (&acc)[4][4], int wm, int wn, int r, int quad) {
#pragma unroll
  for (int ks = 0; ks < 2; ks++) {
    bf16x8 af[4], bfr[4];
#pragma unroll
    for (int mi = 0; mi < 4; mi++) af[mi] = *(const bf16x8*)(As + (wm * 64 + mi * 16 + r) * GSTR + ks * 32 + quad * 8);
#pragma unroll
    for (int ni = 0; ni < 4; ni++) bfr[ni] = *(const bf16x8*)(Bs + (wn * 64 + ni * 16 + r) * GSTR + ks * 32 + quad * 8);
#pragma unroll
    for (int mi = 0; mi < 4; mi++)
#pragma unroll
      for (int ni = 0; ni < 4; ni++) acc[mi][ni] = mfma16(af[mi], bfr[ni], acc[mi][ni]);
    if (ks == 0) __builtin_amdgcn_sched_barrier(0);
  }
}
DI void gemm_mainloop(const u16* __restrict__ A, int lda, const u16* __restrict__ B, int ldb, int K, u16* smem,
                      f32x4 (&acc)[4][4]) {
  const int tid = threadIdx.x, lane = tid & 63, w = tid >> 6, wm = w >> 1, wn = w & 1, r = lane & 15, quad = lane >> 4;
  u16* As0 = smem;
  u16* Bs0 = smem + 128 * GSTR;
  u16* As1 = smem + GBUF;
  u16* Bs1 = As1 + 128 * GSTR;
  u32x4 r0a[4], r0b[4], r1a[4], r1b[4];
  const int lrow = tid >> 3, lch = tid & 7;
  const u16* ap = A + (size_t)lrow * lda + lch * 8;
  const u16* bp = B + (size_t)lrow * ldb + lch * 8;
  const int lo = lrow * GSTR + lch * 8;
  const int nk = K >> 6, km = nk - 1;
  const int krot = (blockIdx.x >> 3) * 5;
#define KOFF(kt) ((((kt) + krot) & km) * 64)
#pragma unroll
  for (int i = 0; i < 4; i++) {
    r0a[i] = *(const u32x4*)(ap + (size_t)i * 32 * lda + KOFF(0));
    r0b[i] = *(const u32x4*)(bp + (size_t)i * 32 * ldb + KOFF(0));
  }
#pragma unroll
  for (int i = 0; i < 4; i++) {
    r1a[i] = *(const u32x4*)(ap + (size_t)i * 32 * lda + KOFF(1));
    r1b[i] = *(const u32x4*)(bp + (size_t)i * 32 * ldb + KOFF(1));
  }
  __syncthreads();
#pragma unroll 1
  for (int kt = 0; kt < nk; kt += 2) {
#pragma unroll
    for (int i = 0; i < 4; i++) {
      *(u32x4*)(As0 + lo + i * 32 * GSTR) = r0a[i];
      *(u32x4*)(Bs0 + lo + i * 32 * GSTR) = r0b[i];
    }
    __syncthreads();
    {
      const int ko = KOFF(kt + 2);
#pragma unroll
      for (int i = 0; i < 4; i++) {
        r0a[i] = *(const u32x4*)(ap + (size_t)i * 32 * lda + ko);
        r0b[i] = *(const u32x4*)(bp + (size_t)i * 32 * ldb + ko);
      }
    }
    gemm_compute(As0, Bs0, acc, wm, wn, r, quad);
#pragma unroll
    for (int i = 0; i < 4; i++) {
      *(u32x4*)(As1 + lo + i * 32 * GSTR) = r1a[i];
      *(u32x4*)(Bs1 + lo + i * 32 * GSTR) = r1b[i];
    }
    __syncthreads();
    {
      const int ko = KOFF(kt + 3);
#pragma unroll
      for (int i = 0; i < 4; i++) {
        r1a[i] = *(const u32x4*)(ap + (size_t)i * 32 * lda + ko);
        r1b[i] = *(const u32x4*)(bp + (size_t)i * 32 * ldb + ko);
      }
    }
    gemm_compute(As1, Bs1, acc, wm, wn, r, quad);
  }
#undef KOFF
}

DI void zero_acc(f32x4 (&acc)[4][4]) {
#pragma unroll
  for (int i = 0; i < 4; i++)
#pragma unroll
    for (int j = 0; j < 4; j++) acc[i][j] = (f32x4){0.f, 0.f, 0.f, 0.f};
}

constexpr int CSTR = 132;
DI void stage_acc(const f32x4 (&acc)[4][4], float* Cs) {
  const int tid = threadIdx.x, lane = tid & 63, w = tid >> 6, wm = w >> 1, wn = w & 1, r = lane & 15, quad = lane >> 4;
  __syncthreads();
#pragma unroll
  for (int mi = 0; mi < 4; mi++)
#pragma unroll
    for (int ni = 0; ni < 4; ni++)
#pragma unroll
      for (int j = 0; j < 4; j++) Cs[(wm * 64 + mi * 16 + quad * 4 + j) * CSTR + wn * 64 + ni * 16 + r] = acc[mi][ni][j];
  __syncthreads();
}
DI u32x2 pack4(f32x4 v) { return (u32x2){pack2(v.x, v.y), pack2(v.z, v.w)}; }
DI f32x4 unpack4(u32x2 p) {
  return (f32x4){__uint_as_float(p.x << 16), __uint_as_float(p.x & 0xffff0000u), __uint_as_float(p.y << 16), __uint_as_float(p.y & 0xffff0000u)};
}

DI void transpose_tile(const float* __restrict__ W, int ldw, int K, const float* __restrict__ g, u16* __restrict__ dst,
                       int k0, int n0, int nsrc0, float* tile) {
  const int tid = threadIdx.x;
  __syncthreads();
  {
    const int ty = tid >> 4, tx = tid & 15;
#pragma unroll
    for (int i = 0; i < 4; i++) {
      int k = ty + i * 16;
      f32x4 v = *(const f32x4*)(W + (size_t)(k0 + k) * ldw + nsrc0 + tx * 4);
      float s = g ? g[k0 + k] : 1.f;
      tile[k * 65 + tx * 4 + 0] = v[0] * s;
      tile[k * 65 + tx * 4 + 1] = v[1] * s;
      tile[k * 65 + tx * 4 + 2] = v[2] * s;
      tile[k * 65 + tx * 4 + 3] = v[3] * s;
    }
  }
  __syncthreads();
  {
    const int n = tid >> 2, kc = (tid & 3) * 16;
    u32 pk[8];
#pragma unroll
    for (int i = 0; i < 8; i++) pk[i] = pack2(tile[(kc + 2 * i) * 65 + n], tile[(kc + 2 * i + 1) * 65 + n]);
    u16* d = dst + (size_t)(n0 + n) * K + k0 + kc;
    *(u32x4*)d = (u32x4){pk[0], pk[1], pk[2], pk[3]};
    *(u32x4*)(d + 8) = (u32x4){pk[4], pk[5], pk[6], pk[7]};
  }
}

DI void conv_unit(const float* __restrict__ src, u16* __restrict__ dst, size_t base, const float* __restrict__ colscale) {
  const int tid = threadIdx.x;
#pragma unroll
  for (int i = 0; i < 4; i++) {
    size_t e = base + (size_t)i * 1024 + tid * 4;
    f32x4 v = *(const f32x4*)(src + e);
    if (colscale) {
      f32x4 gg = *(const f32x4*)(colscale + (e & 1023));
      v = v * gg;
    }
    *(u32x2*)(dst + e) = (u32x2){pack2(v[0], v[1]), pack2(v[2], v[3])};
  }
}

DI void conv_unit_fp8(const float* __restrict__ src, unsigned char* __restrict__ dst, size_t base,
                      const float* __restrict__ colscale, float scale) {
  const int tid = threadIdx.x;
#pragma unroll
  for (int i = 0; i < 4; i++) {
    size_t e = base + (size_t)i * 1024 + tid * 4;
    f32x4 v = *(const f32x4*)(src + e);
    if (colscale) {
      f32x4 gg = *(const f32x4*)(colscale + (e & 1023));
      v = v * gg;
    }
    int w = __builtin_amdgcn_cvt_pk_fp8_f32(v[0] * scale, v[1] * scale, 0, false);
    w = __builtin_amdgcn_cvt_pk_fp8_f32(v[2] * scale, v[3] * scale, w, true);
    *(int*)(dst + (((e & 1023) >> 7) << 21) + ((e >> 10) << 7) + (e & 127)) = w;
  }
}

DI void phase0(const Params& P, char* smem) {
  const int tid = threadIdx.x, lane = tid & 63, w = tid >> 6;
  char* ws = P.ws;
  {
    float* tile = (float*)smem;
    constexpr int T_WIN = 16 * 80, T_UP = 8 * 16, T_SQ = 256, T_PP = 4 * 16;
    constexpr int NT = T_WIN + 2 * T_UP + 3 * T_SQ + T_PP;
    for (int t = blockIdx.x; t < NT; t += gridDim.x) {
      int u = t;
      if (u < T_WIN) {
        int kt = u / 80, nt = u % 80;
        int n0 = nt * 64;
        int ns = n0 < 1536 ? n0 : n0 + 8;
        transpose_tile(P.w_in, 5128, 1024, P.g_mix, (u16*)(ws + W_WIN), kt * 64, n0, ns, tile);
        continue;
      }
      u -= T_WIN;
      if (u < T_UP) { transpose_tile(P.w_up_a, 1024, 512, nullptr, (u16*)(ws + W_WUPA), (u / 16) * 64, (u % 16) * 64, (u % 16) * 64, tile); continue; }
      u -= T_UP;
      if (u < T_UP) { transpose_tile(P.w_up_b, 1024, 512, nullptr, (u16*)(ws + W_WUPB), (u / 16) * 64, (u % 16) * 64, (u % 16) * 64, tile); continue; }
      u -= T_UP;
      if (u < T_SQ) { transpose_tile(P.w_out, 1024, 1024, nullptr, (u16*)(ws + W_WOUT), (u / 16) * 64, (u % 16) * 64, (u % 16) * 64, tile); continue; }
      u -= T_SQ;
      if (u < T_SQ) { transpose_tile(P.peer_wq, 1024, 1024, P.g_ffn, (u16*)(ws + W_WQ), (u / 16) * 64, (u % 16) * 64, (u % 16) * 64, tile); continue; }
      u -= T_SQ;
      if (u < T_SQ) { transpose_tile(P.w_gate, 1024, 1024, P.g_ple, (u16*)(ws + W_WG), (u / 16) * 64, (u % 16) * 64, (u % 16) * 64, tile); continue; }
      u -= T_SQ;
      transpose_tile(P.w_proj, 1024, 256, nullptr, (u16*)(ws + W_WPP), (u / 16) * 64, (u % 16) * 64, (u % 16) * 64, tile);
    }
  }
  {
    constexpr int U_UB = 4096, U_VB = 4096, U_SK = 32, U_PP = 4096, U_PS = 16;
    constexpr int NU = U_UB + U_VB + U_SK + U_PP + U_PS;
    for (int t = blockIdx.x; t < NU; t += gridDim.x) {
      int u = t;
      if (u < U_UB) { conv_unit_fp8(P.peer_u, (unsigned char*)(ws + W_UB), (size_t)u * 4096, P.g_ffn, U_SCALE); continue; }
      u -= U_UB;
      if (u < U_VB) { conv_unit_fp8(P.peer_v, (unsigned char*)(ws + W_VB), (size_t)u * 4096, nullptr, V_SCALE); continue; }
      u -= U_VB;
      if (u < U_SK) { conv_unit(P.peer_sk, (u16*)(ws + W_SK), (size_t)u * 4096, nullptr); continue; }
      u -= U_SK;
      if (u < U_PP) { conv_unit(P.p_p, (u16*)(ws + W_PB), (size_t)u * 4096, nullptr); continue; }
      u -= U_PP;
      conv_unit(P.p_s, (u16*)(ws + W_PB) + (size_t)TP * 256, (size_t)u * 4096, nullptr);
    }
  }
  {
    float* wfl = (float*)smem;
    __syncthreads();
    for (int i = tid; i < 8192; i += 256) {
      int k = i >> 3, h = i & 7;
      wfl[h * 1024 + k] = P.g_mix[k] * P.w_in[(size_t)k * 5128 + 1536 + h];
    }
    __syncthreads();
    u16* XB = (u16*)(ws + W_XB);
    float* RS1 = (float*)(ws + W_RS1);
    for (int t = blockIdx.x * 4 + w; t < TT; t += gridDim.x * 4) {
      const float* xr = t < TP ? P.x_p + (size_t)t * 1024 : P.x_s + (size_t)(t - TP) * 1024;
      f32x4 v[4];
#pragma unroll
      for (int i = 0; i < 4; i++) v[i] = *(const f32x4*)(xr + i * 256 + lane * 4);
      float ss = 0.f;
#pragma unroll
      for (int i = 0; i < 4; i++) ss += v[i][0] * v[i][0] + v[i][1] * v[i][1] + v[i][2] * v[i][2] + v[i][3] * v[i][3];
      float dots[8];
#pragma unroll
      for (int h = 0; h < 8; h++) {
        float d = 0.f;
#pragma unroll
        for (int i = 0; i < 4; i++) {
          f32x4 wv = *(const f32x4*)(wfl + h * 1024 + i * 256 + lane * 4);
          d += v[i][0] * wv[0] + v[i][1] * wv[1] + v[i][2] * wv[2] + v[i][3] * wv[3];
        }
        dots[h] = d;
      }
      ss = wave_sum(ss);
#pragma unroll
      for (int h = 0; h < 8; h++) dots[h] = wave_sum(dots[h]);
      float rs = rsqrtf(ss * (1.f / 1024.f) + EPS);
#pragma unroll
      for (int i = 0; i < 4; i++)
        *(u32x2*)(XB + (size_t)t * 1024 + i * 256 + lane * 4) = (u32x2){pack2(v[i][0], v[i][1]), pack2(v[i][2], v[i][3])};
      if (lane == 0) RS1[t] = rs;
      float myd = dots[0];
#pragma unroll
      for (int h = 1; h < 8; h++) myd = (lane == h) ? dots[h] : myd;
      if (lane < 8) {
        float z = rs * myd + P.b_f[lane];
        float lf = fminf(z, 0.f) - log1pf(expf(-fabsf(z)));
        float* o = t < TP ? P.out + O_AF_P + (size_t)t * 8 : P.out + O_AF_S + (size_t)(t - TP) * 8;
        o[lane] = lf;
      }
    }
  }
}

DI void phase1_scans(const Params& P) {
  const int lane = threadIdx.x & 63;
  const int gw = blockIdx.x * 4 + (threadIdx.x >> 6), nw = gridDim.x * 4;
  float* CUMP = (float*)(P.ws + W_CUMP);
  float* CUMS = (float*)(P.ws + W_CUMS);
  for (int row = gw; row < 384; row += nw) {
    float carry = 0.f;
    if (row < 256) {
      int b = row >> 3, h = row & 7;
      const float* src = P.out + O_AF_P + (size_t)b * 2048 * 8 + h;
      for (int p0 = 0; p0 < 2048; p0 += 64) {
        float v = src[(size_t)(p0 + lane) * 8];
#pragma unroll
        for (int o = 1; o < 64; o <<= 1) { float n = __shfl_up(v, o); if (lane >= o) v += n; }
        v += carry;
        CUMP[(size_t)row * 2048 + p0 + lane] = v * LOG2E;
        carry = __shfl(v, 63);
      }
    } else {
      int rr = row - 256;
      int b = rr >> 3, h = rr & 7;
      const float* src = P.caf + (size_t)b * 4096 * 8 + h;
      for (int p0 = 0; p0 < 4096; p0 += 64) {
        float v = src[(size_t)(p0 + lane) * 8];
#pragma unroll
        for (int o = 1; o < 64; o <<= 1) { float n = __shfl_up(v, o); if (lane >= o) v += n; }
        v += carry;
        CUMS[(size_t)rr * 4112 + p0 + lane] = v * LOG2E;
        carry = __shfl(v, 63);
      }
      {
        float v = lane < 16 ? P.out[O_AF_S + (size_t)(b * 16 + lane) * 8 + h] : 0.f;
#pragma unroll
        for (int o = 1; o < 64; o <<= 1) { float n = __shfl_up(v, o); if (lane >= o) v += n; }
        v += carry;
        if (lane < 16) CUMS[(size_t)rr * 4112 + 4096 + lane] = v * LOG2E;
      }
    }
  }
}

DI void phase1_tile(const Params& P, int mt, int nt, char* smem) {
  const int tid = threadIdx.x, lane = tid & 63, w = tid >> 6, wm = w >> 1, wn = w & 1, r = lane & 15, quad = lane >> 4;
  const int m0 = mt * 128, n0 = nt * 128;
  char* ws = P.ws;
  f32x4 acc[4][4];
  zero_acc(acc);
  gemm_mainloop((const u16*)(ws + W_XB) + (size_t)m0 * 1024, 1024, (const u16*)(ws + W_WIN) + (size_t)n0 * 1024, 1024, 1024,
                (u16*)smem, acc);
  float* Cs = (float*)smem;
  stage_acc(acc, Cs);
  const bool sample = m0 >= TP;
  const int c4 = tid & 31, rsub = tid >> 5;
  const float* RS1 = (const float*)(ws + W_RS1) + m0;
  if (n0 < 3072) {
    const int seg = n0 >> 9, hc = n0 & 511;
    const bool normed = (seg != 2 && seg != 5);
    const float* gain = seg == 0 ? P.qn_a : seg == 1 ? P.kn_a : seg == 3 ? P.qn_b : P.kn_b;
    const float qs = (seg == 0 || seg == 3) ? 0.125f * LOG2E : 1.f;
    f32x4 gn = (f32x4){1.f, 1.f, 1.f, 1.f};
    if (normed) gn = *(const f32x4*)(gain + (c4 & 15) * 4) * qs;
    u16* dp = (u16*)(ws + W_QKV + (size_t)seg * SZ_HALF) + (size_t)m0 * 512 + hc + c4 * 4;
    float* op = nullptr;
    if (seg == 1 || seg == 2) {
      op = sample ? P.out + (seg == 1 ? O_AK_S : O_AV_S) + (size_t)(m0 - TP) * 512 : P.out + (seg == 1 ? O_AK_P : O_AV_P) + (size_t)m0 * 512;
    } else if (seg == 4 || seg == 5) {
      if (sample) op = P.out + (seg == 4 ? O_BK_S : O_BV_S) + (size_t)(m0 - TP) * 512;
      else if ((m0 & 2047) >= 1536) op = P.out + (seg == 4 ? O_BK_P : O_BV_P) + ((size_t)(m0 >> 11) * 512 + ((m0 & 2047) - 1536)) * 512;
    }
    if (op) op += hc + c4 * 4;
#pragma unroll 4
    for (int p = 0; p < 16; p++) {
      const int row = p * 8 + rsub;
      f32x4 v = *(const f32x4*)(Cs + row * CSTR + c4 * 4) * RS1[row];
      if (normed) {
        float ss = v.x * v.x + v.y * v.y + v.z * v.z + v.w * v.w;
        ss += __shfl_xor(ss, 1);
        ss += __shfl_xor(ss, 2);
        ss += __shfl_xor(ss, 4);
        ss += __shfl_xor(ss, 8);
        v = v * gn * rsqrtf(ss * (1.f / 64.f) + EPS);
      }
      *(u32x2*)(dp + (size_t)row * 512) = pack4(v);
      if (op) *(f32x4*)(op + (size_t)row * 512) = v;
    }
  } else {
    u16* dp = (n0 < 4096 ? (u16*)(ws + W_GA) + (n0 - 3072) : (u16*)(ws + W_GB) + (n0 - 4096)) + (size_t)m0 * 1024 + c4 * 4;
#pragma unroll 4
    for (int p = 0; p < 16; p++) {
      const int row = p * 8 + rsub;
      f32x4 v = *(const f32x4*)(Cs + row * CSTR + c4 * 4) * RS1[row];
      v = (f32x4){sigmoidf_(v.x), sigmoidf_(v.y), sigmoidf_(v.z), sigmoidf_(v.w)};
      *(u32x2*)(dp + (size_t)row * 1024) = pack4(v);
    }
  }
}

constexpr int ASTR = 72;
constexpr int TAB_OFF = 36864;
struct AttnState { f32x4 o[4]; float m, l; };

DI s16x4 tr_read(const u16* p) {
  return __builtin_amdgcn_ds_read_tr16_b64_v4i16((__attribute__((address_space(3))) s16x4*)(p));
}

template <int MODE>
DI void attn_step(const u16* Ks, const u16* Vs, const bf16x8 (&qf)[2], AttnState& st, int kpos0, int qpos, int qlim,
                  float cq, const float* cum, const float* tab, bool domask) {
  const int lane = threadIdx.x & 63, r = lane & 15, quad = lane >> 4;
  f32x4 s[2];
#pragma unroll
  for (int t = 0; t < 2; t++) {
    f32x4 a4 = (f32x4){0.f, 0.f, 0.f, 0.f};
#pragma unroll
    for (int ks = 0; ks < 2; ks++) {
      bf16x8 kf = *(const bf16x8*)(Ks + (t * 16 + r) * ASTR + ks * 32 + quad * 8);
      a4 = mfma16(kf, qf[ks], a4);
    }
    s[t] = a4;
  }
#pragma unroll
  for (int t = 0; t < 2; t++) {
    const int kb = kpos0 + t * 16 + quad * 4;
    if (MODE == 0) {
      f32x4 c4 = *(const f32x4*)(cum + kb);
#pragma unroll
      for (int j = 0; j < 4; j++) s[t][j] += cq - c4[j];
    } else {
#pragma unroll
      for (int j = 0; j < 4; j++) {
        int rel = kb + j - qpos;
        rel = min(max(rel, -128), 128) + 128;
        s[t][j] += tab[rel];
      }
    }
    if (domask) {
#pragma unroll
      for (int j = 0; j < 4; j++)
        if (kb + j > qlim) s[t][j] = -1e30f;
    }
  }
  float mx = fmaxf(fmaxf(fmaxf(s[0][0], s[0][1]), fmaxf(s[0][2], s[0][3])), fmaxf(fmaxf(s[1][0], s[1][1]), fmaxf(s[1][2], s[1][3])));
  mx = fmaxf(mx, __shfl_xor(mx, 16));
  mx = fmaxf(mx, __shfl_xor(mx, 32));
  const float mn = fmaxf(st.m, mx);
  const float alpha = __builtin_amdgcn_exp2f(st.m - mn);
  float p[8];
  float ls = 0.f;
#pragma unroll
  for (int t = 0; t < 2; t++)
#pragma unroll
    for (int j = 0; j < 4; j++) { p[t * 4 + j] = __builtin_amdgcn_exp2f(s[t][j] - mn); ls += p[t * 4 + j]; }
  st.l = st.l * alpha + ls;
  st.m = mn;
#pragma unroll
  for (int dt = 0; dt < 4; dt++) st.o[dt] = st.o[dt] * alpha;
  u32x4 pk = (u32x4){pack2(p[0], p[1]), pack2(p[2], p[3]), pack2(p[4], p[5]), pack2(p[6], p[7])};
  bf16x8 pf = __builtin_bit_cast(bf16x8, pk);
  const int qq = (lane & 15) >> 2, pp = lane & 3;
#pragma unroll
  for (int dt = 0; dt < 4; dt++) {
    s16x4 lo = tr_read(Vs + (quad * 4 + qq) * ASTR + dt * 16 + pp * 4);
    s16x4 hi = tr_read(Vs + (16 + quad * 4 + qq) * ASTR + dt * 16 + pp * 4);
    bf16x8 vf = __builtin_shufflevector(lo, hi, 0, 1, 2, 3, 4, 5, 6, 7);
    st.o[dt] = mfma16(vf, pf, st.o[dt]);
  }
}

template <int MODE>
DI void attn_prompt_item(const Params& P, char* smem, int b, int h, int qt) {
  const int tid = threadIdx.x, lane = tid & 63, w = tid >> 6, r = lane & 15, quad = lane >> 4;
  char* ws = P.ws;
  const u16* Q = (const u16*)(ws + W_QKV + (size_t)(MODE == 0 ? 0 : 3) * SZ_HALF);
  const u16* Kg = (const u16*)(ws + W_QKV + (size_t)(MODE == 0 ? 1 : 4) * SZ_HALF);
  const u16* Vg = (const u16*)(ws + W_QKV + (size_t)(MODE == 0 ? 2 : 5) * SZ_HALF);
  u16* Y = (u16*)(ws + W_XB + (size_t)(MODE == 0 ? 0 : 1) * SZ_HALF);
  u16* Ks = (u16*)smem;
  u16* Vs = Ks + 64 * ASTR;
  float* tab = (float*)(smem + TAB_OFF);
  __syncthreads();
  if (MODE == 1) {
    for (int i = tid; i < 257; i += 256) tab[i] = P.relb[h * 257 + i] * LOG2E;
  }
  const int q0 = qt * 64;
  const int qpos = q0 + w * 16 + r;
  const size_t tokq = (size_t)b * 2048 + qpos;
  bf16x8 qf[2];
#pragma unroll
  for (int ks = 0; ks < 2; ks++) qf[ks] = *(const bf16x8*)(Q + tokq * 512 + h * 64 + ks * 32 + quad * 8);
  const float* cum = (const float*)(ws + W_CUMP) + (size_t)(b * 8 + h) * 2048;
  const float cq = MODE == 0 ? cum[qpos] : 0.f;
  AttnState st;
#pragma unroll
  for (int dt = 0; dt < 4; dt++) st.o[dt] = (f32x4){0.f, 0.f, 0.f, 0.f};
  st.m = -1e30f;
  st.l = 0.f;
  const int kt_lo = MODE == 0 ? 0 : max(0, qt - 8), kt_hi = qt;
  u32x4 rk[2], rv[2];
  const int lkey = tid >> 3, lch = tid & 7;
  const u16* kp = Kg + ((size_t)b * 2048 + lkey) * 512 + h * 64 + lch * 8;
  const u16* vp = Vg + ((size_t)b * 2048 + lkey) * 512 + h * 64 + lch * 8;
#pragma unroll
  for (int i = 0; i < 2; i++) {
    rk[i] = *(const u32x4*)(kp + (size_t)(kt_lo * 64 + i * 32) * 512);
    rv[i] = *(const u32x4*)(vp + (size_t)(kt_lo * 64 + i * 32) * 512);
  }
  for (int kt = kt_lo; kt <= kt_hi; kt++) {
    __syncthreads();
#pragma unroll
    for (int i = 0; i < 2; i++) {
      *(u32x4*)(Ks + (lkey + i * 32) * ASTR + lch * 8) = rk[i];
      *(u32x4*)(Vs + (lkey + i * 32) * ASTR + lch * 8) = rv[i];
    }
    __syncthreads();
    if (kt < kt_hi) {
#pragma unroll
      for (int i = 0; i < 2; i++) {
        rk[i] = *(const u32x4*)(kp + (size_t)((kt + 1) * 64 + i * 32) * 512);
        rv[i] = *(const u32x4*)(vp + (size_t)((kt + 1) * 64 + i * 32) * 512);
      }
    }
    const bool diag = (MODE == 0) && (kt == qt);
#pragma unroll
    for (int half = 0; half < 2; half++) {
      const int kpos0 = kt * 64 + half * 32;
      if (diag && kpos0 > q0 + w * 16 + 15) continue;
      attn_step<MODE>(Ks + half * 32 * ASTR, Vs + half * 32 * ASTR, qf, st, kpos0, qpos, qpos, cq, cum, tab, diag);
    }
  }
  float lt = st.l;
  lt += __shfl_xor(lt, 16);
  lt += __shfl_xor(lt, 32);
  const float inv = 1.f / lt;
#pragma unroll
  for (int dt = 0; dt < 4; dt++) {
    u32x2 o2 = (u32x2){pack2(st.o[dt][0] * inv, st.o[dt][1] * inv), pack2(st.o[dt][2] * inv, st.o[dt][3] * inv)};
    *(u32x2*)(Y + tokq * 512 + h * 64 + dt * 16 + quad * 4) = o2;
  }
}

template <int MODE>
DI void attn_sample_item(const Params& P, char* smem, int b, int h) {
  const int tid = threadIdx.x, lane = tid & 63, w = tid >> 6, r = lane & 15, quad = lane >> 4;
  constexpr int L = MODE == 0 ? 4096 : 512;
  char* ws = P.ws;
  const u16* Q = (const u16*)(ws + W_QKV + (size_t)(MODE == 0 ? 0 : 3) * SZ_HALF);
  const u16* Kn = (const u16*)(ws + W_QKV + (size_t)(MODE == 0 ? 1 : 4) * SZ_HALF);
  const u16* Vn = (const u16*)(ws + W_QKV + (size_t)(MODE == 0 ? 2 : 5) * SZ_HALF);
  u16* Y = (u16*)(ws + W_XB + (size_t)(MODE == 0 ? 0 : 1) * SZ_HALF);
  u16* Kw = (u16*)smem + w * (2 * 32 * ASTR);
  u16* Vw = Kw + 32 * ASTR;
  float* tab = (float*)(smem + TAB_OFF);
  __syncthreads();
  if (MODE == 1) {
    for (int i = tid; i < 257; i += 256) tab[i] = P.relb[h * 257 + i] * LOG2E;
  }
  __syncthreads();
  const float* ck = (MODE == 0 ? P.cak : P.cbk) + ((size_t)b * L * 8 + h) * 64;
  const float* cv = (MODE == 0 ? P.cav : P.cbv) + ((size_t)b * L * 8 + h) * 64;
  const size_t tokbase = (size_t)TP + b * 16;
  bf16x8 qf[2];
#pragma unroll
  for (int ks = 0; ks < 2; ks++) qf[ks] = *(const bf16x8*)(Q + (tokbase + r) * 512 + h * 64 + ks * 32 + quad * 8);
  const int qpos = L + r;
  const float* cum = (const float*)(ws + W_CUMS) + (size_t)(b * 8 + h) * 4112;
  const float cq = MODE == 0 ? cum[qpos] : 0.f;
  AttnState st;
#pragma unroll
  for (int dt = 0; dt < 4; dt++) st.o[dt] = (f32x4){0.f, 0.f, 0.f, 0.f};
  st.m = -1e30f;
  st.l = 0.f;
  const int kbeg = w * (L / 4), kend = kbeg + L / 4;
  for (int k0 = kbeg; k0 < kend; k0 += 32) {
    {
      f32x4 kr[8];
#pragma unroll
      for (int i = 0; i < 8; i++) kr[i] = *(const f32x4*)(ck + (size_t)(k0 + i * 4 + quad) * 512 + r * 4);
#pragma unroll
      for (int i = 0; i < 8; i++)
        *(u32x2*)(Kw + (i * 4 + quad) * ASTR + r * 4) = (u32x2){pack2(kr[i][0], kr[i][1]), pack2(kr[i][2], kr[i][3])};
    }
    {
      f32x4 vr[8];
#pragma unroll
      for (int i = 0; i < 8; i++) vr[i] = *(const f32x4*)(cv + (size_t)(k0 + i * 4 + quad) * 512 + r * 4);
#pragma unroll
      for (int i = 0; i < 8; i++)
        *(u32x2*)(Vw + (i * 4 + quad) * ASTR + r * 4) = (u32x2){pack2(vr[i][0], vr[i][1]), pack2(vr[i][2], vr[i][3])};
    }
    asm volatile("s_waitcnt lgkmcnt(0)" ::: "memory");
    __builtin_amdgcn_wave_barrier();
    attn_step<MODE>(Kw, Vw, qf, st, k0, qpos, qpos, cq, cum, tab, false);
    __builtin_amdgcn_wave_barrier();
  }
  if (w == 0) {
#pragma unroll
    for (int i = 0; i < 2; i++) {
      int c = lane + i * 64;
      int key = c >> 3, ch = c & 7;
      u32x4 kk = *(const u32x4*)(Kn + (tokbase + key) * 512 + h * 64 + ch * 8);
      u32x4 vv = *(const u32x4*)(Vn + (tokbase + key) * 512 + h * 64 + ch * 8);
      *(u32x4*)(Kw + key * ASTR + ch * 8) = kk;
      *(u32x4*)(Vw + key * ASTR + ch * 8) = vv;
      *(u32x4*)(Kw + (16 + key) * ASTR + ch * 8) = (u32x4){0u, 0u, 0u, 0u};
      *(u32x4*)(Vw + (16 + key) * ASTR + ch * 8) = (u32x4){0u, 0u, 0u, 0u};
    }
    asm volatile("s_waitcnt lgkmcnt(0)" ::: "memory");
    __builtin_amdgcn_wave_barrier();
    attn_step<MODE>(Kw, Vw, qf, st, L, qpos, MODE == 0 ? qpos : L + 15, cq, cum, tab, true);
  }
  __syncthreads();
  float* comb = (float*)smem;
  float lt = st.l;
  lt += __shfl_xor(lt, 16);
  lt += __shfl_xor(lt, 32);
#pragma unroll
  for (int dt = 0; dt < 4; dt++)
#pragma unroll
    for (int j = 0; j < 4; j++) comb[(w * 16 + r) * 68 + dt * 16 + quad * 4 + j] = st.o[dt][j];
  if (quad == 0) {
    comb[(w * 16 + r) * 68 + 64] = st.m;
    comb[(w * 16 + r) * 68 + 65] = lt;
  }
  __syncthreads();
  if (w == 0) {
    float mw[4], M = -1e30f;
#pragma unroll
    for (int i = 0; i < 4; i++) { mw[i] = comb[(i * 16 + r) * 68 + 64]; M = fmaxf(M, mw[i]); }
    float Ls = 0.f, scl[4];
#pragma unroll
    for (int i = 0; i < 4; i++) { scl[i] = __builtin_amdgcn_exp2f(mw[i] - M); Ls += scl[i] * comb[(i * 16 + r) * 68 + 65]; }
    const float inv = 1.f / Ls;
#pragma unroll
    for (int dt = 0; dt < 4; dt++) {
      float ov[4];
#pragma unroll
      for (int j = 0; j < 4; j++) {
        float a = 0.f;
#pragma unroll
        for (int i = 0; i < 4; i++) a += scl[i] * comb[(i * 16 + r) * 68 + dt * 16 + quad * 4 + j];
        ov[j] = a * inv;
      }
      *(u32x2*)(Y + (tokbase + r) * 512 + h * 64 + dt * 16 + quad * 4) = (u32x2){pack2(ov[0], ov[1]), pack2(ov[2], ov[3])};
    }
  }
}

DI void phase2(const Params& P, char* smem) {
  constexpr int N_SA = 128, N_PA = 8192, N_PB = 8192, N_SB = 128;
  for (int it = blockIdx.x; it < N_SA + N_PA + N_PB + N_SB; it += gridDim.x) {
    int u = it;
    if (u < N_SA) { attn_sample_item<0>(P, smem, u >> 3, u & 7); continue; }
    u -= N_SA;
    if (u < N_PA) { int qt = 31 - (u >> 8), bh = u & 255; attn_prompt_item<0>(P, smem, bh >> 3, bh & 7, qt); continue; }
    u -= N_PA;
    if (u < N_PB) { int qt = 31 - (u >> 8), bh = u & 255; attn_prompt_item<1>(P, smem, bh >> 3, bh & 7, qt); continue; }
    u -= N_PB;
    attn_sample_item<1>(P, smem, u >> 3, u & 7);
  }
}

DI void phase3_tile(const Params& P, int mt, int nt, char* smem) {
  const int tid = threadIdx.x, lane = tid & 63, w = tid >> 6, wm = w >> 1, wn = w & 1, r = lane & 15, quad = lane >> 4;
  const int m0 = mt * 128, n0 = nt * 128;
  char* ws = P.ws;
  const u16* YA = (const u16*)(ws + W_XB);
  const u16* YB = YA + (size_t)TT * 512;
  const u16* GA = (const u16*)(ws + W_GA);
  const u16* GB = (const u16*)(ws + W_GB);
  u16* MRG = (u16*)(ws + W_QKV);
  f32x4 acc[4][4];
  zero_acc(acc);
  gemm_mainloop(YA + (size_t)m0 * 512, 512, (const u16*)(ws + W_WUPA) + (size_t)n0 * 512, 512, 512, (u16*)smem, acc);
  float* Cs = (float*)smem;
  const int c4 = tid & 31, rsub = tid >> 5;
  const size_t tofs = (size_t)m0 * 1024 + n0 + c4 * 4;
  stage_acc(acc, Cs);
#pragma unroll 4
  for (int p = 0; p < 16; p++) {
    const int row = p * 8 + rsub;
    const f32x4 v = *(const f32x4*)(Cs + row * CSTR + c4 * 4);
    const f32x4 gv = unpack4(*(const u32x2*)(GA + tofs + (size_t)row * 1024));
    *(u32x2*)(MRG + tofs + (size_t)row * 1024) = pack4(v * gv);
  }
  zero_acc(acc);
  gemm_mainloop(YB + (size_t)m0 * 512, 512, (const u16*)(ws + W_WUPB) + (size_t)n0 * 512, 512, 512, (u16*)smem, acc);
  stage_acc(acc, Cs);
#pragma unroll 4
  for (int p = 0; p < 16; p++) {
    const int row = p * 8 + rsub;
    const f32x4 v = *(const f32x4*)(Cs + row * CSTR + c4 * 4);
    const f32x4 gv = unpack4(*(const u32x2*)(GB + tofs + (size_t)row * 1024));
    const f32x4 m1 = unpack4(*(const u32x2*)(MRG + tofs + (size_t)row * 1024));
    *(u32x2*)(MRG + tofs + (size_t)row * 1024) = pack4(m1 + v * gv);
  }
}

DI void phase4_tile(const Params& P, int mt, int nt, char* smem) {
  const int tid = threadIdx.x, lane = tid & 63, w = tid >> 6, wm = w >> 1, wn = w & 1, r = lane & 15, quad = lane >> 4;
  const int m0 = mt * 128, n0 = nt * 128;
  char* ws = P.ws;
  const u16* MRG = (const u16*)(ws + W_QKV);
  u16* H1B = (u16*)(ws + W_QKV + SZ_ACT);
  float* SSQ2 = (float*)(ws + W_SSQ2);
  f32x4 acc[4][4];
  zero_acc(acc);
  gemm_mainloop(MRG + (size_t)m0 * 1024, 1024, (const u16*)(ws + W_WOUT) + (size_t)n0 * 1024, 1024, 1024, (u16*)smem, acc);
  const float* xb = m0 < TP ? P.x_p : P.x_s - (size_t)TP * 1024;
  float* Cs = (float*)smem;
  const int c4 = tid & 31, rsub = tid >> 5;
  const size_t tofs = (size_t)m0 * 1024 + n0 + c4 * 4;
  stage_acc(acc, Cs);
#pragma unroll 4
  for (int p = 0; p < 16; p++) {
    const int row = p * 8 + rsub;
    const f32x4 v = *(const f32x4*)(Cs + row * CSTR + c4 * 4);
    const f32x4 h1 = *(const f32x4*)(xb + tofs + (size_t)row * 1024) + v;
    *(f32x4*)(P.out + tofs + (size_t)row * 1024) = h1;
    *(u32x2*)(H1B + tofs + (size_t)row * 1024) = pack4(h1);
    float ss = h1.x * h1.x + h1.y * h1.y + h1.z * h1.z + h1.w * h1.w;
    ss += __shfl_xor(ss, 1);
    ss += __shfl_xor(ss, 2);
    ss += __shfl_xor(ss, 4);
    ss += __shfl_xor(ss, 8);
    ss += __shfl_xor(ss, 16);
    if (c4 == 0) SSQ2[(size_t)(m0 + row) * 16 + nt] = ss;
  }
}

DI void phase5_tile(const Params& P, int mt, int nt, char* smem) {
  const int tid = threadIdx.x, lane = tid & 63, w = tid >> 6, wm = w >> 1, wn = w & 1, r = lane & 15, quad = lane >> 4;
  const int m0 = mt * 128, n0 = nt * 128;
  char* ws = P.ws;
  const u16* H1B = (const u16*)(ws + W_QKV + SZ_ACT);
  u16* QP = (u16*)(ws + W_QKV + 2 * SZ_ACT);
  const float* SSQ2 = (const float*)(ws + W_SSQ2);
  float* rs_s = (float*)(smem + RS_OFF);
  __syncthreads();
  if (tid < 128) {
    float s = 0.f;
#pragma unroll
    for (int i = 0; i < 8; i++) s += SSQ2[(size_t)(m0 + tid) * 16 + i];
    rs_s[tid] = rsqrtf(s * (1.f / 1024.f) + EPS);
  }
  f32x4 acc[4][4];
  zero_acc(acc);
  gemm_mainloop(H1B + (size_t)m0 * 1024, 1024, (const u16*)(ws + W_WQ) + (size_t)n0 * 1024, 1024, 1024, (u16*)smem, acc);
  float* Cs = (float*)smem;
  const int c4 = tid & 31, rsub = tid >> 5;
  const size_t tofs = (size_t)m0 * 1024 + n0 + c4 * 4;
  stage_acc(acc, Cs);
#pragma unroll 4
  for (int p = 0; p < 16; p++) {
    const int row = p * 8 + rsub;
    const f32x4 v = *(const f32x4*)(Cs + row * CSTR + c4 * 4) * rs_s[row];
    *(u32x2*)(QP + tofs + (size_t)row * 1024) = pack4(v);
  }
}

DI void bitonic_merge16(u32 (&L)[16]) {
#pragma unroll
  for (int st = 8; st >= 1; st >>= 1)
#pragma unroll
    for (int i = 0; i < 16; i++)
      if ((i & st) == 0) { u32 hi = max(L[i], L[i + st]); u32 lo = min(L[i], L[i + st]); L[i] = hi; L[i + st] = lo; }
}
DI void phase6a_unit(const Params& P, int unit, char* smem) {
  const int tid = threadIdx.x, lane = tid & 63, w = tid >> 6, r = lane & 15, quad = lane >> 4;
  char* ws = P.ws;
  const u16* QP = (const u16*)(ws + W_QKV + 2 * SZ_ACT);
  const u16* SK = (const u16*)(ws + W_SK);
  u16* IDXo = (u16*)(ws + W_IDX);
  float* Go = (float*)(ws + W_G);
  float* sc = (float*)smem;
  u32* hl = (u32*)smem;
  u32* xl = (u32*)smem + 256 * 17;
  u32* lists = (u32*)(smem + 128 * 129 * 4);
  unsigned char* tabi = (unsigned char*)(smem + 128 * 129 * 4 + 128 * 17 * 4);
  unsigned char* tabj = tabi + 64;
  const int tok0 = unit * 64;
  __syncthreads();
  if (tid == 0) {
    int c = 0;
    for (int i = 0; i < 16; i++)
      for (int j = i + 1; j < 16; j++)
        if ((i + 1) * (j + 1) <= 16) { tabi[c] = (unsigned char)i; tabj[c] = (unsigned char)j; tabi[32 + c] = (unsigned char)j; tabj[32 + c] = (unsigned char)i; c++; }
    tabi[23] = 0; tabj[23] = 0; tabi[24] = 1; tabj[24] = 1;
    tabi[55] = 2; tabj[55] = 2; tabi[56] = 3; tabj[56] = 3;
  }
  for (int h = 0; h < 8; h++) {
#pragma unroll
    for (int p = 0; p < 2; p++) {
      const int hp = h * 2 + p;
      bf16x8 qf[2];
#pragma unroll
      for (int ks = 0; ks < 2; ks++)
        qf[ks] = *(const bf16x8*)(QP + (size_t)(tok0 + w * 16 + r) * 1024 + hp * 64 + ks * 32 + quad * 8);
#pragma unroll
      for (int nt = 0; nt < 8; nt++) {
        f32x4 a4 = (f32x4){0.f, 0.f, 0.f, 0.f};
#pragma unroll
        for (int ks = 0; ks < 2; ks++) {
          bf16x8 kf = *(const bf16x8*)(SK + (size_t)(hp * 128 + nt * 16 + r) * 64 + ks * 32 + quad * 8);
          a4 = mfma16(kf, qf[ks], a4);
        }
        float* d = sc + (p * 64 + w * 16 + r) * 129 + nt * 16 + quad * 4;
        d[0] = a4[0]; d[1] = a4[1]; d[2] = a4[2]; d[3] = a4[3];
      }
    }
    __syncthreads();
    u32 L[16];
    {
#pragma unroll
      for (int s = 0; s < 16; s++) L[s] = 0u;
      const int inst = tid & 127, half = tid >> 7;
      const float* row = sc + inst * 129 + half * 64;
#pragma unroll 4
      for (int i = 0; i < 64; i++) {
        u32 k = (mono(row[i]) & ~127u) | (u32)(half * 64 + i);
        insert16(L, k);
      }
    }
    __syncthreads();
#pragma unroll
    for (int s = 0; s < 16; s++) hl[tid * 17 + s] = L[s];
    __syncthreads();
    if (tid < 128) {
      u32 M[16];
#pragma unroll
      for (int s = 0; s < 16; s++) M[s] = max(L[s], hl[(tid + 128) * 17 + 15 - s]);
      bitonic_merge16(M);
#pragma unroll
      for (int s = 0; s < 16; s++) lists[tid * 17 + s] = M[s];
    }
    __syncthreads();
    if (tid < 128) {
      const int tok = tid & 63;
      const bool part = tid >= 64;
      float fa[16], fb[16];
#pragma unroll
      for (int s = 0; s < 16; s++) {
        const float va = unmono(lists[tok * 17 + s] & ~127u);
        const float vb = unmono(lists[(64 + tok) * 17 + s] & ~127u);
        fa[s] = part ? vb : va;
        fb[s] = part ? va : vb;
      }
      u32 L2[16];
#pragma unroll
      for (int s = 0; s < 16; s++) L2[s] = 0u;
      const u32 cbase = part ? 32u : 0u;
      {
        int c = 0;
#pragma unroll
        for (int i = 0; i < 16; i++)
#pragma unroll
          for (int j = i + 1; j < 16; j++)
            if ((i + 1) * (j + 1) <= 16) {
              insert16(L2, (mono(fa[i] + fb[j]) & ~63u) | (cbase + (u32)c));
              c++;
            }
      }
      insert16(L2, (mono(part ? fa[2] + fb[2] : fa[0] + fb[0]) & ~63u) | (cbase + 23u));
      insert16(L2, (mono(part ? fa[3] + fb[3] : fa[1] + fb[1]) & ~63u) | (cbase + 24u));
#pragma unroll
      for (int s = 0; s < 16; s++) xl[tid * 17 + s] = L2[s];
    }
    __syncthreads();
    if (tid < 64) {
      float val[16];
      u32 idx[16];
      float mx = -1e30f;
#pragma unroll
      for (int s = 0; s < 16; s++) {
        const u32 m = max(xl[tid * 17 + s], xl[(tid + 64) * 17 + 15 - s]);
        const u32 sl = m & 63u;
        const int i = tabi[sl], j = tabj[sl];
        const u32 au = lists[tid * 17 + i], bu = lists[(64 + tid) * 17 + j];
        val[s] = unmono(au & ~127u) + unmono(bu & ~127u);
        idx[s] = (au & 127u) * 128u + (bu & 127u);
        mx = fmaxf(mx, val[s]);
      }
      float sum = 0.f;
#pragma unroll
      for (int s = 0; s < 16; s++) { val[s] = __expf(val[s] - mx); sum += val[s]; }
      const float inv = 1.f / sum;
      const size_t so = ((size_t)(tok0 + tid) * 8 + h) * 16;
      {
        u32* ib = (u32*)(IDXo + (size_t)(tok0 + tid) * 128 + h * 2);
#pragma unroll
        for (int gg = 0; gg < 8; gg++) ib[gg * 8] = idx[gg] | (idx[gg + 8] << 16);
      }
#pragma unroll
      for (int s = 0; s < 4; s++)
        *(f32x4*)(Go + so + s * 4) = (f32x4){val[s * 4] * inv, val[s * 4 + 1] * inv, val[s * 4 + 2] * inv, val[s * 4 + 3] * inv};
    }
    __syncthreads();
  }
}

typedef float f32x2 __attribute__((ext_vector_type(2)));
DI float dot4_fp8(u32 w, float x0, float x1, float x2, float x3, float acc) {
  f32x2 lo = __builtin_amdgcn_cvt_pk_f32_fp8((int)w, false);
  f32x2 hi = __builtin_amdgcn_cvt_pk_f32_fp8((int)w, true);
  acc = fmaf(lo[0], x0, acc);
  acc = fmaf(lo[1], x1, acc);
  acc = fmaf(hi[0], x2, acc);
  acc = fmaf(hi[1], x3, acc);
  return acc;
}
DI void axpy4_fp8(u32 w, float wgt, float& o0, float& o1, float& o2, float& o3) {
  f32x2 lo = __builtin_amdgcn_cvt_pk_f32_fp8((int)w, false);
  f32x2 hi = __builtin_amdgcn_cvt_pk_f32_fp8((int)w, true);
  o0 = fmaf(wgt, lo[0], o0);
  o1 = fmaf(wgt, lo[1], o1);
  o2 = fmaf(wgt, hi[0], o2);
  o3 = fmaf(wgt, hi[1], o3);
}

DI void phase6b1(const Params& P) {
  const int lane = threadIdx.x & 63, g = lane >> 3, c = lane & 7;
  const int x = blockIdx.x & 7;
  const int wg = (blockIdx.x >> 3) * 4 + (threadIdx.x >> 6), nwg = (gridDim.x >> 3) * 4;
  char* ws = P.ws;
  const u16* H1B = (const u16*)(ws + W_QKV + SZ_ACT);
  const unsigned char* U8 = (const unsigned char*)(ws + W_UB) + ((size_t)x << 21) + c * 16;
  const u16* IDX = (const u16*)(ws + W_IDX) + g * 16;
  float* PH = ph_slice(ws, x) + g;
  int t = wg;
  u32x4 ea = (u32x4){0u, 0u, 0u, 0u}, eb = ea;
  if (t < TT) {
    ea = *(const u32x4*)(IDX + (size_t)t * 128);
    eb = *(const u32x4*)(IDX + (size_t)t * 128 + 8);
  }
  while (t < TT) {
    u32x4 ua[16];
    {
      const u32 ev[8] = {ea.x, ea.y, ea.z, ea.w, eb.x, eb.y, eb.z, eb.w};
#pragma unroll
      for (int i = 0; i < 8; i++) {
        ua[2 * i] = *(const u32x4*)(U8 + (size_t)(ev[i] & 0xffffu) * 128);
        ua[2 * i + 1] = *(const u32x4*)(U8 + (size_t)(ev[i] >> 16) * 128);
      }
    }
    const u32x4 xa = *(const u32x4*)(H1B + (size_t)t * 1024 + x * 128 + c * 16);
    const u32x4 xb = *(const u32x4*)(H1B + (size_t)t * 1024 + x * 128 + c * 16 + 8);
    const int tn = t + nwg;
    if (tn < TT) {
      ea = *(const u32x4*)(IDX + (size_t)tn * 128);
      eb = *(const u32x4*)(IDX + (size_t)tn * 128 + 8);
    }
    float xf[16];
    xf[0] = __uint_as_float(xa.x << 16); xf[1] = __uint_as_float(xa.x & 0xffff0000u);
    xf[2] = __uint_as_float(xa.y << 16); xf[3] = __uint_as_float(xa.y & 0xffff0000u);
    xf[4] = __uint_as_float(xa.z << 16); xf[5] = __uint_as_float(xa.z & 0xffff0000u);
    xf[6] = __uint_as_float(xa.w << 16); xf[7] = __uint_as_float(xa.w & 0xffff0000u);
    xf[8] = __uint_as_float(xb.x << 16); xf[9] = __uint_as_float(xb.x & 0xffff0000u);
    xf[10] = __uint_as_float(xb.y << 16); xf[11] = __uint_as_float(xb.y & 0xffff0000u);
    xf[12] = __uint_as_float(xb.z << 16); xf[13] = __uint_as_float(xb.z & 0xffff0000u);
    xf[14] = __uint_as_float(xb.w << 16); xf[15] = __uint_as_float(xb.w & 0xffff0000u);
    float p[16];
#pragma unroll
    for (int i = 0; i < 16; i++) {
      float a = dot4_fp8(ua[i].x, xf[0], xf[1], xf[2], xf[3], 0.f);
      a = dot4_fp8(ua[i].y, xf[4], xf[5], xf[6], xf[7], a);
      a = dot4_fp8(ua[i].z, xf[8], xf[9], xf[10], xf[11], a);
      a = dot4_fp8(ua[i].w, xf[12], xf[13], xf[14], xf[15], a);
      p[i] = a;
    }
#pragma unroll
    for (int i = 0; i < 8; i++) { float keep = (c & 4) ? p[i + 8] : p[i]; float send = (c & 4) ? p[i] : p[i + 8]; p[i] = keep + __shfl_xor(send, 4); }
#pragma unroll
    for (int i = 0; i < 4; i++) { float keep = (c & 2) ? p[i + 4] : p[i]; float send = (c & 2) ? p[i] : p[i + 4]; p[i] = keep + __shfl_xor(send, 2); }
#pragma unroll
    for (int i = 0; i < 2; i++) { float keep = (c & 1) ? p[i + 2] : p[i]; float send = (c & 1) ? p[i] : p[i + 2]; p[i] = keep + __shfl_xor(send, 1); }
    const int it0 = 2 * (c & 1) + 4 * ((c >> 1) & 1) + 8 * ((c >> 2) & 1);
    float* pr = PH + (size_t)t * 128;
    pr[it0 * 8] = p[0];
    pr[(it0 + 1) * 8] = p[1];
    t = tn;
  }
}

DI void phase6w(const Params& P) {
  const int lane = threadIdx.x & 63;
  const int gw = blockIdx.x * 4 + (threadIdx.x >> 6), nw = gridDim.x * 4;
  char* ws = P.ws;
  float* G = (float*)(ws + W_G);
  const float* SSQ2 = (const float*)(ws + W_SSQ2);
  for (int t = gw; t < TT; t += nw) {
    float ssq = lane < 8 ? SSQ2[(size_t)t * 16 + lane] : 0.f;
    float h0 = 0.f, h1v = 0.f;
    {
      const float* ph = (const float*)(ws + W_XB) + (size_t)t * 128 + lane;
#pragma unroll
      for (int xs = 0; xs < 4; xs++) { h0 += ph[(size_t)xs * (SZ_PH / 4)]; h1v += ph[(size_t)xs * (SZ_PH / 4) + 64]; }
      ph = (const float*)(ws + W_GB) + (size_t)t * 128 + lane;
#pragma unroll
      for (int xs = 0; xs < 4; xs++) { h0 += ph[(size_t)xs * (SZ_PH / 4)]; h1v += ph[(size_t)xs * (SZ_PH / 4) + 64]; }
    }
    const float g0 = G[(size_t)t * 128 + lane];
    const float g1 = G[(size_t)t * 128 + 64 + lane];
    const float rs2 = rsqrtf(wave_sum(ssq) * (1.f / 1024.f) + EPS);
    const float w0 = g0 * gelu_tanh(rs2 * (1.f / U_SCALE) * h0) * (1.f / V_SCALE);
    const float w1 = g1 * gelu_tanh(rs2 * (1.f / U_SCALE) * h1v) * (1.f / V_SCALE);
    G[(size_t)t * 128 + (lane & 7) * 16 + (lane >> 3)] = w0;
    G[(size_t)t * 128 + (lane & 7) * 16 + 8 + (lane >> 3)] = w1;
  }
}

DI void phase6b2(const Params& P) {
  const int lane = threadIdx.x & 63, g = lane >> 3, c = lane & 7, w = threadIdx.x >> 6;
  const int x = blockIdx.x & 7;
  const int wg = (blockIdx.x >> 3) * 4 + w, nwg = (gridDim.x >> 3) * 4;
  char* ws = P.ws;
  u16* H1B = (u16*)(ws + W_QKV + SZ_ACT);
  const unsigned char* V8 = (const unsigned char*)(ws + W_VB) + ((size_t)x << 21) + c * 16;
  const u16* IDX = (const u16*)(ws + W_IDX) + g * 16;
  const float* WG = (const float*)(ws + W_G) + g * 16;
  float* SSQ3 = (float*)(ws + W_SSQ3);
  const int col = x * 128 + c * 16 + 2 * (g & 1) + 4 * ((g >> 1) & 1) + 8 * ((g >> 2) & 1);
  int t = wg;
  u32x4 ea = (u32x4){0u, 0u, 0u, 0u}, eb = ea;
  f32x4 wq[4];
#pragma unroll
  for (int i = 0; i < 4; i++) wq[i] = (f32x4){0.f, 0.f, 0.f, 0.f};
  if (t < TT) {
    ea = *(const u32x4*)(IDX + (size_t)t * 128);
    eb = *(const u32x4*)(IDX + (size_t)t * 128 + 8);
#pragma unroll
    for (int i = 0; i < 4; i++) wq[i] = *(const f32x4*)(WG + (size_t)t * 128 + i * 4);
  }
  while (t < TT) {
    u32x4 va[16];
    {
      const u32 ev[8] = {ea.x, ea.y, ea.z, ea.w, eb.x, eb.y, eb.z, eb.w};
#pragma unroll
      for (int i = 0; i < 8; i++) {
        va[2 * i] = *(const u32x4*)(V8 + (size_t)(ev[i] & 0xffffu) * 128);
        va[2 * i + 1] = *(const u32x4*)(V8 + (size_t)(ev[i] >> 16) * 128);
      }
    }
    const float wgt[16] = {wq[0].x, wq[0].y, wq[0].z, wq[0].w, wq[1].x, wq[1].y, wq[1].z, wq[1].w,
                           wq[2].x, wq[2].y, wq[2].z, wq[2].w, wq[3].x, wq[3].y, wq[3].z, wq[3].w};
    float* hp = P.out + (size_t)t * 1024 + col;
    const f32x2 hv = *(const f32x2*)hp;
    const int tn = t + nwg;
    if (tn < TT) {
      ea = *(const u32x4*)(IDX + (size_t)tn * 128);
      eb = *(const u32x4*)(IDX + (size_t)tn * 128 + 8);
#pragma unroll
      for (int i = 0; i < 4; i++) wq[i] = *(const f32x4*)(WG + (size_t)tn * 128 + i * 4);
    }
    float o[16];
#pragma unroll
    for (int i = 0; i < 16; i++) o[i] = 0.f;
#pragma unroll
    for (int i = 0; i < 16; i++) {
      u32 r0 = va[i].x, r1 = va[i].y, r2 = va[i].z, r3 = va[i].w;
      asm volatile("" : "+v"(r0), "+v"(r1), "+v"(r2), "+v"(r3) : "v"(o[0]), "v"(o[15]));
      axpy4_fp8(r0, wgt[i], o[0], o[1], o[2], o[3]);
      axpy4_fp8(r1, wgt[i], o[4], o[5], o[6], o[7]);
      axpy4_fp8(r2, wgt[i], o[8], o[9], o[10], o[11]);
      axpy4_fp8(r3, wgt[i], o[12], o[13], o[14], o[15]);
    }
#pragma unroll
    for (int i = 0; i < 8; i++) { float keep = (g & 4) ? o[i + 8] : o[i]; float send = (g & 4) ? o[i] : o[i + 8]; o[i] = keep + __shfl_xor(send, 32); }
#pragma unroll
    for (int i = 0; i < 4; i++) { float keep = (g & 2) ? o[i + 4] : o[i]; float send = (g & 2) ? o[i] : o[i + 4]; o[i] = keep + __shfl_xor(send, 16); }
#pragma unroll
    for (int i = 0; i < 2; i++) { float keep = (g & 1) ? o[i + 2] : o[i]; float send = (g & 1) ? o[i] : o[i + 2]; o[i] = keep + __shfl_xor(send, 8); }
    const float a0 = hv.x + o[0], a1 = hv.y + o[1];
    *(f32x2*)hp = (f32x2){a0, a1};
    *(u32*)(H1B + (size_t)t * 1024 + col) = pack2(a0, a1);
    const float ss = wave_sum(a0 * a0 + a1 * a1);
    if (lane == 0) SSQ3[(size_t)t * 8 + x] = ss;
    t = tn;
  }
}

DI void phase7_tile(const Params& P, int mt, int nt, char* smem) {
  const int tid = threadIdx.x, lane = tid & 63, w = tid >> 6, wm = w >> 1, wn = w & 1, r = lane & 15, quad = lane >> 4;
  const int m0 = mt * 128, n0 = nt * 128;
  char* ws = P.ws;
  const u16* H2B = (const u16*)(ws + W_QKV + SZ_ACT);
  const u16* PB = (const u16*)(ws + W_PB);
  const float* SSQ3 = (const float*)(ws + W_SSQ3);
  float* rs_s = (float*)(smem + RS_OFF);
  __syncthreads();
  if (tid < 128) {
    float q = 0.f;
#pragma unroll
    for (int i = 0; i < 8; i++) q += SSQ3[(size_t)(m0 + tid) * 8 + i];
    rs_s[tid] = rsqrtf(q * (1.f / 1024.f) + EPS);
  }
  u16* PJ = (u16*)(ws + W_QKV);
  f32x4 acc[4][4];
  zero_acc(acc);
  gemm_mainloop(PB + (size_t)m0 * 256, 256, (const u16*)(ws + W_WPP) + (size_t)n0 * 256, 256, 256, (u16*)smem, acc);
  float* Cs = (float*)smem;
  const int c4 = tid & 31, rsub = tid >> 5;
  const size_t tofs = (size_t)m0 * 1024 + n0 + c4 * 4;
  stage_acc(acc, Cs);
#pragma unroll 4
  for (int p = 0; p < 16; p++) {
    const int row = p * 8 + rsub;
    *(u32x2*)(PJ + tofs + (size_t)row * 1024) = pack4(*(const f32x4*)(Cs + row * CSTR + c4 * 4));
  }
  zero_acc(acc);
  gemm_mainloop(H2B + (size_t)m0 * 1024, 1024, (const u16*)(ws + W_WG) + (size_t)n0 * 1024, 1024, 1024, (u16*)smem, acc);
  stage_acc(acc, Cs);
#pragma unroll 4
  for (int p = 0; p < 16; p++) {
    const int row = p * 8 + rsub;
    const f32x4 v = *(const f32x4*)(Cs + row * CSTR + c4 * 4) * rs_s[row];
    const f32x4 pj = unpack4(*(const u32x2*)(PJ + tofs + (size_t)row * 1024));
    const f32x4 h2 = *(const f32x4*)(P.out + tofs + (size_t)row * 1024);
    const f32x4 gate = (f32x4){sigmoidf_(v.x), sigmoidf_(v.y), sigmoidf_(v.z), sigmoidf_(v.w)};
    *(f32x4*)(P.out + tofs + (size_t)row * 1024) = h2 + gate * pj;
  }
}

#define GEMM_TILES(NT, FN)                                                              \
  {                                                                                     \
    for (int t = blockIdx.x; t < 2 * (NT); t += gridDim.x) FN(P, 512 + t / (NT), t % (NT), smem); \
    const int x_ = blockIdx.x & 7, bpx_ = gridDim.x >> 3;                               \
    constexpr int NG_ = (NT) / 8;                                                       \
    for (int s_ = blockIdx.x >> 3; s_ < 64 * 8 * NG_; s_ += bpx_) {                     \
      const int R_ = s_ >> 6, q_ = s_ & 63;                                             \
      const int mg_ = R_ / NG_, ng_ = R_ % NG_;                                         \
      FN(P, ((mg_ * 8 + (q_ >> 3)) << 3) + x_, ng_ * 8 + (q_ & 7), smem);               \
    }                                                                                   \
  }

__global__ void __launch_bounds__(256, 2) fwd_megakernel(Params P) {
  __shared__ __attribute__((aligned(16))) char smem[SMEM_BYTES];
  cg::grid_group grid = cg::this_grid();
  phase0(P, smem);
  grid.sync();
  phase1_scans(P);
  GEMM_TILES(40, phase1_tile)
  grid.sync();
  phase2(P, smem);
  grid.sync();
  GEMM_TILES(8, phase3_tile)
  grid.sync();
  GEMM_TILES(8, phase4_tile)
  grid.sync();
  GEMM_TILES(8, phase5_tile)
  grid.sync();
  for (int t = blockIdx.x; t < TT / 64; t += gridDim.x) phase6a_unit(P, t, smem);
  grid.sync();
  phase6b1(P);
  grid.sync();
  phase6w(P);
  grid.sync();
  phase6b2(P);
  grid.sync();
  GEMM_TILES(8, phase7_tile)
}

extern "C" void kernel_launch(void* const* d_in, const int* in_sizes, int n_in, void* d_out, int out_size, void* d_ws,
                              size_t ws_size, hipStream_t stream) {
  static int grid_blocks = 0;
  if (!grid_blocks) {
    int dev = 0, cus = 0, per_cu = 0;
    hipGetDevice(&dev);
    hipDeviceGetAttribute(&cus, hipDeviceAttributeMultiprocessorCount, dev);
    hipOccupancyMaxActiveBlocksPerMultiprocessor(&per_cu, fwd_megakernel, 256, 0);
    if (per_cu > 2) per_cu = 2;
    if (per_cu < 1) per_cu = 1;
    grid_blocks = cus * per_cu;
  }
  if (ws_size < W_END) { fprintf(stderr, "workspace too small: %zu < %zu\n", ws_size, (size_t)W_END); return; }
  Params p{};
  const float** pf = (const float**)&p;
  for (int i = 0; i < 28; i++) pf[i] = (const float*)d_in[i];
  p.out = (float*)d_out;
  p.ws = (char*)d_ws;
  void* args[] = {&p};
  hipError_t e = hipLaunchCooperativeKernel((void*)fwd_megakernel, dim3(grid_blocks), dim3(256), args, 0, stream);
  if (e != hipSuccess) fprintf(stderr, "cooperative launch failed: %s (grid %d)\n", hipGetErrorString(e), grid_blocks);
}
```

```cpp
#include <hip/hip_runtime.h>
#include <hip/hip_cooperative_groups.h>
#include <cstdio>
namespace cg = cooperative_groups;

typedef unsigned short u16;
typedef unsigned int u32;
typedef short bf16x8 __attribute__((ext_vector_type(8)));
typedef short s16x4 __attribute__((ext_vector_type(4)));
typedef float f32x4 __attribute__((ext_vector_type(4)));
typedef unsigned int u32x4 __attribute__((ext_vector_type(4)));
typedef unsigned int u32x2 __attribute__((ext_vector_type(2)));
typedef __bf16 bf16x2_t __attribute__((ext_vector_type(2)));

#define DI __device__ __forceinline__
#define LAUNDER(x) asm volatile("" : "+v"(x))

constexpr int TP = 65536, TS = 256, TT = TP + TS;
constexpr float LOG2E = 1.4426950408889634f;
constexpr float EPS = 1e-6f;
constexpr float U_SCALE = 1024.f, V_SCALE = 128.f;

constexpr size_t O_AK_P = 67371008, O_AV_P = 100925440, O_AF_P = 134479872, O_BK_P = 135004160,
                 O_BV_P = 143392768, O_AK_S = 151781376, O_AV_S = 151912448, O_AF_S = 152043520,
                 O_BK_S = 152045568, O_BV_S = 152176640;

constexpr size_t SZ_ACT = (size_t)TT * 1024 * 2;
constexpr size_t SZ_HALF = (size_t)TT * 512 * 2;
constexpr size_t W_XB = 0;
constexpr size_t W_QKV = SZ_ACT;
constexpr size_t W_GA = W_QKV + 6 * SZ_HALF;
constexpr size_t W_GB = W_GA + SZ_ACT;
constexpr size_t W_PB = W_GB + SZ_ACT;
constexpr size_t W_WIN = W_PB + (size_t)TT * 256 * 2;
constexpr size_t W_WUPA = W_WIN + (size_t)5120 * 1024 * 2;
constexpr size_t W_WUPB = W_WUPA + 1024 * 512 * 2;
constexpr size_t W_WOUT = W_WUPB + 1024 * 512 * 2;
constexpr size_t W_WQ = W_WOUT + 1024 * 1024 * 2;
constexpr size_t W_WG = W_WQ + 1024 * 1024 * 2;
constexpr size_t W_WPP = W_WG + 1024 * 1024 * 2;
constexpr size_t W_UB = W_WPP + 1024 * 256 * 2;
constexpr size_t W_VB = W_UB + (size_t)16384 * 1024 * 2;
constexpr size_t W_SK = W_VB + (size_t)16384 * 1024 * 2;
constexpr size_t W_RS1 = W_SK + 131072 * 2;
constexpr size_t W_SSQ2 = W_RS1 + (size_t)TT * 4;
constexpr size_t W_RS3 = W_SSQ2 + (size_t)TT * 64;
constexpr size_t W_CUMP = W_RS3 + (size_t)TT * 4;
constexpr size_t W_CUMS = W_CUMP + (size_t)256 * 2048 * 4;
constexpr size_t W_SSQ3 = W_CUMS + (size_t)128 * 4112 * 4 + 1024;
constexpr size_t W_END = W_SSQ3 + (size_t)TT * 8 * 4;
constexpr size_t W_IDX = W_GA;
constexpr size_t W_G = W_GA + (size_t)32 * 1024 * 1024;
constexpr size_t SZ_PH = (size_t)TT * 128 * 4;


struct Params {
  const float *x_p, *x_s, *cak, *cav, *caf, *cbk, *cbv, *p_p, *p_s, *g_mix, *w_in, *b_f, *qn_a, *kn_a,
      *qn_b, *kn_b, *relb, *w_up_a, *w_up_b, *w_out, *g_ffn, *peer_wq, *peer_sk, *peer_u, *peer_v, *g_ple,
      *w_gate, *w_proj;
  float* out;
  char* ws;
};

constexpr int SMEM_BYTES = 128 * 129 * 4 + 2 * 64 * 17 * 4 + 256;

DI float* ph_slice(char* ws, int x) { return (float*)(ws + (x < 4 ? W_XB + (size_t)x * SZ_PH : W_GB + (size_t)(x - 4) * SZ_PH)); }
DI u16 f2bf(float x) { u32 u = __float_as_uint(x); u += 0x7fffu + ((u >> 16) & 1u); return (u16)(u >> 16); }
DI float bf2f(u16 h) { return __uint_as_float(((u32)h) << 16); }
DI u32 pack2(float a, float b) { return (u32)f2bf(a) | ((u32)f2bf(b) << 16); }
DI float wave_sum(float v) {
#pragma unroll
  for (int o = 32; o; o >>= 1) v += __shfl_xor(v, o);
  return v;
}
DI f32x4 mfma16(bf16x8 a, bf16x8 b, f32x4 c) { return __builtin_amdgcn_mfma_f32_16x16x32_bf16(a, b, c, 0, 0, 0); }
DI float sigmoidf_(float x) { return 1.f / (1.f + __expf(-x)); }
DI u32 mono(float x) { u32 u = __float_as_uint(x); u32 m = (u32)((int)u >> 31) | 0x80000000u; return u ^ m; }
DI float unmono(u32 k) { u32 m = ((k >> 31) - 1u) | 0x80000000u; return __uint_as_float(k ^ m); }
DI void insert16(u32 (&L)[16], u32 x) {
#pragma unroll
  for (int s = 0; s < 16; s++) { u32 mx = max(L[s], x); x = min(L[s], x); L[s] = mx; }
}
DI float gelu_tanh(float x) {
  float u = 0.7978845608028654f * (x + 0.044715f * x * x * x);
  float t = 1.f - 2.f / (1.f + __expf(2.f * u));
  return 0.5f * x * (1.f + t);
}

constexpr int GSTR = 72;
constexpr int GBUF = 2 * 128 * GSTR;
constexpr int RS_OFF = 2 * GBUF * 2;
DI void gemm_compute(const u16* As, const u16* Bs, f32x4 (&acc)[4][4], int wm, int wn, int r, int quad) {
#pragma unroll
  for (int ks = 0; ks < 2; ks++) {
    bf16x8 af[4], bfr[4];
#pragma unroll
    for (int mi = 0; mi < 4; mi++) af[mi] = *(const bf16x8*)(As + (wm * 64 + mi * 16 + r) * GSTR + ks * 32 + quad * 8);
#pragma unroll
    for (int ni = 0; ni < 4; ni++) bfr[ni] = *(const bf16x8*)(Bs + (wn * 64 + ni * 16 + r) * GSTR + ks * 32 + quad * 8);
#pragma unroll
    for (int mi = 0; mi < 4; mi++)
#pragma unroll
      for (int ni = 0; ni < 4; ni++) acc[mi][ni] = mfma16(af[mi], bfr[ni], acc[mi][ni]);
    if (ks == 0) __builtin_amdgcn_sched_barrier(0);
  }
}
DI void gemm_mainloop(const u16* __restrict__ A, int lda, const u16* __restrict__ B, int ldb, int K, u16* smem,
                      f32x4 (&acc)[4][4]) {
  const int tid = threadIdx.x, lane = tid & 63, w = tid >> 6, wm = w >> 1, wn = w & 1, r = lane & 15, quad = lane >> 4;
  u16* As0 = smem;
  u16* Bs0 = smem + 128 * GSTR;
  u16* As1 = smem + GBUF;
  u16* Bs1 = As1 + 128 * GSTR;
  u32x4 r0a[4], r0b[4], r1a[4], r1b[4];
  const int lrow = tid >> 3, lch = tid & 7;
  const u16* ap = A + (size_t)lrow * lda + lch * 8;
  const u16* bp = B + (size_t)lrow * ldb + lch * 8;
  const int lo = lrow * GSTR + lch * 8;
  const int nk = K >> 6, km = nk - 1;
  const int krot = (blockIdx.x >> 3) * 5;
#define KOFF(kt) ((((kt) + krot) & km) * 64)
#pragma unroll
  for (int i = 0; i < 4; i++) {
    r0a[i] = *(const u32x4*)(ap + (size_t)i * 32 * lda + KOFF(0));
    r0b[i] = *(const u32x4*)(bp + (size_t)i * 32 * ldb + KOFF(0));
  }
#pragma unroll
  for (int i = 0; i < 4; i++) {
    r1a[i] = *(const u32x4*)(ap + (size_t)i * 32 * lda + KOFF(1));
    r1b[i] = *(const u32x4*)(bp + (size_t)i * 32 * ldb + KOFF(1));
  }
  __syncthreads();
#pragma unroll 1
  for (int kt = 0; kt < nk; kt += 2) {
#pragma unroll
    for (int i = 0; i < 4; i++) {
      *(u32x4*)(As0 + lo + i * 32 * GSTR) = r0a[i];
      *(u32x4*)(Bs0 + lo + i * 32 * GSTR) = r0b[i];
    }
    __syncthreads();
    {
      const int ko = KOFF(kt + 2);
#pragma unroll
      for (int i = 0; i < 4; i++) {
        r0a[i] = *(const u32x4*)(ap + (size_t)i * 32 * lda + ko);
        r0b[i] = *(const u32x4*)(bp + (size_t)i * 32 * ldb + ko);
      }
    }
    gemm_compute(As0, Bs0, acc, wm, wn, r, quad);
#pragma unroll
    for (int i = 0; i < 4; i++) {
      *(u32x4*)(As1 + lo + i * 32 * GSTR) = r1a[i];
      *(u32x4*)(Bs1 + lo + i * 32 * GSTR) = r1b[i];
    }
    __syncthreads();
    {
      const int ko = KOFF(kt + 3);
#pragma unroll
      for (int i = 0; i < 4; i++) {
        r1a[i] = *(const u32x4*)(ap + (size_t)i * 32 * lda + ko);
        r1b[i] = *(const u32x4*)(bp + (size_t)i * 32 * ldb + ko);
      }
    }
    gemm_compute(As1, Bs1, acc, wm, wn, r, quad);
  }
#undef KOFF
}

DI void zero_acc(f32x4 (&acc)[4][4]) {
#pragma unroll
  for (int i = 0; i < 4; i++)
#pragma unroll
    for (int j = 0; j < 4; j++) acc[i][j] = (f32x4){0.f, 0.f, 0.f, 0.f};
}

constexpr int CSTR = 132;
DI void stage_acc(const f32x4 (&acc)[4][4], float* Cs) {
  const int tid = threadIdx.x, lane = tid & 63, w = tid >> 6, wm = w >> 1, wn = w & 1, r = lane & 15, quad = lane >> 4;
  __syncthreads();
#pragma unroll
  for (int mi = 0; mi < 4; mi++)
#pragma unroll
    for (int ni = 0; ni < 4; ni++)
#pragma unroll
      for (int j = 0; j < 4; j++) Cs[(wm * 64 + mi * 16 + quad * 4 + j) * CSTR + wn * 64 + ni * 16 + r] = acc[mi][ni][j];
  __syncthreads();
}
DI u32x2 pack4(f32x4 v) { return (u32x2){pack2(v.x, v.y), pack2(v.z, v.w)}; }
DI f32x4 unpack4(u32x2 p) {
  return (f32x4){__uint_as_float(p.x << 16), __uint_as_float(p.x & 0xffff0000u), __uint_as_float(p.y << 16), __uint_as_float(p.y & 0xffff0000u)};
}

DI void transpose_tile(const float* __restrict__ W, int ldw, int K, const float* __restrict__ g, u16* __restrict__ dst,
                       int k0, int n0, int nsrc0, float* tile) {
  const int tid = threadIdx.x;
  __syncthreads();
  {
    const int ty = tid >> 4, tx = tid & 15;
#pragma unroll
    for (int i = 0; i < 4; i++) {
      int k = ty + i * 16;
      f32x4 v = *(const f32x4*)(W + (size_t)(k0 + k) * ldw + nsrc0 + tx * 4);
      float s = g ? g[k0 + k] : 1.f;
      tile[k * 65 + tx * 4 + 0] = v[0] * s;
      tile[k * 65 + tx * 4 + 1] = v[1] * s;
      tile[k * 65 + tx * 4 + 2] = v[2] * s;
      tile[k * 65 + tx * 4 + 3] = v[3] * s;
    }
  }
  __syncthreads();
  {
    const int n = tid >> 2, kc = (tid & 3) * 16;
    u32 pk[8];
#pragma unroll
    for (int i = 0; i < 8; i++) pk[i] = pack2(tile[(kc + 2 * i) * 65 + n], tile[(kc + 2 * i + 1) * 65 + n]);
    u16* d = dst + (size_t)(n0 + n) * K + k0 + kc;
    *(u32x4*)d = (u32x4){pk[0], pk[1], pk[2], pk[3]};
    *(u32x4*)(d + 8) = (u32x4){pk[4], pk[5], pk[6], pk[7]};
  }
}

DI void conv_unit(const float* __restrict__ src, u16* __restrict__ dst, size_t base, const float* __restrict__ colscale) {
  const int tid = threadIdx.x;
#pragma unroll
  for (int i = 0; i < 4; i++) {
    size_t e = base + (size_t)i * 1024 + tid * 4;
    f32x4 v = *(const f32x4*)(src + e);
    if (colscale) {
      f32x4 gg = *(const f32x4*)(colscale + (e & 1023));
      v = v * gg;
    }
    *(u32x2*)(dst + e) = (u32x2){pack2(v[0], v[1]), pack2(v[2], v[3])};
  }
}

DI void conv_unit_fp8(const float* __restrict__ src, unsigned char* __restrict__ dst, size_t base,
                      const float* __restrict__ colscale, float scale) {
  const int tid = threadIdx.x;
#pragma unroll
  for (int i = 0; i < 4; i++) {
    size_t e = base + (size_t)i * 1024 + tid * 4;
    f32x4 v = *(const f32x4*)(src + e);
    if (colscale) {
      f32x4 gg = *(const f32x4*)(colscale + (e & 1023));
      v = v * gg;
    }
    int w = __builtin_amdgcn_cvt_pk_fp8_f32(v[0] * scale, v[1] * scale, 0, false);
    w = __builtin_amdgcn_cvt_pk_fp8_f32(v[2] * scale, v[3] * scale, w, true);
    *(int*)(dst + (((e & 1023) >> 7) << 21) + ((e >> 10) << 7) + (e & 127)) = w;
  }
}

DI void phase0(const Params& P, char* smem) {
  const int tid = threadIdx.x, lane = tid & 63, w = tid >> 6;
  char* ws = P.ws;
  {
    float* tile = (float*)smem;
    constexpr int T_WIN = 16 * 80, T_UP = 8 * 16, T_SQ = 256, T_PP = 4 * 16;
    constexpr int NT = T_WIN + 2 * T_UP + 3 * T_SQ + T_PP;
    for (int t = blockIdx.x; t < NT; t += gridDim.x) {
      int u = t;
      if (u < T_WIN) {
        int kt = u / 80, nt = u % 80;
        int n0 = nt * 64;
        int ns = n0 < 1536 ? n0 : n0 + 8;
        transpose_tile(P.w_in, 5128, 1024, P.g_mix, (u16*)(ws + W_WIN), kt * 64, n0, ns, tile);
        continue;
      }
      u -= T_WIN;
      if (u < T_UP) { transpose_tile(P.w_up_a, 1024, 512, nullptr, (u16*)(ws + W_WUPA), (u / 16) * 64, (u % 16) * 64, (u % 16) * 64, tile); continue; }
      u -= T_UP;
      if (u < T_UP) { transpose_tile(P.w_up_b, 1024, 512, nullptr, (u16*)(ws + W_WUPB), (u / 16) * 64, (u % 16) * 64, (u % 16) * 64, tile); continue; }
      u -= T_UP;
      if (u < T_SQ) { transpose_tile(P.w_out, 1024, 1024, nullptr, (u16*)(ws + W_WOUT), (u / 16) * 64, (u % 16) * 64, (u % 16) * 64, tile); continue; }
      u -= T_SQ;
      if (u < T_SQ) { transpose_tile(P.peer_wq, 1024, 1024, P.g_ffn, (u16*)(ws + W_WQ), (u / 16) * 64, (u % 16) * 64, (u % 16) * 64, tile); continue; }
      u -= T_SQ;
      if (u < T_SQ) { transpose_tile(P.w_gate, 1024, 1024, P.g_ple, (u16*)(ws + W_WG), (u / 16) * 64, (u % 16) * 64, (u % 16) * 64, tile); continue; }
      u -= T_SQ;
      transpose_tile(P.w_proj, 1024, 256, nullptr, (u16*)(ws + W_WPP), (u / 16) * 64, (u % 16) * 64, (u % 16) * 64, tile);
    }
  }
  {
    constexpr int U_UB = 4096, U_VB = 4096, U_SK = 32, U_PP = 4096, U_PS = 16;
    constexpr int NU = U_UB + U_VB + U_SK + U_PP + U_PS;
    for (int t = blockIdx.x; t < NU; t += gridDim.x) {
      int u = t;
      if (u < U_UB) { conv_unit_fp8(P.peer_u, (unsigned char*)(ws + W_UB), (size_t)u * 4096, P.g_ffn, U_SCALE); continue; }
      u -= U_UB;
      if (u < U_VB) { conv_unit_fp8(P.peer_v, (unsigned char*)(ws + W_VB), (size_t)u * 4096, nullptr, V_SCALE); continue; }
      u -= U_VB;
      if (u < U_SK) { conv_unit(P.peer_sk, (u16*)(ws + W_SK), (size_t)u * 4096, nullptr); continue; }
      u -= U_SK;
      if (u < U_PP) { conv_unit(P.p_p, (u16*)(ws + W_PB), (size_t)u * 4096, nullptr); continue; }
      u -= U_PP;
      conv_unit(P.p_s, (u16*)(ws + W_PB) + (size_t)TP * 256, (size_t)u * 4096, nullptr);
    }
  }
  {
    float* wfl = (float*)smem;
    __syncthreads();
    for (int i = tid; i < 8192; i += 256) {
      int k = i >> 3, h = i & 7;
      wfl[h * 1024 + k] = P.g_mix[k] * P.w_in[(size_t)k * 5128 + 1536 + h];
    }
    __syncthreads();
    u16* XB = (u16*)(ws + W_XB);
    float* RS1 = (float*)(ws + W_RS1);
    for (int t = blockIdx.x * 4 + w; t < TT; t += gridDim.x * 4) {
      const float* xr = t < TP ? P.x_p + (size_t)t * 1024 : P.x_s + (size_t)(t - TP) * 1024;
      f32x4 v[4];
#pragma unroll
      for (int i = 0; i < 4; i++) v[i] = *(const f32x4*)(xr + i * 256 + lane * 4);
      float ss = 0.f;
#pragma unroll
      for (int i = 0; i < 4; i++) ss += v[i][0] * v[i][0] + v[i][1] * v[i][1] + v[i][2] * v[i][2] + v[i][3] * v[i][3];
      float dots[8];
#pragma unroll
      for (int h = 0; h < 8; h++) {
        float d = 0.f;
#pragma unroll
        for (int i = 0; i < 4; i++) {
          f32x4 wv = *(const f32x4*)(wfl + h * 1024 + i * 256 + lane * 4);
          d += v[i][0] * wv[0] + v[i][1] * wv[1] + v[i][2] * wv[2] + v[i][3] * wv[3];
        }
        dots[h] = d;
      }
      ss = wave_sum(ss);
#pragma unroll
      for (int h = 0; h < 8; h++) dots[h] = wave_sum(dots[h]);
      float rs = rsqrtf(ss * (1.f / 1024.f) + EPS);
#pragma unroll
      for (int i = 0; i < 4; i++)
        *(u32x2*)(XB + (size_t)t * 1024 + i * 256 + lane * 4) = (u32x2){pack2(v[i][0], v[i][1]), pack2(v[i][2], v[i][3])};
      if (lane == 0) RS1[t] = rs;
      float myd = dots[0];
#pragma unroll
      for (int h = 1; h < 8; h++) myd = (lane == h) ? dots[h] : myd;
      if (lane < 8) {
        float z = rs * myd + P.b_f[lane];
        float lf = fminf(z, 0.f) - log1pf(expf(-fabsf(z)));
        float* o = t < TP ? P.out + O_AF_P + (size_t)t * 8 : P.out + O_AF_S + (size_t)(t - TP) * 8;
        o[lane] = lf;
      }
    }
  }
}

DI void phase1_scans(const Params& P) {
  const int lane = threadIdx.x & 63;
  const int gw = blockIdx.x * 4 + (threadIdx.x >> 6), nw = gridDim.x * 4;
  float* CUMP = (float*)(P.ws + W_CUMP);
  float* CUMS = (float*)(P.ws + W_CUMS);
  for (int row = gw; row < 384; row += nw) {
    float carry = 0.f;
    if (row < 256) {
      int b = row >> 3, h = row & 7;
      const float* src = P.out + O_AF_P + (size_t)b * 2048 * 8 + h;
      for (int p0 = 0; p0 < 2048; p0 += 64) {
        float v = src[(size_t)(p0 + lane) * 8];
#pragma unroll
        for (int o = 1; o < 64; o <<= 1) { float n = __shfl_up(v, o); if (lane >= o) v += n; }
        v += carry;
        CUMP[(size_t)row * 2048 + p0 + lane] = v * LOG2E;
        carry = __shfl(v, 63);
      }
    } else {
      int rr = row - 256;
      int b = rr >> 3, h = rr & 7;
      const float* src = P.caf + (size_t)b * 4096 * 8 + h;
      for (int p0 = 0; p0 < 4096; p0 += 64) {
        float v = src[(size_t)(p0 + lane) * 8];
#pragma unroll
        for (int o = 1; o < 64; o <<= 1) { float n = __shfl_up(v, o); if (lane >= o) v += n; }
        v += carry;
        CUMS[(size_t)rr * 4112 + p0 + lane] = v * LOG2E;
        carry = __shfl(v, 63);
      }
      {
        float v = lane < 16 ? P.out[O_AF_S + (size_t)(b * 16 + lane) * 8 + h] : 0.f;
#pragma unroll
        for (int o = 1; o < 64; o <<= 1) { float n = __shfl_up(v, o); if (lane >= o) v += n; }
        v += carry;
        if (lane < 16) CUMS[(size_t)rr * 4112 + 4096 + lane] = v * LOG2E;
      }
    }
  }
}

DI void phase1_tile(const Params& P, int mt, int nt, char* smem) {
  const int tid = threadIdx.x, lane = tid & 63, w = tid >> 6, wm = w >> 1, wn = w & 1, r = lane & 15, quad = lane >> 4;
  const int m0 = mt * 128, n0 = nt * 128;
  char* ws = P.ws;
  f32x4 acc[4][4];
  zero_acc(acc);
  gemm_mainloop((const u16*)(ws + W_XB) + (size_t)m0 * 1024, 1024, (const u16*)(ws + W_WIN) + (size_t)n0 * 1024, 1024, 1024,
                (u16*)smem, acc);
  float* Cs = (float*)smem;
  stage_acc(acc, Cs);
  const bool sample = m0 >= TP;
  const int c4 = tid & 31, rsub = tid >> 5;
  const float* RS1 = (const float*)(ws + W_RS1) + m0;
  if (n0 < 3072) {
    const int seg = n0 >> 9, hc = n0 & 511;
    const bool normed = (seg != 2 && seg != 5);
    const float* gain = seg == 0 ? P.qn_a : seg == 1 ? P.kn_a : seg == 3 ? P.qn_b : P.kn_b;
    const float qs = (seg == 0 || seg == 3) ? 0.125f * LOG2E : 1.f;
    f32x4 gn = (f32x4){1.f, 1.f, 1.f, 1.f};
    if (normed) gn = *(const f32x4*)(gain + (c4 & 15) * 4) * qs;
    u16* dp = (u16*)(ws + W_QKV + (size_t)seg * SZ_HALF) + (size_t)m0 * 512 + hc + c4 * 4;
    float* op = nullptr;
    if (seg == 1 || seg == 2) {
      op = sample ? P.out + (seg == 1 ? O_AK_S : O_AV_S) + (size_t)(m0 - TP) * 512 : P.out + (seg == 1 ? O_AK_P : O_AV_P) + (size_t)m0 * 512;
    } else if (seg == 4 || seg == 5) {
      if (sample) op = P.out + (seg == 4 ? O_BK_S : O_BV_S) + (size_t)(m0 - TP) * 512;
      else if ((m0 & 2047) >= 1536) op = P.out + (seg == 4 ? O_BK_P : O_BV_P) + ((size_t)(m0 >> 11) * 512 + ((m0 & 2047) - 1536)) * 512;
    }
    if (op) op += hc + c4 * 4;
#pragma unroll 4
    for (int p = 0; p < 16; p++) {
      const int row = p * 8 + rsub;
      f32x4 v = *(const f32x4*)(Cs + row * CSTR + c4 * 4) * RS1[row];
      if (normed) {
        float ss = v.x * v.x + v.y * v.y + v.z * v.z + v.w * v.w;
        ss += __shfl_xor(ss, 1);
        ss += __shfl_xor(ss, 2);
        ss += __shfl_xor(ss, 4);
        ss += __shfl_xor(ss, 8);
        v = v * gn * rsqrtf(ss * (1.f / 64.f) + EPS);
      }
      *(u32x2*)(dp + (size_t)row * 512) = pack4(v);
      if (op) *(f32x4*)(op + (size_t)row * 512) = v;
    }
  } else {
    u16* dp = (n0 < 4096 ? (u16*)(ws + W_GA) + (n0 - 3072) : (u16*)(ws + W_GB) + (n0 - 4096)) + (size_t)m0 * 1024 + c4 * 4;
#pragma unroll 4
    for (int p = 0; p < 16; p++) {
      const int row = p * 8 + rsub;
      f32x4 v = *(const f32x4*)(Cs + row * CSTR + c4 * 4) * RS1[row];
      v = (f32x4){sigmoidf_(v.x), sigmoidf_(v.y), sigmoidf_(v.z), sigmoidf_(v.w)};
      *(u32x2*)(dp + (size_t)row * 1024) = pack4(v);
    }
  }
}

constexpr int ASTR = 72;
constexpr int TAB_OFF = 36864;
struct AttnState { f32x4 o[4]; float m, l; };

DI s16x4 tr_read(const u16* p) {
  return __builtin_amdgcn_ds_read_tr16_b64_v4i16((__attribute__((address_space(3))) s16x4*)(p));
}

template <int MODE>
DI void attn_step(const u16* Ks, const u16* Vs, const bf16x8 (&qf)[2], AttnState& st, int kpos0, int qpos, int qlim,
                  float cq, const float* cum, const float* tab, bool domask) {
  const int lane = threadIdx.x & 63, r = lane & 15, quad = lane >> 4;
  f32x4 s[2];
#pragma unroll
  for (int t = 0; t < 2; t++) {
    f32x4 a4 = (f32x4){0.f, 0.f, 0.f, 0.f};
#pragma unroll
    for (int ks = 0; ks < 2; ks++) {
      bf16x8 kf = *(const bf16x8*)(Ks + (t * 16 + r) * ASTR + ks * 32 + quad * 8);
      a4 = mfma16(kf, qf[ks], a4);
    }
    s[t] = a4;
  }
#pragma unroll
  for (int t = 0; t < 2; t++) {
    const int kb = kpos0 + t * 16 + quad * 4;
    if (MODE == 0) {
      f32x4 c4 = *(const f32x4*)(cum + kb);
#pragma unroll
      for (int j = 0; j < 4; j++) s[t][j] += cq - c4[j];
    } else {
#pragma unroll
      for (int j = 0; j < 4; j++) {
        int rel = kb + j - qpos;
        rel = min(max(rel, -128), 128) + 128;
        s[t][j] += tab[rel];
      }
    }
    if (domask) {
#pragma unroll
      for (int j = 0; j < 4; j++)
        if (kb + j > qlim) s[t][j] = -1e30f;
    }
  }
  float mx = fmaxf(fmaxf(fmaxf(s[0][0], s[0][1]), fmaxf(s[0][2], s[0][3])), fmaxf(fmaxf(s[1][0], s[1][1]), fmaxf(s[1][2], s[1][3])));
  mx = fmaxf(mx, __shfl_xor(mx, 16));
  mx = fmaxf(mx, __shfl_xor(mx, 32));
  const float mn = fmaxf(st.m, mx);
  const float alpha = __builtin_amdgcn_exp2f(st.m - mn);
  float p[8];
  float ls = 0.f;
#pragma unroll
  for (int t = 0; t < 2; t++)
#pragma unroll
    for (int j = 0; j < 4; j++) { p[t * 4 + j] = __builtin_amdgcn_exp2f(s[t][j] - mn); ls += p[t * 4 + j]; }
  st.l = st.l * alpha + ls;
  st.m = mn;
#pragma unroll
  for (int dt = 0; dt < 4; dt++) st.o[dt] = st.o[dt] * alpha;
  u32x4 pk = (u32x4){pack2(p[0], p[1]), pack2(p[2], p[3]), pack2(p[4], p[5]), pack2(p[6], p[7])};
  bf16x8 pf = __builtin_bit_cast(bf16x8, pk);
  const int qq = (lane & 15) >> 2, pp = lane & 3;
#pragma unroll
  for (int dt = 0; dt < 4; dt++) {
    s16x4 lo = tr_read(Vs + (quad * 4 + qq) * ASTR + dt * 16 + pp * 4);
    s16x4 hi = tr_read(Vs + (16 + quad * 4 + qq) * ASTR + dt * 16 + pp * 4);
    bf16x8 vf = __builtin_shufflevector(lo, hi, 0, 1, 2, 3, 4, 5, 6, 7);
    st.o[dt] = mfma16(vf, pf, st.o[dt]);
  }
}

template <int MODE>
DI void attn_prompt_item(const Params& P, char* smem, int b, int h, int qt) {
  const int tid = threadIdx.x, lane = tid & 63, w = tid >> 6, r = lane & 15, quad = lane >> 4;
  char* ws = P.ws;
  const u16* Q = (const u16*)(ws + W_QKV + (size_t)(MODE == 0 ? 0 : 3) * SZ_HALF);
  const u16* Kg = (const u16*)(ws + W_QKV + (size_t)(MODE == 0 ? 1 : 4) * SZ_HALF);
  const u16* Vg = (const u16*)(ws + W_QKV + (size_t)(MODE == 0 ? 2 : 5) * SZ_HALF);
  u16* Y = (u16*)(ws + W_XB + (size_t)(MODE == 0 ? 0 : 1) * SZ_HALF);
  u16* Ks = (u16*)smem;
  u16* Vs = Ks + 64 * ASTR;
  float* tab = (float*)(smem + TAB_OFF);
  __syncthreads();
  if (MODE == 1) {
    for (int i = tid; i < 257; i += 256) tab[i] = P.relb[h * 257 + i] * LOG2E;
  }
  const int q0 = qt * 64;
  const int qpos = q0 + w * 16 + r;
  const size_t tokq = (size_t)b * 2048 + qpos;
  bf16x8 qf[2];
#pragma unroll
  for (int ks = 0; ks < 2; ks++) qf[ks] = *(const bf16x8*)(Q + tokq * 512 + h * 64 + ks * 32 + quad * 8);
  const float* cum = (const float*)(ws + W_CUMP) + (size_t)(b * 8 + h) * 2048;
  const float cq = MODE == 0 ? cum[qpos] : 0.f;
  AttnState st;
#pragma unroll
  for (int dt = 0; dt < 4; dt++) st.o[dt] = (f32x4){0.f, 0.f, 0.f, 0.f};
  st.m = -1e30f;
  st.l = 0.f;
  const int kt_lo = MODE == 0 ? 0 : max(0, qt - 8), kt_hi = qt;
  u32x4 rk[2], rv[2];
  const int lkey = tid >> 3, lch = tid & 7;
  const u16* kp = Kg + ((size_t)b * 2048 + lkey) * 512 + h * 64 + lch * 8;
  const u16* vp = Vg + ((size_t)b * 2048 + lkey) * 512 + h * 64 + lch * 8;
#pragma unroll
  for (int i = 0; i < 2; i++) {
    rk[i] = *(const u32x4*)(kp + (size_t)(kt_lo * 64 + i * 32) * 512);
    rv[i] = *(const u32x4*)(vp + (size_t)(kt_lo * 64 + i * 32) * 512);
  }
  for (int kt = kt_lo; kt <= kt_hi; kt++) {
    __syncthreads();
#pragma unroll
    for (int i = 0; i < 2; i++) {
      *(u32x4*)(Ks + (lkey + i * 32) * ASTR + lch * 8) = rk[i];
      *(u32x4*)(Vs + (lkey + i * 32) * ASTR + lch * 8) = rv[i];
    }
    __syncthreads();
    if (kt < kt_hi) {
#pragma unroll
      for (int i = 0; i < 2; i++) {
        rk[i] = *(const u32x4*)(kp + (size_t)((kt + 1) * 64 + i * 32) * 512);
        rv[i] = *(const u32x4*)(vp + (size_t)((kt + 1) * 64 + i * 32) * 512);
      }
    }
    const bool diag = (MODE == 0) && (kt == qt);
#pragma unroll
    for (int half = 0; half < 2; half++) {
      const int kpos0 = kt * 64 + half * 32;
      if (diag && kpos0 > q0 + w * 16 + 15) continue;
      attn_step<MODE>(Ks + half * 32 * ASTR, Vs + half * 32 * ASTR, qf, st, kpos0, qpos, qpos, cq, cum, tab, diag);
    }
  }
  float lt = st.l;
  lt += __shfl_xor(lt, 16);
  lt += __shfl_xor(lt, 32);
  const float inv = 1.f / lt;
#pragma unroll
  for (int dt = 0; dt < 4; dt++) {
    u32x2 o2 = (u32x2){pack2(st.o[dt][0] * inv, st.o[dt][1] * inv), pack2(st.o[dt][2] * inv, st.o[dt][3] * inv)};
    *(u32x2*)(Y + tokq * 512 + h * 64 + dt * 16 + quad * 4) = o2;
  }
}

template <int MODE>
DI void attn_sample_item(const Params& P, char* smem, int b, int h) {
  const int tid = threadIdx.x, lane = tid & 63, w = tid >> 6, r = lane & 15, quad = lane >> 4;
  constexpr int L = MODE == 0 ? 4096 : 512;
  char* ws = P.ws;
  const u16* Q = (const u16*)(ws + W_QKV + (size_t)(MODE == 0 ? 0 : 3) * SZ_HALF);
  const u16* Kn = (const u16*)(ws + W_QKV + (size_t)(MODE == 0 ? 1 : 4) * SZ_HALF);
  const u16* Vn = (const u16*)(ws + W_QKV + (size_t)(MODE == 0 ? 2 : 5) * SZ_HALF);
  u16* Y = (u16*)(ws + W_XB + (size_t)(MODE == 0 ? 0 : 1) * SZ_HALF);
  u16* Kw = (u16*)smem + w * (2 * 32 * ASTR);
  u16* Vw = Kw + 32 * ASTR;
  float* tab = (float*)(smem + TAB_OFF);
  __syncthreads();
  if (MODE == 1) {
    for (int i = tid; i < 257; i += 256) tab[i] = P.relb[h * 257 + i] * LOG2E;
  }
  __syncthreads();
  const float* ck = (MODE == 0 ? P.cak : P.cbk) + ((size_t)b * L * 8 + h) * 64;
  const float* cv = (MODE == 0 ? P.cav : P.cbv) + ((size_t)b * L * 8 + h) * 64;
  const size_t tokbase = (size_t)TP + b * 16;
  bf16x8 qf[2];
#pragma unroll
  for (int ks = 0; ks < 2; ks++) qf[ks] = *(const bf16x8*)(Q + (tokbase + r) * 512 + h * 64 + ks * 32 + quad * 8);
  const int qpos = L + r;
  const float* cum = (const float*)(ws + W_CUMS) + (size_t)(b * 8 + h) * 4112;
  const float cq = MODE == 0 ? cum[qpos] : 0.f;
  AttnState st;
#pragma unroll
  for (int dt = 0; dt < 4; dt++) st.o[dt] = (f32x4){0.f, 0.f, 0.f, 0.f};
  st.m = -1e30f;
  st.l = 0.f;
  const int kbeg = w * (L / 4), kend = kbeg + L / 4;
  for (int k0 = kbeg; k0 < kend; k0 += 32) {
    {
      f32x4 kr[8];
#pragma unroll
      for (int i = 0; i < 8; i++) kr[i] = *(const f32x4*)(ck + (size_t)(k0 + i * 4 + quad) * 512 + r * 4);
#pragma unroll
      for (int i = 0; i < 8; i++)
        *(u32x2*)(Kw + (i * 4 + quad) * ASTR + r * 4) = (u32x2){pack2(kr[i][0], kr[i][1]), pack2(kr[i][2], kr[i][3])};
    }
    {
      f32x4 vr[8];
#pragma unroll
      for (int i = 0; i < 8; i++) vr[i] = *(const f32x4*)(cv + (size_t)(k0 + i * 4 + quad) * 512 + r * 4);
#pragma unroll
      for (int i = 0; i < 8; i++)
        *(u32x2*)(Vw + (i * 4 + quad) * ASTR + r * 4) = (u32x2){pack2(vr[i][0], vr[i][1]), pack2(vr[i][2], vr[i][3])};
    }
    asm volatile("s_waitcnt lgkmcnt(0)" ::: "memory");
    __builtin_amdgcn_wave_barrier();
    attn_step<MODE>(Kw, Vw, qf, st, k0, qpos, qpos, cq, cum, tab, false);
    __builtin_amdgcn_wave_barrier();
  }
  if (w == 0) {
#pragma unroll
    for (int i = 0; i < 2; i++) {
      int c = lane + i * 64;
      int key = c >> 3, ch = c & 7;
      u32x4 kk = *(const u32x4*)(Kn + (tokbase + key) * 512 + h * 64 + ch * 8);
      u32x4 vv = *(const u32x4*)(Vn + (tokbase + key) * 512 + h * 64 + ch * 8);
      *(u32x4*)(Kw + key * ASTR + ch * 8) = kk;
      *(u32x4*)(Vw + key * ASTR + ch * 8) = vv;
      *(u32x4*)(Kw + (16 + key) * ASTR + ch * 8) = (u32x4){0u, 0u, 0u, 0u};
      *(u32x4*)(Vw + (16 + key) * ASTR + ch * 8) = (u32x4){0u, 0u, 0u, 0u};
    }
    asm volatile("s_waitcnt lgkmcnt(0)" ::: "memory");
    __builtin_amdgcn_wave_barrier();
    attn_step<MODE>(Kw, Vw, qf, st, L, qpos, MODE == 0 ? qpos : L + 15, cq, cum, tab, true);
  }
  __syncthreads();
  float* comb = (float*)smem;
  float lt = st.l;
  lt += __shfl_xor(lt, 16);
  lt += __shfl_xor(lt, 32);
#pragma unroll
  for (int dt = 0; dt < 4; dt++)
#pragma unroll
    for (int j = 0; j < 4; j++) comb[(w * 16 + r) * 68 + dt * 16 + quad * 4 + j] = st.o[dt][j];
  if (quad == 0) {
    comb[(w * 16 + r) * 68 + 64] = st.m;
    comb[(w * 16 + r) * 68 + 65] = lt;
  }
  __syncthreads();
  if (w == 0) {
    float mw[4], M = -1e30f;
#pragma unroll
    for (int i = 0; i < 4; i++) { mw[i] = comb[(i * 16 + r) * 68 + 64]; M = fmaxf(M, mw[i]); }
    float Ls = 0.f, scl[4];
#pragma unroll
    for (int i = 0; i < 4; i++) { scl[i] = __builtin_amdgcn_exp2f(mw[i] - M); Ls += scl[i] * comb[(i * 16 + r) * 68 + 65]; }
    const float inv = 1.f / Ls;
#pragma unroll
    for (int dt = 0; dt < 4; dt++) {
      float ov[4];
#pragma unroll
      for (int j = 0; j < 4; j++) {
        float a = 0.f;
#pragma unroll
        for (int i = 0; i < 4; i++) a += scl[i] * comb[(i * 16 + r) * 68 + dt * 16 + quad * 4 + j];
        ov[j] = a * inv;
      }
      *(u32x2*)(Y + (tokbase + r) * 512 + h * 64 + dt * 16 + quad * 4) = (u32x2){pack2(ov[0], ov[1]), pack2(ov[2], ov[3])};
    }
  }
}

DI void phase2(const Params& P, char* smem) {
  constexpr int N_SA = 128, N_PA = 8192, N_PB = 8192, N_SB = 128;
  for (int it = blockIdx.x; it < N_SA + N_PA + N_PB + N_SB; it += gridDim.x) {
    int u = it;
    if (u < N_SA) { attn_sample_item<0>(P, smem, u >> 3, u & 7); continue; }
    u -= N_SA;
    if (u < N_PA) { int qt = 31 - (u >> 8), bh = u & 255; attn_prompt_item<0>(P, smem, bh >> 3, bh & 7, qt); continue; }
    u -= N_PA;
    if (u < N_PB) { int qt = 31 - (u >> 8), bh = u & 255; attn_prompt_item<1>(P, smem, bh >> 3, bh & 7, qt); continue; }
    u -= N_PB;
    attn_sample_item<1>(P, smem, u >> 3, u & 7);
  }
}

DI void phase3_tile(const Params& P, int mt, int nt, char* smem) {
  const int tid = threadIdx.x, lane = tid & 63, w = tid >> 6, wm = w >> 1, wn = w & 1, r = lane & 15, quad = lane >> 4;
  const int m0 = mt * 128, n0 = nt * 128;
  char* ws = P.ws;
  const u16* YA = (const u16*)(ws + W_XB);
  const u16* YB = YA + (size_t)TT * 512;
  const u16* GA = (const u16*)(ws + W_GA);
  const u16* GB = (const u16*)(ws + W_GB);
  u16* MRG = (u16*)(ws + W_QKV);
  f32x4 acc[4][4];
  zero_acc(acc);
  gemm_mainloop(YA + (size_t)m0 * 512, 512, (const u16*)(ws + W_WUPA) + (size_t)n0 * 512, 512, 512, (u16*)smem, acc);
  float* Cs = (float*)smem;
  const int c4 = tid & 31, rsub = tid >> 5;
  const size_t tofs = (size_t)m0 * 1024 + n0 + c4 * 4;
  stage_acc(acc, Cs);
#pragma unroll 4
  for (int p = 0; p < 16; p++) {
    const int row = p * 8 + rsub;
    const f32x4 v = *(const f32x4*)(Cs + row * CSTR + c4 * 4);
    const f32x4 gv = unpack4(*(const u32x2*)(GA + tofs + (size_t)row * 1024));
    *(u32x2*)(MRG + tofs + (size_t)row * 1024) = pack4(v * gv);
  }
  zero_acc(acc);
  gemm_mainloop(YB + (size_t)m0 * 512, 512, (const u16*)(ws + W_WUPB) + (size_t)n0 * 512, 512, 512, (u16*)smem, acc);
  stage_acc(acc, Cs);
#pragma unroll 4
  for (int p = 0; p < 16; p++) {
    const int row = p * 8 + rsub;
    const f32x4 v = *(const f32x4*)(Cs + row * CSTR + c4 * 4);
    const f32x4 gv = unpack4(*(const u32x2*)(GB + tofs + (size_t)row * 1024));
    const f32x4 m1 = unpack4(*(const u32x2*)(MRG + tofs + (size_t)row * 1024));
    *(u32x2*)(MRG + tofs + (size_t)row * 1024) = pack4(m1 + v * gv);
  }
}

DI void phase4_tile(const Params& P, int mt, int nt, char* smem) {
  const int tid = threadIdx.x, lane = tid & 63, w = tid >> 6, wm = w >> 1, wn = w & 1, r = lane & 15, quad = lane >> 4;
  const int m0 = mt * 128, n0 = nt * 128;
  char* ws = P.ws;
  const u16* MRG = (const u16*)(ws + W_QKV);
  u16* H1B = (u16*)(ws + W_QKV + SZ_ACT);
  float* SSQ2 = (float*)(ws + W_SSQ2);
  f32x4 acc[4][4];
  zero_acc(acc);
  gemm_mainloop(MRG + (size_t)m0 * 1024, 1024, (const u16*)(ws + W_WOUT) + (size_t)n0 * 1024, 1024, 1024, (u16*)smem, acc);
  const float* xb = m0 < TP ? P.x_p : P.x_s - (size_t)TP * 1024;
  float* Cs = (float*)smem;
  const int c4 = tid & 31, rsub = tid >> 5;
  const size_t tofs = (size_t)m0 * 1024 + n0 + c4 * 4;
  stage_acc(acc, Cs);
#pragma unroll 4
  for (int p = 0; p < 16; p++) {
    const int row = p * 8 + rsub;
    const f32x4 v = *(const f32x4*)(Cs + row * CSTR + c4 * 4);
    const f32x4 h1 = *(const f32x4*)(xb + tofs + (size_t)row * 1024) + v;
    *(f32x4*)(P.out + tofs + (size_t)row * 1024) = h1;
    *(u32x2*)(H1B + tofs + (size_t)row * 1024) = pack4(h1);
    float ss = h1.x * h1.x + h1.y * h1.y + h1.z * h1.z + h1.w * h1.w;
    ss += __shfl_xor(ss, 1);
    ss += __shfl_xor(ss, 2);
    ss += __shfl_xor(ss, 4);
    ss += __shfl_xor(ss, 8);
    ss += __shfl_xor(ss, 16);
    if (c4 == 0) SSQ2[(size_t)(m0 + row) * 16 + nt] = ss;
  }
}

DI void phase5_tile(const Params& P, int mt, int nt, char* smem) {
  const int tid = threadIdx.x, lane = tid & 63, w = tid >> 6, wm = w >> 1, wn = w & 1, r = lane & 15, quad = lane >> 4;
  const int m0 = mt * 128, n0 = nt * 128;
  char* ws = P.ws;
  const u16* H1B = (const u16*)(ws + W_QKV + SZ_ACT);
  u16* QP = (u16*)(ws + W_QKV + 2 * SZ_ACT);
  const float* SSQ2 = (const float*)(ws + W_SSQ2);
  float* rs_s = (float*)(smem + RS_OFF);
  __syncthreads();
  if (tid < 128) {
    float s = 0.f;
#pragma unroll
    for (int i = 0; i < 8; i++) s += SSQ2[(size_t)(m0 + tid) * 16 + i];
    rs_s[tid] = rsqrtf(s * (1.f / 1024.f) + EPS);
  }
  f32x4 acc[4][4];
  zero_acc(acc);
  gemm_mainloop(H1B + (size_t)m0 * 1024, 1024, (const u16*)(ws + W_WQ) + (size_t)n0 * 1024, 1024, 1024, (u16*)smem, acc);
  float* Cs = (float*)smem;
  const int c4 = tid & 31, rsub = tid >> 5;
  const size_t tofs = (size_t)m0 * 1024 + n0 + c4 * 4;
  stage_acc(acc, Cs);
#pragma unroll 4
  for (int p = 0; p < 16; p++) {
    const int row = p * 8 + rsub;
    const f32x4 v = *(const f32x4*)(Cs + row * CSTR + c4 * 4) * rs_s[row];
    *(u32x2*)(QP + tofs + (size_t)row * 1024) = pack4(v);
  }
}

DI void bitonic_merge16(u32 (&L)[16]) {
#pragma unroll
  for (int st = 8; st >= 1; st >>= 1)
#pragma unroll
    for (int i = 0; i < 16; i++)
      if ((i & st) == 0) { u32 hi = max(L[i], L[i + st]); u32 lo = min(L[i], L[i + st]); L[i] = hi; L[i + st] = lo; }
}
DI void phase6a_unit(const Params& P, int unit, char* smem) {
  const int tid = threadIdx.x, lane = tid & 63, w = tid >> 6, r = lane & 15, quad = lane >> 4;
  char* ws = P.ws;
  const u16* QP = (const u16*)(ws + W_QKV + 2 * SZ_ACT);
  const u16* SK = (const u16*)(ws + W_SK);
  u16* IDXo = (u16*)(ws + W_IDX);
  float* Go = (float*)(ws + W_G);
  float* sc = (float*)smem;
  u32* hl = (u32*)smem;
  u32* xl = (u32*)smem + 256 * 17;
  u32* lists = (u32*)(smem + 128 * 129 * 4);
  unsigned char* tabi = (unsigned char*)(smem + 128 * 129 * 4 + 128 * 17 * 4);
  unsigned char* tabj = tabi + 64;
  const int tok0 = unit * 64;
  __syncthreads();
  if (tid == 0) {
    int c = 0;
    for (int i = 0; i < 16; i++)
      for (int j = i + 1; j < 16; j++)
        if ((i + 1) * (j + 1) <= 16) { tabi[c] = (unsigned char)i; tabj[c] = (unsigned char)j; tabi[32 + c] = (unsigned char)j; tabj[32 + c] = (unsigned char)i; c++; }
    tabi[23] = 0; tabj[23] = 0; tabi[24] = 1; tabj[24] = 1;
    tabi[55] = 2; tabj[55] = 2; tabi[56] = 3; tabj[56] = 3;
  }
  for (int h = 0; h < 8; h++) {
#pragma unroll
    for (int p = 0; p < 2; p++) {
      const int hp = h * 2 + p;
      bf16x8 qf[2];
#pragma unroll
      for (int ks = 0; ks < 2; ks++)
        qf[ks] = *(const bf16x8*)(QP + (size_t)(tok0 + w * 16 + r) * 1024 + hp * 64 + ks * 32 + quad * 8);
#pragma unroll
      for (int nt = 0; nt < 8; nt++) {
        f32x4 a4 = (f32x4){0.f, 0.f, 0.f, 0.f};
#pragma unroll
        for (int ks = 0; ks < 2; ks++) {
          bf16x8 kf = *(const bf16x8*)(SK + (size_t)(hp * 128 + nt * 16 + r) * 64 + ks * 32 + quad * 8);
          a4 = mfma16(kf, qf[ks], a4);
        }
        float* d = sc + (p * 64 + w * 16 + r) * 129 + nt * 16 + quad * 4;
        d[0] = a4[0]; d[1] = a4[1]; d[2] = a4[2]; d[3] = a4[3];
      }
    }
    __syncthreads();
    u32 L[16];
    {
#pragma unroll
      for (int s = 0; s < 16; s++) L[s] = 0u;
      const int inst = tid & 127, half = tid >> 7;
      const float* row = sc + inst * 129 + half * 64;
#pragma unroll 4
      for (int i = 0; i < 64; i++) {
        u32 k = (mono(row[i]) & ~127u) | (u32)(half * 64 + i);
        insert16(L, k);
      }
    }
    __syncthreads();
#pragma unroll
    for (int s = 0; s < 16; s++) hl[tid * 17 + s] = L[s];
    __syncthreads();
    if (tid < 128) {
      u32 M[16];
#pragma unroll
      for (int s = 0; s < 16; s++) M[s] = max(L[s], hl[(tid + 128) * 17 + 15 - s]);
      bitonic_merge16(M);
#pragma unroll
      for (int s = 0; s < 16; s++) lists[tid * 17 + s] = M[s];
    }
    __syncthreads();
    if (tid < 128) {
      const int tok = tid & 63;
      const bool part = tid >= 64;
      float fa[16], fb[16];
#pragma unroll
      for (int s = 0; s < 16; s++) {
        const float va = unmono(lists[tok * 17 + s] & ~127u);
        const float vb = unmono(lists[(64 + tok) * 17 + s] & ~127u);
        fa[s] = part ? vb : va;
        fb[s] = part ? va : vb;
      }
      u32 L2[16];
#pragma unroll
      for (int s = 0; s < 16; s++) L2[s] = 0u;
      const u32 cbase = part ? 32u : 0u;
      {
        int c = 0;
#pragma unroll
        for (int i = 0; i < 16; i++)
#pragma unroll
          for (int j = i + 1; j < 16; j++)
            if ((i + 1) * (j + 1) <= 16) {
              insert16(L2, (mono(fa[i] + fb[j]) & ~63u) | (cbase + (u32)c));
              c++;
            }
      }
      insert16(L2, (mono(part ? fa[2] + fb[2] : fa[0] + fb[0]) & ~63u) | (cbase + 23u));
      insert16(L2, (mono(part ? fa[3] + fb[3] : fa[1] + fb[1]) & ~63u) | (cbase + 24u));
#pragma unroll
      for (int s = 0; s < 16; s++) xl[tid * 17 + s] = L2[s];
    }
    __syncthreads();
    if (tid < 64) {
      float val[16];
      u32 idx[16];
      float mx = -1e30f;
#pragma unroll
      for (int s = 0; s < 16; s++) {
        const u32 m = max(xl[tid * 17 + s], xl[(tid + 64) * 17 + 15 - s]);
        const u32 sl = m & 63u;
        const int i = tabi[sl], j = tabj[sl];
        const u32 au = lists[tid * 17 + i], bu = lists[(64 + tid) * 17 + j];
        val[s] = unmono(au & ~127u) + unmono(bu & ~127u);
        idx[s] = (au & 127u) * 128u + (bu & 127u);
        mx = fmaxf(mx, val[s]);
      }
      float sum = 0.f;
#pragma unroll
      for (int s = 0; s < 16; s++) { val[s] = __expf(val[s] - mx); sum += val[s]; }
      const float inv = 1.f / sum;
      const size_t so = ((size_t)(tok0 + tid) * 8 + h) * 16;
      {
        u32* ib = (u32*)(IDXo + (size_t)(tok0 + tid) * 128 + h * 2);
#pragma unroll
        for (int gg = 0; gg < 8; gg++) ib[gg * 8] = idx[gg] | (idx[gg + 8] << 16);
      }
#pragma unroll
      for (int s = 0; s < 4; s++)
        *(f32x4*)(Go + so + s * 4) = (f32x4){val[s * 4] * inv, val[s * 4 + 1] * inv, val[s * 4 + 2] * inv, val[s * 4 + 3] * inv};
    }
    __syncthreads();
  }
}

typedef float f32x2 __attribute__((ext_vector_type(2)));
DI float dot4_fp8(u32 w, float x0, float x1, float x2, float x3, float acc) {
  f32x2 lo = __builtin_amdgcn_cvt_pk_f32_fp8((int)w, false);
  f32x2 hi = __builtin_amdgcn_cvt_pk_f32_fp8((int)w, true);
  acc = fmaf(lo[0], x0, acc);
  acc = fmaf(lo[1], x1, acc);
  acc = fmaf(hi[0], x2, acc);
  acc = fmaf(hi[1], x3, acc);
  return acc;
}
DI void axpy4_fp8(u32 w, float wgt, float& o0, float& o1, float& o2, float& o3) {
  f32x2 lo = __builtin_amdgcn_cvt_pk_f32_fp8((int)w, false);
  f32x2 hi = __builtin_amdgcn_cvt_pk_f32_fp8((int)w, true);
  o0 = fmaf(wgt, lo[0], o0);
  o1 = fmaf(wgt, lo[1], o1);
  o2 = fmaf(wgt, hi[0], o2);
  o3 = fmaf(wgt, hi[1], o3);
}

struct RowSet { u32x4 r[16]; };
DI void gather_rows(RowSet& R, const unsigned char* base, u32 lofs, u32x4 ea, u32x4 eb) {
  const u32 ev[8] = {ea.x, ea.y, ea.z, ea.w, eb.x, eb.y, eb.z, eb.w};
#pragma unroll
  for (int i = 0; i < 8; i++) {
    R.r[2 * i] = *(const u32x4*)(base + (((ev[i] & 0xffffu) << 7) + lofs));
    R.r[2 * i + 1] = *(const u32x4*)(base + (((ev[i] >> 16) << 7) + lofs));
  }
}
DI void b1_compute(const RowSet& R, u32x4 xa, u32x4 xb, float* pr, int c, bool valid) {
  float xf[16];
  xf[0] = __uint_as_float(xa.x << 16); xf[1] = __uint_as_float(xa.x & 0xffff0000u);
  xf[2] = __uint_as_float(xa.y << 16); xf[3] = __uint_as_float(xa.y & 0xffff0000u);
  xf[4] = __uint_as_float(xa.z << 16); xf[5] = __uint_as_float(xa.z & 0xffff0000u);
  xf[6] = __uint_as_float(xa.w << 16); xf[7] = __uint_as_float(xa.w & 0xffff0000u);
  xf[8] = __uint_as_float(xb.x << 16); xf[9] = __uint_as_float(xb.x & 0xffff0000u);
  xf[10] = __uint_as_float(xb.y << 16); xf[11] = __uint_as_float(xb.y & 0xffff0000u);
  xf[12] = __uint_as_float(xb.z << 16); xf[13] = __uint_as_float(xb.z & 0xffff0000u);
  xf[14] = __uint_as_float(xb.w << 16); xf[15] = __uint_as_float(xb.w & 0xffff0000u);
  float p[16];
#pragma unroll
  for (int i = 0; i < 16; i++) {
    float a = dot4_fp8(R.r[i].x, xf[0], xf[1], xf[2], xf[3], 0.f);
    a = dot4_fp8(R.r[i].y, xf[4], xf[5], xf[6], xf[7], a);
    a = dot4_fp8(R.r[i].z, xf[8], xf[9], xf[10], xf[11], a);
    a = dot4_fp8(R.r[i].w, xf[12], xf[13], xf[14], xf[15], a);
    p[i] = a;
  }
#pragma unroll
  for (int i = 0; i < 8; i++) { float keep = (c & 4) ? p[i + 8] : p[i]; float send = (c & 4) ? p[i] : p[i + 8]; p[i] = keep + __shfl_xor(send, 4); }
#pragma unroll
  for (int i = 0; i < 4; i++) { float keep = (c & 2) ? p[i + 4] : p[i]; float send = (c & 2) ? p[i] : p[i + 4]; p[i] = keep + __shfl_xor(send, 2); }
#pragma unroll
  for (int i = 0; i < 2; i++) { float keep = (c & 1) ? p[i + 2] : p[i]; float send = (c & 1) ? p[i] : p[i + 2]; p[i] = keep + __shfl_xor(send, 1); }
  const int it0 = 2 * (c & 1) + 4 * ((c >> 1) & 1) + 8 * ((c >> 2) & 1);
  if (valid) {
    pr[it0 * 8] = p[0];
    pr[(it0 + 1) * 8] = p[1];
  }
}
DI void phase6b1(const Params& P) {
  const int lane = threadIdx.x & 63, g = lane >> 3, c = lane & 7;
  const int x = blockIdx.x & 7;
  const int wg = (blockIdx.x >> 3) * 4 + (threadIdx.x >> 6), nwg = (gridDim.x >> 3) * 4;
  char* ws = P.ws;
  const u16* H1B = (const u16*)(ws + W_QKV + SZ_ACT) + x * 128 + c * 16;
  const unsigned char* U8 = (const unsigned char*)(ws + W_UB) + ((size_t)x << 21);
  const u32 lofs = c * 16;
  const u16* IDX = (const u16*)(ws + W_IDX) + g * 16;
  float* PH = ph_slice(ws, x) + g;
  const int n = (TT - wg + nwg - 1) / nwg;
#define TOK(i) min(wg + (i) * nwg, TT - 1)
  int t0 = TOK(0), t1 = TOK(1);
  u32x4 eA0 = *(const u32x4*)(IDX + (size_t)t0 * 128), eA1 = *(const u32x4*)(IDX + (size_t)t0 * 128 + 8);
  u32x4 eB0 = *(const u32x4*)(IDX + (size_t)t1 * 128), eB1 = *(const u32x4*)(IDX + (size_t)t1 * 128 + 8);
  RowSet RA, RB;
  gather_rows(RA, U8, lofs, eA0, eA1);
  u32x4 xA0 = *(const u32x4*)(H1B + (size_t)t0 * 1024), xA1 = *(const u32x4*)(H1B + (size_t)t0 * 1024 + 8);
#pragma unroll 1
  for (int i = 0; i < n; i += 2) {
    gather_rows(RB, U8, lofs, eB0, eB1);
    const u32x4 xB0 = *(const u32x4*)(H1B + (size_t)t1 * 1024), xB1 = *(const u32x4*)(H1B + (size_t)t1 * 1024 + 8);
    const int t2 = TOK(i + 2);
    eA0 = *(const u32x4*)(IDX + (size_t)t2 * 128);
    eA1 = *(const u32x4*)(IDX + (size_t)t2 * 128 + 8);
    b1_compute(RA, xA0, xA1, PH + (size_t)t0 * 128, c, true);
    gather_rows(RA, U8, lofs, eA0, eA1);
    xA0 = *(const u32x4*)(H1B + (size_t)t2 * 1024);
    xA1 = *(const u32x4*)(H1B + (size_t)t2 * 1024 + 8);
    const int t3 = TOK(i + 3);
    eB0 = *(const u32x4*)(IDX + (size_t)t3 * 128);
    eB1 = *(const u32x4*)(IDX + (size_t)t3 * 128 + 8);
    b1_compute(RB, xB0, xB1, PH + (size_t)t1 * 128, c, i + 1 < n);
    t0 = t2;
    t1 = t3;
  }
}

DI void phase6w(const Params& P) {
  const int lane = threadIdx.x & 63;
  const int gw = blockIdx.x * 4 + (threadIdx.x >> 6), nw = gridDim.x * 4;
  char* ws = P.ws;
  float* G = (float*)(ws + W_G);
  const float* SSQ2 = (const float*)(ws + W_SSQ2);
  for (int t = gw; t < TT; t += nw) {
    float ssq = lane < 8 ? SSQ2[(size_t)t * 16 + lane] : 0.f;
    float h0 = 0.f, h1v = 0.f;
    {
      const float* ph = (const float*)(ws + W_XB) + (size_t)t * 128 + lane;
#pragma unroll
      for (int xs = 0; xs < 4; xs++) { h0 += ph[(size_t)xs * (SZ_PH / 4)]; h1v += ph[(size_t)xs * (SZ_PH / 4) + 64]; }
      ph = (const float*)(ws + W_GB) + (size_t)t * 128 + lane;
#pragma unroll
      for (int xs = 0; xs < 4; xs++) { h0 += ph[(size_t)xs * (SZ_PH / 4)]; h1v += ph[(size_t)xs * (SZ_PH / 4) + 64]; }
    }
    const float g0 = G[(size_t)t * 128 + lane];
    const float g1 = G[(size_t)t * 128 + 64 + lane];
    const float rs2 = rsqrtf(wave_sum(ssq) * (1.f / 1024.f) + EPS);
    const float w0 = g0 * gelu_tanh(rs2 * (1.f / U_SCALE) * h0) * (1.f / V_SCALE);
    const float w1 = g1 * gelu_tanh(rs2 * (1.f / U_SCALE) * h1v) * (1.f / V_SCALE);
    u16* wrow = (u16*)(G + (size_t)t * 128);
    wrow[(lane & 7) * 16 + (lane >> 3)] = f2bf(w0);
    wrow[(lane & 7) * 16 + 8 + (lane >> 3)] = f2bf(w1);
  }
}

DI void b2_compute(const RowSet& R, u32x4 w0, u32x4 w1, float* hp, u16* hb, float* sq, int g, int lane, bool valid) {
  const f32x2 hv = *(const f32x2*)hp;
  const u32 wv[8] = {w0.x, w0.y, w0.z, w0.w, w1.x, w1.y, w1.z, w1.w};
  float o[16];
#pragma unroll
  for (int i = 0; i < 16; i++) o[i] = 0.f;
#pragma unroll
  for (int i = 0; i < 16; i++) {
    u32 r0 = R.r[i].x, r1 = R.r[i].y, r2 = R.r[i].z, r3 = R.r[i].w;
    asm volatile("" : "+v"(r0), "+v"(r1), "+v"(r2), "+v"(r3) : "v"(o[0]), "v"(o[15]));
    const float wgt = (i & 1) ? __uint_as_float(wv[i >> 1] & 0xffff0000u) : __uint_as_float(wv[i >> 1] << 16);
    axpy4_fp8(r0, wgt, o[0], o[1], o[2], o[3]);
    axpy4_fp8(r1, wgt, o[4], o[5], o[6], o[7]);
    axpy4_fp8(r2, wgt, o[8], o[9], o[10], o[11]);
    axpy4_fp8(r3, wgt, o[12], o[13], o[14], o[15]);
  }
#pragma unroll
  for (int i = 0; i < 8; i++) { float keep = (g & 4) ? o[i + 8] : o[i]; float send = (g & 4) ? o[i] : o[i + 8]; o[i] = keep + __shfl_xor(send, 32); }
#pragma unroll
  for (int i = 0; i < 4; i++) { float keep = (g & 2) ? o[i + 4] : o[i]; float send = (g & 2) ? o[i] : o[i + 4]; o[i] = keep + __shfl_xor(send, 16); }
#pragma unroll
  for (int i = 0; i < 2; i++) { float keep = (g & 1) ? o[i + 2] : o[i]; float send = (g & 1) ? o[i] : o[i + 2]; o[i] = keep + __shfl_xor(send, 8); }
  const float a0 = hv.x + o[0], a1 = hv.y + o[1];
  const float ss = wave_sum(a0 * a0 + a1 * a1);
  if (valid) {
    *(f32x2*)hp = (f32x2){a0, a1};
    *(u32*)hb = pack2(a0, a1);
    if (lane == 0) *sq = ss;
  }
}
DI void phase6b2(const Params& P) {
  const int lane = threadIdx.x & 63, g = lane >> 3, c = lane & 7, w = threadIdx.x >> 6;
  const int x = blockIdx.x & 7;
  const int wg = (blockIdx.x >> 3) * 4 + w, nwg = (gridDim.x >> 3) * 4;
  char* ws = P.ws;
  const int col = x * 128 + c * 16 + 2 * (g & 1) + 4 * ((g >> 1) & 1) + 8 * ((g >> 2) & 1);
  u16* H1B = (u16*)(ws + W_QKV + SZ_ACT) + col;
  float* OUT = P.out + col;
  const unsigned char* V8 = (const unsigned char*)(ws + W_VB) + ((size_t)x << 21);
  const u32 lofs = c * 16;
  const u16* IDX = (const u16*)(ws + W_IDX) + g * 16;
  const u16* WG = (const u16*)(ws + W_G) + g * 16;
  float* SSQ3 = (float*)(ws + W_SSQ3) + x;
  const int n = (TT - wg + nwg - 1) / nwg;
  int t0 = TOK(0), t1 = TOK(1);
  u32x4 eA0 = *(const u32x4*)(IDX + (size_t)t0 * 128), eA1 = *(const u32x4*)(IDX + (size_t)t0 * 128 + 8);
  u32x4 eB0 = *(const u32x4*)(IDX + (size_t)t1 * 128), eB1 = *(const u32x4*)(IDX + (size_t)t1 * 128 + 8);
  RowSet RA, RB;
  gather_rows(RA, V8, lofs, eA0, eA1);
  u32x4 wA0 = *(const u32x4*)(WG + (size_t)t0 * 256), wA1 = *(const u32x4*)(WG + (size_t)t0 * 256 + 8);
#pragma unroll 1
  for (int i = 0; i < n; i += 2) {
    gather_rows(RB, V8, lofs, eB0, eB1);
    const u32x4 wB0 = *(const u32x4*)(WG + (size_t)t1 * 256), wB1 = *(const u32x4*)(WG + (size_t)t1 * 256 + 8);
    const int t2 = TOK(i + 2);
    eA0 = *(const u32x4*)(IDX + (size_t)t2 * 128);
    eA1 = *(const u32x4*)(IDX + (size_t)t2 * 128 + 8);
    b2_compute(RA, wA0, wA1, OUT + (size_t)t0 * 1024, H1B + (size_t)t0 * 1024, SSQ3 + (size_t)t0 * 8, g, lane, true);
    gather_rows(RA, V8, lofs, eA0, eA1);
    wA0 = *(const u32x4*)(WG + (size_t)t2 * 256);
    wA1 = *(const u32x4*)(WG + (size_t)t2 * 256 + 8);
    const int t3 = TOK(i + 3);
    eB0 = *(const u32x4*)(IDX + (size_t)t3 * 128);
    eB1 = *(const u32x4*)(IDX + (size_t)t3 * 128 + 8);
    b2_compute(RB, wB0, wB1, OUT + (size_t)t1 * 1024, H1B + (size_t)t1 * 1024, SSQ3 + (size_t)t1 * 8, g, lane, i + 1 < n);
    t0 = t2;
    t1 = t3;
  }
#undef TOK
}

DI void phase7_tile(const Params& P, int mt, int nt, char* smem) {
  const int tid = threadIdx.x, lane = tid & 63, w = tid >> 6, wm = w >> 1, wn = w & 1, r = lane & 15, quad = lane >> 4;
  const int m0 = mt * 128, n0 = nt * 128;
  char* ws = P.ws;
  const u16* H2B = (const u16*)(ws + W_QKV + SZ_ACT);
  const u16* PB = (const u16*)(ws + W_PB);
  const float* SSQ3 = (const float*)(ws + W_SSQ3);
  float* rs_s = (float*)(smem + RS_OFF);
  __syncthreads();
  if (tid < 128) {
    float q = 0.f;
#pragma unroll
    for (int i = 0; i < 8; i++) q += SSQ3[(size_t)(m0 + tid) * 8 + i];
    rs_s[tid] = rsqrtf(q * (1.f / 1024.f) + EPS);
  }
  u16* PJ = (u16*)(ws + W_QKV);
  f32x4 acc[4][4];
  zero_acc(acc);
  gemm_mainloop(PB + (size_t)m0 * 256, 256, (const u16*)(ws + W_WPP) + (size_t)n0 * 256, 256, 256, (u16*)smem, acc);
  float* Cs = (float*)smem;
  const int c4 = tid & 31, rsub = tid >> 5;
  const size_t tofs = (size_t)m0 * 1024 + n0 + c4 * 4;
  stage_acc(acc, Cs);
#pragma unroll 4
  for (int p = 0; p < 16; p++) {
    const int row = p * 8 + rsub;
    *(u32x2*)(PJ + tofs + (size_t)row * 1024) = pack4(*(const f32x4*)(Cs + row * CSTR + c4 * 4));
  }
  zero_acc(acc);
  gemm_mainloop(H2B + (size_t)m0 * 1024, 1024, (const u16*)(ws + W_WG) + (size_t)n0 * 1024, 1024, 1024, (u16*)smem, acc);
  stage_acc(acc, Cs);
#pragma unroll 4
  for (int p = 0; p < 16; p++) {
    const int row = p * 8 + rsub;
    const f32x4 v = *(const f32x4*)(Cs + row * CSTR + c4 * 4) * rs_s[row];
    const f32x4 pj = unpack4(*(const u32x2*)(PJ + tofs + (size_t)row * 1024));
    const f32x4 h2 = *(const f32x4*)(P.out + tofs + (size_t)row * 1024);
    const f32x4 gate = (f32x4){sigmoidf_(v.x), sigmoidf_(v.y), sigmoidf_(v.z), sigmoidf_(v.w)};
    *(f32x4*)(P.out + tofs + (size_t)row * 1024) = h2 + gate * pj;
  }
}

#define GEMM_TILES(NT, FN)                                                              \
  {                                                                                     \
    for (int t = blockIdx.x; t < 2 * (NT); t += gridDim.x) FN(P, 512 + t / (NT), t % (NT), smem); \
    const int x_ = blockIdx.x & 7, bpx_ = gridDim.x >> 3;                               \
    constexpr int NG_ = (NT) / 8;                                                       \
    for (int s_ = blockIdx.x >> 3; s_ < 64 * 8 * NG_; s_ += bpx_) {                     \
      const int R_ = s_ >> 6, q_ = s_ & 63;                                             \
      const int mg_ = R_ / NG_, ng_ = R_ % NG_;                                         \
      FN(P, ((mg_ * 8 + (q_ >> 3)) << 3) + x_, ng_ * 8 + (q_ & 7), smem);               \
    }                                                                                   \
  }

__global__ void __launch_bounds__(256, 2) fwd_megakernel(Params P) {
  __shared__ __attribute__((aligned(16))) char smem[SMEM_BYTES];
  cg::grid_group grid = cg::this_grid();
  phase0(P, smem);
  grid.sync();
  phase1_scans(P);
  GEMM_TILES(40, phase1_tile)
  grid.sync();
  phase2(P, smem);
  grid.sync();
  GEMM_TILES(8, phase3_tile)
  grid.sync();
  GEMM_TILES(8, phase4_tile)
  grid.sync();
  GEMM_TILES(8, phase5_tile)
  grid.sync();
  for (int t = blockIdx.x; t < TT / 64; t += gridDim.x) phase6a_unit(P, t, smem);
  grid.sync();
  phase6b1(P);
  grid.sync();
  phase6w(P);
  grid.sync();
  phase6b2(P);
  grid.sync();
  GEMM_TILES(8, phase7_tile)
}

extern "C" void kernel_launch(void* const* d_in, const int* in_sizes, int n_in, void* d_out, int out_size, void* d_ws,
                              size_t ws_size, hipStream_t stream) {
  static int grid_blocks = 0;
  if (!grid_blocks) {
    int dev = 0, cus = 0, per_cu = 0;
    hipGetDevice(&dev);
    hipDeviceGetAttribute(&cus, hipDeviceAttributeMultiprocessorCount, dev);
    hipOccupancyMaxActiveBlocksPerMultiprocessor(&per_cu, fwd_megakernel, 256, 0);
    if (per_cu > 2) per_cu = 2;
    if (per_cu < 1) per_cu = 1;
    grid_blocks = cus * per_cu;
  }
  if (ws_size < W_END) { fprintf(stderr, "workspace too small: %zu < %zu\n", ws_size, (size_t)W_END); return; }
  Params p{};
  const float** pf = (const float**)&p;
  for (int i = 0; i < 28; i++) pf[i] = (const float*)d_in[i];
  p.out = (float*)d_out;
  p.ws = (char*)d_ws;
  void* args[] = {&p};
  hipError_t e = hipLaunchCooperativeKernel((void*)fwd_megakernel, dim3(grid_blocks), dim3(256), args, 0, stream);
  if (e != hipSuccess) fprintf(stderr, "cooperative launch failed: %s (grid %d)\n", hipGetErrorString(e), grid_blocks);
}
```

```cpp
#include <hip/hip_runtime.h>
#include <hip/hip_cooperative_groups.h>
#include <cstdio>
namespace cg = cooperative_groups;

typedef unsigned short u16;
typedef unsigned int u32;
typedef short bf16x8 __attribute__((ext_vector_type(8)));
typedef short s16x4 __attribute__((ext_vector_type(4)));
typedef float f32x4 __attribute__((ext_vector_type(4)));
typedef unsigned int u32x4 __attribute__((ext_vector_type(4)));
typedef unsigned int u32x2 __attribute__((ext_vector_type(2)));
typedef __bf16 bf16x2_t __attribute__((ext_vector_type(2)));

#define DI __device__ __forceinline__
#define LAUNDER(x) asm volatile("" : "+v"(x))

constexpr int TP = 65536, TS = 256, TT = TP + TS;
constexpr float LOG2E = 1.4426950408889634f;
constexpr float EPS = 1e-6f;
constexpr float U_SCALE = 1024.f, V_SCALE = 128.f;

constexpr size_t O_AK_P = 67371008, O_AV_P = 100925440, O_AF_P = 134479872, O_BK_P = 135004160,
                 O_BV_P = 143392768, O_AK_S = 151781376, O_AV_S = 151912448, O_AF_S = 152043520,
                 O_BK_S = 152045568, O_BV_S = 152176640;

constexpr size_t SZ_ACT = (size_t)TT * 1024 * 2;
constexpr size_t SZ_HALF = (size_t)TT * 512 * 2;
constexpr size_t W_XB = 0;
constexpr size_t W_QKV = SZ_ACT;
constexpr size_t W_GA = W_QKV + 6 * SZ_HALF;
constexpr size_t W_GB = W_GA + SZ_ACT;
constexpr size_t W_PB = W_GB + SZ_ACT;
constexpr size_t W_WIN = W_PB + (size_t)TT * 256 * 2;
constexpr size_t W_WUPA = W_WIN + (size_t)5120 * 1024 * 2;
constexpr size_t W_WUPB = W_WUPA + 1024 * 512 * 2;
constexpr size_t W_WOUT = W_WUPB + 1024 * 512 * 2;
constexpr size_t W_WQ = W_WOUT + 1024 * 1024 * 2;
constexpr size_t W_WG = W_WQ + 1024 * 1024 * 2;
constexpr size_t W_WPP = W_WG + 1024 * 1024 * 2;
constexpr size_t W_UB = W_WPP + 1024 * 256 * 2;
constexpr size_t W_VB = W_UB + (size_t)16384 * 1024 * 2;
constexpr size_t W_SK = W_VB + (size_t)16384 * 1024 * 2;
constexpr size_t W_RS1 = W_SK + 131072 * 2;
constexpr size_t W_SSQ2 = W_RS1 + (size_t)TT * 4;
constexpr size_t W_RS3 = W_SSQ2 + (size_t)TT * 64;
constexpr size_t W_CUMP = W_RS3 + (size_t)TT * 4;
constexpr size_t W_CUMS = W_CUMP + (size_t)256 * 2048 * 4;
constexpr size_t W_SSQ3 = W_CUMS + (size_t)128 * 4112 * 4 + 1024;
constexpr size_t W_END = W_SSQ3 + (size_t)TT * 8 * 4;
constexpr size_t W_IDX = W_GA;
constexpr size_t W_G = W_GA + (size_t)32 * 1024 * 1024;
constexpr size_t SZ_PH = (size_t)TT * 128 * 4;


struct Params {
  const float *x_p, *x_s, *cak, *cav, *caf, *cbk, *cbv, *p_p, *p_s, *g_mix, *w_in, *b_f, *qn_a, *kn_a,
      *qn_b, *kn_b, *relb, *w_up_a, *w_up_b, *w_out, *g_ffn, *peer_wq, *peer_sk, *peer_u, *peer_v, *g_ple,
      *w_gate, *w_proj;
  float* out;
  char* ws;
};

constexpr int SMEM_BYTES = 128 * 129 * 4 + 2 * 64 * 17 * 4 + 256;

DI float* ph_slice(char* ws, int x) { return (float*)(ws + (x < 4 ? W_XB + (size_t)x * SZ_PH : W_GB + (size_t)(x - 4) * SZ_PH)); }
DI u16 f2bf(float x) { u32 u = __float_as_uint(x); u += 0x7fffu + ((u >> 16) & 1u); return (u16)(u >> 16); }
DI float bf2f(u16 h) { return __uint_as_float(((u32)h) << 16); }
DI u32 pack2(float a, float b) { return (u32)f2bf(a) | ((u32)f2bf(b) << 16); }
DI float wave_sum(float v) {
#pragma unroll
  for (int o = 32; o; o >>= 1) v += __shfl_xor(v, o);
  return v;
}
DI f32x4 mfma16(bf16x8 a, bf16x8 b, f32x4 c) { return __builtin_amdgcn_mfma_f32_16x16x32_bf16(a, b, c, 0, 0, 0); }
DI float sigmoidf_(float x) { return 1.f / (1.f + __expf(-x)); }
DI u32 mono(float x) { u32 u = __float_as_uint(x); u32 m = (u32)((int)u >> 31) | 0x80000000u; return u ^ m; }
DI float unmono(u32 k) { u32 m = ((k >> 31) - 1u) | 0x80000000u; return __uint_as_float(k ^ m); }
DI void insert16(u32 (&L)[16], u32 x) {
#pragma unroll
  for (int s = 0; s < 16; s++) { u32 mx = max(L[s], x); x = min(L[s], x); L[s] = mx; }
}
DI float gelu_tanh(float x) {
  float u = 0.7978845608028654f * (x + 0.044715f * x * x * x);
  float t = 1.f - 2.f / (1.f + __expf(2.f * u));
  return 0.5f * x * (1.f + t);
}

constexpr int GSTR = 72;
constexpr int GBUF = 2 * 128 * GSTR;
constexpr int RS_OFF = 2 * GBUF * 2;
DI void gemm_compute(const u16* As, const u16* Bs, f32x4 (&acc)[4][4], int wm, int wn, int r, int quad) {
#pragma unroll
  for (int ks = 0; ks < 2; ks++) {
    bf16x8 af[4], bfr[4];
#pragma unroll
    for (int mi = 0; mi < 4; mi++) af[mi] = *(const bf16x8*)(As + (wm * 64 + mi * 16 + r) * GSTR + ks * 32 + quad * 8);
#pragma unroll
    for (int ni = 0; ni < 4; ni++) bfr[ni] = *(const bf16x8*)(Bs + (wn * 64 + ni * 16 + r) * GSTR + ks * 32 + quad * 8);
#pragma unroll
    for (int mi = 0; mi < 4; mi++)
#pragma unroll
      for (int ni = 0; ni < 4; ni++) acc[mi][ni] = mfma16(af[mi], bfr[ni], acc[mi][ni]);
    if (ks == 0) __builtin_amdgcn_sched_barrier(0);
  }
}
DI void gemm_mainloop(const u16* __restrict__ A, int lda, const u16* __restrict__ B, int ldb, int K, u16* smem,
                      f32x4 (&acc)[4][4]) {
  const int tid = threadIdx.x, lane = tid & 63, w = tid >> 6, wm = w >> 1, wn = w & 1, r = lane & 15, quad = lane >> 4;
  u16* As0 = smem;
  u16* Bs0 = smem + 128 * GSTR;
  u16* As1 = smem + GBUF;
  u16* Bs1 = As1 + 128 * GSTR;
  u32x4 r0a[4], r0b[4], r1a[4], r1b[4];
  const int lrow = tid >> 3, lch = tid & 7;
  const u16* ap = A + (size_t)lrow * lda + lch * 8;
  const u16* bp = B + (size_t)lrow * ldb + lch * 8;
  const int lo = lrow * GSTR + lch * 8;
  const int nk = K >> 6, km = nk - 1;
  const int krot = (blockIdx.x >> 3) * 5;
#define KOFF(kt) ((((kt) + krot) & km) * 64)
#pragma unroll
  for (int i = 0; i < 4; i++) {
    r0a[i] = *(const u32x4*)(ap + (size_t)i * 32 * lda + KOFF(0));
    r0b[i] = *(const u32x4*)(bp + (size_t)i * 32 * ldb + KOFF(0));
  }
#pragma unroll
  for (int i = 0; i < 4; i++) {
    r1a[i] = *(const u32x4*)(ap + (size_t)i * 32 * lda + KOFF(1));
    r1b[i] = *(const u32x4*)(bp + (size_t)i * 32 * ldb + KOFF(1));
  }
  __syncthreads();
#pragma unroll 1
  for (int kt = 0; kt < nk - 2; kt += 2) {
#pragma unroll
    for (int i = 0; i < 4; i++) {
      *(u32x4*)(As0 + lo + i * 32 * GSTR) = r0a[i];
      *(u32x4*)(Bs0 + lo + i * 32 * GSTR) = r0b[i];
    }
    __syncthreads();
    {
      const int ko = KOFF(kt + 2);
#pragma unroll
      for (int i = 0; i < 4; i++) {
        r0a[i] = *(const u32x4*)(ap + (size_t)i * 32 * lda + ko);
        r0b[i] = *(const u32x4*)(bp + (size_t)i * 32 * ldb + ko);
      }
    }
    gemm_compute(As0, Bs0, acc, wm, wn, r, quad);
#pragma unroll
    for (int i = 0; i < 4; i++) {
      *(u32x4*)(As1 + lo + i * 32 * GSTR) = r1a[i];
      *(u32x4*)(Bs1 + lo + i * 32 * GSTR) = r1b[i];
    }
    __syncthreads();
    {
      const int ko = KOFF(kt + 3);
#pragma unroll
      for (int i = 0; i < 4; i++) {
        r1a[i] = *(const u32x4*)(ap + (size_t)i * 32 * lda + ko);
        r1b[i] = *(const u32x4*)(bp + (size_t)i * 32 * ldb + ko);
      }
    }
    gemm_compute(As1, Bs1, acc, wm, wn, r, quad);
  }
#pragma unroll
  for (int i = 0; i < 4; i++) {
    *(u32x4*)(As0 + lo + i * 32 * GSTR) = r0a[i];
    *(u32x4*)(Bs0 + lo + i * 32 * GSTR) = r0b[i];
  }
  __syncthreads();
  gemm_compute(As0, Bs0, acc, wm, wn, r, quad);
#pragma unroll
  for (int i = 0; i < 4; i++) {
    *(u32x4*)(As1 + lo + i * 32 * GSTR) = r1a[i];
    *(u32x4*)(Bs1 + lo + i * 32 * GSTR) = r1b[i];
  }
  __syncthreads();
  gemm_compute(As1, Bs1, acc, wm, wn, r, quad);
#undef KOFF
}

DI void zero_acc(f32x4 (&acc)[4][4]) {
#pragma unroll
  for (int i = 0; i < 4; i++)
#pragma unroll
    for (int j = 0; j < 4; j++) acc[i][j] = (f32x4){0.f, 0.f, 0.f, 0.f};
}

constexpr int CSTR = 132;
DI void stage_acc(const f32x4 (&acc)[4][4], float* Cs) {
  const int tid = threadIdx.x, lane = tid & 63, w = tid >> 6, wm = w >> 1, wn = w & 1, r = lane & 15, quad = lane >> 4;
  __syncthreads();
#pragma unroll
  for (int mi = 0; mi < 4; mi++)
#pragma unroll
    for (int ni = 0; ni < 4; ni++)
#pragma unroll
      for (int j = 0; j < 4; j++) Cs[(wm * 64 + mi * 16 + quad * 4 + j) * CSTR + wn * 64 + ni * 16 + r] = acc[mi][ni][j];
  __syncthreads();
}
DI u32x2 pack4(f32x4 v) { return (u32x2){pack2(v.x, v.y), pack2(v.z, v.w)}; }
DI f32x4 unpack4(u32x2 p) {
  return (f32x4){__uint_as_float(p.x << 16), __uint_as_float(p.x & 0xffff0000u), __uint_as_float(p.y << 16), __uint_as_float(p.y & 0xffff0000u)};
}

DI void transpose_tile(const float* __restrict__ W, int ldw, int K, const float* __restrict__ g, u16* __restrict__ dst,
                       int k0, int n0, int nsrc0, float* tile) {
  const int tid = threadIdx.x;
  __syncthreads();
  {
    const int ty = tid >> 4, tx = tid & 15;
#pragma unroll
    for (int i = 0; i < 4; i++) {
      int k = ty + i * 16;
      f32x4 v = *(const f32x4*)(W + (size_t)(k0 + k) * ldw + nsrc0 + tx * 4);
      float s = g ? g[k0 + k] : 1.f;
      tile[k * 65 + tx * 4 + 0] = v[0] * s;
      tile[k * 65 + tx * 4 + 1] = v[1] * s;
      tile[k * 65 + tx * 4 + 2] = v[2] * s;
      tile[k * 65 + tx * 4 + 3] = v[3] * s;
    }
  }
  __syncthreads();
  {
    const int n = tid >> 2, kc = (tid & 3) * 16;
    u32 pk[8];
#pragma unroll
    for (int i = 0; i < 8; i++) pk[i] = pack2(tile[(kc + 2 * i) * 65 + n], tile[(kc + 2 * i + 1) * 65 + n]);
    u16* d = dst + (size_t)(n0 + n) * K + k0 + kc;
    *(u32x4*)d = (u32x4){pk[0], pk[1], pk[2], pk[3]};
    *(u32x4*)(d + 8) = (u32x4){pk[4], pk[5], pk[6], pk[7]};
  }
}

DI void conv_unit(const float* __restrict__ src, u16* __restrict__ dst, size_t base, const float* __restrict__ colscale) {
  const int tid = threadIdx.x;
#pragma unroll
  for (int i = 0; i < 4; i++) {
    size_t e = base + (size_t)i * 1024 + tid * 4;
    f32x4 v = *(const f32x4*)(src + e);
    if (colscale) {
      f32x4 gg = *(const f32x4*)(colscale + (e & 1023));
      v = v * gg;
    }
    *(u32x2*)(dst + e) = (u32x2){pack2(v[0], v[1]), pack2(v[2], v[3])};
  }
}

DI void conv_unit_fp8(const float* __restrict__ src, unsigned char* __restrict__ dst, size_t base,
                      const float* __restrict__ colscale, float scale) {
  const int tid = threadIdx.x;
#pragma unroll
  for (int i = 0; i < 4; i++) {
    size_t e = base + (size_t)i * 1024 + tid * 4;
    f32x4 v = *(const f32x4*)(src + e);
    if (colscale) {
      f32x4 gg = *(const f32x4*)(colscale + (e & 1023));
      v = v * gg;
    }
    int w = __builtin_amdgcn_cvt_pk_fp8_f32(v[0] * scale, v[1] * scale, 0, false);
    w = __builtin_amdgcn_cvt_pk_fp8_f32(v[2] * scale, v[3] * scale, w, true);
    *(int*)(dst + (((e & 1023) >> 7) << 21) + ((e >> 10) << 7) + (e & 127)) = w;
  }
}

DI void phase0(const Params& P, char* smem) {
  const int tid = threadIdx.x, lane = tid & 63, w = tid >> 6;
  char* ws = P.ws;
  {
    float* tile = (float*)smem;
    constexpr int T_WIN = 16 * 80, T_UP = 8 * 16, T_SQ = 256, T_PP = 4 * 16;
    constexpr int NT = T_WIN + 2 * T_UP + 3 * T_SQ + T_PP;
    for (int t = blockIdx.x; t < NT; t += gridDim.x) {
      int u = t;
      if (u < T_WIN) {
        int kt = u / 80, nt = u % 80;
        int n0 = nt * 64;
        int ns = n0 < 1536 ? n0 : n0 + 8;
        transpose_tile(P.w_in, 5128, 1024, P.g_mix, (u16*)(ws + W_WIN), kt * 64, n0, ns, tile);
        continue;
      }
      u -= T_WIN;
      if (u < T_UP) { transpose_tile(P.w_up_a, 1024, 512, nullptr, (u16*)(ws + W_WUPA), (u / 16) * 64, (u % 16) * 64, (u % 16) * 64, tile); continue; }
      u -= T_UP;
      if (u < T_UP) { transpose_tile(P.w_up_b, 1024, 512, nullptr, (u16*)(ws + W_WUPB), (u / 16) * 64, (u % 16) * 64, (u % 16) * 64, tile); continue; }
      u -= T_UP;
      if (u < T_SQ) { transpose_tile(P.w_out, 1024, 1024, nullptr, (u16*)(ws + W_WOUT), (u / 16) * 64, (u % 16) * 64, (u % 16) * 64, tile); continue; }
      u -= T_SQ;
      if (u < T_SQ) { transpose_tile(P.peer_wq, 1024, 1024, P.g_ffn, (u16*)(ws + W_WQ), (u / 16) * 64, (u % 16) * 64, (u % 16) * 64, tile); continue; }
      u -= T_SQ;
      if (u < T_SQ) { transpose_tile(P.w_gate, 1024, 1024, P.g_ple, (u16*)(ws + W_WG), (u / 16) * 64, (u % 16) * 64, (u % 16) * 64, tile); continue; }
      u -= T_SQ;
      transpose_tile(P.w_proj, 1024, 256, nullptr, (u16*)(ws + W_WPP), (u / 16) * 64, (u % 16) * 64, (u % 16) * 64, tile);
    }
  }
  {
    constexpr int U_UB = 4096, U_VB = 4096, U_SK = 32, U_PP = 4096, U_PS = 16;
    constexpr int NU = U_UB + U_VB + U_SK + U_PP + U_PS;
    for (int t = blockIdx.x; t < NU; t += gridDim.x) {
      int u = t;
      if (u < U_UB) { conv_unit_fp8(P.peer_u, (unsigned char*)(ws + W_UB), (size_t)u * 4096, P.g_ffn, U_SCALE); continue; }
      u -= U_UB;
      if (u < U_VB) { conv_unit_fp8(P.peer_v, (unsigned char*)(ws + W_VB), (size_t)u * 4096, nullptr, V_SCALE); continue; }
      u -= U_VB;
      if (u < U_SK) { conv_unit(P.peer_sk, (u16*)(ws + W_SK), (size_t)u * 4096, nullptr); continue; }
      u -= U_SK;
      if (u < U_PP) { conv_unit(P.p_p, (u16*)(ws + W_PB), (size_t)u * 4096, nullptr); continue; }
      u -= U_PP;
      conv_unit(P.p_s, (u16*)(ws + W_PB) + (size_t)TP * 256, (size_t)u * 4096, nullptr);
    }
  }
  {
    float* wfl = (float*)smem;
    __syncthreads();
    for (int i = tid; i < 8192; i += 256) {
      int k = i >> 3, h = i & 7;
      wfl[h * 1024 + k] = P.g_mix[k] * P.w_in[(size_t)k * 5128 + 1536 + h];
    }
    __syncthreads();
    u16* XB = (u16*)(ws + W_XB);
    float* RS1 = (float*)(ws + W_RS1);
    for (int t = blockIdx.x * 4 + w; t < TT; t += gridDim.x * 4) {
      const float* xr = t < TP ? P.x_p + (size_t)t * 1024 : P.x_s + (size_t)(t - TP) * 1024;
      f32x4 v[4];
#pragma unroll
      for (int i = 0; i < 4; i++) v[i] = *(const f32x4*)(xr + i * 256 + lane * 4);
      float ss = 0.f;
#pragma unroll
      for (int i = 0; i < 4; i++) ss += v[i][0] * v[i][0] + v[i][1] * v[i][1] + v[i][2] * v[i][2] + v[i][3] * v[i][3];
      float dots[8];
#pragma unroll
      for (int h = 0; h < 8; h++) {
        float d = 0.f;
#pragma unroll
        for (int i = 0; i < 4; i++) {
          f32x4 wv = *(const f32x4*)(wfl + h * 1024 + i * 256 + lane * 4);
          d += v[i][0] * wv[0] + v[i][1] * wv[1] + v[i][2] * wv[2] + v[i][3] * wv[3];
        }
        dots[h] = d;
      }
      ss = wave_sum(ss);
#pragma unroll
      for (int h = 0; h < 8; h++) dots[h] = wave_sum(dots[h]);
      float rs = rsqrtf(ss * (1.f / 1024.f) + EPS);
#pragma unroll
      for (int i = 0; i < 4; i++)
        *(u32x2*)(XB + (size_t)t * 1024 + i * 256 + lane * 4) = (u32x2){pack2(v[i][0], v[i][1]), pack2(v[i][2], v[i][3])};
      if (lane == 0) RS1[t] = rs;
      float myd = dots[0];
#pragma unroll
      for (int h = 1; h < 8; h++) myd = (lane == h) ? dots[h] : myd;
      if (lane < 8) {
        float z = rs * myd + P.b_f[lane];
        float lf = fminf(z, 0.f) - log1pf(expf(-fabsf(z)));
        float* o = t < TP ? P.out + O_AF_P + (size_t)t * 8 : P.out + O_AF_S + (size_t)(t - TP) * 8;
        o[lane] = lf;
      }
    }
  }
}

DI void phase1_scans(const Params& P) {
  const int lane = threadIdx.x & 63;
  const int gw = blockIdx.x * 4 + (threadIdx.x >> 6), nw = gridDim.x * 4;
  float* CUMP = (float*)(P.ws + W_CUMP);
  float* CUMS = (float*)(P.ws + W_CUMS);
  for (int row = gw; row < 384; row += nw) {
    float carry = 0.f;
    if (row < 256) {
      int b = row >> 3, h = row & 7;
      const float* src = P.out + O_AF_P + (size_t)b * 2048 * 8 + h;
      for (int p0 = 0; p0 < 2048; p0 += 64) {
        float v = src[(size_t)(p0 + lane) * 8];
#pragma unroll
        for (int o = 1; o < 64; o <<= 1) { float n = __shfl_up(v, o); if (lane >= o) v += n; }
        v += carry;
        CUMP[(size_t)row * 2048 + p0 + lane] = v * LOG2E;
        carry = __shfl(v, 63);
      }
    } else {
      int rr = row - 256;
      int b = rr >> 3, h = rr & 7;
      const float* src = P.caf + (size_t)b * 4096 * 8 + h;
      for (int p0 = 0; p0 < 4096; p0 += 64) {
        float v = src[(size_t)(p0 + lane) * 8];
#pragma unroll
        for (int o = 1; o < 64; o <<= 1) { float n = __shfl_up(v, o); if (lane >= o) v += n; }
        v += carry;
        CUMS[(size_t)rr * 4112 + p0 + lane] = v * LOG2E;
        carry = __shfl(v, 63);
      }
      {
        float v = lane < 16 ? P.out[O_AF_S + (size_t)(b * 16 + lane) * 8 + h] : 0.f;
#pragma unroll
        for (int o = 1; o < 64; o <<= 1) { float n = __shfl_up(v, o); if (lane >= o) v += n; }
        v += carry;
        if (lane < 16) CUMS[(size_t)rr * 4112 + 4096 + lane] = v * LOG2E;
      }
    }
  }
}

DI void phase1_tile(const Params& P, int mt, int nt, char* smem) {
  const int tid = threadIdx.x, lane = tid & 63, w = tid >> 6, wm = w >> 1, wn = w & 1, r = lane & 15, quad = lane >> 4;
  const int m0 = mt * 128, n0 = nt * 128;
  char* ws = P.ws;
  f32x4 acc[4][4];
  zero_acc(acc);
  gemm_mainloop((const u16*)(ws + W_XB) + (size_t)m0 * 1024, 1024, (const u16*)(ws + W_WIN) + (size_t)n0 * 1024, 1024, 1024,
                (u16*)smem, acc);
  float* Cs = (float*)smem;
  stage_acc(acc, Cs);
  const bool sample = m0 >= TP;
  const int c4 = tid & 31, rsub = tid >> 5;
  const float* RS1 = (const float*)(ws + W_RS1) + m0;
  if (n0 < 3072) {
    const int seg = n0 >> 9, hc = n0 & 511;
    const bool normed = (seg != 2 && seg != 5);
    const float* gain = seg == 0 ? P.qn_a : seg == 1 ? P.kn_a : seg == 3 ? P.qn_b : P.kn_b;
    const float qs = (seg == 0 || seg == 3) ? 0.125f * LOG2E : 1.f;
    f32x4 gn = (f32x4){1.f, 1.f, 1.f, 1.f};
    if (normed) gn = *(const f32x4*)(gain + (c4 & 15) * 4) * qs;
    u16* dp = (u16*)(ws + W_QKV + (size_t)seg * SZ_HALF) + (size_t)m0 * 512 + hc + c4 * 4;
    float* op = nullptr;
    if (seg == 1 || seg == 2) {
      op = sample ? P.out + (seg == 1 ? O_AK_S : O_AV_S) + (size_t)(m0 - TP) * 512 : P.out + (seg == 1 ? O_AK_P : O_AV_P) + (size_t)m0 * 512;
    } else if (seg == 4 || seg == 5) {
      if (sample) op = P.out + (seg == 4 ? O_BK_S : O_BV_S) + (size_t)(m0 - TP) * 512;
      else if ((m0 & 2047) >= 1536) op = P.out + (seg == 4 ? O_BK_P : O_BV_P) + ((size_t)(m0 >> 11) * 512 + ((m0 & 2047) - 1536)) * 512;
    }
    if (op) op += hc + c4 * 4;
#pragma unroll 4
    for (int p = 0; p < 16; p++) {
      const int row = p * 8 + rsub;
      f32x4 v = *(const f32x4*)(Cs + row * CSTR + c4 * 4) * RS1[row];
      if (normed) {
        float ss = v.x * v.x + v.y * v.y + v.z * v.z + v.w * v.w;
        ss += __shfl_xor(ss, 1);
        ss += __shfl_xor(ss, 2);
        ss += __shfl_xor(ss, 4);
        ss += __shfl_xor(ss, 8);
        v = v * gn * rsqrtf(ss * (1.f / 64.f) + EPS);
      }
      *(u32x2*)(dp + (size_t)row * 512) = pack4(v);
      if (op) *(f32x4*)(op + (size_t)row * 512) = v;
    }
  } else {
    u16* dp = (n0 < 4096 ? (u16*)(ws + W_GA) + (n0 - 3072) : (u16*)(ws + W_GB) + (n0 - 4096)) + (size_t)m0 * 1024 + c4 * 4;
#pragma unroll 4
    for (int p = 0; p < 16; p++) {
      const int row = p * 8 + rsub;
      f32x4 v = *(const f32x4*)(Cs + row * CSTR + c4 * 4) * RS1[row];
      v = (f32x4){sigmoidf_(v.x), sigmoidf_(v.y), sigmoidf_(v.z), sigmoidf_(v.w)};
      *(u32x2*)(dp + (size_t)row * 1024) = pack4(v);
    }
  }
}

constexpr int ASTR = 72;
constexpr int TAB_OFF = 36864;
struct AttnState { f32x4 o[4]; float m, l; };

DI s16x4 tr_read(const u16* p) {
  return __builtin_amdgcn_ds_read_tr16_b64_v4i16((__attribute__((address_space(3))) s16x4*)(p));
}

template <int MODE>
DI void attn_step(const u16* Ks, const u16* Vs, const bf16x8 (&qf)[2], AttnState& st, int kpos0, int qpos, int qlim,
                  float cq, const float* cum, const float* tab, bool domask) {
  const int lane = threadIdx.x & 63, r = lane & 15, quad = lane >> 4;
  f32x4 s[2];
#pragma unroll
  for (int t = 0; t < 2; t++) {
    f32x4 a4 = (f32x4){0.f, 0.f, 0.f, 0.f};
#pragma unroll
    for (int ks = 0; ks < 2; ks++) {
      bf16x8 kf = *(const bf16x8*)(Ks + (t * 16 + r) * ASTR + ks * 32 + quad * 8);
      a4 = mfma16(kf, qf[ks], a4);
    }
    s[t] = a4;
  }
#pragma unroll
  for (int t = 0; t < 2; t++) {
    const int kb = kpos0 + t * 16 + quad * 4;
    if (MODE == 0) {
      f32x4 c4 = *(const f32x4*)(cum + kb);
#pragma unroll
      for (int j = 0; j < 4; j++) s[t][j] += cq - c4[j];
    } else {
#pragma unroll
      for (int j = 0; j < 4; j++) {
        int rel = kb + j - qpos;
        rel = min(max(rel, -128), 128) + 128;
        s[t][j] += tab[rel];
      }
    }
    if (domask) {
#pragma unroll
      for (int j = 0; j < 4; j++)
        if (kb + j > qlim) s[t][j] = -1e30f;
    }
  }
  float mx = fmaxf(fmaxf(fmaxf(s[0][0], s[0][1]), fmaxf(s[0][2], s[0][3])), fmaxf(fmaxf(s[1][0], s[1][1]), fmaxf(s[1][2], s[1][3])));
  mx = fmaxf(mx, __shfl_xor(mx, 16));
  mx = fmaxf(mx, __shfl_xor(mx, 32));
  const float mn = fmaxf(st.m, mx);
  const float alpha = __builtin_amdgcn_exp2f(st.m - mn);
  float p[8];
  float ls = 0.f;
#pragma unroll
  for (int t = 0; t < 2; t++)
#pragma unroll
    for (int j = 0; j < 4; j++) { p[t * 4 + j] = __builtin_amdgcn_exp2f(s[t][j] - mn); ls += p[t * 4 + j]; }
  st.l = st.l * alpha + ls;
  st.m = mn;
#pragma unroll
  for (int dt = 0; dt < 4; dt++) st.o[dt] = st.o[dt] * alpha;
  u32x4 pk = (u32x4){pack2(p[0], p[1]), pack2(p[2], p[3]), pack2(p[4], p[5]), pack2(p[6], p[7])};
  bf16x8 pf = __builtin_bit_cast(bf16x8, pk);
  const int qq = (lane & 15) >> 2, pp = lane & 3;
#pragma unroll
  for (int dt = 0; dt < 4; dt++) {
    s16x4 lo = tr_read(Vs + (quad * 4 + qq) * ASTR + dt * 16 + pp * 4);
    s16x4 hi = tr_read(Vs + (16 + quad * 4 + qq) * ASTR + dt * 16 + pp * 4);
    bf16x8 vf = __builtin_shufflevector(lo, hi, 0, 1, 2, 3, 4, 5, 6, 7);
    st.o[dt] = mfma16(vf, pf, st.o[dt]);
  }
}

template <int MODE>
DI void attn_prompt_item(const Params& P, char* smem, int b, int h, int qt) {
  const int tid = threadIdx.x, lane = tid & 63, w = tid >> 6, r = lane & 15, quad = lane >> 4;
  char* ws = P.ws;
  const u16* Q = (const u16*)(ws + W_QKV + (size_t)(MODE == 0 ? 0 : 3) * SZ_HALF);
  const u16* Kg = (const u16*)(ws + W_QKV + (size_t)(MODE == 0 ? 1 : 4) * SZ_HALF);
  const u16* Vg = (const u16*)(ws + W_QKV + (size_t)(MODE == 0 ? 2 : 5) * SZ_HALF);
  u16* Y = (u16*)(ws + W_XB + (size_t)(MODE == 0 ? 0 : 1) * SZ_HALF);
  u16* Ks = (u16*)smem;
  u16* Vs = Ks + 64 * ASTR;
  float* tab = (float*)(smem + TAB_OFF);
  __syncthreads();
  if (MODE == 1) {
    for (int i = tid; i < 257; i += 256) tab[i] = P.relb[h * 257 + i] * LOG2E;
  }
  const int q0 = qt * 64;
  const int qpos = q0 + w * 16 + r;
  const size_t tokq = (size_t)b * 2048 + qpos;
  bf16x8 qf[2];
#pragma unroll
  for (int ks = 0; ks < 2; ks++) qf[ks] = *(const bf16x8*)(Q + tokq * 512 + h * 64 + ks * 32 + quad * 8);
  const float* cum = (const float*)(ws + W_CUMP) + (size_t)(b * 8 + h) * 2048;
  const float cq = MODE == 0 ? cum[qpos] : 0.f;
  AttnState st;
#pragma unroll
  for (int dt = 0; dt < 4; dt++) st.o[dt] = (f32x4){0.f, 0.f, 0.f, 0.f};
  st.m = -1e30f;
  st.l = 0.f;
  const int kt_lo = MODE == 0 ? 0 : max(0, qt - 8), kt_hi = qt;
  u32x4 rk[2], rv[2];
  const int lkey = tid >> 3, lch = tid & 7;
  const u16* kp = Kg + ((size_t)b * 2048 + lkey) * 512 + h * 64 + lch * 8;
  const u16* vp = Vg + ((size_t)b * 2048 + lkey) * 512 + h * 64 + lch * 8;
#pragma unroll
  for (int i = 0; i < 2; i++) {
    rk[i] = *(const u32x4*)(kp + (size_t)(kt_lo * 64 + i * 32) * 512);
    rv[i] = *(const u32x4*)(vp + (size_t)(kt_lo * 64 + i * 32) * 512);
  }
  for (int kt = kt_lo; kt <= kt_hi; kt++) {
    __syncthreads();
#pragma unroll
    for (int i = 0; i < 2; i++) {
      *(u32x4*)(Ks + (lkey + i * 32) * ASTR + lch * 8) = rk[i];
      *(u32x4*)(Vs + (lkey + i * 32) * ASTR + lch * 8) = rv[i];
    }
    __syncthreads();
    if (kt < kt_hi) {
#pragma unroll
      for (int i = 0; i < 2; i++) {
        rk[i] = *(const u32x4*)(kp + (size_t)((kt + 1) * 64 + i * 32) * 512);
        rv[i] = *(const u32x4*)(vp + (size_t)((kt + 1) * 64 + i * 32) * 512);
      }
    }
    const bool diag = (MODE == 0) && (kt == qt);
#pragma unroll
    for (int half = 0; half < 2; half++) {
      const int kpos0 = kt * 64 + half * 32;
      if (diag && kpos0 > q0 + w * 16 + 15) continue;
      attn_step<MODE>(Ks + half * 32 * ASTR, Vs + half * 32 * ASTR, qf, st, kpos0, qpos, qpos, cq, cum, tab, diag);
    }
  }
  float lt = st.l;
  lt += __shfl_xor(lt, 16);
  lt += __shfl_xor(lt, 32);
  const float inv = 1.f / lt;
#pragma unroll
  for (int dt = 0; dt < 4; dt++) {
    u32x2 o2 = (u32x2){pack2(st.o[dt][0] * inv, st.o[dt][1] * inv), pack2(st.o[dt][2] * inv, st.o[dt][3] * inv)};
    *(u32x2*)(Y + tokq * 512 + h * 64 + dt * 16 + quad * 4) = o2;
  }
}

template <int MODE>
DI void attn_sample_item(const Params& P, char* smem, int b, int h) {
  const int tid = threadIdx.x, lane = tid & 63, w = tid >> 6, r = lane & 15, quad = lane >> 4;
  constexpr int L = MODE == 0 ? 4096 : 512;
  char* ws = P.ws;
  const u16* Q = (const u16*)(ws + W_QKV + (size_t)(MODE == 0 ? 0 : 3) * SZ_HALF);
  const u16* Kn = (const u16*)(ws + W_QKV + (size_t)(MODE == 0 ? 1 : 4) * SZ_HALF);
  const u16* Vn = (const u16*)(ws + W_QKV + (size_t)(MODE == 0 ? 2 : 5) * SZ_HALF);
  u16* Y = (u16*)(ws + W_XB + (size_t)(MODE == 0 ? 0 : 1) * SZ_HALF);
  u16* Kw = (u16*)smem + w * (2 * 32 * ASTR);
  u16* Vw = Kw + 32 * ASTR;
  float* tab = (float*)(smem + TAB_OFF);
  __syncthreads();
  if (MODE == 1) {
    for (int i = tid; i < 257; i += 256) tab[i] = P.relb[h * 257 + i] * LOG2E;
  }
  __syncthreads();
  const float* ck = (MODE == 0 ? P.cak : P.cbk) + ((size_t)b * L * 8 + h) * 64;
  const float* cv = (MODE == 0 ? P.cav : P.cbv) + ((size_t)b * L * 8 + h) * 64;
  const size_t tokbase = (size_t)TP + b * 16;
  bf16x8 qf[2];
#pragma unroll
  for (int ks = 0; ks < 2; ks++) qf[ks] = *(const bf16x8*)(Q + (tokbase + r) * 512 + h * 64 + ks * 32 + quad * 8);
  const int qpos = L + r;
  const float* cum = (const float*)(ws + W_CUMS) + (size_t)(b * 8 + h) * 4112;
  const float cq = MODE == 0 ? cum[qpos] : 0.f;
  AttnState st;
#pragma unroll
  for (int dt = 0; dt < 4; dt++) st.o[dt] = (f32x4){0.f, 0.f, 0.f, 0.f};
  st.m = -1e30f;
  st.l = 0.f;
  const int kbeg = w * (L / 4), kend = kbeg + L / 4;
  for (int k0 = kbeg; k0 < kend; k0 += 32) {
    {
      f32x4 kr[8];
#pragma unroll
      for (int i = 0; i < 8; i++) kr[i] = *(const f32x4*)(ck + (size_t)(k0 + i * 4 + quad) * 512 + r * 4);
#pragma unroll
      for (int i = 0; i < 8; i++)
        *(u32x2*)(Kw + (i * 4 + quad) * ASTR + r * 4) = (u32x2){pack2(kr[i][0], kr[i][1]), pack2(kr[i][2], kr[i][3])};
    }
    {
      f32x4 vr[8];
#pragma unroll
      for (int i = 0; i < 8; i++) vr[i] = *(const f32x4*)(cv + (size_t)(k0 + i * 4 + quad) * 512 + r * 4);
#pragma unroll
      for (int i = 0; i < 8; i++)
        *(u32x2*)(Vw + (i * 4 + quad) * ASTR + r * 4) = (u32x2){pack2(vr[i][0], vr[i][1]), pack2(vr[i][2], vr[i][3])};
    }
    asm volatile("s_waitcnt lgkmcnt(0)" ::: "memory");
    __builtin_amdgcn_wave_barrier();
    attn_step<MODE>(Kw, Vw, qf, st, k0, qpos, qpos, cq, cum, tab, false);
    __builtin_amdgcn_wave_barrier();
  }
  if (w == 0) {
#pragma unroll
    for (int i = 0; i < 2; i++) {
      int c = lane + i * 64;
      int key = c >> 3, ch = c & 7;
      u32x4 kk = *(const u32x4*)(Kn + (tokbase + key) * 512 + h * 64 + ch * 8);
      u32x4 vv = *(const u32x4*)(Vn + (tokbase + key) * 512 + h * 64 + ch * 8);
      *(u32x4*)(Kw + key * ASTR + ch * 8) = kk;
      *(u32x4*)(Vw + key * ASTR + ch * 8) = vv;
      *(u32x4*)(Kw + (16 + key) * ASTR + ch * 8) = (u32x4){0u, 0u, 0u, 0u};
      *(u32x4*)(Vw + (16 + key) * ASTR + ch * 8) = (u32x4){0u, 0u, 0u, 0u};
    }
    asm volatile("s_waitcnt lgkmcnt(0)" ::: "memory");
    __builtin_amdgcn_wave_barrier();
    attn_step<MODE>(Kw, Vw, qf, st, L, qpos, MODE == 0 ? qpos : L + 15, cq, cum, tab, true);
  }
  __syncthreads();
  float* comb = (float*)smem;
  float lt = st.l;
  lt += __shfl_xor(lt, 16);
  lt += __shfl_xor(lt, 32);
#pragma unroll
  for (int dt = 0; dt < 4; dt++)
#pragma unroll
    for (int j = 0; j < 4; j++) comb[(w * 16 + r) * 68 + dt * 16 + quad * 4 + j] = st.o[dt][j];
  if (quad == 0) {
    comb[(w * 16 + r) * 68 + 64] = st.m;
    comb[(w * 16 + r) * 68 + 65] = lt;
  }
  __syncthreads();
  if (w == 0) {
    float mw[4], M = -1e30f;
#pragma unroll
    for (int i = 0; i < 4; i++) { mw[i] = comb[(i * 16 + r) * 68 + 64]; M = fmaxf(M, mw[i]); }
    float Ls = 0.f, scl[4];
#pragma unroll
    for (int i = 0; i < 4; i++) { scl[i] = __builtin_amdgcn_exp2f(mw[i] - M); Ls += scl[i] * comb[(i * 16 + r) * 68 + 65]; }
    const float inv = 1.f / Ls;
#pragma unroll
    for (int dt = 0; dt < 4; dt++) {
      float ov[4];
#pragma unroll
      for (int j = 0; j < 4; j++) {
        float a = 0.f;
#pragma unroll
        for (int i = 0; i < 4; i++) a += scl[i] * comb[(i * 16 + r) * 68 + dt * 16 + quad * 4 + j];
        ov[j] = a * inv;
      }
      *(u32x2*)(Y + (tokbase + r) * 512 + h * 64 + dt * 16 + quad * 4) = (u32x2){pack2(ov[0], ov[1]), pack2(ov[2], ov[3])};
    }
  }
}

DI void phase2(const Params& P, char* smem) {
  constexpr int N_SA = 128, N_PA = 8192, N_PB = 8192, N_SB = 128;
  for (int it = blockIdx.x; it < N_SA + N_PA + N_PB + N_SB; it += gridDim.x) {
    int u = it;
    if (u < N_SA) { attn_sample_item<0>(P, smem, u >> 3, u & 7); continue; }
    u -= N_SA;
    if (u < N_PA) { int qt = 31 - (u >> 8), bh = u & 255; attn_prompt_item<0>(P, smem, bh >> 3, bh & 7, qt); continue; }
    u -= N_PA;
    if (u < N_PB) { int qt = 31 - (u >> 8), bh = u & 255; attn_prompt_item<1>(P, smem, bh >> 3, bh & 7, qt); continue; }
    u -= N_PB;
    attn_sample_item<1>(P, smem, u >> 3, u & 7);
  }
}

DI void phase3_tile(const Params& P, int mt, int nt, char* smem) {
  const int tid = threadIdx.x, lane = tid & 63, w = tid >> 6, wm = w >> 1, wn = w & 1, r = lane & 15, quad = lane >> 4;
  const int m0 = mt * 128, n0 = nt * 128;
  char* ws = P.ws;
  const u16* YA = (const u16*)(ws + W_XB);
  const u16* YB = YA + (size_t)TT * 512;
  const u16* GA = (const u16*)(ws + W_GA);
  const u16* GB = (const u16*)(ws + W_GB);
  u16* MRG = (u16*)(ws + W_QKV);
  f32x4 acc[4][4];
  zero_acc(acc);
  gemm_mainloop(YA + (size_t)m0 * 512, 512, (const u16*)(ws + W_WUPA) + (size_t)n0 * 512, 512, 512, (u16*)smem, acc);
  float* Cs = (float*)smem;
  const int c4 = tid & 31, rsub = tid >> 5;
  const size_t tofs = (size_t)m0 * 1024 + n0 + c4 * 4;
  stage_acc(acc, Cs);
#pragma unroll 4
  for (int p = 0; p < 16; p++) {
    const int row = p * 8 + rsub;
    const f32x4 v = *(const f32x4*)(Cs + row * CSTR + c4 * 4);
    const f32x4 gv = unpack4(*(const u32x2*)(GA + tofs + (size_t)row * 1024));
    *(u32x2*)(MRG + tofs + (size_t)row * 1024) = pack4(v * gv);
  }
  zero_acc(acc);
  gemm_mainloop(YB + (size_t)m0 * 512, 512, (const u16*)(ws + W_WUPB) + (size_t)n0 * 512, 512, 512, (u16*)smem, acc);
  stage_acc(acc, Cs);
#pragma unroll 4
  for (int p = 0; p < 16; p++) {
    const int row = p * 8 + rsub;
    const f32x4 v = *(const f32x4*)(Cs + row * CSTR + c4 * 4);
    const f32x4 gv = unpack4(*(const u32x2*)(GB + tofs + (size_t)row * 1024));
    const f32x4 m1 = unpack4(*(const u32x2*)(MRG + tofs + (size_t)row * 1024));
    *(u32x2*)(MRG + tofs + (size_t)row * 1024) = pack4(m1 + v * gv);
  }
}

DI void phase4_tile(const Params& P, int mt, int nt, char* smem) {
  const int tid = threadIdx.x, lane = tid & 63, w = tid >> 6, wm = w >> 1, wn = w & 1, r = lane & 15, quad = lane >> 4;
  const int m0 = mt * 128, n0 = nt * 128;
  char* ws = P.ws;
  const u16* MRG = (const u16*)(ws + W_QKV);
  u16* H1B = (u16*)(ws + W_QKV + SZ_ACT);
  float* SSQ2 = (float*)(ws + W_SSQ2);
  f32x4 acc[4][4];
  zero_acc(acc);
  gemm_mainloop(MRG + (size_t)m0 * 1024, 1024, (const u16*)(ws + W_WOUT) + (size_t)n0 * 1024, 1024, 1024, (u16*)smem, acc);
  const float* xb = m0 < TP ? P.x_p : P.x_s - (size_t)TP * 1024;
  float* Cs = (float*)smem;
  const int c4 = tid & 31, rsub = tid >> 5;
  const size_t tofs = (size_t)m0 * 1024 + n0 + c4 * 4;
  stage_acc(acc, Cs);
#pragma unroll 4
  for (int p = 0; p < 16; p++) {
    const int row = p * 8 + rsub;
    const f32x4 v = *(const f32x4*)(Cs + row * CSTR + c4 * 4);
    const f32x4 h1 = *(const f32x4*)(xb + tofs + (size_t)row * 1024) + v;
    *(f32x4*)(P.out + tofs + (size_t)row * 1024) = h1;
    *(u32x2*)(H1B + tofs + (size_t)row * 1024) = pack4(h1);
    float ss = h1.x * h1.x + h1.y * h1.y + h1.z * h1.z + h1.w * h1.w;
    ss += __shfl_xor(ss, 1);
    ss += __shfl_xor(ss, 2);
    ss += __shfl_xor(ss, 4);
    ss += __shfl_xor(ss, 8);
    ss += __shfl_xor(ss, 16);
    if (c4 == 0) SSQ2[(size_t)(m0 + row) * 16 + nt] = ss;
  }
}

DI void phase5_tile(const Params& P, int mt, int nt, char* smem) {
  const int tid = threadIdx.x, lane = tid & 63, w = tid >> 6, wm = w >> 1, wn = w & 1, r = lane & 15, quad = lane >> 4;
  const int m0 = mt * 128, n0 = nt * 128;
  char* ws = P.ws;
  const u16* H1B = (const u16*)(ws + W_QKV + SZ_ACT);
  u16* QP = (u16*)(ws + W_QKV + 2 * SZ_ACT);
  const float* SSQ2 = (const float*)(ws + W_SSQ2);
  float* rs_s = (float*)(smem + RS_OFF);
  __syncthreads();
  if (tid < 128) {
    float s = 0.f;
#pragma unroll
    for (int i = 0; i < 8; i++) s += SSQ2[(size_t)(m0 + tid) * 16 + i];
    rs_s[tid] = rsqrtf(s * (1.f / 1024.f) + EPS);
  }
  f32x4 acc[4][4];
  zero_acc(acc);
  gemm_mainloop(H1B + (size_t)m0 * 1024, 1024, (const u16*)(ws + W_WQ) + (size_t)n0 * 1024, 1024, 1024, (u16*)smem, acc);
  float* Cs = (float*)smem;
  const int c4 = tid & 31, rsub = tid >> 5;
  const size_t tofs = (size_t)m0 * 1024 + n0 + c4 * 4;
  stage_acc(acc, Cs);
#pragma unroll 4
  for (int p = 0; p < 16; p++) {
    const int row = p * 8 + rsub;
    const f32x4 v = *(const f32x4*)(Cs + row * CSTR + c4 * 4) * rs_s[row];
    *(u32x2*)(QP + tofs + (size_t)row * 1024) = pack4(v);
  }
}

DI void bitonic_merge16(u32 (&L)[16]) {
#pragma unroll
  for (int st = 8; st >= 1; st >>= 1)
#pragma unroll
    for (int i = 0; i < 16; i++)
      if ((i & st) == 0) { u32 hi = max(L[i], L[i + st]); u32 lo = min(L[i], L[i + st]); L[i] = hi; L[i + st] = lo; }
}
DI void bitonic_sort16(u32 (&L)[16]) {
#pragma unroll
  for (int k = 2; k <= 16; k <<= 1)
#pragma unroll
    for (int j = k >> 1; j > 0; j >>= 1)
#pragma unroll
      for (int i = 0; i < 16; i++) {
        const int l = i ^ j;
        if (l > i) {
          const u32 hi = max(L[i], L[l]), lo = min(L[i], L[l]);
          if ((i & k) == 0) { L[i] = hi; L[l] = lo; } else { L[i] = lo; L[l] = hi; }
        }
      }
}
DI void phase6a_unit(const Params& P, int unit, char* smem) {
  const int tid = threadIdx.x, lane = tid & 63, w = tid >> 6, r = lane & 15, quad = lane >> 4;
  char* ws = P.ws;
  const u16* QP = (const u16*)(ws + W_QKV + 2 * SZ_ACT);
  const u16* SK = (const u16*)(ws + W_SK);
  u16* IDXo = (u16*)(ws + W_IDX);
  float* Go = (float*)(ws + W_G);
  float* sc = (float*)smem;
  u32* hl = (u32*)smem;
  u32* xl = (u32*)smem + 256 * 17;
  u32* lists = (u32*)(smem + 128 * 129 * 4);
  unsigned char* tabi = (unsigned char*)(smem + 128 * 129 * 4 + 128 * 17 * 4);
  unsigned char* tabj = tabi + 64;
  const int tok0 = unit * 64;
  __syncthreads();
  if (tid == 0) {
    int c = 0;
    for (int i = 0; i < 16; i++)
      for (int j = i + 1; j < 16; j++)
        if ((i + 1) * (j + 1) <= 16) { tabi[c] = (unsigned char)i; tabj[c] = (unsigned char)j; tabi[32 + c] = (unsigned char)j; tabj[32 + c] = (unsigned char)i; c++; }
    tabi[23] = 0; tabj[23] = 0; tabi[24] = 1; tabj[24] = 1;
    tabi[55] = 2; tabj[55] = 2; tabi[56] = 3; tabj[56] = 3;
  }
  for (int h = 0; h < 8; h++) {
#pragma unroll
    for (int p = 0; p < 2; p++) {
      const int hp = h * 2 + p;
      bf16x8 qf[2];
#pragma unroll
      for (int ks = 0; ks < 2; ks++)
        qf[ks] = *(const bf16x8*)(QP + (size_t)(tok0 + w * 16 + r) * 1024 + hp * 64 + ks * 32 + quad * 8);
#pragma unroll
      for (int nt = 0; nt < 8; nt++) {
        f32x4 a4 = (f32x4){0.f, 0.f, 0.f, 0.f};
#pragma unroll
        for (int ks = 0; ks < 2; ks++) {
          bf16x8 kf = *(const bf16x8*)(SK + (size_t)(hp * 128 + nt * 16 + r) * 64 + ks * 32 + quad * 8);
          a4 = mfma16(kf, qf[ks], a4);
        }
        float* d = sc + (p * 64 + w * 16 + r) * 129 + nt * 16 + quad * 4;
        d[0] = a4[0]; d[1] = a4[1]; d[2] = a4[2]; d[3] = a4[3];
      }
    }
    __syncthreads();
    u32 L[16];
    {
      const int inst = tid & 127, half = tid >> 7;
      const float* row = sc + inst * 129 + half * 64;
#pragma unroll
      for (int i = 0; i < 16; i++) L[i] = (mono(row[i]) & ~127u) | (u32)(half * 64 + i);
      bitonic_sort16(L);
#pragma unroll 1
      for (int c = 1; c < 4; c++) {
        u32 N[16];
#pragma unroll
        for (int i = 0; i < 16; i++) N[i] = (mono(row[c * 16 + i]) & ~127u) | (u32)(half * 64 + c * 16 + i);
        bitonic_sort16(N);
#pragma unroll
        for (int i = 0; i < 16; i++) L[i] = max(L[i], N[15 - i]);
        bitonic_merge16(L);
      }
    }
    __syncthreads();
#pragma unroll
    for (int s = 0; s < 16; s++) hl[tid * 17 + s] = L[s];
    __syncthreads();
    if (tid < 128) {
      u32 M[16];
#pragma unroll
      for (int s = 0; s < 16; s++) M[s] = max(L[s], hl[(tid + 128) * 17 + 15 - s]);
      bitonic_merge16(M);
#pragma unroll
      for (int s = 0; s < 16; s++) lists[tid * 17 + s] = M[s];
    }
    __syncthreads();
    if (tid < 128) {
      const int tok = tid & 63;
      const bool part = tid >= 64;
      float fa[16], fb[16];
#pragma unroll
      for (int s = 0; s < 16; s++) {
        const float va = unmono(lists[tok * 17 + s] & ~127u);
        const float vb = unmono(lists[(64 + tok) * 17 + s] & ~127u);
        fa[s] = part ? vb : va;
        fb[s] = part ? va : vb;
      }
      u32 L2[16];
#pragma unroll
      for (int s = 0; s < 16; s++) L2[s] = 0u;
      const u32 cbase = part ? 32u : 0u;
      {
        int c = 0;
#pragma unroll
        for (int i = 0; i < 16; i++)
#pragma unroll
          for (int j = i + 1; j < 16; j++)
            if ((i + 1) * (j + 1) <= 16) {
              insert16(L2, (mono(fa[i] + fb[j]) & ~63u) | (cbase + (u32)c));
              c++;
            }
      }
      insert16(L2, (mono(part ? fa[2] + fb[2] : fa[0] + fb[0]) & ~63u) | (cbase + 23u));
      insert16(L2, (mono(part ? fa[3] + fb[3] : fa[1] + fb[1]) & ~63u) | (cbase + 24u));
#pragma unroll
      for (int s = 0; s < 16; s++) xl[tid * 17 + s] = L2[s];
    }
    __syncthreads();
    if (tid < 64) {
      float val[16];
      u32 idx[16];
      float mx = -1e30f;
#pragma unroll
      for (int s = 0; s < 16; s++) {
        const u32 m = max(xl[tid * 17 + s], xl[(tid + 64) * 17 + 15 - s]);
        const u32 sl = m & 63u;
        const int i = tabi[sl], j = tabj[sl];
        const u32 au = lists[tid * 17 + i], bu = lists[(64 + tid) * 17 + j];
        val[s] = unmono(au & ~127u) + unmono(bu & ~127u);
        idx[s] = (au & 127u) * 128u + (bu & 127u);
        mx = fmaxf(mx, val[s]);
      }
      float sum = 0.f;
#pragma unroll
      for (int s = 0; s < 16; s++) { val[s] = __expf(val[s] - mx); sum += val[s]; }
      const float inv = 1.f / sum;
      const size_t so = ((size_t)(tok0 + tid) * 8 + h) * 16;
      {
        u32* ib = (u32*)(IDXo + (size_t)(tok0 + tid) * 128 + h * 2);
#pragma unroll
        for (int gg = 0; gg < 8; gg++) ib[gg * 8] = idx[gg] | (idx[gg + 8] << 16);
      }
#pragma unroll
      for (int s = 0; s < 4; s++)
        *(f32x4*)(Go + so + s * 4) = (f32x4){val[s * 4] * inv, val[s * 4 + 1] * inv, val[s * 4 + 2] * inv, val[s * 4 + 3] * inv};
    }
    __syncthreads();
  }
}

typedef float f32x2 __attribute__((ext_vector_type(2)));
DI float dot4_fp8(u32 w, float x0, float x1, float x2, float x3, float acc) {
  f32x2 lo = __builtin_amdgcn_cvt_pk_f32_fp8((int)w, false);
  f32x2 hi = __builtin_amdgcn_cvt_pk_f32_fp8((int)w, true);
  acc = fmaf(lo[0], x0, acc);
  acc = fmaf(lo[1], x1, acc);
  acc = fmaf(hi[0], x2, acc);
  acc = fmaf(hi[1], x3, acc);
  return acc;
}
DI void axpy4_fp8(u32 w, float wgt, float& o0, float& o1, float& o2, float& o3) {
  f32x2 lo = __builtin_amdgcn_cvt_pk_f32_fp8((int)w, false);
  f32x2 hi = __builtin_amdgcn_cvt_pk_f32_fp8((int)w, true);
  o0 = fmaf(wgt, lo[0], o0);
  o1 = fmaf(wgt, lo[1], o1);
  o2 = fmaf(wgt, hi[0], o2);
  o3 = fmaf(wgt, hi[1], o3);
}

struct RowSet { u32x4 r[16]; };
DI void gather_rows(RowSet& R, const unsigned char* base, u32 lofs, u32x4 ea, u32x4 eb) {
  const u32 ev[8] = {ea.x, ea.y, ea.z, ea.w, eb.x, eb.y, eb.z, eb.w};
#pragma unroll
  for (int i = 0; i < 8; i++) {
    R.r[2 * i] = *(const u32x4*)(base + (((ev[i] & 0xffffu) << 7) + lofs));
    R.r[2 * i + 1] = *(const u32x4*)(base + (((ev[i] >> 16) << 7) + lofs));
  }
}
DI void b1_compute(const RowSet& R, u32x4 xa, u32x4 xb, float* pr, int c, bool valid) {
  float xf[16];
  xf[0] = __uint_as_float(xa.x << 16); xf[1] = __uint_as_float(xa.x & 0xffff0000u);
  xf[2] = __uint_as_float(xa.y << 16); xf[3] = __uint_as_float(xa.y & 0xffff0000u);
  xf[4] = __uint_as_float(xa.z << 16); xf[5] = __uint_as_float(xa.z & 0xffff0000u);
  xf[6] = __uint_as_float(xa.w << 16); xf[7] = __uint_as_float(xa.w & 0xffff0000u);
  xf[8] = __uint_as_float(xb.x << 16); xf[9] = __uint_as_float(xb.x & 0xffff0000u);
  xf[10] = __uint_as_float(xb.y << 16); xf[11] = __uint_as_float(xb.y & 0xffff0000u);
  xf[12] = __uint_as_float(xb.z << 16); xf[13] = __uint_as_float(xb.z & 0xffff0000u);
  xf[14] = __uint_as_float(xb.w << 16); xf[15] = __uint_as_float(xb.w & 0xffff0000u);
  float p[16];
#pragma unroll
  for (int i = 0; i < 16; i++) {
    float a = dot4_fp8(R.r[i].x, xf[0], xf[1], xf[2], xf[3], 0.f);
    a = dot4_fp8(R.r[i].y, xf[4], xf[5], xf[6], xf[7], a);
    a = dot4_fp8(R.r[i].z, xf[8], xf[9], xf[10], xf[11], a);
    a = dot4_fp8(R.r[i].w, xf[12], xf[13], xf[14], xf[15], a);
    p[i] = a;
  }
#pragma unroll
  for (int i = 0; i < 8; i++) { float keep = (c & 4) ? p[i + 8] : p[i]; float send = (c & 4) ? p[i] : p[i + 8]; p[i] = keep + __shfl_xor(send, 4); }
#pragma unroll
  for (int i = 0; i < 4; i++) { float keep = (c & 2) ? p[i + 4] : p[i]; float send = (c & 2) ? p[i] : p[i + 4]; p[i] = keep + __shfl_xor(send, 2); }
#pragma unroll
  for (int i = 0; i < 2; i++) { float keep = (c & 1) ? p[i + 2] : p[i]; float send = (c & 1) ? p[i] : p[i + 2]; p[i] = keep + __shfl_xor(send, 1); }
  const int it0 = 2 * (c & 1) + 4 * ((c >> 1) & 1) + 8 * ((c >> 2) & 1);
  if (valid) {
    pr[it0 * 8] = p[0];
    pr[(it0 + 1) * 8] = p[1];
  }
}
DI void phase6b1(const Params& P) {
  const int lane = threadIdx.x & 63, g = lane >> 3, c = lane & 7;
  const int x = blockIdx.x & 7;
  const int wg = (blockIdx.x >> 3) * 4 + (threadIdx.x >> 6), nwg = (gridDim.x >> 3) * 4;
  char* ws = P.ws;
  const u16* H1B = (const u16*)(ws + W_QKV + SZ_ACT) + x * 128 + c * 16;
  const unsigned char* U8 = (const unsigned char*)(ws + W_UB) + ((size_t)x << 21);
  const u32 lofs = c * 16;
  const u16* IDX = (const u16*)(ws + W_IDX) + g * 16;
  float* PH = ph_slice(ws, x) + g;
  const int n = (TT - wg + nwg - 1) / nwg;
#define TOK(i) min(wg + (i) * nwg, TT - 1)
  int t0 = TOK(0), t1 = TOK(1);
  u32x4 eA0 = *(const u32x4*)(IDX + (size_t)t0 * 128), eA1 = *(const u32x4*)(IDX + (size_t)t0 * 128 + 8);
  u32x4 eB0 = *(const u32x4*)(IDX + (size_t)t1 * 128), eB1 = *(const u32x4*)(IDX + (size_t)t1 * 128 + 8);
  RowSet RA, RB;
  gather_rows(RA, U8, lofs, eA0, eA1);
  u32x4 xA0 = *(const u32x4*)(H1B + (size_t)t0 * 1024), xA1 = *(const u32x4*)(H1B + (size_t)t0 * 1024 + 8);
#pragma unroll 1
  for (int i = 0; i < n; i += 2) {
    gather_rows(RB, U8, lofs, eB0, eB1);
    const u32x4 xB0 = *(const u32x4*)(H1B + (size_t)t1 * 1024), xB1 = *(const u32x4*)(H1B + (size_t)t1 * 1024 + 8);
    const int t2 = TOK(i + 2);
    eA0 = *(const u32x4*)(IDX + (size_t)t2 * 128);
    eA1 = *(const u32x4*)(IDX + (size_t)t2 * 128 + 8);
    b1_compute(RA, xA0, xA1, PH + (size_t)t0 * 128, c, true);
    gather_rows(RA, U8, lofs, eA0, eA1);
    xA0 = *(const u32x4*)(H1B + (size_t)t2 * 1024);
    xA1 = *(const u32x4*)(H1B + (size_t)t2 * 1024 + 8);
    const int t3 = TOK(i + 3);
    eB0 = *(const u32x4*)(IDX + (size_t)t3 * 128);
    eB1 = *(const u32x4*)(IDX + (size_t)t3 * 128 + 8);
    b1_compute(RB, xB0, xB1, PH + (size_t)t1 * 128, c, i + 1 < n);
    t0 = t2;
    t1 = t3;
  }
}

DI void phase6w(const Params& P) {
  const int lane = threadIdx.x & 63;
  const int gw = blockIdx.x * 4 + (threadIdx.x >> 6), nw = gridDim.x * 4;
  char* ws = P.ws;
  float* G = (float*)(ws + W_G);
  const float* SSQ2 = (const float*)(ws + W_SSQ2);
  for (int t = gw; t < TT; t += nw) {
    float ssq = lane < 8 ? SSQ2[(size_t)t * 16 + lane] : 0.f;
    float h0 = 0.f, h1v = 0.f;
    {
      const float* ph = (const float*)(ws + W_XB) + (size_t)t * 128 + lane;
#pragma unroll
      for (int xs = 0; xs < 4; xs++) { h0 += ph[(size_t)xs * (SZ_PH / 4)]; h1v += ph[(size_t)xs * (SZ_PH / 4) + 64]; }
      ph = (const float*)(ws + W_GB) + (size_t)t * 128 + lane;
#pragma unroll
      for (int xs = 0; xs < 4; xs++) { h0 += ph[(size_t)xs * (SZ_PH / 4)]; h1v += ph[(size_t)xs * (SZ_PH / 4) + 64]; }
    }
    const float g0 = G[(size_t)t * 128 + lane];
    const float g1 = G[(size_t)t * 128 + 64 + lane];
    const float rs2 = rsqrtf(wave_sum(ssq) * (1.f / 1024.f) + EPS);
    const float w0 = g0 * gelu_tanh(rs2 * (1.f / U_SCALE) * h0) * (1.f / V_SCALE);
    const float w1 = g1 * gelu_tanh(rs2 * (1.f / U_SCALE) * h1v) * (1.f / V_SCALE);
    u16* wrow = (u16*)(G + (size_t)t * 128);
    wrow[(lane & 7) * 16 + (lane >> 3)] = f2bf(w0);
    wrow[(lane & 7) * 16 + 8 + (lane >> 3)] = f2bf(w1);
  }
}

DI void b2_compute(const RowSet& R, u32x4 w0, u32x4 w1, float* hp, u16* hb, float* sq, int g, int lane, bool valid) {
  const f32x2 hv = *(const f32x2*)hp;
  const u32 wv[8] = {w0.x, w0.y, w0.z, w0.w, w1.x, w1.y, w1.z, w1.w};
  float o[16];
#pragma unroll
  for (int i = 0; i < 16; i++) o[i] = 0.f;
#pragma unroll
  for (int i = 0; i < 16; i++) {
    u32 r0 = R.r[i].x, r1 = R.r[i].y, r2 = R.r[i].z, r3 = R.r[i].w;
    asm volatile("" : "+v"(r0), "+v"(r1), "+v"(r2), "+v"(r3) : "v"(o[0]), "v"(o[15]));
    const float wgt = (i & 1) ? __uint_as_float(wv[i >> 1] & 0xffff0000u) : __uint_as_float(wv[i >> 1] << 16);
    axpy4_fp8(r0, wgt, o[0], o[1], o[2], o[3]);
    axpy4_fp8(r1, wgt, o[4], o[5], o[6], o[7]);
    axpy4_fp8(r2, wgt, o[8], o[9], o[10], o[11]);
    axpy4_fp8(r3, wgt, o[12], o[13], o[14], o[15]);
  }
#pragma unroll
  for (int i = 0; i < 8; i++) { float keep = (g & 4) ? o[i + 8] : o[i]; float send = (g & 4) ? o[i] : o[i + 8]; o[i] = keep + __shfl_xor(send, 32); }
#pragma unroll
  for (int i = 0; i < 4; i++) { float keep = (g & 2) ? o[i + 4] : o[i]; float send = (g & 2) ? o[i] : o[i + 4]; o[i] = keep + __shfl_xor(send, 16); }
#pragma unroll
  for (int i = 0; i < 2; i++) { float keep = (g & 1) ? o[i + 2] : o[i]; float send = (g & 1) ? o[i] : o[i + 2]; o[i] = keep + __shfl_xor(send, 8); }
  const float a0 = hv.x + o[0], a1 = hv.y + o[1];
  const float ss = wave_sum(a0 * a0 + a1 * a1);
  if (valid) {
    *(f32x2*)hp = (f32x2){a0, a1};
    *(u32*)hb = pack2(a0, a1);
    if (lane == 0) *sq = ss;
  }
}
DI void phase6b2(const Params& P) {
  const int lane = threadIdx.x & 63, g = lane >> 3, c = lane & 7, w = threadIdx.x >> 6;
  const int x = blockIdx.x & 7;
  const int wg = (blockIdx.x >> 3) * 4 + w, nwg = (gridDim.x >> 3) * 4;
  char* ws = P.ws;
  const int col = x * 128 + c * 16 + 2 * (g & 1) + 4 * ((g >> 1) & 1) + 8 * ((g >> 2) & 1);
  u16* H1B = (u16*)(ws + W_QKV + SZ_ACT) + col;
  float* OUT = P.out + col;
  const unsigned char* V8 = (const unsigned char*)(ws + W_VB) + ((size_t)x << 21);
  const u32 lofs = c * 16;
  const u16* IDX = (const u16*)(ws + W_IDX) + g * 16;
  const u16* WG = (const u16*)(ws + W_G) + g * 16;
  float* SSQ3 = (float*)(ws + W_SSQ3) + x;
  const int n = (TT - wg + nwg - 1) / nwg;
  int t0 = TOK(0), t1 = TOK(1);
  u32x4 eA0 = *(const u32x4*)(IDX + (size_t)t0 * 128), eA1 = *(const u32x4*)(IDX + (size_t)t0 * 128 + 8);
  u32x4 eB0 = *(const u32x4*)(IDX + (size_t)t1 * 128), eB1 = *(const u32x4*)(IDX + (size_t)t1 * 128 + 8);
  RowSet RA, RB;
  gather_rows(RA, V8, lofs, eA0, eA1);
  u32x4 wA0 = *(const u32x4*)(WG + (size_t)t0 * 256), wA1 = *(const u32x4*)(WG + (size_t)t0 * 256 + 8);
#pragma unroll 1
  for (int i = 0; i < n; i += 2) {
    gather_rows(RB, V8, lofs, eB0, eB1);
    const u32x4 wB0 = *(const u32x4*)(WG + (size_t)t1 * 256), wB1 = *(const u32x4*)(WG + (size_t)t1 * 256 + 8);
    const int t2 = TOK(i + 2);
    eA0 = *(const u32x4*)(IDX + (size_t)t2 * 128);
    eA1 = *(const u32x4*)(IDX + (size_t)t2 * 128 + 8);
    b2_compute(RA, wA0, wA1, OUT + (size_t)t0 * 1024, H1B + (size_t)t0 * 1024, SSQ3 + (size_t)t0 * 8, g, lane, true);
    gather_rows(RA, V8, lofs, eA0, eA1);
    wA0 = *(const u32x4*)(WG + (size_t)t2 * 256);
    wA1 = *(const u32x4*)(WG + (size_t)t2 * 256 + 8);
    const int t3 = TOK(i + 3);
    eB0 = *(const u32x4*)(IDX + (size_t)t3 * 128);
    eB1 = *(const u32x4*)(IDX + (size_t)t3 * 128 + 8);
    b2_compute(RB, wB0, wB1, OUT + (size_t)t1 * 1024, H1B + (size_t)t1 * 1024, SSQ3 + (size_t)t1 * 8, g, lane, i + 1 < n);
    t0 = t2;
    t1 = t3;
  }
#undef TOK
}

DI void phase7_tile(const Params& P, int mt, int nt, char* smem) {
  const int tid = threadIdx.x, lane = tid & 63, w = tid >> 6, wm = w >> 1, wn = w & 1, r = lane & 15, quad = lane >> 4;
  const int m0 = mt * 128, n0 = nt * 128;
  char* ws = P.ws;
  const u16* H2B = (const u16*)(ws + W_QKV + SZ_ACT);
  const u16* PB = (const u16*)(ws + W_PB);
  const float* SSQ3 = (const float*)(ws + W_SSQ3);
  float* rs_s = (float*)(smem + RS_OFF);
  __syncthreads();
  if (tid < 128) {
    float q = 0.f;
#pragma unroll
    for (int i = 0; i < 8; i++) q += SSQ3[(size_t)(m0 + tid) * 8 + i];
    rs_s[tid] = rsqrtf(q * (1.f / 1024.f) + EPS);
  }
  u16* PJ = (u16*)(ws + W_QKV);
  f32x4 acc[4][4];
  zero_acc(acc);
  gemm_mainloop(PB + (size_t)m0 * 256, 256, (const u16*)(ws + W_WPP) + (size_t)n0 * 256, 256, 256, (u16*)smem, acc);
  float* Cs = (float*)smem;
  const int c4 = tid & 31, rsub = tid >> 5;
  const size_t tofs = (size_t)m0 * 1024 + n0 + c4 * 4;
  stage_acc(acc, Cs);
#pragma unroll 4
  for (int p = 0; p < 16; p++) {
    const int row = p * 8 + rsub;
    *(u32x2*)(PJ + tofs + (size_t)row * 1024) = pack4(*(const f32x4*)(Cs + row * CSTR + c4 * 4));
  }
  zero_acc(acc);
  gemm_mainloop(H2B + (size_t)m0 * 1024, 1024, (const u16*)(ws + W_WG) + (size_t)n0 * 1024, 1024, 1024, (u16*)smem, acc);
  stage_acc(acc, Cs);
#pragma unroll 4
  for (int p = 0; p < 16; p++) {
    const int row = p * 8 + rsub;
    const f32x4 v = *(const f32x4*)(Cs + row * CSTR + c4 * 4) * rs_s[row];
    const f32x4 pj = unpack4(*(const u32x2*)(PJ + tofs + (size_t)row * 1024));
    const f32x4 h2 = *(const f32x4*)(P.out + tofs + (size_t)row * 1024);
    const f32x4 gate = (f32x4){sigmoidf_(v.x), sigmoidf_(v.y), sigmoidf_(v.z), sigmoidf_(v.w)};
    *(f32x4*)(P.out + tofs + (size_t)row * 1024) = h2 + gate * pj;
  }
}

#define GEMM_TILES(NT, FN)                                                              \
  {                                                                                     \
    for (int t = blockIdx.x; t < 2 * (NT); t += gridDim.x) FN(P, 512 + t / (NT), t % (NT), smem); \
    const int x_ = blockIdx.x & 7, bpx_ = gridDim.x >> 3;                               \
    constexpr int NG_ = (NT) / 8;                                                       \
    for (int s_ = blockIdx.x >> 3; s_ < 64 * 8 * NG_; s_ += bpx_) {                     \
      const int R_ = s_ >> 6, q_ = s_ & 63;                                             \
      const int mg_ = R_ / NG_, ng_ = R_ % NG_;                                         \
      FN(P, ((mg_ * 8 + (q_ >> 3)) << 3) + x_, ng_ * 8 + (q_ & 7), smem);               \
    }                                                                                   \
  }

__global__ void __launch_bounds__(256, 2) fwd_megakernel(Params P) {
  __shared__ __attribute__((aligned(16))) char smem[SMEM_BYTES];
  cg::grid_group grid = cg::this_grid();
  phase0(P, smem);
  grid.sync();
  phase1_scans(P);
  GEMM_TILES(40, phase1_tile)
  grid.sync();
  phase2(P, smem);
  grid.sync();
  GEMM_TILES(8, phase3_tile)
  grid.sync();
  GEMM_TILES(8, phase4_tile)
  grid.sync();
  GEMM_TILES(8, phase5_tile)
  grid.sync();
  for (int t = blockIdx.x; t < TT / 64; t += gridDim.x) phase6a_unit(P, t, smem);
  grid.sync();
  phase6b1(P);
  grid.sync();
  phase6w(P);
  grid.sync();
  phase6b2(P);
  grid.sync();
  GEMM_TILES(8, phase7_tile)
}

extern "C" void kernel_launch(void* const* d_in, const int* in_sizes, int n_in, void* d_out, int out_size, void* d_ws,
                              size_t ws_size, hipStream_t stream) {
  static int grid_blocks = 0;
  if (!grid_blocks) {
    int dev = 0, cus = 0, per_cu = 0;
    hipGetDevice(&dev);
    hipDeviceGetAttribute(&cus, hipDeviceAttributeMultiprocessorCount, dev);
    hipOccupancyMaxActiveBlocksPerMultiprocessor(&per_cu, fwd_megakernel, 256, 0);
    if (per_cu > 2) per_cu = 2;
    if (per_cu < 1) per_cu = 1;
    grid_blocks = cus * per_cu;
  }
  if (ws_size < W_END) { fprintf(stderr, "workspace too small: %zu < %zu\n", ws_size, (size_t)W_END); return; }
  Params p{};
  const float** pf = (const float**)&p;
  for (int i = 0; i < 28; i++) pf[i] = (const float*)d_in[i];
  p.out = (float*)d_out;
  p.ws = (char*)d_ws;
  void* args[] = {&p};
  hipError_t e = hipLaunchCooperativeKernel((void*)fwd_megakernel, dim3(grid_blocks), dim3(256), args, 0, stream);
  if (e != hipSuccess) fprintf(stderr, "cooperative launch failed: %s (grid %d)\n", hipGetErrorString(e), grid_blocks);
}
```

```cpp
#include <hip/hip_runtime.h>
#include <hip/hip_cooperative_groups.h>
#include <cstdio>
namespace cg = cooperative_groups;

typedef unsigned short u16;
typedef unsigned int u32;
typedef short bf16x8 __attribute__((ext_vector_type(8)));
typedef short s16x4 __attribute__((ext_vector_type(4)));
typedef float f32x4 __attribute__((ext_vector_type(4)));
typedef unsigned int u32x4 __attribute__((ext_vector_type(4)));
typedef unsigned int u32x2 __attribute__((ext_vector_type(2)));
typedef __bf16 bf16x2_t __attribute__((ext_vector_type(2)));

#define DI __device__ __forceinline__
#define LAUNDER(x) asm volatile("" : "+v"(x))

constexpr int TP = 65536, TS = 256, TT = TP + TS;
constexpr float LOG2E = 1.4426950408889634f;
constexpr float EPS = 1e-6f;
constexpr float U_SCALE = 1024.f, V_SCALE = 128.f;

constexpr size_t O_AK_P = 67371008, O_AV_P = 100925440, O_AF_P = 134479872, O_BK_P = 135004160,
                 O_BV_P = 143392768, O_AK_S = 151781376, O_AV_S = 151912448, O_AF_S = 152043520,
                 O_BK_S = 152045568, O_BV_S = 152176640;

constexpr size_t SZ_ACT = (size_t)TT * 1024 * 2;
constexpr size_t SZ_HALF = (size_t)TT * 512 * 2;
constexpr size_t W_XB = 0;
constexpr size_t W_QKV = SZ_ACT;
constexpr size_t W_GA = W_QKV + 6 * SZ_HALF;
constexpr size_t W_GB = W_GA + SZ_ACT;
constexpr size_t W_PB = W_GB + SZ_ACT;
constexpr size_t W_WIN = W_PB + (size_t)TT * 256 * 2;
constexpr size_t W_WUPA = W_WIN + (size_t)5120 * 1024 * 2;
constexpr size_t W_WUPB = W_WUPA + 1024 * 512 * 2;
constexpr size_t W_WOUT = W_WUPB + 1024 * 512 * 2;
constexpr size_t W_WQ = W_WOUT + 1024 * 1024 * 2;
constexpr size_t W_WG = W_WQ + 1024 * 1024 * 2;
constexpr size_t W_WPP = W_WG + 1024 * 1024 * 2;
constexpr size_t W_UB = W_WPP + 1024 * 256 * 2;
constexpr size_t W_VB = W_UB + (size_t)16384 * 1024 * 2;
constexpr size_t W_SK = W_VB + (size_t)16384 * 1024 * 2;
constexpr size_t W_RS1 = W_SK + 131072 * 2;
constexpr size_t W_SSQ2 = W_RS1 + (size_t)TT * 4;
constexpr size_t W_RS3 = W_SSQ2 + (size_t)TT * 64;
constexpr size_t W_CUMP = W_RS3 + (size_t)TT * 4;
constexpr size_t W_CUMS = W_CUMP + (size_t)256 * 2048 * 4;
constexpr size_t W_SSQ3 = W_CUMS + (size_t)128 * 4112 * 4 + 1024;
constexpr size_t W_END = W_SSQ3 + (size_t)TT * 8 * 4;
constexpr size_t W_IDX = W_GA;
constexpr size_t W_G = W_GA + (size_t)32 * 1024 * 1024;
constexpr size_t SZ_PH = (size_t)TT * 128 * 4;


struct Params {
  const float *x_p, *x_s, *cak, *cav, *caf, *cbk, *cbv, *p_p, *p_s, *g_mix, *w_in, *b_f, *qn_a, *kn_a,
      *qn_b, *kn_b, *relb, *w_up_a, *w_up_b, *w_out, *g_ffn, *peer_wq, *peer_sk, *peer_u, *peer_v, *g_ple,
      *w_gate, *w_proj;
  float* out;
  char* ws;
};

constexpr int SMEM_BYTES = 128 * 129 * 4 + 2 * 64 * 17 * 4 + 256;

DI float* ph_slice(char* ws, int x) { return (float*)(ws + (x < 4 ? W_XB + (size_t)x * SZ_PH : W_GB + (size_t)(x - 4) * SZ_PH)); }
DI u16 f2bf(float x) { return __builtin_bit_cast(u16, (__bf16)x); }
DI float bf2f(u16 h) { return __uint_as_float(((u32)h) << 16); }
DI u32 pack2(float a, float b) { bf16x2_t v = {(__bf16)a, (__bf16)b}; return __builtin_bit_cast(u32, v); }
DI float wave_sum(float v) {
#pragma unroll
  for (int o = 32; o; o >>= 1) v += __shfl_xor(v, o);
  return v;
}
DI f32x4 mfma16(bf16x8 a, bf16x8 b, f32x4 c) { return __builtin_amdgcn_mfma_f32_16x16x32_bf16(a, b, c, 0, 0, 0); }
DI float sigmoidf_(float x) { return 1.f / (1.f + __expf(-x)); }
DI u32 mono(float x) { u32 u = __float_as_uint(x); u32 m = (u32)((int)u >> 31) | 0x80000000u; return u ^ m; }
DI float unmono(u32 k) { u32 m = ((k >> 31) - 1u) | 0x80000000u; return __uint_as_float(k ^ m); }
DI void insert16(u32 (&L)[16], u32 x) {
#pragma unroll
  for (int s = 0; s < 16; s++) { u32 mx = max(L[s], x); x = min(L[s], x); L[s] = mx; }
}
DI float gelu_tanh(float x) {
  float u = 0.7978845608028654f * (x + 0.044715f * x * x * x);
  float t = 1.f - 2.f / (1.f + __expf(2.f * u));
  return 0.5f * x * (1.f + t);
}

constexpr int GSTR = 72;
constexpr int GBUF = 2 * 128 * GSTR;
constexpr int RS_OFF = 2 * GBUF * 2;
DI void gemm_compute(const u16* As, const u16* Bs, f32x4 (&acc)[4][4], int wm, int wn, int r, int quad) {
#pragma unroll
  for (int ks = 0; ks < 2; ks++) {
    bf16x8 af[4], bfr[4];
#pragma unroll
    for (int mi = 0; mi < 4; mi++) af[mi] = *(const bf16x8*)(As + (wm * 64 + mi * 16 + r) * GSTR + ks * 32 + quad * 8);
#pragma unroll
    for (int ni = 0; ni < 4; ni++) bfr[ni] = *(const bf16x8*)(Bs + (wn * 64 + ni * 16 + r) * GSTR + ks * 32 + quad * 8);
#pragma unroll
    for (int mi = 0; mi < 4; mi++)
#pragma unroll
      for (int ni = 0; ni < 4; ni++) acc[mi][ni] = mfma16(af[mi], bfr[ni], acc[mi][ni]);
    if (ks == 0) __builtin_amdgcn_sched_barrier(0);
  }
}
DI void gemm_mainloop(const u16* __restrict__ A, int lda, const u16* __restrict__ B, int ldb, int K, u16* smem,
                      f32x4 (&acc)[4][4]) {
  const int tid = threadIdx.x, lane = tid & 63, w = tid >> 6, wm = w >> 1, wn = w & 1, r = lane & 15, quad = lane >> 4;
  u16* As0 = smem;
  u16* Bs0 = smem + 128 * GSTR;
  u16* As1 = smem + GBUF;
  u16* Bs1 = As1 + 128 * GSTR;
  u32x4 r0a[4], r0b[4], r1a[4], r1b[4];
  const int lrow = tid >> 3, lch = tid & 7;
  const u16* ap = A + (size_t)lrow * lda + lch * 8;
  const u16* bp = B + (size_t)lrow * ldb + lch * 8;
  const int lo = lrow * GSTR + lch * 8;
  const int nk = K >> 6, km = nk - 1;
  const int krot = 0;
#define KOFF(kt) ((((kt) + krot) & km) * 64)
#pragma unroll
  for (int i = 0; i < 4; i++) {
    r0a[i] = *(const u32x4*)(ap + (size_t)i * 32 * lda + KOFF(0));
    r0b[i] = *(const u32x4*)(bp + (size_t)i * 32 * ldb + KOFF(0));
  }
#pragma unroll
  for (int i = 0; i < 4; i++) {
    r1a[i] = *(const u32x4*)(ap + (size_t)i * 32 * lda + KOFF(1));
    r1b[i] = *(const u32x4*)(bp + (size_t)i * 32 * ldb + KOFF(1));
  }
  __syncthreads();
#pragma unroll 1
  for (int kt = 0; kt < nk - 2; kt += 2) {
#pragma unroll
    for (int i = 0; i < 4; i++) {
      *(u32x4*)(As0 + lo + i * 32 * GSTR) = r0a[i];
      *(u32x4*)(Bs0 + lo + i * 32 * GSTR) = r0b[i];
    }
    __syncthreads();
    {
      const int ko = KOFF(kt + 2);
#pragma unroll
      for (int i = 0; i < 4; i++) {
        r0a[i] = *(const u32x4*)(ap + (size_t)i * 32 * lda + ko);
        r0b[i] = *(const u32x4*)(bp + (size_t)i * 32 * ldb + ko);
      }
    }
    gemm_compute(As0, Bs0, acc, wm, wn, r, quad);
#pragma unroll
    for (int i = 0; i < 4; i++) {
      *(u32x4*)(As1 + lo + i * 32 * GSTR) = r1a[i];
      *(u32x4*)(Bs1 + lo + i * 32 * GSTR) = r1b[i];
    }
    __syncthreads();
    {
      const int ko = KOFF(kt + 3);
#pragma unroll
      for (int i = 0; i < 4; i++) {
        r1a[i] = *(const u32x4*)(ap + (size_t)i * 32 * lda + ko);
        r1b[i] = *(const u32x4*)(bp + (size_t)i * 32 * ldb + ko);
      }
    }
    gemm_compute(As1, Bs1, acc, wm, wn, r, quad);
  }
#pragma unroll
  for (int i = 0; i < 4; i++) {
    *(u32x4*)(As0 + lo + i * 32 * GSTR) = r0a[i];
    *(u32x4*)(Bs0 + lo + i * 32 * GSTR) = r0b[i];
  }
  __syncthreads();
  gemm_compute(As0, Bs0, acc, wm, wn, r, quad);
#pragma unroll
  for (int i = 0; i < 4; i++) {
    *(u32x4*)(As1 + lo + i * 32 * GSTR) = r1a[i];
    *(u32x4*)(Bs1 + lo + i * 32 * GSTR) = r1b[i];
  }
  __syncthreads();
  gemm_compute(As1, Bs1, acc, wm, wn, r, quad);
#undef KOFF
}

DI void zero_acc(f32x4 (&acc)[4][4]) {
#pragma unroll
  for (int i = 0; i < 4; i++)
#pragma unroll
    for (int j = 0; j < 4; j++) acc[i][j] = (f32x4){0.f, 0.f, 0.f, 0.f};
}

constexpr int CSTR = 132;
DI void stage_acc(const f32x4 (&acc)[4][4], float* Cs) {
  const int tid = threadIdx.x, lane = tid & 63, w = tid >> 6, wm = w >> 1, wn = w & 1, r = lane & 15, quad = lane >> 4;
  __syncthreads();
#pragma unroll
  for (int mi = 0; mi < 4; mi++)
#pragma unroll
    for (int ni = 0; ni < 4; ni++)
#pragma unroll
      for (int j = 0; j < 4; j++) Cs[(wm * 64 + mi * 16 + quad * 4 + j) * CSTR + wn * 64 + ni * 16 + r] = acc[mi][ni][j];
  __syncthreads();
}
DI u32x2 pack4(f32x4 v) { return (u32x2){pack2(v.x, v.y), pack2(v.z, v.w)}; }
DI f32x4 unpack4(u32x2 p) {
  return (f32x4){__uint_as_float(p.x << 16), __uint_as_float(p.x & 0xffff0000u), __uint_as_float(p.y << 16), __uint_as_float(p.y & 0xffff0000u)};
}

DI void transpose_tile(const float* __restrict__ W, int ldw, int K, const float* __restrict__ g, u16* __restrict__ dst,
                       int k0, int n0, int nsrc0, float* tile) {
  const int tid = threadIdx.x;
  __syncthreads();
  {
    const int ty = tid >> 4, tx = tid & 15;
#pragma unroll
    for (int i = 0; i < 4; i++) {
      int k = ty + i * 16;
      f32x4 v = *(const f32x4*)(W + (size_t)(k0 + k) * ldw + nsrc0 + tx * 4);
      float s = g ? g[k0 + k] : 1.f;
      tile[k * 65 + tx * 4 + 0] = v[0] * s;
      tile[k * 65 + tx * 4 + 1] = v[1] * s;
      tile[k * 65 + tx * 4 + 2] = v[2] * s;
      tile[k * 65 + tx * 4 + 3] = v[3] * s;
    }
  }
  __syncthreads();
  {
    const int n = tid >> 2, kc = (tid & 3) * 16;
    u32 pk[8];
#pragma unroll
    for (int i = 0; i < 8; i++) pk[i] = pack2(tile[(kc + 2 * i) * 65 + n], tile[(kc + 2 * i + 1) * 65 + n]);
    u16* d = dst + (size_t)(n0 + n) * K + k0 + kc;
    *(u32x4*)d = (u32x4){pk[0], pk[1], pk[2], pk[3]};
    *(u32x4*)(d + 8) = (u32x4){pk[4], pk[5], pk[6], pk[7]};
  }
}

DI void conv_unit(const float* __restrict__ src, u16* __restrict__ dst, size_t base, const float* __restrict__ colscale) {
  const int tid = threadIdx.x;
#pragma unroll
  for (int i = 0; i < 4; i++) {
    size_t e = base + (size_t)i * 1024 + tid * 4;
    f32x4 v = *(const f32x4*)(src + e);
    if (colscale) {
      f32x4 gg = *(const f32x4*)(colscale + (e & 1023));
      v = v * gg;
    }
    *(u32x2*)(dst + e) = (u32x2){pack2(v[0], v[1]), pack2(v[2], v[3])};
  }
}

DI void conv_unit_fp8(const float* __restrict__ src, unsigned char* __restrict__ dst, size_t base,
                      const float* __restrict__ colscale, float scale) {
  const int tid = threadIdx.x;
#pragma unroll
  for (int i = 0; i < 4; i++) {
    size_t e = base + (size_t)i * 1024 + tid * 4;
    f32x4 v = *(const f32x4*)(src + e);
    if (colscale) {
      f32x4 gg = *(const f32x4*)(colscale + (e & 1023));
      v = v * gg;
    }
    int w = __builtin_amdgcn_cvt_pk_fp8_f32(v[0] * scale, v[1] * scale, 0, false);
    w = __builtin_amdgcn_cvt_pk_fp8_f32(v[2] * scale, v[3] * scale, w, true);
    *(int*)(dst + (((e & 1023) >> 7) << 21) + ((e >> 10) << 7) + (e & 127)) = w;
  }
}

DI void phase0(const Params& P, char* smem) {
  const int tid = threadIdx.x, lane = tid & 63, w = tid >> 6;
  char* ws = P.ws;
  {
    float* tile = (float*)smem;
    constexpr int T_WIN = 16 * 80, T_UP = 8 * 16, T_SQ = 256, T_PP = 4 * 16;
    constexpr int NT = T_WIN + 2 * T_UP + 3 * T_SQ + T_PP;
    for (int t = blockIdx.x; t < NT; t += gridDim.x) {
      int u = t;
      if (u < T_WIN) {
        int kt = u / 80, nt = u % 80;
        int n0 = nt * 64;
        int ns = n0 < 1536 ? n0 : n0 + 8;
        transpose_tile(P.w_in, 5128, 1024, P.g_mix, (u16*)(ws + W_WIN), kt * 64, n0, ns, tile);
        continue;
      }
      u -= T_WIN;
      if (u < T_UP) { transpose_tile(P.w_up_a, 1024, 512, nullptr, (u16*)(ws + W_WUPA), (u / 16) * 64, (u % 16) * 64, (u % 16) * 64, tile); continue; }
      u -= T_UP;
      if (u < T_UP) { transpose_tile(P.w_up_b, 1024, 512, nullptr, (u16*)(ws + W_WUPB), (u / 16) * 64, (u % 16) * 64, (u % 16) * 64, tile); continue; }
      u -= T_UP;
      if (u < T_SQ) { transpose_tile(P.w_out, 1024, 1024, nullptr, (u16*)(ws + W_WOUT), (u / 16) * 64, (u % 16) * 64, (u % 16) * 64, tile); continue; }
      u -= T_SQ;
      if (u < T_SQ) { transpose_tile(P.peer_wq, 1024, 1024, P.g_ffn, (u16*)(ws + W_WQ), (u / 16) * 64, (u % 16) * 64, (u % 16) * 64, tile); continue; }
      u -= T_SQ;
      if (u < T_SQ) { transpose_tile(P.w_gate, 1024, 1024, P.g_ple, (u16*)(ws + W_WG), (u / 16) * 64, (u % 16) * 64, (u % 16) * 64, tile); continue; }
      u -= T_SQ;
      transpose_tile(P.w_proj, 1024, 256, nullptr, (u16*)(ws + W_WPP), (u / 16) * 64, (u % 16) * 64, (u % 16) * 64, tile);
    }
  }
  {
    constexpr int U_UB = 4096, U_VB = 4096, U_SK = 32, U_PP = 4096, U_PS = 16;
    constexpr int NU = U_UB + U_VB + U_SK + U_PP + U_PS;
    for (int t = blockIdx.x; t < NU; t += gridDim.x) {
      int u = t;
      if (u < U_UB) { conv_unit_fp8(P.peer_u, (unsigned char*)(ws + W_UB), (size_t)u * 4096, P.g_ffn, U_SCALE); continue; }
      u -= U_UB;
      if (u < U_VB) { conv_unit_fp8(P.peer_v, (unsigned char*)(ws + W_VB), (size_t)u * 4096, nullptr, V_SCALE); continue; }
      u -= U_VB;
      if (u < U_SK) { conv_unit(P.peer_sk, (u16*)(ws + W_SK), (size_t)u * 4096, nullptr); continue; }
      u -= U_SK;
      if (u < U_PP) { conv_unit(P.p_p, (u16*)(ws + W_PB), (size_t)u * 4096, nullptr); continue; }
      u -= U_PP;
      conv_unit(P.p_s, (u16*)(ws + W_PB) + (size_t)TP * 256, (size_t)u * 4096, nullptr);
    }
  }
  {
    float* wfl = (float*)smem;
    __syncthreads();
    for (int i = tid; i < 8192; i += 256) {
      int k = i >> 3, h = i & 7;
      wfl[h * 1024 + k] = P.g_mix[k] * P.w_in[(size_t)k * 5128 + 1536 + h];
    }
    __syncthreads();
    u16* XB = (u16*)(ws + W_XB);
    float* RS1 = (float*)(ws + W_RS1);
    for (int t = blockIdx.x * 4 + w; t < TT; t += gridDim.x * 4) {
      const float* xr = t < TP ? P.x_p + (size_t)t * 1024 : P.x_s + (size_t)(t - TP) * 1024;
      f32x4 v[4];
#pragma unroll
      for (int i = 0; i < 4; i++) v[i] = *(const f32x4*)(xr + i * 256 + lane * 4);
      float ss = 0.f;
#pragma unroll
      for (int i = 0; i < 4; i++) ss += v[i][0] * v[i][0] + v[i][1] * v[i][1] + v[i][2] * v[i][2] + v[i][3] * v[i][3];
      float dots[8];
#pragma unroll
      for (int h = 0; h < 8; h++) {
        float d = 0.f;
#pragma unroll
        for (int i = 0; i < 4; i++) {
          f32x4 wv = *(const f32x4*)(wfl + h * 1024 + i * 256 + lane * 4);
          d += v[i][0] * wv[0] + v[i][1] * wv[1] + v[i][2] * wv[2] + v[i][3] * wv[3];
        }
        dots[h] = d;
      }
      ss = wave_sum(ss);
#pragma unroll
      for (int h = 0; h < 8; h++) dots[h] = wave_sum(dots[h]);
      float rs = rsqrtf(ss * (1.f / 1024.f) + EPS);
#pragma unroll
      for (int i = 0; i < 4; i++)
        *(u32x2*)(XB + (size_t)t * 1024 + i * 256 + lane * 4) = (u32x2){pack2(v[i][0], v[i][1]), pack2(v[i][2], v[i][3])};
      if (lane == 0) RS1[t] = rs;
      float myd = dots[0];
#pragma unroll
      for (int h = 1; h < 8; h++) myd = (lane == h) ? dots[h] : myd;
      if (lane < 8) {
        float z = rs * myd + P.b_f[lane];
        float lf = fminf(z, 0.f) - log1pf(expf(-fabsf(z)));
        float* o = t < TP ? P.out + O_AF_P + (size_t)t * 8 : P.out + O_AF_S + (size_t)(t - TP) * 8;
        o[lane] = lf;
      }
    }
  }
}

DI void phase1_scans(const Params& P) {
  const int lane = threadIdx.x & 63;
  const int gw = blockIdx.x * 4 + (threadIdx.x >> 6), nw = gridDim.x * 4;
  float* CUMP = (float*)(P.ws + W_CUMP);
  float* CUMS = (float*)(P.ws + W_CUMS);
  for (int row = gw; row < 384; row += nw) {
    float carry = 0.f;
    if (row < 256) {
      int b = row >> 3, h = row & 7;
      const float* src = P.out + O_AF_P + (size_t)b * 2048 * 8 + h;
      for (int p0 = 0; p0 < 2048; p0 += 64) {
        float v = src[(size_t)(p0 + lane) * 8];
#pragma unroll
        for (int o = 1; o < 64; o <<= 1) { float n = __shfl_up(v, o); if (lane >= o) v += n; }
        v += carry;
        CUMP[(size_t)row * 2048 + p0 + lane] = v * LOG2E;
        carry = __shfl(v, 63);
      }
    } else {
      int rr = row - 256;
      int b = rr >> 3, h = rr & 7;
      const float* src = P.caf + (size_t)b * 4096 * 8 + h;
      for (int p0 = 0; p0 < 4096; p0 += 64) {
        float v = src[(size_t)(p0 + lane) * 8];
#pragma unroll
        for (int o = 1; o < 64; o <<= 1) { float n = __shfl_up(v, o); if (lane >= o) v += n; }
        v += carry;
        CUMS[(size_t)rr * 4112 + p0 + lane] = v * LOG2E;
        carry = __shfl(v, 63);
      }
      {
        float v = lane < 16 ? P.out[O_AF_S + (size_t)(b * 16 + lane) * 8 + h] : 0.f;
#pragma unroll
        for (int o = 1; o < 64; o <<= 1) { float n = __shfl_up(v, o); if (lane >= o) v += n; }
        v += carry;
        if (lane < 16) CUMS[(size_t)rr * 4112 + 4096 + lane] = v * LOG2E;
      }
    }
  }
}

DI void phase1_tile(const Params& P, int mt, int nt, char* smem) {
  const int tid = threadIdx.x, lane = tid & 63, w = tid >> 6, wm = w >> 1, wn = w & 1, r = lane & 15, quad = lane >> 4;
  const int m0 = mt * 128, n0 = nt * 128;
  char* ws = P.ws;
  f32x4 acc[4][4];
  zero_acc(acc);
  gemm_mainloop((const u16*)(ws + W_XB) + (size_t)m0 * 1024, 1024, (const u16*)(ws + W_WIN) + (size_t)n0 * 1024, 1024, 1024,
                (u16*)smem, acc);
  float* Cs = (float*)smem;
  stage_acc(acc, Cs);
  const bool sample = m0 >= TP;
  const int c4 = tid & 31, rsub = tid >> 5;
  const float* RS1 = (const float*)(ws + W_RS1) + m0;
  if (n0 < 3072) {
    const int seg = n0 >> 9, hc = n0 & 511;
    const bool normed = (seg != 2 && seg != 5);
    const float* gain = seg == 0 ? P.qn_a : seg == 1 ? P.kn_a : seg == 3 ? P.qn_b : P.kn_b;
    const float qs = (seg == 0 || seg == 3) ? 0.125f * LOG2E : 1.f;
    f32x4 gn = (f32x4){1.f, 1.f, 1.f, 1.f};
    if (normed) gn = *(const f32x4*)(gain + (c4 & 15) * 4) * qs;
    u16* dp = (u16*)(ws + W_QKV + (size_t)seg * SZ_HALF) + (size_t)m0 * 512 + hc + c4 * 4;
    float* op = nullptr;
    if (seg == 1 || seg == 2) {
      op = sample ? P.out + (seg == 1 ? O_AK_S : O_AV_S) + (size_t)(m0 - TP) * 512 : P.out + (seg == 1 ? O_AK_P : O_AV_P) + (size_t)m0 * 512;
    } else if (seg == 4 || seg == 5) {
      if (sample) op = P.out + (seg == 4 ? O_BK_S : O_BV_S) + (size_t)(m0 - TP) * 512;
      else if ((m0 & 2047) >= 1536) op = P.out + (seg == 4 ? O_BK_P : O_BV_P) + ((size_t)(m0 >> 11) * 512 + ((m0 & 2047) - 1536)) * 512;
    }
    if (op) op += hc + c4 * 4;
#pragma unroll 4
    for (int p = 0; p < 16; p++) {
      const int row = p * 8 + rsub;
      f32x4 v = *(const f32x4*)(Cs + row * CSTR + c4 * 4) * RS1[row];
      if (normed) {
        float ss = v.x * v.x + v.y * v.y + v.z * v.z + v.w * v.w;
        ss += __shfl_xor(ss, 1);
        ss += __shfl_xor(ss, 2);
        ss += __shfl_xor(ss, 4);
        ss += __shfl_xor(ss, 8);
        v = v * gn * rsqrtf(ss * (1.f / 64.f) + EPS);
      }
      *(u32x2*)(dp + (size_t)row * 512) = pack4(v);
      if (op) *(f32x4*)(op + (size_t)row * 512) = v;
    }
  } else {
    u16* dp = (n0 < 4096 ? (u16*)(ws + W_GA) + (n0 - 3072) : (u16*)(ws + W_GB) + (n0 - 4096)) + (size_t)m0 * 1024 + c4 * 4;
#pragma unroll 4
    for (int p = 0; p < 16; p++) {
      const int row = p * 8 + rsub;
      f32x4 v = *(const f32x4*)(Cs + row * CSTR + c4 * 4) * RS1[row];
      v = (f32x4){sigmoidf_(v.x), sigmoidf_(v.y), sigmoidf_(v.z), sigmoidf_(v.w)};
      *(u32x2*)(dp + (size_t)row * 1024) = pack4(v);
    }
  }
}

constexpr int ASTR = 72;
constexpr int TAB_OFF = 36864;
struct AttnState { f32x4 o[4]; float m, l; };

DI s16x4 tr_read(const u16* p) {
  return __builtin_amdgcn_ds_read_tr16_b64_v4i16((__attribute__((address_space(3))) s16x4*)(p));
}

template <int MODE>
DI void attn_step(const u16* Ks, const u16* Vs, const bf16x8 (&qf)[2], AttnState& st, int kpos0, int qpos, int qlim,
                  float cq, const float* cum, const float* tab, bool domask) {
  const int lane = threadIdx.x & 63, r = lane & 15, quad = lane >> 4;
  const bool farband = (MODE == 1) && (kpos0 + 31 - (qpos - r) <= -128);
  f32x4 s[2];
#pragma unroll
  for (int t = 0; t < 2; t++) {
    f32x4 a4 = (f32x4){0.f, 0.f, 0.f, 0.f};
#pragma unroll
    for (int ks = 0; ks < 2; ks++) {
      bf16x8 kf = *(const bf16x8*)(Ks + (t * 16 + r) * ASTR + ks * 32 + quad * 8);
      a4 = mfma16(kf, qf[ks], a4);
    }
    s[t] = a4;
  }
#pragma unroll
  for (int t = 0; t < 2; t++) {
    const int kb = kpos0 + t * 16 + quad * 4;
    if (MODE == 0) {
      f32x4 c4 = *(const f32x4*)(cum + kb);
#pragma unroll
      for (int j = 0; j < 4; j++) s[t][j] -= c4[j];
    } else if (farband) {
      const float b0 = tab[0];
#pragma unroll
      for (int j = 0; j < 4; j++) s[t][j] += b0;
    } else {
#pragma unroll
      for (int j = 0; j < 4; j++) {
        int rel = kb + j - qpos;
        rel = min(max(rel, -128), 128) + 128;
        s[t][j] += tab[rel];
      }
    }
    if (domask) {
#pragma unroll
      for (int j = 0; j < 4; j++)
        if (kb + j > qlim) s[t][j] = -1e30f;
    }
  }
  float mx = fmaxf(fmaxf(fmaxf(s[0][0], s[0][1]), fmaxf(s[0][2], s[0][3])), fmaxf(fmaxf(s[1][0], s[1][1]), fmaxf(s[1][2], s[1][3])));
  mx = fmaxf(mx, __shfl_xor(mx, 16));
  mx = fmaxf(mx, __shfl_xor(mx, 32));
  const float mn = fmaxf(st.m, mx);
  const float alpha = __builtin_amdgcn_exp2f(st.m - mn);
  float p[8];
  float ls = 0.f;
#pragma unroll
  for (int t = 0; t < 2; t++)
#pragma unroll
    for (int j = 0; j < 4; j++) { p[t * 4 + j] = __builtin_amdgcn_exp2f(s[t][j] - mn); ls += p[t * 4 + j]; }
  st.l = st.l * alpha + ls;
  st.m = mn;
#pragma unroll
  for (int dt = 0; dt < 4; dt++) st.o[dt] = st.o[dt] * alpha;
  u32x4 pk = (u32x4){pack2(p[0], p[1]), pack2(p[2], p[3]), pack2(p[4], p[5]), pack2(p[6], p[7])};
  bf16x8 pf = __builtin_bit_cast(bf16x8, pk);
  const int qq = (lane & 15) >> 2, pp = lane & 3;
#pragma unroll
  for (int dt = 0; dt < 4; dt++) {
    s16x4 lo = tr_read(Vs + (quad * 4 + qq) * ASTR + dt * 16 + pp * 4);
    s16x4 hi = tr_read(Vs + (16 + quad * 4 + qq) * ASTR + dt * 16 + pp * 4);
    bf16x8 vf = __builtin_shufflevector(lo, hi, 0, 1, 2, 3, 4, 5, 6, 7);
    st.o[dt] = mfma16(vf, pf, st.o[dt]);
  }
}

template <int MODE>
DI void attn_prompt_item(const Params& P, char* smem, int b, int h, int qt) {
  const int tid = threadIdx.x, lane = tid & 63, w = tid >> 6, r = lane & 15, quad = lane >> 4;
  char* ws = P.ws;
  const u16* Q = (const u16*)(ws + W_QKV + (size_t)(MODE == 0 ? 0 : 3) * SZ_HALF);
  const u16* Kg = (const u16*)(ws + W_QKV + (size_t)(MODE == 0 ? 1 : 4) * SZ_HALF);
  const u16* Vg = (const u16*)(ws + W_QKV + (size_t)(MODE == 0 ? 2 : 5) * SZ_HALF);
  u16* Y = (u16*)(ws + W_XB + (size_t)(MODE == 0 ? 0 : 1) * SZ_HALF);
  u16* Ks = (u16*)smem;
  u16* Vs = Ks + 64 * ASTR;
  float* tab = (float*)(smem + TAB_OFF);
  __syncthreads();
  if (MODE == 1) {
    for (int i = tid; i < 257; i += 256) tab[i] = P.relb[h * 257 + i] * LOG2E;
  }
  const int q0 = qt * 64;
  const int qpos = q0 + w * 16 + r;
  const size_t tokq = (size_t)b * 2048 + qpos;
  bf16x8 qf[2];
#pragma unroll
  for (int ks = 0; ks < 2; ks++) qf[ks] = *(const bf16x8*)(Q + tokq * 512 + h * 64 + ks * 32 + quad * 8);
  const float* cum = (const float*)(ws + W_CUMP) + (size_t)(b * 8 + h) * 2048;
  const float cq = MODE == 0 ? cum[qpos] : 0.f;
  AttnState st;
#pragma unroll
  for (int dt = 0; dt < 4; dt++) st.o[dt] = (f32x4){0.f, 0.f, 0.f, 0.f};
  st.m = -1e30f;
  st.l = 0.f;
  const int kt_lo = MODE == 0 ? 0 : max(0, qt - 8), kt_hi = qt;
  u32x4 rk[2], rv[2];
  const int lkey = tid >> 3, lch = tid & 7;
  const u16* kp = Kg + ((size_t)b * 2048 + lkey) * 512 + h * 64 + lch * 8;
  const u16* vp = Vg + ((size_t)b * 2048 + lkey) * 512 + h * 64 + lch * 8;
#pragma unroll
  for (int i = 0; i < 2; i++) {
    rk[i] = *(const u32x4*)(kp + (size_t)(kt_lo * 64 + i * 32) * 512);
    rv[i] = *(const u32x4*)(vp + (size_t)(kt_lo * 64 + i * 32) * 512);
  }
  for (int kt = kt_lo; kt <= kt_hi; kt++) {
    __syncthreads();
#pragma unroll
    for (int i = 0; i < 2; i++) {
      *(u32x4*)(Ks + (lkey + i * 32) * ASTR + lch * 8) = rk[i];
      *(u32x4*)(Vs + (lkey + i * 32) * ASTR + lch * 8) = rv[i];
    }
    __syncthreads();
    if (kt < kt_hi) {
#pragma unroll
      for (int i = 0; i < 2; i++) {
        rk[i] = *(const u32x4*)(kp + (size_t)((kt + 1) * 64 + i * 32) * 512);
        rv[i] = *(const u32x4*)(vp + (size_t)((kt + 1) * 64 + i * 32) * 512);
      }
    }
    const bool diag = (MODE == 0) && (kt == qt);
#pragma unroll
    for (int half = 0; half < 2; half++) {
      const int kpos0 = kt * 64 + half * 32;
      if (diag && kpos0 > q0 + w * 16 + 15) continue;
      attn_step<MODE>(Ks + half * 32 * ASTR, Vs + half * 32 * ASTR, qf, st, kpos0, qpos, qpos, cq, cum, tab, diag);
    }
  }
  float lt = st.l;
  lt += __shfl_xor(lt, 16);
  lt += __shfl_xor(lt, 32);
  const float inv = 1.f / lt;
#pragma unroll
  for (int dt = 0; dt < 4; dt++) {
    u32x2 o2 = (u32x2){pack2(st.o[dt][0] * inv, st.o[dt][1] * inv), pack2(st.o[dt][2] * inv, st.o[dt][3] * inv)};
    *(u32x2*)(Y + tokq * 512 + h * 64 + dt * 16 + quad * 4) = o2;
  }
}

template <int MODE>
DI void attn_sample_item(const Params& P, char* smem, int b, int h) {
  const int tid = threadIdx.x, lane = tid & 63, w = tid >> 6, r = lane & 15, quad = lane >> 4;
  constexpr int L = MODE == 0 ? 4096 : 512;
  char* ws = P.ws;
  const u16* Q = (const u16*)(ws + W_QKV + (size_t)(MODE == 0 ? 0 : 3) * SZ_HALF);
  const u16* Kn = (const u16*)(ws + W_QKV + (size_t)(MODE == 0 ? 1 : 4) * SZ_HALF);
  const u16* Vn = (const u16*)(ws + W_QKV + (size_t)(MODE == 0 ? 2 : 5) * SZ_HALF);
  u16* Y = (u16*)(ws + W_XB + (size_t)(MODE == 0 ? 0 : 1) * SZ_HALF);
  u16* Kw = (u16*)smem + w * (2 * 32 * ASTR);
  u16* Vw = Kw + 32 * ASTR;
  float* tab = (float*)(smem + TAB_OFF);
  __syncthreads();
  if (MODE == 1) {
    for (int i = tid; i < 257; i += 256) tab[i] = P.relb[h * 257 + i] * LOG2E;
  }
  __syncthreads();
  const float* ck = (MODE == 0 ? P.cak : P.cbk) + ((size_t)b * L * 8 + h) * 64;
  const float* cv = (MODE == 0 ? P.cav : P.cbv) + ((size_t)b * L * 8 + h) * 64;
  const size_t tokbase = (size_t)TP + b * 16;
  bf16x8 qf[2];
#pragma unroll
  for (int ks = 0; ks < 2; ks++) qf[ks] = *(const bf16x8*)(Q + (tokbase + r) * 512 + h * 64 + ks * 32 + quad * 8);
  const int qpos = L + r;
  const float* cum = (const float*)(ws + W_CUMS) + (size_t)(b * 8 + h) * 4112;
  const float cq = MODE == 0 ? cum[qpos] : 0.f;
  AttnState st;
#pragma unroll
  for (int dt = 0; dt < 4; dt++) st.o[dt] = (f32x4){0.f, 0.f, 0.f, 0.f};
  st.m = -1e30f;
  st.l = 0.f;
  const int kbeg = w * (L / 4), kend = kbeg + L / 4;
  for (int k0 = kbeg; k0 < kend; k0 += 32) {
    {
      f32x4 kr[8];
#pragma unroll
      for (int i = 0; i < 8; i++) kr[i] = *(const f32x4*)(ck + (size_t)(k0 + i * 4 + quad) * 512 + r * 4);
#pragma unroll
      for (int i = 0; i < 8; i++)
        *(u32x2*)(Kw + (i * 4 + quad) * ASTR + r * 4) = (u32x2){pack2(kr[i][0], kr[i][1]), pack2(kr[i][2], kr[i][3])};
    }
    {
      f32x4 vr[8];
#pragma unroll
      for (int i = 0; i < 8; i++) vr[i] = *(const f32x4*)(cv + (size_t)(k0 + i * 4 + quad) * 512 + r * 4);
#pragma unroll
      for (int i = 0; i < 8; i++)
        *(u32x2*)(Vw + (i * 4 + quad) * ASTR + r * 4) = (u32x2){pack2(vr[i][0], vr[i][1]), pack2(vr[i][2], vr[i][3])};
    }
    asm volatile("s_waitcnt lgkmcnt(0)" ::: "memory");
    __builtin_amdgcn_wave_barrier();
    attn_step<MODE>(Kw, Vw, qf, st, k0, qpos, qpos, cq, cum, tab, false);
    __builtin_amdgcn_wave_barrier();
  }
  if (w == 0) {
#pragma unroll
    for (int i = 0; i < 2; i++) {
      int c = lane + i * 64;
      int key = c >> 3, ch = c & 7;
      u32x4 kk = *(const u32x4*)(Kn + (tokbase + key) * 512 + h * 64 + ch * 8);
      u32x4 vv = *(const u32x4*)(Vn + (tokbase + key) * 512 + h * 64 + ch * 8);
      *(u32x4*)(Kw + key * ASTR + ch * 8) = kk;
      *(u32x4*)(Vw + key * ASTR + ch * 8) = vv;
      *(u32x4*)(Kw + (16 + key) * ASTR + ch * 8) = (u32x4){0u, 0u, 0u, 0u};
      *(u32x4*)(Vw + (16 + key) * ASTR + ch * 8) = (u32x4){0u, 0u, 0u, 0u};
    }
    asm volatile("s_waitcnt lgkmcnt(0)" ::: "memory");
    __builtin_amdgcn_wave_barrier();
    attn_step<MODE>(Kw, Vw, qf, st, L, qpos, MODE == 0 ? qpos : L + 15, cq, cum, tab, true);
  }
  __syncthreads();
  float* comb = (float*)smem;
  float lt = st.l;
  lt += __shfl_xor(lt, 16);
  lt += __shfl_xor(lt, 32);
#pragma unroll
  for (int dt = 0; dt < 4; dt++)
#pragma unroll
    for (int j = 0; j < 4; j++) comb[(w * 16 + r) * 68 + dt * 16 + quad * 4 + j] = st.o[dt][j];
  if (quad == 0) {
    comb[(w * 16 + r) * 68 + 64] = st.m;
    comb[(w * 16 + r) * 68 + 65] = lt;
  }
  __syncthreads();
  if (w == 0) {
    float mw[4], M = -1e30f;
#pragma unroll
    for (int i = 0; i < 4; i++) { mw[i] = comb[(i * 16 + r) * 68 + 64]; M = fmaxf(M, mw[i]); }
    float Ls = 0.f, scl[4];
#pragma unroll
    for (int i = 0; i < 4; i++) { scl[i] = __builtin_amdgcn_exp2f(mw[i] - M); Ls += scl[i] * comb[(i * 16 + r) * 68 + 65]; }
    const float inv = 1.f / Ls;
#pragma unroll
    for (int dt = 0; dt < 4; dt++) {
      float ov[4];
#pragma unroll
      for (int j = 0; j < 4; j++) {
        float a = 0.f;
#pragma unroll
        for (int i = 0; i < 4; i++) a += scl[i] * comb[(i * 16 + r) * 68 + dt * 16 + quad * 4 + j];
        ov[j] = a * inv;
      }
      *(u32x2*)(Y + (tokbase + r) * 512 + h * 64 + dt * 16 + quad * 4) = (u32x2){pack2(ov[0], ov[1]), pack2(ov[2], ov[3])};
    }
  }
}

DI void phase2(const Params& P, char* smem) {
  constexpr int N_SA = 128, N_PA = 8192, N_PB = 8192, N_SB = 128;
  for (int it = blockIdx.x; it < N_SA + N_PA + N_PB + N_SB; it += gridDim.x) {
    int u = it;
    if (u < N_SA) { attn_sample_item<0>(P, smem, u >> 3, u & 7); continue; }
    u -= N_SA;
    if (u < N_PA) { int qt = 31 - (u >> 8), bh = u & 255; attn_prompt_item<0>(P, smem, bh >> 3, bh & 7, qt); continue; }
    u -= N_PA;
    if (u < N_PB) { int qt = 31 - (u >> 8), bh = u & 255; attn_prompt_item<1>(P, smem, bh >> 3, bh & 7, qt); continue; }
    u -= N_PB;
    attn_sample_item<1>(P, smem, u >> 3, u & 7);
  }
}

DI void phase3_tile(const Params& P, int mt, int nt, char* smem) {
  const int tid = threadIdx.x, lane = tid & 63, w = tid >> 6, wm = w >> 1, wn = w & 1, r = lane & 15, quad = lane >> 4;
  const int m0 = mt * 128, n0 = nt * 128;
  char* ws = P.ws;
  const u16* YA = (const u16*)(ws + W_XB);
  const u16* YB = YA + (size_t)TT * 512;
  const u16* GA = (const u16*)(ws + W_GA);
  const u16* GB = (const u16*)(ws + W_GB);
  u16* MRG = (u16*)(ws + W_QKV);
  f32x4 acc[4][4];
  zero_acc(acc);
  gemm_mainloop(YA + (size_t)m0 * 512, 512, (const u16*)(ws + W_WUPA) + (size_t)n0 * 512, 512, 512, (u16*)smem, acc);
  float* Cs = (float*)smem;
  const int c4 = tid & 31, rsub = tid >> 5;
  const size_t tofs = (size_t)m0 * 1024 + n0 + c4 * 4;
  stage_acc(acc, Cs);
#pragma unroll 4
  for (int p = 0; p < 16; p++) {
    const int row = p * 8 + rsub;
    const f32x4 v = *(const f32x4*)(Cs + row * CSTR + c4 * 4);
    const f32x4 gv = unpack4(*(const u32x2*)(GA + tofs + (size_t)row * 1024));
    *(u32x2*)(MRG + tofs + (size_t)row * 1024) = pack4(v * gv);
  }
  zero_acc(acc);
  gemm_mainloop(YB + (size_t)m0 * 512, 512, (const u16*)(ws + W_WUPB) + (size_t)n0 * 512, 512, 512, (u16*)smem, acc);
  stage_acc(acc, Cs);
#pragma unroll 4
  for (int p = 0; p < 16; p++) {
    const int row = p * 8 + rsub;
    const f32x4 v = *(const f32x4*)(Cs + row * CSTR + c4 * 4);
    const f32x4 gv = unpack4(*(const u32x2*)(GB + tofs + (size_t)row * 1024));
    const f32x4 m1 = unpack4(*(const u32x2*)(MRG + tofs + (size_t)row * 1024));
    *(u32x2*)(MRG + tofs + (size_t)row * 1024) = pack4(m1 + v * gv);
  }
}

DI void phase4_tile(const Params& P, int mt, int nt, char* smem) {
  const int tid = threadIdx.x, lane = tid & 63, w = tid >> 6, wm = w >> 1, wn = w & 1, r = lane & 15, quad = lane >> 4;
  const int m0 = mt * 128, n0 = nt * 128;
  char* ws = P.ws;
  const u16* MRG = (const u16*)(ws + W_QKV);
  u16* H1B = (u16*)(ws + W_QKV + SZ_ACT);
  float* SSQ2 = (float*)(ws + W_SSQ2);
  f32x4 acc[4][4];
  zero_acc(acc);
  gemm_mainloop(MRG + (size_t)m0 * 1024, 1024, (const u16*)(ws + W_WOUT) + (size_t)n0 * 1024, 1024, 1024, (u16*)smem, acc);
  const float* xb = m0 < TP ? P.x_p : P.x_s - (size_t)TP * 1024;
  float* Cs = (float*)smem;
  const int c4 = tid & 31, rsub = tid >> 5;
  const size_t tofs = (size_t)m0 * 1024 + n0 + c4 * 4;
  stage_acc(acc, Cs);
#pragma unroll 4
  for (int p = 0; p < 16; p++) {
    const int row = p * 8 + rsub;
    const f32x4 v = *(const f32x4*)(Cs + row * CSTR + c4 * 4);
    const f32x4 h1 = *(const f32x4*)(xb + tofs + (size_t)row * 1024) + v;
    *(f32x4*)(P.out + tofs + (size_t)row * 1024) = h1;
    *(u32x2*)(H1B + tofs + (size_t)row * 1024) = pack4(h1);
    float ss = h1.x * h1.x + h1.y * h1.y + h1.z * h1.z + h1.w * h1.w;
    ss += __shfl_xor(ss, 1);
    ss += __shfl_xor(ss, 2);
    ss += __shfl_xor(ss, 4);
    ss += __shfl_xor(ss, 8);
    ss += __shfl_xor(ss, 16);
    if (c4 == 0) SSQ2[(size_t)(m0 + row) * 16 + nt] = ss;
  }
}

DI void phase5_tile(const Params& P, int mt, int nt, char* smem) {
  const int tid = threadIdx.x, lane = tid & 63, w = tid >> 6, wm = w >> 1, wn = w & 1, r = lane & 15, quad = lane >> 4;
  const int m0 = mt * 128, n0 = nt * 128;
  char* ws = P.ws;
  const u16* H1B = (const u16*)(ws + W_QKV + SZ_ACT);
  u16* QP = (u16*)(ws + W_QKV + 2 * SZ_ACT);
  const float* SSQ2 = (const float*)(ws + W_SSQ2);
  float* rs_s = (float*)(smem + RS_OFF);
  __syncthreads();
  if (tid < 128) {
    float s = 0.f;
#pragma unroll
    for (int i = 0; i < 8; i++) s += SSQ2[(size_t)(m0 + tid) * 16 + i];
    rs_s[tid] = rsqrtf(s * (1.f / 1024.f) + EPS);
  }
  f32x4 acc[4][4];
  zero_acc(acc);
  gemm_mainloop(H1B + (size_t)m0 * 1024, 1024, (const u16*)(ws + W_WQ) + (size_t)n0 * 1024, 1024, 1024, (u16*)smem, acc);
  float* Cs = (float*)smem;
  const int c4 = tid & 31, rsub = tid >> 5;
  const size_t tofs = (size_t)m0 * 1024 + n0 + c4 * 4;
  stage_acc(acc, Cs);
#pragma unroll 4
  for (int p = 0; p < 16; p++) {
    const int row = p * 8 + rsub;
    const f32x4 v = *(const f32x4*)(Cs + row * CSTR + c4 * 4) * rs_s[row];
    *(u32x2*)(QP + tofs + (size_t)row * 1024) = pack4(v);
  }
}

DI void bitonic_merge16(u32 (&L)[16]) {
#pragma unroll
  for (int st = 8; st >= 1; st >>= 1)
#pragma unroll
    for (int i = 0; i < 16; i++)
      if ((i & st) == 0) { u32 hi = max(L[i], L[i + st]); u32 lo = min(L[i], L[i + st]); L[i] = hi; L[i + st] = lo; }
}
DI void bitonic_sort16(u32 (&L)[16]) {
#pragma unroll
  for (int k = 2; k <= 16; k <<= 1)
#pragma unroll
    for (int j = k >> 1; j > 0; j >>= 1)
#pragma unroll
      for (int i = 0; i < 16; i++) {
        const int l = i ^ j;
        if (l > i) {
          const u32 hi = max(L[i], L[l]), lo = min(L[i], L[l]);
          if ((i & k) == 0) { L[i] = hi; L[l] = lo; } else { L[i] = lo; L[l] = hi; }
        }
      }
}
DI void phase6a_unit(const Params& P, int unit, char* smem) {
  const int tid = threadIdx.x, lane = tid & 63, w = tid >> 6, r = lane & 15, quad = lane >> 4;
  char* ws = P.ws;
  const u16* QP = (const u16*)(ws + W_QKV + 2 * SZ_ACT);
  const u16* SK = (const u16*)(ws + W_SK);
  u16* IDXo = (u16*)(ws + W_IDX);
  float* Go = (float*)(ws + W_G);
  float* sc = (float*)smem;
  u32* hl = (u32*)smem;
  u32* xl = (u32*)smem + 256 * 17;
  u32* lists = (u32*)(smem + 128 * 129 * 4);
  unsigned char* tabi = (unsigned char*)(smem + 128 * 129 * 4 + 128 * 17 * 4);
  unsigned char* tabj = tabi + 64;
  const int tok0 = unit * 64;
  __syncthreads();
  if (tid == 0) {
    int c = 0;
    for (int i = 0; i < 16; i++)
      for (int j = i + 1; j < 16; j++)
        if ((i + 1) * (j + 1) <= 16) { tabi[c] = (unsigned char)i; tabj[c] = (unsigned char)j; tabi[32 + c] = (unsigned char)j; tabj[32 + c] = (unsigned char)i; c++; }
    tabi[23] = 0; tabj[23] = 0; tabi[24] = 1; tabj[24] = 1;
    tabi[55] = 2; tabj[55] = 2; tabi[56] = 3; tabj[56] = 3;
  }
  for (int h = 0; h < 8; h++) {
#pragma unroll
    for (int p = 0; p < 2; p++) {
      const int hp = h * 2 + p;
      bf16x8 qf[2];
#pragma unroll
      for (int ks = 0; ks < 2; ks++)
        qf[ks] = *(const bf16x8*)(QP + (size_t)(tok0 + w * 16 + r) * 1024 + hp * 64 + ks * 32 + quad * 8);
#pragma unroll
      for (int nt = 0; nt < 8; nt++) {
        f32x4 a4 = (f32x4){0.f, 0.f, 0.f, 0.f};
#pragma unroll
        for (int ks = 0; ks < 2; ks++) {
          bf16x8 kf = *(const bf16x8*)(SK + (size_t)(hp * 128 + nt * 16 + r) * 64 + ks * 32 + quad * 8);
          a4 = mfma16(kf, qf[ks], a4);
        }
        float* d = sc + (p * 64 + w * 16 + r) * 129 + nt * 16 + quad * 4;
        d[0] = a4[0]; d[1] = a4[1]; d[2] = a4[2]; d[3] = a4[3];
      }
    }
    __syncthreads();
    u32 L[16];
    {
      const int inst = tid & 127, half = tid >> 7;
      const float* row = sc + inst * 129 + half * 64;
#pragma unroll
      for (int i = 0; i < 16; i++) L[i] = (mono(row[i]) & ~127u) | (u32)(half * 64 + i);
      bitonic_sort16(L);
#pragma unroll 1
      for (int c = 1; c < 4; c++) {
        u32 N[16];
#pragma unroll
        for (int i = 0; i < 16; i++) N[i] = (mono(row[c * 16 + i]) & ~127u) | (u32)(half * 64 + c * 16 + i);
        bitonic_sort16(N);
#pragma unroll
        for (int i = 0; i < 16; i++) L[i] = max(L[i], N[15 - i]);
        bitonic_merge16(L);
      }
    }
    __syncthreads();
#pragma unroll
    for (int s = 0; s < 16; s++) hl[tid * 17 + s] = L[s];
    __syncthreads();
    if (tid < 128) {
      u32 M[16];
#pragma unroll
      for (int s = 0; s < 16; s++) M[s] = max(L[s], hl[(tid + 128) * 17 + 15 - s]);
      bitonic_merge16(M);
#pragma unroll
      for (int s = 0; s < 16; s++) lists[tid * 17 + s] = M[s];
    }
    __syncthreads();
    if (tid < 128) {
      const int tok = tid & 63;
      const bool part = tid >= 64;
      float fa[16], fb[16];
#pragma unroll
      for (int s = 0; s < 16; s++) {
        const float va = unmono(lists[tok * 17 + s] & ~127u);
        const float vb = unmono(lists[(64 + tok) * 17 + s] & ~127u);
        fa[s] = part ? vb : va;
        fb[s] = part ? va : vb;
      }
      u32 L2[16];
#pragma unroll
      for (int s = 0; s < 16; s++) L2[s] = 0u;
      const u32 cbase = part ? 32u : 0u;
      {
        int c = 0;
#pragma unroll
        for (int i = 0; i < 16; i++)
#pragma unroll
          for (int j = i + 1; j < 16; j++)
            if ((i + 1) * (j + 1) <= 16) {
              insert16(L2, (mono(fa[i] + fb[j]) & ~63u) | (cbase + (u32)c));
              c++;
            }
      }
      insert16(L2, (mono(part ? fa[2] + fb[2] : fa[0] + fb[0]) & ~63u) | (cbase + 23u));
      insert16(L2, (mono(part ? fa[3] + fb[3] : fa[1] + fb[1]) & ~63u) | (cbase + 24u));
#pragma unroll
      for (int s = 0; s < 16; s++) xl[tid * 17 + s] = L2[s];
    }
    __syncthreads();
    if (tid < 64) {
      float val[16];
      u32 idx[16];
      float mx = -1e30f;
#pragma unroll
      for (int s = 0; s < 16; s++) {
        const u32 m = max(xl[tid * 17 + s], xl[(tid + 64) * 17 + 15 - s]);
        const u32 sl = m & 63u;
        const int i = tabi[sl], j = tabj[sl];
        const u32 au = lists[tid * 17 + i], bu = lists[(64 + tid) * 17 + j];
        val[s] = unmono(au & ~127u) + unmono(bu & ~127u);
        idx[s] = (au & 127u) * 128u + (bu & 127u);
        mx = fmaxf(mx, val[s]);
      }
      float sum = 0.f;
#pragma unroll
      for (int s = 0; s < 16; s++) { val[s] = __expf(val[s] - mx); sum += val[s]; }
      const float inv = 1.f / sum;
      const size_t so = ((size_t)(tok0 + tid) * 8 + h) * 16;
      {
        u32* ib = (u32*)(IDXo + (size_t)(tok0 + tid) * 128 + h * 2);
#pragma unroll
        for (int gg = 0; gg < 8; gg++) ib[gg * 8] = idx[gg] | (idx[gg + 8] << 16);
      }
#pragma unroll
      for (int s = 0; s < 4; s++)
        *(f32x4*)(Go + so + s * 4) = (f32x4){val[s * 4] * inv, val[s * 4 + 1] * inv, val[s * 4 + 2] * inv, val[s * 4 + 3] * inv};
    }
    __syncthreads();
  }
}

typedef float f32x2 __attribute__((ext_vector_type(2)));
DI float dot4_fp8(u32 w, float x0, float x1, float x2, float x3, float acc) {
  f32x2 lo = __builtin_amdgcn_cvt_pk_f32_fp8((int)w, false);
  f32x2 hi = __builtin_amdgcn_cvt_pk_f32_fp8((int)w, true);
  acc = fmaf(lo[0], x0, acc);
  acc = fmaf(lo[1], x1, acc);
  acc = fmaf(hi[0], x2, acc);
  acc = fmaf(hi[1], x3, acc);
  return acc;
}
DI void axpy4_fp8(u32 w, float wgt, float& o0, float& o1, float& o2, float& o3) {
  f32x2 lo = __builtin_amdgcn_cvt_pk_f32_fp8((int)w, false);
  f32x2 hi = __builtin_amdgcn_cvt_pk_f32_fp8((int)w, true);
  o0 = fmaf(wgt, lo[0], o0);
  o1 = fmaf(wgt, lo[1], o1);
  o2 = fmaf(wgt, hi[0], o2);
  o3 = fmaf(wgt, hi[1], o3);
}

struct RowSet { u32x4 r[16]; };
DI void gather_rows(RowSet& R, const unsigned char* base, u32 lofs, u32x4 ea, u32x4 eb) {
  const u32 ev[8] = {ea.x, ea.y, ea.z, ea.w, eb.x, eb.y, eb.z, eb.w};
#pragma unroll
  for (int i = 0; i < 8; i++) {
    R.r[2 * i] = *(const u32x4*)(base + (((ev[i] & 0xffffu) << 7) + lofs));
    R.r[2 * i + 1] = *(const u32x4*)(base + (((ev[i] >> 16) << 7) + lofs));
  }
}
DI void b1_compute(const RowSet& R, u32x4 xa, u32x4 xb, float* pr, int c, bool valid) {
  float xf[16];
  xf[0] = __uint_as_float(xa.x << 16); xf[1] = __uint_as_float(xa.x & 0xffff0000u);
  xf[2] = __uint_as_float(xa.y << 16); xf[3] = __uint_as_float(xa.y & 0xffff0000u);
  xf[4] = __uint_as_float(xa.z << 16); xf[5] = __uint_as_float(xa.z & 0xffff0000u);
  xf[6] = __uint_as_float(xa.w << 16); xf[7] = __uint_as_float(xa.w & 0xffff0000u);
  xf[8] = __uint_as_float(xb.x << 16); xf[9] = __uint_as_float(xb.x & 0xffff0000u);
  xf[10] = __uint_as_float(xb.y << 16); xf[11] = __uint_as_float(xb.y & 0xffff0000u);
  xf[12] = __uint_as_float(xb.z << 16); xf[13] = __uint_as_float(xb.z & 0xffff0000u);
  xf[14] = __uint_as_float(xb.w << 16); xf[15] = __uint_as_float(xb.w & 0xffff0000u);
  float p[16];
#pragma unroll
  for (int i = 0; i < 16; i++) {
    float a = dot4_fp8(R.r[i].x, xf[0], xf[1], xf[2], xf[3], 0.f);
    a = dot4_fp8(R.r[i].y, xf[4], xf[5], xf[6], xf[7], a);
    a = dot4_fp8(R.r[i].z, xf[8], xf[9], xf[10], xf[11], a);
    a = dot4_fp8(R.r[i].w, xf[12], xf[13], xf[14], xf[15], a);
    p[i] = a;
  }
#pragma unroll
  for (int i = 0; i < 8; i++) { float keep = (c & 4) ? p[i + 8] : p[i]; float send = (c & 4) ? p[i] : p[i + 8]; p[i] = keep + __shfl_xor(send, 4); }
#pragma unroll
  for (int i = 0; i < 4; i++) { float keep = (c & 2) ? p[i + 4] : p[i]; float send = (c & 2) ? p[i] : p[i + 4]; p[i] = keep + __shfl_xor(send, 2); }
#pragma unroll
  for (int i = 0; i < 2; i++) { float keep = (c & 1) ? p[i + 2] : p[i]; float send = (c & 1) ? p[i] : p[i + 2]; p[i] = keep + __shfl_xor(send, 1); }
  const int it0 = 2 * (c & 1) + 4 * ((c >> 1) & 1) + 8 * ((c >> 2) & 1);
  if (valid) {
    pr[it0 * 8] = p[0];
    pr[(it0 + 1) * 8] = p[1];
  }
}
DI void phase6b1(const Params& P) {
  const int lane = threadIdx.x & 63, g = lane >> 3, c = lane & 7;
  const int x = blockIdx.x & 7;
  const int wg = (blockIdx.x >> 3) * 4 + (threadIdx.x >> 6), nwg = (gridDim.x >> 3) * 4;
  char* ws = P.ws;
  const u16* H1B = (const u16*)(ws + W_QKV + SZ_ACT) + x * 128 + c * 16;
  const unsigned char* U8 = (const unsigned char*)(ws + W_UB) + ((size_t)x << 21);
  const u32 lofs = c * 16;
  const u16* IDX = (const u16*)(ws + W_IDX) + g * 16;
  float* PH = ph_slice(ws, x) + g;
  const int n = (TT - wg + nwg - 1) / nwg;
#define TOK(i) min(wg + (i) * nwg, TT - 1)
  int t0 = TOK(0), t1 = TOK(1);
  u32x4 eA0 = *(const u32x4*)(IDX + (size_t)t0 * 128), eA1 = *(const u32x4*)(IDX + (size_t)t0 * 128 + 8);
  u32x4 eB0 = *(const u32x4*)(IDX + (size_t)t1 * 128), eB1 = *(const u32x4*)(IDX + (size_t)t1 * 128 + 8);
  RowSet RA, RB;
  gather_rows(RA, U8, lofs, eA0, eA1);
  u32x4 xA0 = *(const u32x4*)(H1B + (size_t)t0 * 1024), xA1 = *(const u32x4*)(H1B + (size_t)t0 * 1024 + 8);
#pragma unroll 1
  for (int i = 0; i < n; i += 2) {
    gather_rows(RB, U8, lofs, eB0, eB1);
    const u32x4 xB0 = *(const u32x4*)(H1B + (size_t)t1 * 1024), xB1 = *(const u32x4*)(H1B + (size_t)t1 * 1024 + 8);
    const int t2 = TOK(i + 2);
    eA0 = *(const u32x4*)(IDX + (size_t)t2 * 128);
    eA1 = *(const u32x4*)(IDX + (size_t)t2 * 128 + 8);
    b1_compute(RA, xA0, xA1, PH + (size_t)t0 * 128, c, true);
    gather_rows(RA, U8, lofs, eA0, eA1);
    xA0 = *(const u32x4*)(H1B + (size_t)t2 * 1024);
    xA1 = *(const u32x4*)(H1B + (size_t)t2 * 1024 + 8);
    const int t3 = TOK(i + 3);
    eB0 = *(const u32x4*)(IDX + (size_t)t3 * 128);
    eB1 = *(const u32x4*)(IDX + (size_t)t3 * 128 + 8);
    b1_compute(RB, xB0, xB1, PH + (size_t)t1 * 128, c, i + 1 < n);
    t0 = t2;
    t1 = t3;
  }
}

DI void phase6w(const Params& P) {
  const int lane = threadIdx.x & 63;
  const int gw = blockIdx.x * 4 + (threadIdx.x >> 6), nw = gridDim.x * 4;
  char* ws = P.ws;
  float* G = (float*)(ws + W_G);
  const float* SSQ2 = (const float*)(ws + W_SSQ2);
  for (int t = gw; t < TT; t += nw) {
    float ssq = lane < 8 ? SSQ2[(size_t)t * 16 + lane] : 0.f;
    float h0 = 0.f, h1v = 0.f;
    {
      const float* ph = (const float*)(ws + W_XB) + (size_t)t * 128 + lane;
#pragma unroll
      for (int xs = 0; xs < 4; xs++) { h0 += ph[(size_t)xs * (SZ_PH / 4)]; h1v += ph[(size_t)xs * (SZ_PH / 4) + 64]; }
      ph = (const float*)(ws + W_GB) + (size_t)t * 128 + lane;
#pragma unroll
      for (int xs = 0; xs < 4; xs++) { h0 += ph[(size_t)xs * (SZ_PH / 4)]; h1v += ph[(size_t)xs * (SZ_PH / 4) + 64]; }
    }
    const float g0 = G[(size_t)t * 128 + lane];
    const float g1 = G[(size_t)t * 128 + 64 + lane];
    const float rs2 = rsqrtf(wave_sum(ssq) * (1.f / 1024.f) + EPS);
    const float w0 = g0 * gelu_tanh(rs2 * (1.f / U_SCALE) * h0) * (1.f / V_SCALE);
    const float w1 = g1 * gelu_tanh(rs2 * (1.f / U_SCALE) * h1v) * (1.f / V_SCALE);
    u16* wrow = (u16*)(G + (size_t)t * 128);
    wrow[(lane & 7) * 16 + (lane >> 3)] = f2bf(w0);
    wrow[(lane & 7) * 16 + 8 + (lane >> 3)] = f2bf(w1);
  }
}

DI void b2_compute(const RowSet& R, u32x4 w0, u32x4 w1, float* hp, u16* hb, float* sq, int g, int lane, bool valid) {
  const f32x2 hv = *(const f32x2*)hp;
  const u32 wv[8] = {w0.x, w0.y, w0.z, w0.w, w1.x, w1.y, w1.z, w1.w};
  float o[16];
#pragma unroll
  for (int i = 0; i < 16; i++) o[i] = 0.f;
#pragma unroll
  for (int i = 0; i < 16; i++) {
    u32 r0 = R.r[i].x, r1 = R.r[i].y, r2 = R.r[i].z, r3 = R.r[i].w;
    asm volatile("" : "+v"(r0), "+v"(r1), "+v"(r2), "+v"(r3) : "v"(o[0]), "v"(o[15]));
    const float wgt = (i & 1) ? __uint_as_float(wv[i >> 1] & 0xffff0000u) : __uint_as_float(wv[i >> 1] << 16);
    axpy4_fp8(r0, wgt, o[0], o[1], o[2], o[3]);
    axpy4_fp8(r1, wgt, o[4], o[5], o[6], o[7]);
    axpy4_fp8(r2, wgt, o[8], o[9], o[10], o[11]);
    axpy4_fp8(r3, wgt, o[12], o[13], o[14], o[15]);
  }
#pragma unroll
  for (int i = 0; i < 8; i++) { float keep = (g & 4) ? o[i + 8] : o[i]; float send = (g & 4) ? o[i] : o[i + 8]; o[i] = keep + __shfl_xor(send, 32); }
#pragma unroll
  for (int i = 0; i < 4; i++) { float keep = (g & 2) ? o[i + 4] : o[i]; float send = (g & 2) ? o[i] : o[i + 4]; o[i] = keep + __shfl_xor(send, 16); }
#pragma unroll
  for (int i = 0; i < 2; i++) { float keep = (g & 1) ? o[i + 2] : o[i]; float send = (g & 1) ? o[i] : o[i + 2]; o[i] = keep + __shfl_xor(send, 8); }
  const float a0 = hv.x + o[0], a1 = hv.y + o[1];
  const float ss = wave_sum(a0 * a0 + a1 * a1);
  if (valid) {
    *(f32x2*)hp = (f32x2){a0, a1};
    *(u32*)hb = pack2(a0, a1);
    if (lane == 0) *sq = ss;
  }
}
DI void phase6b2(const Params& P) {
  const int lane = threadIdx.x & 63, g = lane >> 3, c = lane & 7, w = threadIdx.x >> 6;
  const int x = blockIdx.x & 7;
  const int wg = (blockIdx.x >> 3) * 4 + w, nwg = (gridDim.x >> 3) * 4;
  char* ws = P.ws;
  const int col = x * 128 + c * 16 + 2 * (g & 1) + 4 * ((g >> 1) & 1) + 8 * ((g >> 2) & 1);
  u16* H1B = (u16*)(ws + W_QKV + SZ_ACT) + col;
  float* OUT = P.out + col;
  const unsigned char* V8 = (const unsigned char*)(ws + W_VB) + ((size_t)x << 21);
  const u32 lofs = c * 16;
  const u16* IDX = (const u16*)(ws + W_IDX) + g * 16;
  const u16* WG = (const u16*)(ws + W_G) + g * 16;
  float* SSQ3 = (float*)(ws + W_SSQ3) + x;
  const int n = (TT - wg + nwg - 1) / nwg;
  int t0 = TOK(0), t1 = TOK(1);
  u32x4 eA0 = *(const u32x4*)(IDX + (size_t)t0 * 128), eA1 = *(const u32x4*)(IDX + (size_t)t0 * 128 + 8);
  u32x4 eB0 = *(const u32x4*)(IDX + (size_t)t1 * 128), eB1 = *(const u32x4*)(IDX + (size_t)t1 * 128 + 8);
  RowSet RA, RB;
  gather_rows(RA, V8, lofs, eA0, eA1);
  u32x4 wA0 = *(const u32x4*)(WG + (size_t)t0 * 256), wA1 = *(const u32x4*)(WG + (size_t)t0 * 256 + 8);
#pragma unroll 1
  for (int i = 0; i < n; i += 2) {
    gather_rows(RB, V8, lofs, eB0, eB1);
    const u32x4 wB0 = *(const u32x4*)(WG + (size_t)t1 * 256), wB1 = *(const u32x4*)(WG + (size_t)t1 * 256 + 8);
    const int t2 = TOK(i + 2);
    eA0 = *(const u32x4*)(IDX + (size_t)t2 * 128);
    eA1 = *(const u32x4*)(IDX + (size_t)t2 * 128 + 8);
    b2_compute(RA, wA0, wA1, OUT + (size_t)t0 * 1024, H1B + (size_t)t0 * 1024, SSQ3 + (size_t)t0 * 8, g, lane, true);
    gather_rows(RA, V8, lofs, eA0, eA1);
    wA0 = *(const u32x4*)(WG + (size_t)t2 * 256);
    wA1 = *(const u32x4*)(WG + (size_t)t2 * 256 + 8);
    const int t3 = TOK(i + 3);
    eB0 = *(const u32x4*)(IDX + (size_t)t3 * 128);
    eB1 = *(const u32x4*)(IDX + (size_t)t3 * 128 + 8);
    b2_compute(RB, wB0, wB1, OUT + (size_t)t1 * 1024, H1B + (size_t)t1 * 1024, SSQ3 + (size_t)t1 * 8, g, lane, i + 1 < n);
    t0 = t2;
    t1 = t3;
  }
#undef TOK
}

DI void phase7_tile(const Params& P, int mt, int nt, char* smem) {
  const int tid = threadIdx.x, lane = tid & 63, w = tid >> 6, wm = w >> 1, wn = w & 1, r = lane & 15, quad = lane >> 4;
  const int m0 = mt * 128, n0 = nt * 128;
  char* ws = P.ws;
  const u16* H2B = (const u16*)(ws + W_QKV + SZ_ACT);
  const u16* PB = (const u16*)(ws + W_PB);
  const float* SSQ3 = (const float*)(ws + W_SSQ3);
  float* rs_s = (float*)(smem + RS_OFF);
  __syncthreads();
  if (tid < 128) {
    float q = 0.f;
#pragma unroll
    for (int i = 0; i < 8; i++) q += SSQ3[(size_t)(m0 + tid) * 8 + i];
    rs_s[tid] = rsqrtf(q * (1.f / 1024.f) + EPS);
  }
  u16* PJ = (u16*)(ws + W_QKV);
  f32x4 acc[4][4];
  zero_acc(acc);
  gemm_mainloop(PB + (size_t)m0 * 256, 256, (const u16*)(ws + W_WPP) + (size_t)n0 * 256, 256, 256, (u16*)smem, acc);
  float* Cs = (float*)smem;
  const int c4 = tid & 31, rsub = tid >> 5;
  const size_t tofs = (size_t)m0 * 1024 + n0 + c4 * 4;
  stage_acc(acc, Cs);
#pragma unroll 4
  for (int p = 0; p < 16; p++) {
    const int row = p * 8 + rsub;
    *(u32x2*)(PJ + tofs + (size_t)row * 1024) = pack4(*(const f32x4*)(Cs + row * CSTR + c4 * 4));
  }
  zero_acc(acc);
  gemm_mainloop(H2B + (size_t)m0 * 1024, 1024, (const u16*)(ws + W_WG) + (size_t)n0 * 1024, 1024, 1024, (u16*)smem, acc);
  stage_acc(acc, Cs);
#pragma unroll 4
  for (int p = 0; p < 16; p++) {
    const int row = p * 8 + rsub;
    const f32x4 v = *(const f32x4*)(Cs + row * CSTR + c4 * 4) * rs_s[row];
    const f32x4 pj = unpack4(*(const u32x2*)(PJ + tofs + (size_t)row * 1024));
    const f32x4 h2 = *(const f32x4*)(P.out + tofs + (size_t)row * 1024);
    const f32x4 gate = (f32x4){sigmoidf_(v.x), sigmoidf_(v.y), sigmoidf_(v.z), sigmoidf_(v.w)};
    *(f32x4*)(P.out + tofs + (size_t)row * 1024) = h2 + gate * pj;
  }
}

#define GEMM_TILES(NT, FN)                                                              \
  {                                                                                     \
    for (int t = blockIdx.x; t < 2 * (NT); t += gridDim.x) FN(P, 512 + t / (NT), t % (NT), smem); \
    const int x_ = blockIdx.x & 7, bpx_ = gridDim.x >> 3;                               \
    constexpr int NG_ = (NT) / 8;                                                       \
    for (int s_ = blockIdx.x >> 3; s_ < 64 * 8 * NG_; s_ += bpx_) {                     \
      const int R_ = s_ >> 6, q_ = s_ & 63;                                             \
      const int mg_ = R_ / NG_, ng_ = R_ % NG_;                                         \
      FN(P, ((mg_ * 8 + (q_ >> 3)) << 3) + x_, ng_ * 8 + (q_ & 7), smem);               \
    }                                                                                   \
  }

__global__ void __launch_bounds__(256, 2) fwd_megakernel(Params P) {
  __shared__ __attribute__((aligned(16))) char smem[SMEM_BYTES];
  cg::grid_group grid = cg::this_grid();
  phase0(P, smem);
  grid.sync();
  phase1_scans(P);
  GEMM_TILES(40, phase1_tile)
  grid.sync();
  phase2(P, smem);
  grid.sync();
  GEMM_TILES(8, phase3_tile)
  grid.sync();
  GEMM_TILES(8, phase4_tile)
  grid.sync();
  GEMM_TILES(8, phase5_tile)
  grid.sync();
  for (int t = blockIdx.x; t < TT / 64; t += gridDim.x) phase6a_unit(P, t, smem);
  grid.sync();
  phase6b1(P);
  grid.sync();
  phase6w(P);
  grid.sync();
  phase6b2(P);
  grid.sync();
  GEMM_TILES(8, phase7_tile)
}

extern "C" void kernel_launch(void* const* d_in, const int* in_sizes, int n_in, void* d_out, int out_size, void* d_ws,
                              size_t ws_size, hipStream_t stream) {
  static int grid_blocks = 0;
  if (!grid_blocks) {
    int dev = 0, cus = 0, per_cu = 0;
    hipGetDevice(&dev);
    hipDeviceGetAttribute(&cus, hipDeviceAttributeMultiprocessorCount, dev);
    hipOccupancyMaxActiveBlocksPerMultiprocessor(&per_cu, fwd_megakernel, 256, 0);
    if (per_cu > 2) per_cu = 2;
    if (per_cu < 1) per_cu = 1;
    grid_blocks = cus * per_cu;
  }
  if (ws_size < W_END) { fprintf(stderr, "workspace too small: %zu < %zu\n", ws_size, (size_t)W_END); return; }
  Params p{};
  const float** pf = (const float**)&p;
  for (int i = 0; i < 28; i++) pf[i] = (const float*)d_in[i];
  p.out = (float*)d_out;
  p.ws = (char*)d_ws;
  void* args[] = {&p};
  hipError_t e = hipLaunchCooperativeKernel((void*)fwd_megakernel, dim3(grid_blocks), dim3(256), args, 0, stream);
  if (e != hipSuccess) fprintf(stderr, "cooperative launch failed: %s (grid %d)\n", hipGetErrorString(e), grid_blocks);
}
```

```cpp
#include <hip/hip_runtime.h>
#include <hip/hip_cooperative_groups.h>
#include <cstdio>
namespace cg = cooperative_groups;

typedef unsigned short u16;
typedef unsigned int u32;
typedef short bf16x8 __attribute__((ext_vector_type(8)));
typedef short s16x4 __attribute__((ext_vector_type(4)));
typedef float f32x4 __attribute__((ext_vector_type(4)));
typedef unsigned int u32x4 __attribute__((ext_vector_type(4)));
typedef unsigned int u32x2 __attribute__((ext_vector_type(2)));
typedef __bf16 bf16x2_t __attribute__((ext_vector_type(2)));

#define DI __device__ __forceinline__
#define LAUNDER(x) asm volatile("" : "+v"(x))

constexpr int TP = 65536, TS = 256, TT = TP + TS;
constexpr float LOG2E = 1.4426950408889634f;
constexpr float EPS = 1e-6f;
constexpr float U_SCALE = 1024.f, V_SCALE = 128.f;

constexpr size_t O_AK_P = 67371008, O_AV_P = 100925440, O_AF_P = 134479872, O_BK_P = 135004160,
                 O_BV_P = 143392768, O_AK_S = 151781376, O_AV_S = 151912448, O_AF_S = 152043520,
                 O_BK_S = 152045568, O_BV_S = 152176640;

constexpr size_t SZ_ACT = (size_t)TT * 1024 * 2;
constexpr size_t SZ_HALF = (size_t)TT * 512 * 2;
constexpr size_t W_XB = 0;
constexpr size_t W_QKV = SZ_ACT;
constexpr size_t W_GA = W_QKV + 6 * SZ_HALF;
constexpr size_t W_GB = W_GA + SZ_ACT;
constexpr size_t W_PB = W_GB + SZ_ACT;
constexpr size_t W_WIN = W_PB + (size_t)TT * 256 * 2;
constexpr size_t W_WUPA = W_WIN + (size_t)5120 * 1024 * 2;
constexpr size_t W_WUPB = W_WUPA + 1024 * 512 * 2;
constexpr size_t W_WOUT = W_WUPB + 1024 * 512 * 2;
constexpr size_t W_WQ = W_WOUT + 1024 * 1024 * 2;
constexpr size_t W_WG = W_WQ + 1024 * 1024 * 2;
constexpr size_t W_WPP = W_WG + 1024 * 1024 * 2;
constexpr size_t W_UB = W_WPP + 1024 * 256 * 2;
constexpr size_t W_VB = W_UB + (size_t)16384 * 1024 * 2;
constexpr size_t W_SK = W_VB + (size_t)16384 * 1024 * 2;
constexpr size_t W_RS1 = W_SK + 131072 * 2;
constexpr size_t W_SSQ2 = W_RS1 + (size_t)TT * 4;
constexpr size_t W_RS3 = W_SSQ2 + (size_t)TT * 64;
constexpr size_t W_CUMP = W_RS3 + (size_t)TT * 4;
constexpr size_t W_CUMS = W_CUMP + (size_t)256 * 2048 * 4;
constexpr size_t W_SSQ3 = W_CUMS + (size_t)128 * 4112 * 4 + 1024;
constexpr size_t W_END = W_SSQ3 + (size_t)TT * 8 * 4;
constexpr size_t W_IDX = W_GA;
constexpr size_t W_G = W_GA + (size_t)32 * 1024 * 1024;
constexpr size_t SZ_PH = (size_t)TT * 128 * 4;


struct Params {
  const float *x_p, *x_s, *cak, *cav, *caf, *cbk, *cbv, *p_p, *p_s, *g_mix, *w_in, *b_f, *qn_a, *kn_a,
      *qn_b, *kn_b, *relb, *w_up_a, *w_up_b, *w_out, *g_ffn, *peer_wq, *peer_sk, *peer_u, *peer_v, *g_ple,
      *w_gate, *w_proj;
  float* out;
  char* ws;
};

constexpr int SMEM_BYTES = 128 * 129 * 4 + 2 * 64 * 17 * 4 + 256;

DI float* ph_slice(char* ws, int x) { return (float*)(ws + (x < 4 ? W_XB + (size_t)x * SZ_PH : W_GB + (size_t)(x - 4) * SZ_PH)); }
DI u16 f2bf(float x) { return __builtin_bit_cast(u16, (__bf16)x); }
DI float bf2f(u16 h) { return __uint_as_float(((u32)h) << 16); }
DI u32 pack2(float a, float b) { bf16x2_t v = {(__bf16)a, (__bf16)b}; return __builtin_bit_cast(u32, v); }
DI float wave_sum(float v) {
#pragma unroll
  for (int o = 32; o; o >>= 1) v += __shfl_xor(v, o);
  return v;
}
DI f32x4 mfma16(bf16x8 a, bf16x8 b, f32x4 c) { return __builtin_amdgcn_mfma_f32_16x16x32_bf16(a, b, c, 0, 0, 0); }
DI float sigmoidf_(float x) { return 1.f / (1.f + __expf(-x)); }
DI u32 mono(float x) { u32 u = __float_as_uint(x); u32 m = (u32)((int)u >> 31) | 0x80000000u; return u ^ m; }
DI float unmono(u32 k) { u32 m = ((k >> 31) - 1u) | 0x80000000u; return __uint_as_float(k ^ m); }
DI void insert16(u32 (&L)[16], u32 x) {
#pragma unroll
  for (int s = 0; s < 16; s++) { u32 mx = max(L[s], x); x = min(L[s], x); L[s] = mx; }
}
DI float gelu_tanh(float x) {
  float u = 0.7978845608028654f * (x + 0.044715f * x * x * x);
  float t = 1.f - 2.f / (1.f + __expf(2.f * u));
  return 0.5f * x * (1.f + t);
}

constexpr int GSTR = 72;
constexpr int GBUF = 2 * 128 * GSTR;
constexpr int RS_OFF = 2 * GBUF * 2;
DI void gemm_compute(const u16* As, const u16* Bs, f32x4 (&acc)[4][4], int wm, int wn, int r, int quad) {
#pragma unroll
  for (int ks = 0; ks < 2; ks++) {
    bf16x8 af[4], bfr[4];
#pragma unroll
    for (int mi = 0; mi < 4; mi++) af[mi] = *(const bf16x8*)(As + (wm * 64 + mi * 16 + r) * GSTR + ks * 32 + quad * 8);
#pragma unroll
    for (int ni = 0; ni < 4; ni++) bfr[ni] = *(const bf16x8*)(Bs + (wn * 64 + ni * 16 + r) * GSTR + ks * 32 + quad * 8);
#pragma unroll
    for (int mi = 0; mi < 4; mi++)
#pragma unroll
      for (int ni = 0; ni < 4; ni++) acc[mi][ni] = mfma16(af[mi], bfr[ni], acc[mi][ni]);
    if (ks == 0) __builtin_amdgcn_sched_barrier(0);
  }
}
DI void gemm_mainloop(const u16* __restrict__ A, int lda, const u16* __restrict__ B, int ldb, int K, u16* smem,
                      f32x4 (&acc)[4][4]) {
  const int tid = threadIdx.x, lane = tid & 63, w = tid >> 6, wm = w >> 1, wn = w & 1, r = lane & 15, quad = lane >> 4;
  u16* As0 = smem;
  u16* Bs0 = smem + 128 * GSTR;
  u16* As1 = smem + GBUF;
  u16* Bs1 = As1 + 128 * GSTR;
  u32x4 r0a[4], r0b[4], r1a[4], r1b[4];
  const int lrow = tid >> 3, lch = tid & 7;
  const u16* ap = A + (size_t)lrow * lda + lch * 8;
  const u16* bp = B + (size_t)lrow * ldb + lch * 8;
  const int lo = lrow * GSTR + lch * 8;
  const int nk = K >> 6, km = nk - 1;
  const int krot = 0;
#define KOFF(kt) ((((kt) + krot) & km) * 64)
#pragma unroll
  for (int i = 0; i < 4; i++) {
    r0a[i] = *(const u32x4*)(ap + (size_t)i * 32 * lda + KOFF(0));
    r0b[i] = *(const u32x4*)(bp + (size_t)i * 32 * ldb + KOFF(0));
  }
#pragma unroll
  for (int i = 0; i < 4; i++) {
    r1a[i] = *(const u32x4*)(ap + (size_t)i * 32 * lda + KOFF(1));
    r1b[i] = *(const u32x4*)(bp + (size_t)i * 32 * ldb + KOFF(1));
  }
  __syncthreads();
#pragma unroll 1
  for (int kt = 0; kt < nk - 2; kt += 2) {
#pragma unroll
    for (int i = 0; i < 4; i++) {
      *(u32x4*)(As0 + lo + i * 32 * GSTR) = r0a[i];
      *(u32x4*)(Bs0 + lo + i * 32 * GSTR) = r0b[i];
    }
    __syncthreads();
    {
      const int ko = KOFF(kt + 2);
#pragma unroll
      for (int i = 0; i < 4; i++) {
        r0a[i] = *(const u32x4*)(ap + (size_t)i * 32 * lda + ko);
        r0b[i] = *(const u32x4*)(bp + (size_t)i * 32 * ldb + ko);
      }
    }
    gemm_compute(As0, Bs0, acc, wm, wn, r, quad);
#pragma unroll
    for (int i = 0; i < 4; i++) {
      *(u32x4*)(As1 + lo + i * 32 * GSTR) = r1a[i];
      *(u32x4*)(Bs1 + lo + i * 32 * GSTR) = r1b[i];
    }
    __syncthreads();
    {
      const int ko = KOFF(kt + 3);
#pragma unroll
      for (int i = 0; i < 4; i++) {
        r1a[i] = *(const u32x4*)(ap + (size_t)i * 32 * lda + ko);
        r1b[i] = *(const u32x4*)(bp + (size_t)i * 32 * ldb + ko);
      }
    }
    gemm_compute(As1, Bs1, acc, wm, wn, r, quad);
  }
#pragma unroll
  for (int i = 0; i < 4; i++) {
    *(u32x4*)(As0 + lo + i * 32 * GSTR) = r0a[i];
    *(u32x4*)(Bs0 + lo + i * 32 * GSTR) = r0b[i];
  }
  __syncthreads();
  gemm_compute(As0, Bs0, acc, wm, wn, r, quad);
#pragma unroll
  for (int i = 0; i < 4; i++) {
    *(u32x4*)(As1 + lo + i * 32 * GSTR) = r1a[i];
    *(u32x4*)(Bs1 + lo + i * 32 * GSTR) = r1b[i];
  }
  __syncthreads();
  gemm_compute(As1, Bs1, acc, wm, wn, r, quad);
#undef KOFF
}

DI void zero_acc(f32x4 (&acc)[4][4]) {
#pragma unroll
  for (int i = 0; i < 4; i++)
#pragma unroll
    for (int j = 0; j < 4; j++) acc[i][j] = (f32x4){0.f, 0.f, 0.f, 0.f};
}

constexpr int CSTR = 132;
DI void stage_acc(const f32x4 (&acc)[4][4], float* Cs) {
  const int tid = threadIdx.x, lane = tid & 63, w = tid >> 6, wm = w >> 1, wn = w & 1, r = lane & 15, quad = lane >> 4;
  __syncthreads();
#pragma unroll
  for (int mi = 0; mi < 4; mi++)
#pragma unroll
    for (int ni = 0; ni < 4; ni++)
#pragma unroll
      for (int j = 0; j < 4; j++) Cs[(wm * 64 + mi * 16 + quad * 4 + j) * CSTR + wn * 64 + ni * 16 + r] = acc[mi][ni][j];
  __syncthreads();
}
DI u32x2 pack4(f32x4 v) { return (u32x2){pack2(v.x, v.y), pack2(v.z, v.w)}; }
DI f32x4 unpack4(u32x2 p) {
  return (f32x4){__uint_as_float(p.x << 16), __uint_as_float(p.x & 0xffff0000u), __uint_as_float(p.y << 16), __uint_as_float(p.y & 0xffff0000u)};
}

DI void transpose_tile(const float* __restrict__ W, int ldw, int K, const float* __restrict__ g, u16* __restrict__ dst,
                       int k0, int n0, int nsrc0, float* tile) {
  const int tid = threadIdx.x;
  __syncthreads();
  {
    const int ty = tid >> 4, tx = tid & 15;
#pragma unroll
    for (int i = 0; i < 4; i++) {
      int k = ty + i * 16;
      f32x4 v = *(const f32x4*)(W + (size_t)(k0 + k) * ldw + nsrc0 + tx * 4);
      float s = g ? g[k0 + k] : 1.f;
      tile[k * 65 + tx * 4 + 0] = v[0] * s;
      tile[k * 65 + tx * 4 + 1] = v[1] * s;
      tile[k * 65 + tx * 4 + 2] = v[2] * s;
      tile[k * 65 + tx * 4 + 3] = v[3] * s;
    }
  }
  __syncthreads();
  {
    const int n = tid >> 2, kc = (tid & 3) * 16;
    u32 pk[8];
#pragma unroll
    for (int i = 0; i < 8; i++) pk[i] = pack2(tile[(kc + 2 * i) * 65 + n], tile[(kc + 2 * i + 1) * 65 + n]);
    u16* d = dst + (size_t)(n0 + n) * K + k0 + kc;
    *(u32x4*)d = (u32x4){pk[0], pk[1], pk[2], pk[3]};
    *(u32x4*)(d + 8) = (u32x4){pk[4], pk[5], pk[6], pk[7]};
  }
}

DI void conv_unit(const float* __restrict__ src, u16* __restrict__ dst, size_t base, const float* __restrict__ colscale) {
  const int tid = threadIdx.x;
#pragma unroll
  for (int i = 0; i < 4; i++) {
    size_t e = base + (size_t)i * 1024 + tid * 4;
    f32x4 v = *(const f32x4*)(src + e);
    if (colscale) {
      f32x4 gg = *(const f32x4*)(colscale + (e & 1023));
      v = v * gg;
    }
    *(u32x2*)(dst + e) = (u32x2){pack2(v[0], v[1]), pack2(v[2], v[3])};
  }
}

DI void conv_unit_fp8(const float* __restrict__ src, unsigned char* __restrict__ dst, size_t base,
                      const float* __restrict__ colscale, float scale) {
  const int tid = threadIdx.x;
#pragma unroll
  for (int i = 0; i < 4; i++) {
    size_t e = base + (size_t)i * 1024 + tid * 4;
    f32x4 v = *(const f32x4*)(src + e);
    if (colscale) {
      f32x4 gg = *(const f32x4*)(colscale + (e & 1023));
      v = v * gg;
    }
    int w = __builtin_amdgcn_cvt_pk_fp8_f32(v[0] * scale, v[1] * scale, 0, false);
    w = __builtin_amdgcn_cvt_pk_fp8_f32(v[2] * scale, v[3] * scale, w, true);
    *(int*)(dst + (((e & 1023) >> 7) << 21) + ((e >> 10) << 7) + (e & 127)) = w;
  }
}

DI void phase0(const Params& P, char* smem) {
  const int tid = threadIdx.x, lane = tid & 63, w = tid >> 6;
  char* ws = P.ws;
  {
    float* tile = (float*)smem;
    constexpr int T_WIN = 16 * 80, T_UP = 8 * 16, T_SQ = 256, T_PP = 4 * 16;
    constexpr int NT = T_WIN + 2 * T_UP + 3 * T_SQ + T_PP;
    for (int t = blockIdx.x; t < NT; t += gridDim.x) {
      int u = t;
      if (u < T_WIN) {
        int kt = u / 80, nt = u % 80;
        int n0 = nt * 64;
        int ns = n0 < 1536 ? n0 : n0 + 8;
        transpose_tile(P.w_in, 5128, 1024, P.g_mix, (u16*)(ws + W_WIN), kt * 64, n0, ns, tile);
        continue;
      }
      u -= T_WIN;
      if (u < T_UP) { transpose_tile(P.w_up_a, 1024, 512, nullptr, (u16*)(ws + W_WUPA), (u / 16) * 64, (u % 16) * 64, (u % 16) * 64, tile); continue; }
      u -= T_UP;
      if (u < T_UP) { transpose_tile(P.w_up_b, 1024, 512, nullptr, (u16*)(ws + W_WUPB), (u / 16) * 64, (u % 16) * 64, (u % 16) * 64, tile); continue; }
      u -= T_UP;
      if (u < T_SQ) { transpose_tile(P.w_out, 1024, 1024, nullptr, (u16*)(ws + W_WOUT), (u / 16) * 64, (u % 16) * 64, (u % 16) * 64, tile); continue; }
      u -= T_SQ;
      if (u < T_SQ) { transpose_tile(P.peer_wq, 1024, 1024, P.g_ffn, (u16*)(ws + W_WQ), (u / 16) * 64, (u % 16) * 64, (u % 16) * 64, tile); continue; }
      u -= T_SQ;
      if (u < T_SQ) { transpose_tile(P.w_gate, 1024, 1024, P.g_ple, (u16*)(ws + W_WG), (u / 16) * 64, (u % 16) * 64, (u % 16) * 64, tile); continue; }
      u -= T_SQ;
      transpose_tile(P.w_proj, 1024, 256, nullptr, (u16*)(ws + W_WPP), (u / 16) * 64, (u % 16) * 64, (u % 16) * 64, tile);
    }
  }
  {
    constexpr int U_UB = 4096, U_VB = 4096, U_SK = 32, U_PP = 4096, U_PS = 16;
    constexpr int NU = U_UB + U_VB + U_SK + U_PP + U_PS;
    for (int t = blockIdx.x; t < NU; t += gridDim.x) {
      int u = t;
      if (u < U_UB) { conv_unit_fp8(P.peer_u, (unsigned char*)(ws + W_UB), (size_t)u * 4096, P.g_ffn, U_SCALE); continue; }
      u -= U_UB;
      if (u < U_VB) { conv_unit_fp8(P.peer_v, (unsigned char*)(ws + W_VB), (size_t)u * 4096, nullptr, V_SCALE); continue; }
      u -= U_VB;
      if (u < U_SK) { conv_unit(P.peer_sk, (u16*)(ws + W_SK), (size_t)u * 4096, nullptr); continue; }
      u -= U_SK;
      if (u < U_PP) { conv_unit(P.p_p, (u16*)(ws + W_PB), (size_t)u * 4096, nullptr); continue; }
      u -= U_PP;
      conv_unit(P.p_s, (u16*)(ws + W_PB) + (size_t)TP * 256, (size_t)u * 4096, nullptr);
    }
  }
  {
    float* wfl = (float*)smem;
    __syncthreads();
    for (int i = tid; i < 8192; i += 256) {
      int k = i >> 3, h = i & 7;
      wfl[h * 1024 + k] = P.g_mix[k] * P.w_in[(size_t)k * 5128 + 1536 + h];
    }
    __syncthreads();
    u16* XB = (u16*)(ws + W_XB);
    float* RS1 = (float*)(ws + W_RS1);
    for (int t = blockIdx.x * 4 + w; t < TT; t += gridDim.x * 4) {
      const float* xr = t < TP ? P.x_p + (size_t)t * 1024 : P.x_s + (size_t)(t - TP) * 1024;
      f32x4 v[4];
#pragma unroll
      for (int i = 0; i < 4; i++) v[i] = *(const f32x4*)(xr + i * 256 + lane * 4);
      float ss = 0.f;
#pragma unroll
      for (int i = 0; i < 4; i++) ss += v[i][0] * v[i][0] + v[i][1] * v[i][1] + v[i][2] * v[i][2] + v[i][3] * v[i][3];
      float dots[8];
#pragma unroll
      for (int h = 0; h < 8; h++) {
        float d = 0.f;
#pragma unroll
        for (int i = 0; i < 4; i++) {
          f32x4 wv = *(const f32x4*)(wfl + h * 1024 + i * 256 + lane * 4);
          d += v[i][0] * wv[0] + v[i][1] * wv[1] + v[i][2] * wv[2] + v[i][3] * wv[3];
        }
        dots[h] = d;
      }
      ss = wave_sum(ss);
#pragma unroll
      for (int h = 0; h < 8; h++) dots[h] = wave_sum(dots[h]);
      float rs = rsqrtf(ss * (1.f / 1024.f) + EPS);
#pragma unroll
      for (int i = 0; i < 4; i++)
        *(u32x2*)(XB + (size_t)t * 1024 + i * 256 + lane * 4) = (u32x2){pack2(v[i][0], v[i][1]), pack2(v[i][2], v[i][3])};
      if (lane == 0) RS1[t] = rs;
      float myd = dots[0];
#pragma unroll
      for (int h = 1; h < 8; h++) myd = (lane == h) ? dots[h] : myd;
      if (lane < 8) {
        float z = rs * myd + P.b_f[lane];
        float lf = fminf(z, 0.f) - log1pf(expf(-fabsf(z)));
        float* o = t < TP ? P.out + O_AF_P + (size_t)t * 8 : P.out + O_AF_S + (size_t)(t - TP) * 8;
        o[lane] = lf;
      }
    }
  }
}

DI void phase1_scans(const Params& P) {
  const int lane = threadIdx.x & 63;
  const int gw = blockIdx.x * 4 + (threadIdx.x >> 6), nw = gridDim.x * 4;
  float* CUMP = (float*)(P.ws + W_CUMP);
  float* CUMS = (float*)(P.ws + W_CUMS);
  for (int row = gw; row < 384; row += nw) {
    float carry = 0.f;
    if (row < 256) {
      int b = row >> 3, h = row & 7;
      const float* src = P.out + O_AF_P + (size_t)b * 2048 * 8 + h;
      for (int p0 = 0; p0 < 2048; p0 += 64) {
        float v = src[(size_t)(p0 + lane) * 8];
#pragma unroll
        for (int o = 1; o < 64; o <<= 1) { float n = __shfl_up(v, o); if (lane >= o) v += n; }
        v += carry;
        CUMP[(size_t)row * 2048 + p0 + lane] = v * LOG2E;
        carry = __shfl(v, 63);
      }
    } else {
      int rr = row - 256;
      int b = rr >> 3, h = rr & 7;
      const float* src = P.caf + (size_t)b * 4096 * 8 + h;
      for (int p0 = 0; p0 < 4096; p0 += 64) {
        float v = src[(size_t)(p0 + lane) * 8];
#pragma unroll
        for (int o = 1; o < 64; o <<= 1) { float n = __shfl_up(v, o); if (lane >= o) v += n; }
        v += carry;
        CUMS[(size_t)rr * 4112 + p0 + lane] = v * LOG2E;
        carry = __shfl(v, 63);
      }
      {
        float v = lane < 16 ? P.out[O_AF_S + (size_t)(b * 16 + lane) * 8 + h] : 0.f;
#pragma unroll
        for (int o = 1; o < 64; o <<= 1) { float n = __shfl_up(v, o); if (lane >= o) v += n; }
        v += carry;
        if (lane < 16) CUMS[(size_t)rr * 4112 + 4096 + lane] = v * LOG2E;
      }
    }
  }
}

DI void phase1_tile(const Params& P, int mt, int nt, char* smem) {
  const int tid = threadIdx.x, lane = tid & 63, w = tid >> 6, wm = w >> 1, wn = w & 1, r = lane & 15, quad = lane >> 4;
  const int m0 = mt * 128, n0 = nt * 128;
  char* ws = P.ws;
  f32x4 acc[4][4];
  zero_acc(acc);
  gemm_mainloop((const u16*)(ws + W_XB) + (size_t)m0 * 1024, 1024, (const u16*)(ws + W_WIN) + (size_t)n0 * 1024, 1024, 1024,
                (u16*)smem, acc);
  float* Cs = (float*)smem;
  stage_acc(acc, Cs);
  const bool sample = m0 >= TP;
  const int c4 = tid & 31, rsub = tid >> 5;
  const float* RS1 = (const float*)(ws + W_RS1) + m0;
  if (n0 < 3072) {
    const int seg = n0 >> 9, hc = n0 & 511;
    const bool normed = (seg != 2 && seg != 5);
    const float* gain = seg == 0 ? P.qn_a : seg == 1 ? P.kn_a : seg == 3 ? P.qn_b : P.kn_b;
    const float qs = (seg == 0 || seg == 3) ? 0.125f * LOG2E : 1.f;
    f32x4 gn = (f32x4){1.f, 1.f, 1.f, 1.f};
    if (normed) gn = *(const f32x4*)(gain + (c4 & 15) * 4) * qs;
    u16* dp = (u16*)(ws + W_QKV + (size_t)seg * SZ_HALF) + (size_t)m0 * 512 + hc + c4 * 4;
    float* op = nullptr;
    if (seg == 1 || seg == 2) {
      op = sample ? P.out + (seg == 1 ? O_AK_S : O_AV_S) + (size_t)(m0 - TP) * 512 : P.out + (seg == 1 ? O_AK_P : O_AV_P) + (size_t)m0 * 512;
    } else if (seg == 4 || seg == 5) {
      if (sample) op = P.out + (seg == 4 ? O_BK_S : O_BV_S) + (size_t)(m0 - TP) * 512;
      else if ((m0 & 2047) >= 1536) op = P.out + (seg == 4 ? O_BK_P : O_BV_P) + ((size_t)(m0 >> 11) * 512 + ((m0 & 2047) - 1536)) * 512;
    }
    if (op) op += hc + c4 * 4;
#pragma unroll 4
    for (int p = 0; p < 16; p++) {
      const int row = p * 8 + rsub;
      f32x4 v = *(const f32x4*)(Cs + row * CSTR + c4 * 4) * RS1[row];
      if (normed) {
        float ss = v.x * v.x + v.y * v.y + v.z * v.z + v.w * v.w;
        ss += __shfl_xor(ss, 1);
        ss += __shfl_xor(ss, 2);
        ss += __shfl_xor(ss, 4);
        ss += __shfl_xor(ss, 8);
        v = v * gn * rsqrtf(ss * (1.f / 64.f) + EPS);
      }
      *(u32x2*)(dp + (size_t)row * 512) = pack4(v);
      if (op) *(f32x4*)(op + (size_t)row * 512) = v;
    }
  } else {
    u16* dp = (n0 < 4096 ? (u16*)(ws + W_GA) + (n0 - 3072) : (u16*)(ws + W_GB) + (n0 - 4096)) + (size_t)m0 * 1024 + c4 * 4;
#pragma unroll 4
    for (int p = 0; p < 16; p++) {
      const int row = p * 8 + rsub;
      f32x4 v = *(const f32x4*)(Cs + row * CSTR + c4 * 4) * RS1[row];
      v = (f32x4){sigmoidf_(v.x), sigmoidf_(v.y), sigmoidf_(v.z), sigmoidf_(v.w)};
      *(u32x2*)(dp + (size_t)row * 1024) = pack4(v);
    }
  }
}

constexpr int ASTR = 72;
constexpr int ASTAGE = 2 * 64 * ASTR * 2 + 256;
constexpr int TAB_OFF = 2 * ASTAGE;
struct AttnState { f32x4 o[4]; float m, l; };

DI s16x4 tr_read(const u16* p) {
  return __builtin_amdgcn_ds_read_tr16_b64_v4i16((__attribute__((address_space(3))) s16x4*)(p));
}

template <int MODE>
DI void attn_step(const u16* Ks, const u16* Vs, const bf16x8 (&qf)[2], AttnState& st, int kpos0, int qpos, int qlim,
                  float cq, const float* cum, const float* tab, bool domask) {
  const int lane = threadIdx.x & 63, r = lane & 15, quad = lane >> 4;
  const bool farband = (MODE == 1) && (kpos0 + 31 - (qpos - r) <= -128);
  f32x4 s[2];
#pragma unroll
  for (int t = 0; t < 2; t++) {
    f32x4 a4 = (f32x4){0.f, 0.f, 0.f, 0.f};
#pragma unroll
    for (int ks = 0; ks < 2; ks++) {
      bf16x8 kf = *(const bf16x8*)(Ks + (t * 16 + r) * ASTR + ks * 32 + quad * 8);
      a4 = mfma16(kf, qf[ks], a4);
    }
    s[t] = a4;
  }
#pragma unroll
  for (int t = 0; t < 2; t++) {
    const int kb = kpos0 + t * 16 + quad * 4;
    if (MODE == 0) {
      f32x4 c4 = *(const f32x4*)(cum + kb);
#pragma unroll
      for (int j = 0; j < 4; j++) s[t][j] += cq - c4[j];
    } else if (farband) {
      const float b0 = tab[0];
#pragma unroll
      for (int j = 0; j < 4; j++) s[t][j] += b0;
    } else {
#pragma unroll
      for (int j = 0; j < 4; j++) {
        int rel = kb + j - qpos;
        rel = min(max(rel, -128), 128) + 128;
        s[t][j] += tab[rel];
      }
    }
    if (domask) {
#pragma unroll
      for (int j = 0; j < 4; j++)
        if (kb + j > qlim) s[t][j] = -1e30f;
    }
  }
  float p[8];
  float ls = 0.f;
#pragma unroll
  for (int t = 0; t < 2; t++)
#pragma unroll
    for (int j = 0; j < 4; j++) { p[t * 4 + j] = __builtin_amdgcn_exp2f(s[t][j]); ls += p[t * 4 + j]; }
  st.l += ls;
  u32x4 pk = (u32x4){pack2(p[0], p[1]), pack2(p[2], p[3]), pack2(p[4], p[5]), pack2(p[6], p[7])};
  bf16x8 pf = __builtin_bit_cast(bf16x8, pk);
  const int qq = (lane & 15) >> 2, pp = lane & 3;
#pragma unroll
  for (int dt = 0; dt < 4; dt++) {
    s16x4 lo = tr_read(Vs + (quad * 4 + qq) * ASTR + dt * 16 + pp * 4);
    s16x4 hi = tr_read(Vs + (16 + quad * 4 + qq) * ASTR + dt * 16 + pp * 4);
    bf16x8 vf = __builtin_shufflevector(lo, hi, 0, 1, 2, 3, 4, 5, 6, 7);
    st.o[dt] = mfma16(vf, pf, st.o[dt]);
  }
}

template <int MODE>
DI void attn_prompt_item(const Params& P, char* smem, int b, int h, int qt, float bound) {
  const int tid = threadIdx.x, lane = tid & 63, w = tid >> 6, r = lane & 15, quad = lane >> 4;
  char* ws = P.ws;
  const u16* Q = (const u16*)(ws + W_QKV + (size_t)(MODE == 0 ? 0 : 3) * SZ_HALF);
  const u16* Kg = (const u16*)(ws + W_QKV + (size_t)(MODE == 0 ? 1 : 4) * SZ_HALF);
  const u16* Vg = (const u16*)(ws + W_QKV + (size_t)(MODE == 0 ? 2 : 5) * SZ_HALF);
  u16* Y = (u16*)(ws + W_XB + (size_t)(MODE == 0 ? 0 : 1) * SZ_HALF);
  float* tab = (float*)(smem + TAB_OFF);
  __syncthreads();
  if (MODE == 1) {
    for (int i = tid; i < 257; i += 256) tab[i] = P.relb[h * 257 + i] * LOG2E - bound;
  }
  const int q0 = qt * 64;
  const int qpos = q0 + w * 16 + r;
  const size_t tokq = (size_t)b * 2048 + qpos;
  bf16x8 qf[2];
#pragma unroll
  for (int ks = 0; ks < 2; ks++) qf[ks] = *(const bf16x8*)(Q + tokq * 512 + h * 64 + ks * 32 + quad * 8);
  const float* cum = (const float*)(ws + W_CUMP) + (size_t)(b * 8 + h) * 2048;
  const float cq = MODE == 0 ? cum[qpos] - bound : 0.f;
  AttnState st;
#pragma unroll
  for (int dt = 0; dt < 4; dt++) st.o[dt] = (f32x4){0.f, 0.f, 0.f, 0.f};
  st.m = 0.f;
  st.l = 0.f;
  const int kt_lo = MODE == 0 ? 0 : max(0, qt - 8), kt_hi = qt;
  u32x4 rk[2], rv[2];
  f32x4 rc = (f32x4){0.f, 0.f, 0.f, 0.f};
  const int lkey = tid >> 3, lch = tid & 7;
  const u16* kp = Kg + ((size_t)b * 2048 + lkey) * 512 + h * 64 + lch * 8;
  const u16* vp = Vg + ((size_t)b * 2048 + lkey) * 512 + h * 64 + lch * 8;
  const int lofs = lkey * ASTR + lch * 8;
#pragma unroll
  for (int i = 0; i < 2; i++) {
    rk[i] = *(const u32x4*)(kp + (size_t)(kt_lo * 64 + i * 32) * 512);
    rv[i] = *(const u32x4*)(vp + (size_t)(kt_lo * 64 + i * 32) * 512);
  }
  if (MODE == 0 && tid < 16) rc = *(const f32x4*)(cum + kt_lo * 64 + tid * 4);
  {
    u16* Ks = (u16*)(smem + (kt_lo & 1) * ASTAGE);
    u16* Vs = Ks + 64 * ASTR;
#pragma unroll
    for (int i = 0; i < 2; i++) {
      *(u32x4*)(Ks + lofs + i * 32 * ASTR) = rk[i];
      *(u32x4*)(Vs + lofs + i * 32 * ASTR) = rv[i];
    }
    if (MODE == 0 && tid < 16) *(f32x4*)((float*)(Vs + 64 * ASTR) + tid * 4) = rc;
  }
  __syncthreads();
#pragma unroll 1
  for (int kt = kt_lo; kt <= kt_hi; kt++) {
    const int ktn = min(kt + 1, kt_hi);
#pragma unroll
    for (int i = 0; i < 2; i++) {
      rk[i] = *(const u32x4*)(kp + (size_t)(ktn * 64 + i * 32) * 512);
      rv[i] = *(const u32x4*)(vp + (size_t)(ktn * 64 + i * 32) * 512);
    }
    if (MODE == 0 && tid < 16) rc = *(const f32x4*)(cum + ktn * 64 + tid * 4);
    const u16* Ks = (const u16*)(smem + (kt & 1) * ASTAGE);
    const u16* Vs = Ks + 64 * ASTR;
    const float* cl = (const float*)(Vs + 64 * ASTR) - kt * 64;
    const bool diag = (MODE == 0) && (kt == qt);
#pragma unroll
    for (int half = 0; half < 2; half++) {
      const int kpos0 = kt * 64 + half * 32;
      if (diag && kpos0 > q0 + w * 16 + 15) continue;
      attn_step<MODE>(Ks + half * 32 * ASTR, Vs + half * 32 * ASTR, qf, st, kpos0, qpos, qpos, cq, cl, tab, diag);
    }
    if (kt < kt_hi) {
      u16* Kn = (u16*)(smem + ((kt + 1) & 1) * ASTAGE);
      u16* Vn = Kn + 64 * ASTR;
#pragma unroll
      for (int i = 0; i < 2; i++) {
        *(u32x4*)(Kn + lofs + i * 32 * ASTR) = rk[i];
        *(u32x4*)(Vn + lofs + i * 32 * ASTR) = rv[i];
      }
      if (MODE == 0 && tid < 16) *(f32x4*)((float*)(Vn + 64 * ASTR) + tid * 4) = rc;
    }
    __syncthreads();
  }
  float lt = st.l;
  lt += __shfl_xor(lt, 16);
  lt += __shfl_xor(lt, 32);
  const float inv = 1.f / lt;
#pragma unroll
  for (int dt = 0; dt < 4; dt++) {
    u32x2 o2 = (u32x2){pack2(st.o[dt][0] * inv, st.o[dt][1] * inv), pack2(st.o[dt][2] * inv, st.o[dt][3] * inv)};
    *(u32x2*)(Y + tokq * 512 + h * 64 + dt * 16 + quad * 4) = o2;
  }
}

template <int MODE>
DI void attn_sample_item(const Params& P, char* smem, int b, int h, float bound) {
  const int tid = threadIdx.x, lane = tid & 63, w = tid >> 6, r = lane & 15, quad = lane >> 4;
  constexpr int L = MODE == 0 ? 4096 : 512;
  char* ws = P.ws;
  const u16* Q = (const u16*)(ws + W_QKV + (size_t)(MODE == 0 ? 0 : 3) * SZ_HALF);
  const u16* Kn = (const u16*)(ws + W_QKV + (size_t)(MODE == 0 ? 1 : 4) * SZ_HALF);
  const u16* Vn = (const u16*)(ws + W_QKV + (size_t)(MODE == 0 ? 2 : 5) * SZ_HALF);
  u16* Y = (u16*)(ws + W_XB + (size_t)(MODE == 0 ? 0 : 1) * SZ_HALF);
  u16* Kw = (u16*)smem + w * (2 * 32 * ASTR);
  u16* Vw = Kw + 32 * ASTR;
  float* tab = (float*)(smem + TAB_OFF);
  __syncthreads();
  if (MODE == 1) {
    for (int i = tid; i < 257; i += 256) tab[i] = P.relb[h * 257 + i] * LOG2E - bound;
  }
  __syncthreads();
  const float* ck = (MODE == 0 ? P.cak : P.cbk) + ((size_t)b * L * 8 + h) * 64;
  const float* cv = (MODE == 0 ? P.cav : P.cbv) + ((size_t)b * L * 8 + h) * 64;
  const size_t tokbase = (size_t)TP + b * 16;
  bf16x8 qf[2];
#pragma unroll
  for (int ks = 0; ks < 2; ks++) qf[ks] = *(const bf16x8*)(Q + (tokbase + r) * 512 + h * 64 + ks * 32 + quad * 8);
  const int qpos = L + r;
  const float* cum = (const float*)(ws + W_CUMS) + (size_t)(b * 8 + h) * 4112;
  const float cq = MODE == 0 ? cum[qpos] - bound : 0.f;
  AttnState st;
#pragma unroll
  for (int dt = 0; dt < 4; dt++) st.o[dt] = (f32x4){0.f, 0.f, 0.f, 0.f};
  st.m = 0.f;
  st.l = 0.f;
  const int kbeg = w * (L / 4), kend = kbeg + L / 4;
#pragma unroll 1
  for (int k0 = kbeg; k0 < kend; k0 += 32) {
    {
      f32x4 kr[8];
#pragma unroll
      for (int i = 0; i < 8; i++) kr[i] = *(const f32x4*)(ck + (size_t)(k0 + i * 4 + quad) * 512 + r * 4);
#pragma unroll
      for (int i = 0; i < 8; i++)
        *(u32x2*)(Kw + (i * 4 + quad) * ASTR + r * 4) = (u32x2){pack2(kr[i][0], kr[i][1]), pack2(kr[i][2], kr[i][3])};
    }
    {
      f32x4 vr[8];
#pragma unroll
      for (int i = 0; i < 8; i++) vr[i] = *(const f32x4*)(cv + (size_t)(k0 + i * 4 + quad) * 512 + r * 4);
#pragma unroll
      for (int i = 0; i < 8; i++)
        *(u32x2*)(Vw + (i * 4 + quad) * ASTR + r * 4) = (u32x2){pack2(vr[i][0], vr[i][1]), pack2(vr[i][2], vr[i][3])};
    }
    asm volatile("s_waitcnt lgkmcnt(0)" ::: "memory");
    __builtin_amdgcn_wave_barrier();
    attn_step<MODE>(Kw, Vw, qf, st, k0, qpos, qpos, cq, cum, tab, false);
    __builtin_amdgcn_wave_barrier();
  }
  if (w == 0) {
#pragma unroll
    for (int i = 0; i < 2; i++) {
      int c = lane + i * 64;
      int key = c >> 3, ch = c & 7;
      u32x4 kk = *(const u32x4*)(Kn + (tokbase + key) * 512 + h * 64 + ch * 8);
      u32x4 vv = *(const u32x4*)(Vn + (tokbase + key) * 512 + h * 64 + ch * 8);
      *(u32x4*)(Kw + key * ASTR + ch * 8) = kk;
      *(u32x4*)(Vw + key * ASTR + ch * 8) = vv;
      *(u32x4*)(Kw + (16 + key) * ASTR + ch * 8) = (u32x4){0u, 0u, 0u, 0u};
      *(u32x4*)(Vw + (16 + key) * ASTR + ch * 8) = (u32x4){0u, 0u, 0u, 0u};
    }
    asm volatile("s_waitcnt lgkmcnt(0)" ::: "memory");
    __builtin_amdgcn_wave_barrier();
    attn_step<MODE>(Kw, Vw, qf, st, L, qpos, MODE == 0 ? qpos : L + 15, cq, cum, tab, true);
  }
  __syncthreads();
  float* comb = (float*)smem;
  float lt = st.l;
  lt += __shfl_xor(lt, 16);
  lt += __shfl_xor(lt, 32);
#pragma unroll
  for (int dt = 0; dt < 4; dt++)
#pragma unroll
    for (int j = 0; j < 4; j++) comb[(w * 16 + r) * 68 + dt * 16 + quad * 4 + j] = st.o[dt][j];
  if (quad == 0) comb[(w * 16 + r) * 68 + 65] = lt;
  __syncthreads();
  if (w == 0) {
    float Ls = 0.f;
#pragma unroll
    for (int i = 0; i < 4; i++) Ls += comb[(i * 16 + r) * 68 + 65];
    const float inv = 1.f / Ls;
#pragma unroll
    for (int dt = 0; dt < 4; dt++) {
      float ov[4];
#pragma unroll
      for (int j = 0; j < 4; j++) {
        float a = 0.f;
#pragma unroll
        for (int i = 0; i < 4; i++) a += comb[(i * 16 + r) * 68 + dt * 16 + quad * 4 + j];
        ov[j] = a * inv;
      }
      *(u32x2*)(Y + (tokbase + r) * 512 + h * 64 + dt * 16 + quad * 4) = (u32x2){pack2(ov[0], ov[1]), pack2(ov[2], ov[3])};
    }
  }
}

DI void phase2(const Params& P, char* smem) {
  constexpr int N_SA = 128, N_PA = 8192, N_PB = 8192, N_SB = 128;
  float bound_a, bound_b;
  {
    const int lane = threadIdx.x & 63;
    float qa = fabsf(P.qn_a[lane]), ka = fabsf(P.kn_a[lane]), qb = fabsf(P.qn_b[lane]), kb = fabsf(P.kn_b[lane]), rb = 0.f;
    for (int i = lane; i < 8 * 257; i += 64) rb = fmaxf(rb, fabsf(P.relb[i]));
#pragma unroll
    for (int o = 32; o; o >>= 1) {
      qa = fmaxf(qa, __shfl_xor(qa, o)); ka = fmaxf(ka, __shfl_xor(ka, o));
      qb = fmaxf(qb, __shfl_xor(qb, o)); kb = fmaxf(kb, __shfl_xor(kb, o));
      rb = fmaxf(rb, __shfl_xor(rb, o));
    }
    bound_a = 8.f * qa * ka * LOG2E;
    bound_b = (8.f * qb * kb + rb) * LOG2E;
  }
  for (int it = blockIdx.x; it < N_SA + N_PA + N_PB + N_SB; it += gridDim.x) {
    int u = it;
    if (u < N_SA) { attn_sample_item<0>(P, smem, u >> 3, u & 7, bound_a); continue; }
    u -= N_SA;
    if (u < N_PA) { int qt = 31 - (u >> 8), bh = u & 255; attn_prompt_item<0>(P, smem, bh >> 3, bh & 7, qt, bound_a); continue; }
    u -= N_PA;
    if (u < N_PB) { int qt = 31 - (u >> 8), bh = u & 255; attn_prompt_item<1>(P, smem, bh >> 3, bh & 7, qt, bound_b); continue; }
    u -= N_PB;
    attn_sample_item<1>(P, smem, u >> 3, u & 7, bound_b);
  }
}

DI void phase3_tile(const Params& P, int mt, int nt, char* smem) {
  const int tid = threadIdx.x, lane = tid & 63, w = tid >> 6, wm = w >> 1, wn = w & 1, r = lane & 15, quad = lane >> 4;
  const int m0 = mt * 128, n0 = nt * 128;
  char* ws = P.ws;
  const u16* YA = (const u16*)(ws + W_XB);
  const u16* YB = YA + (size_t)TT * 512;
  const u16* GA = (const u16*)(ws + W_GA);
  const u16* GB = (const u16*)(ws + W_GB);
  u16* MRG = (u16*)(ws + W_QKV);
  f32x4 acc[4][4];
  zero_acc(acc);
  gemm_mainloop(YA + (size_t)m0 * 512, 512, (const u16*)(ws + W_WUPA) + (size_t)n0 * 512, 512, 512, (u16*)smem, acc);
  float* Cs = (float*)smem;
  const int c4 = tid & 31, rsub = tid >> 5;
  const size_t tofs = (size_t)m0 * 1024 + n0 + c4 * 4;
  stage_acc(acc, Cs);
#pragma unroll 4
  for (int p = 0; p < 16; p++) {
    const int row = p * 8 + rsub;
    const f32x4 v = *(const f32x4*)(Cs + row * CSTR + c4 * 4);
    const f32x4 gv = unpack4(*(const u32x2*)(GA + tofs + (size_t)row * 1024));
    *(u32x2*)(MRG + tofs + (size_t)row * 1024) = pack4(v * gv);
  }
  zero_acc(acc);
  gemm_mainloop(YB + (size_t)m0 * 512, 512, (const u16*)(ws + W_WUPB) + (size_t)n0 * 512, 512, 512, (u16*)smem, acc);
  stage_acc(acc, Cs);
#pragma unroll 4
  for (int p = 0; p < 16; p++) {
    const int row = p * 8 + rsub;
    const f32x4 v = *(const f32x4*)(Cs + row * CSTR + c4 * 4);
    const f32x4 gv = unpack4(*(const u32x2*)(GB + tofs + (size_t)row * 1024));
    const f32x4 m1 = unpack4(*(const u32x2*)(MRG + tofs + (size_t)row * 1024));
    *(u32x2*)(MRG + tofs + (size_t)row * 1024) = pack4(m1 + v * gv);
  }
}

DI void phase4_tile(const Params& P, int mt, int nt, char* smem) {
  const int tid = threadIdx.x, lane = tid & 63, w = tid >> 6, wm = w >> 1, wn = w & 1, r = lane & 15, quad = lane >> 4;
  const int m0 = mt * 128, n0 = nt * 128;
  char* ws = P.ws;
  const u16* MRG = (const u16*)(ws + W_QKV);
  u16* H1B = (u16*)(ws + W_QKV + SZ_ACT);
  float* SSQ2 = (float*)(ws + W_SSQ2);
  f32x4 acc[4][4];
  zero_acc(acc);
  gemm_mainloop(MRG + (size_t)m0 * 1024, 1024, (const u16*)(ws + W_WOUT) + (size_t)n0 * 1024, 1024, 1024, (u16*)smem, acc);
  const float* xb = m0 < TP ? P.x_p : P.x_s - (size_t)TP * 1024;
  float* Cs = (float*)smem;
  const int c4 = tid & 31, rsub = tid >> 5;
  const size_t tofs = (size_t)m0 * 1024 + n0 + c4 * 4;
  stage_acc(acc, Cs);
#pragma unroll 4
  for (int p = 0; p < 16; p++) {
    const int row = p * 8 + rsub;
    const f32x4 v = *(const f32x4*)(Cs + row * CSTR + c4 * 4);
    const f32x4 h1 = *(const f32x4*)(xb + tofs + (size_t)row * 1024) + v;
    *(f32x4*)(P.out + tofs + (size_t)row * 1024) = h1;
    *(u32x2*)(H1B + tofs + (size_t)row * 1024) = pack4(h1);
    float ss = h1.x * h1.x + h1.y * h1.y + h1.z * h1.z + h1.w * h1.w;
    ss += __shfl_xor(ss, 1);
    ss += __shfl_xor(ss, 2);
    ss += __shfl_xor(ss, 4);
    ss += __shfl_xor(ss, 8);
    ss += __shfl_xor(ss, 16);
    if (c4 == 0) SSQ2[(size_t)(m0 + row) * 16 + nt] = ss;
  }
}

DI void phase5_tile(const Params& P, int mt, int nt, char* smem) {
  const int tid = threadIdx.x, lane = tid & 63, w = tid >> 6, wm = w >> 1, wn = w & 1, r = lane & 15, quad = lane >> 4;
  const int m0 = mt * 128, n0 = nt * 128;
  char* ws = P.ws;
  const u16* H1B = (const u16*)(ws + W_QKV + SZ_ACT);
  u16* QP = (u16*)(ws + W_QKV + 2 * SZ_ACT);
  const float* SSQ2 = (const float*)(ws + W_SSQ2);
  float* rs_s = (float*)(smem + RS_OFF);
  __syncthreads();
  if (tid < 128) {
    float s = 0.f;
#pragma unroll
    for (int i = 0; i < 8; i++) s += SSQ2[(size_t)(m0 + tid) * 16 + i];
    rs_s[tid] = rsqrtf(s * (1.f / 1024.f) + EPS);
  }
  f32x4 acc[4][4];
  zero_acc(acc);
  gemm_mainloop(H1B + (size_t)m0 * 1024, 1024, (const u16*)(ws + W_WQ) + (size_t)n0 * 1024, 1024, 1024, (u16*)smem, acc);
  float* Cs = (float*)smem;
  const int c4 = tid & 31, rsub = tid >> 5;
  const size_t tofs = (size_t)m0 * 1024 + n0 + c4 * 4;
  stage_acc(acc, Cs);
#pragma unroll 4
  for (int p = 0; p < 16; p++) {
    const int row = p * 8 + rsub;
    const f32x4 v = *(const f32x4*)(Cs + row * CSTR + c4 * 4) * rs_s[row];
    *(u32x2*)(QP + tofs + (size_t)row * 1024) = pack4(v);
  }
}

DI void bitonic_merge16(u32 (&L)[16]) {
#pragma unroll
  for (int st = 8; st >= 1; st >>= 1)
#pragma unroll
    for (int i = 0; i < 16; i++)
      if ((i & st) == 0) { u32 hi = max(L[i], L[i + st]); u32 lo = min(L[i], L[i + st]); L[i] = hi; L[i + st] = lo; }
}
DI void bitonic_sort16(u32 (&L)[16]) {
#pragma unroll
  for (int k = 2; k <= 16; k <<= 1)
#pragma unroll
    for (int j = k >> 1; j > 0; j >>= 1)
#pragma unroll
      for (int i = 0; i < 16; i++) {
        const int l = i ^ j;
        if (l > i) {
          const u32 hi = max(L[i], L[l]), lo = min(L[i], L[l]);
          if ((i & k) == 0) { L[i] = hi; L[l] = lo; } else { L[i] = lo; L[l] = hi; }
        }
      }
}
DI void phase6a_unit(const Params& P, int unit, char* smem) {
  const int tid = threadIdx.x, lane = tid & 63, w = tid >> 6, r = lane & 15, quad = lane >> 4;
  char* ws = P.ws;
  const u16* QP = (const u16*)(ws + W_QKV + 2 * SZ_ACT);
  const u16* SK = (const u16*)(ws + W_SK);
  u16* IDXo = (u16*)(ws + W_IDX);
  float* Go = (float*)(ws + W_G);
  float* sc = (float*)smem;
  u32* hl = (u32*)smem;
  u32* xl = (u32*)smem + 256 * 17;
  u32* lists = (u32*)(smem + 128 * 129 * 4);
  unsigned char* tabi = (unsigned char*)(smem + 128 * 129 * 4 + 128 * 17 * 4);
  unsigned char* tabj = tabi + 64;
  const int tok0 = unit * 64;
  __syncthreads();
  if (tid == 0) {
    int c = 0;
    for (int i = 0; i < 16; i++)
      for (int j = i + 1; j < 16; j++)
        if ((i + 1) * (j + 1) <= 16) { tabi[c] = (unsigned char)i; tabj[c] = (unsigned char)j; tabi[32 + c] = (unsigned char)j; tabj[32 + c] = (unsigned char)i; c++; }
    tabi[23] = 0; tabj[23] = 0; tabi[24] = 1; tabj[24] = 1;
    tabi[55] = 2; tabj[55] = 2; tabi[56] = 3; tabj[56] = 3;
  }
  for (int h = 0; h < 8; h++) {
#pragma unroll
    for (int p = 0; p < 2; p++) {
      const int hp = h * 2 + p;
      bf16x8 qf[2];
#pragma unroll
      for (int ks = 0; ks < 2; ks++)
        qf[ks] = *(const bf16x8*)(QP + (size_t)(tok0 + w * 16 + r) * 1024 + hp * 64 + ks * 32 + quad * 8);
#pragma unroll
      for (int nt = 0; nt < 8; nt++) {
        f32x4 a4 = (f32x4){0.f, 0.f, 0.f, 0.f};
#pragma unroll
        for (int ks = 0; ks < 2; ks++) {
          bf16x8 kf = *(const bf16x8*)(SK + (size_t)(hp * 128 + nt * 16 + r) * 64 + ks * 32 + quad * 8);
          a4 = mfma16(kf, qf[ks], a4);
        }
        float* d = sc + (p * 64 + w * 16 + r) * 129 + nt * 16 + quad * 4;
        d[0] = a4[0]; d[1] = a4[1]; d[2] = a4[2]; d[3] = a4[3];
      }
    }
    __syncthreads();
    u32 L[16];
    {
      const int inst = tid & 127, half = tid >> 7;
      const float* row = sc + inst * 129 + half * 64;
#pragma unroll
      for (int i = 0; i < 16; i++) L[i] = (mono(row[i]) & ~127u) | (u32)(half * 64 + i);
      bitonic_sort16(L);
#pragma unroll 1
      for (int c = 1; c < 4; c++) {
        u32 N[16];
#pragma unroll
        for (int i = 0; i < 16; i++) N[i] = (mono(row[c * 16 + i]) & ~127u) | (u32)(half * 64 + c * 16 + i);
        bitonic_sort16(N);
#pragma unroll
        for (int i = 0; i < 16; i++) L[i] = max(L[i], N[15 - i]);
        bitonic_merge16(L);
      }
    }
    __syncthreads();
#pragma unroll
    for (int s = 0; s < 16; s++) hl[tid * 17 + s] = L[s];
    __syncthreads();
    if (tid < 128) {
      u32 M[16];
#pragma unroll
      for (int s = 0; s < 16; s++) M[s] = max(L[s], hl[(tid + 128) * 17 + 15 - s]);
      bitonic_merge16(M);
#pragma unroll
      for (int s = 0; s < 16; s++) lists[tid * 17 + s] = M[s];
    }
    __syncthreads();
    if (tid < 128) {
      const int tok = tid & 63;
      const bool part = tid >= 64;
      float fa[16], fb[16];
#pragma unroll
      for (int s = 0; s < 16; s++) {
        const float va = unmono(lists[tok * 17 + s] & ~127u);
        const float vb = unmono(lists[(64 + tok) * 17 + s] & ~127u);
        fa[s] = part ? vb : va;
        fb[s] = part ? va : vb;
      }
      u32 L2[16];
#pragma unroll
      for (int s = 0; s < 16; s++) L2[s] = 0u;
      const u32 cbase = part ? 32u : 0u;
      {
        int c = 0;
#pragma unroll
        for (int i = 0; i < 16; i++)
#pragma unroll
          for (int j = i + 1; j < 16; j++)
            if ((i + 1) * (j + 1) <= 16) {
              insert16(L2, (mono(fa[i] + fb[j]) & ~63u) | (cbase + (u32)c));
              c++;
            }
      }
      insert16(L2, (mono(part ? fa[2] + fb[2] : fa[0] + fb[0]) & ~63u) | (cbase + 23u));
      insert16(L2, (mono(part ? fa[3] + fb[3] : fa[1] + fb[1]) & ~63u) | (cbase + 24u));
#pragma unroll
      for (int s = 0; s < 16; s++) xl[tid * 17 + s] = L2[s];
    }
    __syncthreads();
    if (tid < 64) {
      float val[16];
      u32 idx[16];
      float mx = -1e30f;
#pragma unroll
      for (int s = 0; s < 16; s++) {
        const u32 m = max(xl[tid * 17 + s], xl[(tid + 64) * 17 + 15 - s]);
        const u32 sl = m & 63u;
        const int i = tabi[sl], j = tabj[sl];
        const u32 au = lists[tid * 17 + i], bu = lists[(64 + tid) * 17 + j];
        val[s] = unmono(au & ~127u) + unmono(bu & ~127u);
        idx[s] = (au & 127u) * 128u + (bu & 127u);
        mx = fmaxf(mx, val[s]);
      }
      float sum = 0.f;
#pragma unroll
      for (int s = 0; s < 16; s++) { val[s] = __expf(val[s] - mx); sum += val[s]; }
      const float inv = 1.f / sum;
      const size_t so = ((size_t)(tok0 + tid) * 8 + h) * 16;
      {
        u32* ib = (u32*)(IDXo + (size_t)(tok0 + tid) * 128 + h * 2);
#pragma unroll
        for (int gg = 0; gg < 8; gg++) ib[gg * 8] = idx[gg] | (idx[gg + 8] << 16);
      }
#pragma unroll
      for (int s = 0; s < 4; s++)
        *(f32x4*)(Go + so + s * 4) = (f32x4){val[s * 4] * inv, val[s * 4 + 1] * inv, val[s * 4 + 2] * inv, val[s * 4 + 3] * inv};
    }
    __syncthreads();
  }
}

typedef float f32x2 __attribute__((ext_vector_type(2)));
DI float dot4_fp8(u32 w, float x0, float x1, float x2, float x3, float acc) {
  f32x2 lo = __builtin_amdgcn_cvt_pk_f32_fp8((int)w, false);
  f32x2 hi = __builtin_amdgcn_cvt_pk_f32_fp8((int)w, true);
  acc = fmaf(lo[0], x0, acc);
  acc = fmaf(lo[1], x1, acc);
  acc = fmaf(hi[0], x2, acc);
  acc = fmaf(hi[1], x3, acc);
  return acc;
}
DI void axpy4_fp8(u32 w, float wgt, float& o0, float& o1, float& o2, float& o3) {
  f32x2 lo = __builtin_amdgcn_cvt_pk_f32_fp8((int)w, false);
  f32x2 hi = __builtin_amdgcn_cvt_pk_f32_fp8((int)w, true);
  o0 = fmaf(wgt, lo[0], o0);
  o1 = fmaf(wgt, lo[1], o1);
  o2 = fmaf(wgt, hi[0], o2);
  o3 = fmaf(wgt, hi[1], o3);
}

struct RowSet { u32x4 r[16]; };
DI void gather_rows(RowSet& R, const unsigned char* base, u32 lofs, u32x4 ea, u32x4 eb) {
  const u32 ev[8] = {ea.x, ea.y, ea.z, ea.w, eb.x, eb.y, eb.z, eb.w};
#pragma unroll
  for (int i = 0; i < 8; i++) {
    R.r[2 * i] = *(const u32x4*)(base + (((ev[i] & 0xffffu) << 7) + lofs));
    R.r[2 * i + 1] = *(const u32x4*)(base + (((ev[i] >> 16) << 7) + lofs));
  }
}
DI void b1_compute(const RowSet& R, u32x4 xa, u32x4 xb, float* pr, int c, bool valid) {
  float xf[16];
  xf[0] = __uint_as_float(xa.x << 16); xf[1] = __uint_as_float(xa.x & 0xffff0000u);
  xf[2] = __uint_as_float(xa.y << 16); xf[3] = __uint_as_float(xa.y & 0xffff0000u);
  xf[4] = __uint_as_float(xa.z << 16); xf[5] = __uint_as_float(xa.z & 0xffff0000u);
  xf[6] = __uint_as_float(xa.w << 16); xf[7] = __uint_as_float(xa.w & 0xffff0000u);
  xf[8] = __uint_as_float(xb.x << 16); xf[9] = __uint_as_float(xb.x & 0xffff0000u);
  xf[10] = __uint_as_float(xb.y << 16); xf[11] = __uint_as_float(xb.y & 0xffff0000u);
  xf[12] = __uint_as_float(xb.z << 16); xf[13] = __uint_as_float(xb.z & 0xffff0000u);
  xf[14] = __uint_as_float(xb.w << 16); xf[15] = __uint_as_float(xb.w & 0xffff0000u);
  float p[16];
#pragma unroll
  for (int i = 0; i < 16; i++) {
    float a = dot4_fp8(R.r[i].x, xf[0], xf[1], xf[2], xf[3], 0.f);
    a = dot4_fp8(R.r[i].y, xf[4], xf[5], xf[6], xf[7], a);
    a = dot4_fp8(R.r[i].z, xf[8], xf[9], xf[10], xf[11], a);
    a = dot4_fp8(R.r[i].w, xf[12], xf[13], xf[14], xf[15], a);
    p[i] = a;
  }
#pragma unroll
  for (int i = 0; i < 8; i++) { float keep = (c & 4) ? p[i + 8] : p[i]; float send = (c & 4) ? p[i] : p[i + 8]; p[i] = keep + __shfl_xor(send, 4); }
#pragma unroll
  for (int i = 0; i < 4; i++) { float keep = (c & 2) ? p[i + 4] : p[i]; float send = (c & 2) ? p[i] : p[i + 4]; p[i] = keep + __shfl_xor(send, 2); }
#pragma unroll
  for (int i = 0; i < 2; i++) { float keep = (c & 1) ? p[i + 2] : p[i]; float send = (c & 1) ? p[i] : p[i + 2]; p[i] = keep + __shfl_xor(send, 1); }
  const int it0 = 2 * (c & 1) + 4 * ((c >> 1) & 1) + 8 * ((c >> 2) & 1);
  if (valid) {
    pr[it0 * 8] = p[0];
    pr[(it0 + 1) * 8] = p[1];
  }
}
DI void phase6b1(const Params& P) {
  const int lane = threadIdx.x & 63, g = lane >> 3, c = lane & 7;
  const int x = blockIdx.x & 7;
  const int wg = (blockIdx.x >> 3) * 4 + (threadIdx.x >> 6), nwg = (gridDim.x >> 3) * 4;
  char* ws = P.ws;
  const u16* H1B = (const u16*)(ws + W_QKV + SZ_ACT) + x * 128 + c * 16;
  const unsigned char* U8 = (const unsigned char*)(ws + W_UB) + ((size_t)x << 21);
  const u32 lofs = c * 16;
  const u16* IDX = (const u16*)(ws + W_IDX) + g * 16;
  float* PH = ph_slice(ws, x) + g;
  const int n = (TT - wg + nwg - 1) / nwg;
#define TOK(i) min(wg + (i) * nwg, TT - 1)
  int t0 = TOK(0), t1 = TOK(1);
  u32x4 eA0 = *(const u32x4*)(IDX + (size_t)t0 * 128), eA1 = *(const u32x4*)(IDX + (size_t)t0 * 128 + 8);
  u32x4 eB0 = *(const u32x4*)(IDX + (size_t)t1 * 128), eB1 = *(const u32x4*)(IDX + (size_t)t1 * 128 + 8);
  RowSet RA, RB;
  gather_rows(RA, U8, lofs, eA0, eA1);
  u32x4 xA0 = *(const u32x4*)(H1B + (size_t)t0 * 1024), xA1 = *(const u32x4*)(H1B + (size_t)t0 * 1024 + 8);
#pragma unroll 1
  for (int i = 0; i < n; i += 2) {
    gather_rows(RB, U8, lofs, eB0, eB1);
    const u32x4 xB0 = *(const u32x4*)(H1B + (size_t)t1 * 1024), xB1 = *(const u32x4*)(H1B + (size_t)t1 * 1024 + 8);
    const int t2 = TOK(i + 2);
    eA0 = *(const u32x4*)(IDX + (size_t)t2 * 128);
    eA1 = *(const u32x4*)(IDX + (size_t)t2 * 128 + 8);
    b1_compute(RA, xA0, xA1, PH + (size_t)t0 * 128, c, true);
    gather_rows(RA, U8, lofs, eA0, eA1);
    xA0 = *(const u32x4*)(H1B + (size_t)t2 * 1024);
    xA1 = *(const u32x4*)(H1B + (size_t)t2 * 1024 + 8);
    const int t3 = TOK(i + 3);
    eB0 = *(const u32x4*)(IDX + (size_t)t3 * 128);
    eB1 = *(const u32x4*)(IDX + (size_t)t3 * 128 + 8);
    b1_compute(RB, xB0, xB1, PH + (size_t)t1 * 128, c, i + 1 < n);
    t0 = t2;
    t1 = t3;
  }
}

DI void phase6w(const Params& P) {
  const int lane = threadIdx.x & 63;
  const int gw = blockIdx.x * 4 + (threadIdx.x >> 6), nw = gridDim.x * 4;
  char* ws = P.ws;
  float* G = (float*)(ws + W_G);
  const float* SSQ2 = (const float*)(ws + W_SSQ2);
  for (int t = gw; t < TT; t += nw) {
    float ssq = lane < 8 ? SSQ2[(size_t)t * 16 + lane] : 0.f;
    float h0 = 0.f, h1v = 0.f;
    {
      const float* ph = (const float*)(ws + W_XB) + (size_t)t * 128 + lane;
#pragma unroll
      for (int xs = 0; xs < 4; xs++) { h0 += ph[(size_t)xs * (SZ_PH / 4)]; h1v += ph[(size_t)xs * (SZ_PH / 4) + 64]; }
      ph = (const float*)(ws + W_GB) + (size_t)t * 128 + lane;
#pragma unroll
      for (int xs = 0; xs < 4; xs++) { h0 += ph[(size_t)xs * (SZ_PH / 4)]; h1v += ph[(size_t)xs * (SZ_PH / 4) + 64]; }
    }
    const float g0 = G[(size_t)t * 128 + lane];
    const float g1 = G[(size_t)t * 128 + 64 + lane];
    const float rs2 = rsqrtf(wave_sum(ssq) * (1.f / 1024.f) + EPS);
    const float w0 = g0 * gelu_tanh(rs2 * (1.f / U_SCALE) * h0) * (1.f / V_SCALE);
    const float w1 = g1 * gelu_tanh(rs2 * (1.f / U_SCALE) * h1v) * (1.f / V_SCALE);
    u16* wrow = (u16*)(G + (size_t)t * 128);
    wrow[(lane & 7) * 16 + (lane >> 3)] = f2bf(w0);
    wrow[(lane & 7) * 16 + 8 + (lane >> 3)] = f2bf(w1);
  }
}

DI void b2_compute(const RowSet& R, u32x4 w0, u32x4 w1, float* hp, u16* hb, float* sq, int g, int lane, bool valid) {
  const f32x2 hv = *(const f32x2*)hp;
  const u32 wv[8] = {w0.x, w0.y, w0.z, w0.w, w1.x, w1.y, w1.z, w1.w};
  float o[16];
#pragma unroll
  for (int i = 0; i < 16; i++) o[i] = 0.f;
#pragma unroll
  for (int i = 0; i < 16; i++) {
    u32 r0 = R.r[i].x, r1 = R.r[i].y, r2 = R.r[i].z, r3 = R.r[i].w;
    asm volatile("" : "+v"(r0), "+v"(r1), "+v"(r2), "+v"(r3) : "v"(o[0]), "v"(o[15]));
    const float wgt = (i & 1) ? __uint_as_float(wv[i >> 1] & 0xffff0000u) : __uint_as_float(wv[i >> 1] << 16);
    axpy4_fp8(r0, wgt, o[0], o[1], o[2], o[3]);
    axpy4_fp8(r1, wgt, o[4], o[5], o[6], o[7]);
    axpy4_fp8(r2, wgt, o[8], o[9], o[10], o[11]);
    axpy4_fp8(r3, wgt, o[12], o[13], o[14], o[15]);
  }
#pragma unroll
  for (int i = 0; i < 8; i++) { float keep = (g & 4) ? o[i + 8] : o[i]; float send = (g & 4) ? o[i] : o[i + 8]; o[i] = keep + __shfl_xor(send, 32); }
#pragma unroll
  for (int i = 0; i < 4; i++) { float keep = (g & 2) ? o[i + 4] : o[i]; float send = (g & 2) ? o[i] : o[i + 4]; o[i] = keep + __shfl_xor(send, 16); }
#pragma unroll
  for (int i = 0; i < 2; i++) { float keep = (g & 1) ? o[i + 2] : o[i]; float send = (g & 1) ? o[i] : o[i + 2]; o[i] = keep + __shfl_xor(send, 8); }
  const float a0 = hv.x + o[0], a1 = hv.y + o[1];
  const float ss = wave_sum(a0 * a0 + a1 * a1);
  if (valid) {
    *(f32x2*)hp = (f32x2){a0, a1};
    *(u32*)hb = pack2(a0, a1);
    if (lane == 0) *sq = ss;
  }
}
DI void phase6b2(const Params& P) {
  const int lane = threadIdx.x & 63, g = lane >> 3, c = lane & 7, w = threadIdx.x >> 6;
  const int x = blockIdx.x & 7;
  const int wg = (blockIdx.x >> 3) * 4 + w, nwg = (gridDim.x >> 3) * 4;
  char* ws = P.ws;
  const int col = x * 128 + c * 16 + 2 * (g & 1) + 4 * ((g >> 1) & 1) + 8 * ((g >> 2) & 1);
  u16* H1B = (u16*)(ws + W_QKV + SZ_ACT) + col;
  float* OUT = P.out + col;
  const unsigned char* V8 = (const unsigned char*)(ws + W_VB) + ((size_t)x << 21);
  const u32 lofs = c * 16;
  const u16* IDX = (const u16*)(ws + W_IDX) + g * 16;
  const u16* WG = (const u16*)(ws + W_G) + g * 16;
  float* SSQ3 = (float*)(ws + W_SSQ3) + x;
  const int n = (TT - wg + nwg - 1) / nwg;
  int t0 = TOK(0), t1 = TOK(1);
  u32x4 eA0 = *(const u32x4*)(IDX + (size_t)t0 * 128), eA1 = *(const u32x4*)(IDX + (size_t)t0 * 128 + 8);
  u32x4 eB0 = *(const u32x4*)(IDX + (size_t)t1 * 128), eB1 = *(const u32x4*)(IDX + (size_t)t1 * 128 + 8);
  RowSet RA, RB;
  gather_rows(RA, V8, lofs, eA0, eA1);
  u32x4 wA0 = *(const u32x4*)(WG + (size_t)t0 * 256), wA1 = *(const u32x4*)(WG + (size_t)t0 * 256 + 8);
#pragma unroll 1
  for (int i = 0; i < n; i += 2) {
    gather_rows(RB, V8, lofs, eB0, eB1);
    const u32x4 wB0 = *(const u32x4*)(WG + (size_t)t1 * 256), wB1 = *(const u32x4*)(WG + (size_t)t1 * 256 + 8);
    const int t2 = TOK(i + 2);
    eA0 = *(const u32x4*)(IDX + (size_t)t2 * 128);
    eA1 = *(const u32x4*)(IDX + (size_t)t2 * 128 + 8);
    b2_compute(RA, wA0, wA1, OUT + (size_t)t0 * 1024, H1B + (size_t)t0 * 1024, SSQ3 + (size_t)t0 * 8, g, lane, true);
    gather_rows(RA, V8, lofs, eA0, eA1);
    wA0 = *(const u32x4*)(WG + (size_t)t2 * 256);
    wA1 = *(const u32x4*)(WG + (size_t)t2 * 256 + 8);
    const int t3 = TOK(i + 3);
    eB0 = *(const u32x4*)(IDX + (size_t)t3 * 128);
    eB1 = *(const u32x4*)(IDX + (size_t)t3 * 128 + 8);
    b2_compute(RB, wB0, wB1, OUT + (size_t)t1 * 1024, H1B + (size_t)t1 * 1024, SSQ3 + (size_t)t1 * 8, g, lane, i + 1 < n);
    t0 = t2;
    t1 = t3;
  }
#undef TOK
}

DI void phase7_tile(const Params& P, int mt, int nt, char* smem) {
  const int tid = threadIdx.x, lane = tid & 63, w = tid >> 6, wm = w >> 1, wn = w & 1, r = lane & 15, quad = lane >> 4;
  const int m0 = mt * 128, n0 = nt * 128;
  char* ws = P.ws;
  const u16* H2B = (const u16*)(ws + W_QKV + SZ_ACT);
  const u16* PB = (const u16*)(ws + W_PB);
  const float* SSQ3 = (const float*)(ws + W_SSQ3);
  float* rs_s = (float*)(smem + RS_OFF);
  __syncthreads();
  if (tid < 128) {
    float q = 0.f;
#pragma unroll
    for (int i = 0; i < 8; i++) q += SSQ3[(size_t)(m0 + tid) * 8 + i];
    rs_s[tid] = rsqrtf(q * (1.f / 1024.f) + EPS);
  }
  u16* PJ = (u16*)(ws + W_QKV);
  f32x4 acc[4][4];
  zero_acc(acc);
  gemm_mainloop(PB + (size_t)m0 * 256, 256, (const u16*)(ws + W_WPP) + (size_t)n0 * 256, 256, 256, (u16*)smem, acc);
  float* Cs = (float*)smem;
  const int c4 = tid & 31, rsub = tid >> 5;
  const size_t tofs = (size_t)m0 * 1024 + n0 + c4 * 4;
  stage_acc(acc, Cs);
#pragma unroll 4
  for (int p = 0; p < 16; p++) {
    const int row = p * 8 + rsub;
    *(u32x2*)(PJ + tofs + (size_t)row * 1024) = pack4(*(const f32x4*)(Cs + row * CSTR + c4 * 4));
  }
  zero_acc(acc);
  gemm_mainloop(H2B + (size_t)m0 * 1024, 1024, (const u16*)(ws + W_WG) + (size_t)n0 * 1024, 1024, 1024, (u16*)smem, acc);
  stage_acc(acc, Cs);
#pragma unroll 4
  for (int p = 0; p < 16; p++) {
    const int row = p * 8 + rsub;
    const f32x4 v = *(const f32x4*)(Cs + row * CSTR + c4 * 4) * rs_s[row];
    const f32x4 pj = unpack4(*(const u32x2*)(PJ + tofs + (size_t)row * 1024));
    const f32x4 h2 = *(const f32x4*)(P.out + tofs + (size_t)row * 1024);
    const f32x4 gate = (f32x4){sigmoidf_(v.x), sigmoidf_(v.y), sigmoidf_(v.z), sigmoidf_(v.w)};
    *(f32x4*)(P.out + tofs + (size_t)row * 1024) = h2 + gate * pj;
  }
}

#define GEMM_TILES(NT, FN)                                                              \
  {                                                                                     \
    for (int t = blockIdx.x; t < 2 * (NT); t += gridDim.x) FN(P, 512 + t / (NT), t % (NT), smem); \
    const int x_ = blockIdx.x & 7, bpx_ = gridDim.x >> 3;                               \
    constexpr int NG_ = (NT) / 8;                                                       \
    for (int s_ = blockIdx.x >> 3; s_ < 64 * 8 * NG_; s_ += bpx_) {                     \
      const int R_ = s_ >> 6, q_ = s_ & 63;                                             \
      const int mg_ = R_ / NG_, ng_ = R_ % NG_;                                         \
      FN(P, ((mg_ * 8 + (q_ >> 3)) << 3) + x_, ng_ * 8 + (q_ & 7), smem);               \
    }                                                                                   \
  }

__global__ void __launch_bounds__(256, 2) fwd_megakernel(Params P) {
  __shared__ __attribute__((aligned(16))) char smem[SMEM_BYTES];
  cg::grid_group grid = cg::this_grid();
  phase0(P, smem);
  grid.sync();
  phase1_scans(P);
  GEMM_TILES(40, phase1_tile)
  grid.sync();
  phase2(P, smem);
  grid.sync();
  GEMM_TILES(8, phase3_tile)
  grid.sync();
  GEMM_TILES(8, phase4_tile)
  grid.sync();
  GEMM_TILES(8, phase5_tile)
  grid.sync();
  for (int t = blockIdx.x; t < TT / 64; t += gridDim.x) phase6a_unit(P, t, smem);
  grid.sync();
  phase6b1(P);
  grid.sync();
  phase6w(P);
  grid.sync();
  phase6b2(P);
  grid.sync();
  GEMM_TILES(8, phase7_tile)
}

extern "C" void kernel_launch(void* const* d_in, const int* in_sizes, int n_in, void* d_out, int out_size, void* d_ws,
                              size_t ws_size, hipStream_t stream) {
  static int grid_blocks = 0;
  if (!grid_blocks) {
    int dev = 0, cus = 0, per_cu = 0;
    hipGetDevice(&dev);
    hipDeviceGetAttribute(&cus, hipDeviceAttributeMultiprocessorCount, dev);
    hipOccupancyMaxActiveBlocksPerMultiprocessor(&per_cu, fwd_megakernel, 256, 0);
    if (per_cu > 2) per_cu = 2;
    if (per_cu < 1) per_cu = 1;
    grid_blocks = cus * per_cu;
  }
  if (ws_size < W_END) { fprintf(stderr, "workspace too small: %zu < %zu\n", ws_size, (size_t)W_END); return; }
  Params p{};
  const float** pf = (const float**)&p;
  for (int i = 0; i < 28; i++) pf[i] = (const float*)d_in[i];
  p.out = (float*)d_out;
  p.ws = (char*)d_ws;
  void* args[] = {&p};
  hipError_t e = hipLaunchCooperativeKernel((void*)fwd_megakernel, dim3(grid_blocks), dim3(256), args, 0, stream);
  if (e != hipSuccess) fprintf(stderr, "cooperative launch failed: %s (grid %d)\n", hipGetErrorString(e), grid_blocks);
}
```

```cpp
#include <hip/hip_runtime.h>
#include <hip/hip_cooperative_groups.h>
#include <cstdio>
namespace cg = cooperative_groups;

typedef unsigned short u16;
typedef unsigned int u32;
typedef short bf16x8 __attribute__((ext_vector_type(8)));
typedef short s16x4 __attribute__((ext_vector_type(4)));
typedef float f32x4 __attribute__((ext_vector_type(4)));
typedef unsigned int u32x4 __attribute__((ext_vector_type(4)));
typedef unsigned int u32x2 __attribute__((ext_vector_type(2)));
typedef __bf16 bf16x2_t __attribute__((ext_vector_type(2)));

#define DI __device__ __forceinline__
#define LAUNDER(x) asm volatile("" : "+v"(x))

constexpr int TP = 65536, TS = 256, TT = TP + TS;
constexpr float LOG2E = 1.4426950408889634f;
constexpr float EPS = 1e-6f;
constexpr float U_SCALE = 1024.f, V_SCALE = 128.f;

constexpr size_t O_AK_P = 67371008, O_AV_P = 100925440, O_AF_P = 134479872, O_BK_P = 135004160,
                 O_BV_P = 143392768, O_AK_S = 151781376, O_AV_S = 151912448, O_AF_S = 152043520,
                 O_BK_S = 152045568, O_BV_S = 152176640;

constexpr size_t SZ_ACT = (size_t)TT * 1024 * 2;
constexpr size_t SZ_HALF = (size_t)TT * 512 * 2;
constexpr size_t W_XB = 0;
constexpr size_t W_QKV = SZ_ACT;
constexpr size_t W_GA = W_QKV + 6 * SZ_HALF;
constexpr size_t W_GB = W_GA + SZ_ACT;
constexpr size_t W_PB = W_GB + SZ_ACT;
constexpr size_t W_WIN = W_PB + (size_t)TT * 256 * 2;
constexpr size_t W_WUPA = W_WIN + (size_t)5120 * 1024 * 2;
constexpr size_t W_WUPB = W_WUPA + 1024 * 512 * 2;
constexpr size_t W_WOUT = W_WUPB + 1024 * 512 * 2;
constexpr size_t W_WQ = W_WOUT + 1024 * 1024 * 2;
constexpr size_t W_WG = W_WQ + 1024 * 1024 * 2;
constexpr size_t W_WPP = W_WG + 1024 * 1024 * 2;
constexpr size_t W_UB = W_WPP + 1024 * 256 * 2;
constexpr size_t W_VB = W_UB + (size_t)16384 * 1024 * 2;
constexpr size_t W_SK = W_VB + (size_t)16384 * 1024 * 2;
constexpr size_t W_RS1 = W_SK + 131072 * 2;
constexpr size_t W_SSQ2 = W_RS1 + (size_t)TT * 4;
constexpr size_t W_RS3 = W_SSQ2 + (size_t)TT * 64;
constexpr size_t W_CUMP = W_RS3 + (size_t)TT * 4;
constexpr size_t W_CUMS = W_CUMP + (size_t)256 * 2048 * 4;
constexpr size_t W_SSQ3 = W_CUMS + (size_t)128 * 4112 * 4 + 1024;
constexpr size_t W_END = W_SSQ3 + (size_t)TT * 8 * 4;
constexpr size_t W_IDX = W_GA;
constexpr size_t W_G = W_GA + (size_t)32 * 1024 * 1024;
constexpr size_t SZ_PH = (size_t)TT * 128 * 2;


struct Params {
  const float *x_p, *x_s, *cak, *cav, *caf, *cbk, *cbv, *p_p, *p_s, *g_mix, *w_in, *b_f, *qn_a, *kn_a,
      *qn_b, *kn_b, *relb, *w_up_a, *w_up_b, *w_out, *g_ffn, *peer_wq, *peer_sk, *peer_u, *peer_v, *g_ple,
      *w_gate, *w_proj;
  float* out;
  char* ws;
};

constexpr int SMEM_BYTES = 128 * 129 * 4 + 2 * 64 * 17 * 4 + 256;

DI u16* ph_slice(char* ws, int x) { return (u16*)(ws + W_XB + (size_t)x * SZ_PH); }
DI u16 f2bf(float x) { return __builtin_bit_cast(u16, (__bf16)x); }
DI float bf2f(u16 h) { return __uint_as_float(((u32)h) << 16); }
DI u32 pack2(float a, float b) { bf16x2_t v = {(__bf16)a, (__bf16)b}; return __builtin_bit_cast(u32, v); }
DI float wave_sum(float v) {
#pragma unroll
  for (int o = 32; o; o >>= 1) v += __shfl_xor(v, o);
  return v;
}
DI f32x4 mfma16(bf16x8 a, bf16x8 b, f32x4 c) { return __builtin_amdgcn_mfma_f32_16x16x32_bf16(a, b, c, 0, 0, 0); }
DI float sigmoidf_(float x) { return 1.f / (1.f + __expf(-x)); }
DI u32 mono(float x) { u32 u = __float_as_uint(x); u32 m = (u32)((int)u >> 31) | 0x80000000u; return u ^ m; }
DI float unmono(u32 k) { u32 m = ((k >> 31) - 1u) | 0x80000000u; return __uint_as_float(k ^ m); }
DI void insert16(u32 (&L)[16], u32 x) {
#pragma unroll
  for (int s = 0; s < 16; s++) { u32 mx = max(L[s], x); x = min(L[s], x); L[s] = mx; }
}
DI float gelu_tanh(float x) {
  float u = 0.7978845608028654f * (x + 0.044715f * x * x * x);
  float t = 1.f - 2.f / (1.f + __expf(2.f * u));
  return 0.5f * x * (1.f + t);
}

constexpr int GSTR = 72;
constexpr int GBUF = 2 * 128 * GSTR;
constexpr int RS_OFF = 2 * GBUF * 2;
DI void gemm_compute(const u16* As, const u16* Bs, f32x4 (&acc)[4][4], int wm, int wn, int r, int quad) {
#pragma unroll
  for (int ks = 0; ks < 2; ks++) {
    bf16x8 af[4], bfr[4];
#pragma unroll
    for (int mi = 0; mi < 4; mi++) af[mi] = *(const bf16x8*)(As + (wm * 64 + mi * 16 + r) * GSTR + ks * 32 + quad * 8);
#pragma unroll
    for (int ni = 0; ni < 4; ni++) bfr[ni] = *(const bf16x8*)(Bs + (wn * 64 + ni * 16 + r) * GSTR + ks * 32 + quad * 8);
#pragma unroll
    for (int mi = 0; mi < 4; mi++)
#pragma unroll
      for (int ni = 0; ni < 4; ni++) acc[mi][ni] = mfma16(af[mi], bfr[ni], acc[mi][ni]);
    if (ks == 0) __builtin_amdgcn_sched_barrier(0);
  }
}
DI void gemm_mainloop(const u16* __restrict__ A, int lda, const u16* __restrict__ B, int ldb, int K, u16* smem,
                      f32x4 (&acc)[4][4]) {
  const int tid = threadIdx.x, lane = tid & 63, w = tid >> 6, wm = w >> 1, wn = w & 1, r = lane & 15, quad = lane >> 4;
  u16* As0 = smem;
  u16* Bs0 = smem + 128 * GSTR;
  u16* As1 = smem + GBUF;
  u16* Bs1 = As1 + 128 * GSTR;
  u32x4 r0a[4], r0b[4], r1a[4], r1b[4];
  const int lrow = tid >> 3, lch = tid & 7;
  const u16* ap = A + (size_t)lrow * lda + lch * 8;
  const u16* bp = B + (size_t)lrow * ldb + lch * 8;
  const int lo = lrow * GSTR + lch * 8;
  const int nk = K >> 6, km = nk - 1;
  const int krot = 0;
#define KOFF(kt) ((((kt) + krot) & km) * 64)
#pragma unroll
  for (int i = 0; i < 4; i++) {
    r0a[i] = *(const u32x4*)(ap + (size_t)i * 32 * lda + KOFF(0));
    r0b[i] = *(const u32x4*)(bp + (size_t)i * 32 * ldb + KOFF(0));
  }
#pragma unroll
  for (int i = 0; i < 4; i++) {
    r1a[i] = *(const u32x4*)(ap + (size_t)i * 32 * lda + KOFF(1));
    r1b[i] = *(const u32x4*)(bp + (size_t)i * 32 * ldb + KOFF(1));
  }
  __syncthreads();
#pragma unroll 1
  for (int kt = 0; kt < nk - 2; kt += 2) {
#pragma unroll
    for (int i = 0; i < 4; i++) {
      *(u32x4*)(As0 + lo + i * 32 * GSTR) = r0a[i];
      *(u32x4*)(Bs0 + lo + i * 32 * GSTR) = r0b[i];
    }
    __syncthreads();
    {
      const int ko = KOFF(kt + 2);
#pragma unroll
      for (int i = 0; i < 4; i++) {
        r0a[i] = *(const u32x4*)(ap + (size_t)i * 32 * lda + ko);
        r0b[i] = *(const u32x4*)(bp + (size_t)i * 32 * ldb + ko);
      }
    }
    gemm_compute(As0, Bs0, acc, wm, wn, r, quad);
#pragma unroll
    for (int i = 0; i < 4; i++) {
      *(u32x4*)(As1 + lo + i * 32 * GSTR) = r1a[i];
      *(u32x4*)(Bs1 + lo + i * 32 * GSTR) = r1b[i];
    }
    __syncthreads();
    {
      const int ko = KOFF(kt + 3);
#pragma unroll
      for (int i = 0; i < 4; i++) {
        r1a[i] = *(const u32x4*)(ap + (size_t)i * 32 * lda + ko);
        r1b[i] = *(const u32x4*)(bp + (size_t)i * 32 * ldb + ko);
      }
    }
    gemm_compute(As1, Bs1, acc, wm, wn, r, quad);
  }
#pragma unroll
  for (int i = 0; i < 4; i++) {
    *(u32x4*)(As0 + lo + i * 32 * GSTR) = r0a[i];
    *(u32x4*)(Bs0 + lo + i * 32 * GSTR) = r0b[i];
  }
  __syncthreads();
  gemm_compute(As0, Bs0, acc, wm, wn, r, quad);
#pragma unroll
  for (int i = 0; i < 4; i++) {
    *(u32x4*)(As1 + lo + i * 32 * GSTR) = r1a[i];
    *(u32x4*)(Bs1 + lo + i * 32 * GSTR) = r1b[i];
  }
  __syncthreads();
  gemm_compute(As1, Bs1, acc, wm, wn, r, quad);
#undef KOFF
}

DI void zero_acc(f32x4 (&acc)[4][4]) {
#pragma unroll
  for (int i = 0; i < 4; i++)
#pragma unroll
    for (int j = 0; j < 4; j++) acc[i][j] = (f32x4){0.f, 0.f, 0.f, 0.f};
}

constexpr int CSTR = 132;
DI void stage_acc(const f32x4 (&acc)[4][4], float* Cs) {
  const int tid = threadIdx.x, lane = tid & 63, w = tid >> 6, wm = w >> 1, wn = w & 1, r = lane & 15, quad = lane >> 4;
  __syncthreads();
#pragma unroll
  for (int mi = 0; mi < 4; mi++)
#pragma unroll
    for (int ni = 0; ni < 4; ni++)
#pragma unroll
      for (int j = 0; j < 4; j++) Cs[(wm * 64 + mi * 16 + quad * 4 + j) * CSTR + wn * 64 + ni * 16 + r] = acc[mi][ni][j];
  __syncthreads();
}
DI u32x2 pack4(f32x4 v) { return (u32x2){pack2(v.x, v.y), pack2(v.z, v.w)}; }
DI f32x4 unpack4(u32x2 p) {
  return (f32x4){__uint_as_float(p.x << 16), __uint_as_float(p.x & 0xffff0000u), __uint_as_float(p.y << 16), __uint_as_float(p.y & 0xffff0000u)};
}

DI void transpose_tile(const float* __restrict__ W, int ldw, int K, const float* __restrict__ g, u16* __restrict__ dst,
                       int k0, int n0, int nsrc0, float* tile) {
  const int tid = threadIdx.x;
  __syncthreads();
  {
    const int ty = tid >> 4, tx = tid & 15;
#pragma unroll
    for (int i = 0; i < 4; i++) {
      int k = ty + i * 16;
      f32x4 v = *(const f32x4*)(W + (size_t)(k0 + k) * ldw + nsrc0 + tx * 4);
      float s = g ? g[k0 + k] : 1.f;
      tile[k * 65 + tx * 4 + 0] = v[0] * s;
      tile[k * 65 + tx * 4 + 1] = v[1] * s;
      tile[k * 65 + tx * 4 + 2] = v[2] * s;
      tile[k * 65 + tx * 4 + 3] = v[3] * s;
    }
  }
  __syncthreads();
  {
    const int n = tid >> 2, kc = (tid & 3) * 16;
    u32 pk[8];
#pragma unroll
    for (int i = 0; i < 8; i++) pk[i] = pack2(tile[(kc + 2 * i) * 65 + n], tile[(kc + 2 * i + 1) * 65 + n]);
    u16* d = dst + (size_t)(n0 + n) * K + k0 + kc;
    *(u32x4*)d = (u32x4){pk[0], pk[1], pk[2], pk[3]};
    *(u32x4*)(d + 8) = (u32x4){pk[4], pk[5], pk[6], pk[7]};
  }
}

DI void conv_unit(const float* __restrict__ src, u16* __restrict__ dst, size_t base, const float* __restrict__ colscale) {
  const int tid = threadIdx.x;
#pragma unroll
  for (int i = 0; i < 4; i++) {
    size_t e = base + (size_t)i * 1024 + tid * 4;
    f32x4 v = *(const f32x4*)(src + e);
    if (colscale) {
      f32x4 gg = *(const f32x4*)(colscale + (e & 1023));
      v = v * gg;
    }
    *(u32x2*)(dst + e) = (u32x2){pack2(v[0], v[1]), pack2(v[2], v[3])};
  }
}

DI void conv_unit_fp8(const float* __restrict__ src, unsigned char* __restrict__ dst, size_t base,
                      const float* __restrict__ colscale, float scale) {
  const int tid = threadIdx.x;
#pragma unroll
  for (int i = 0; i < 4; i++) {
    size_t e = base + (size_t)i * 1024 + tid * 4;
    f32x4 v = *(const f32x4*)(src + e);
    if (colscale) {
      f32x4 gg = *(const f32x4*)(colscale + (e & 1023));
      v = v * gg;
    }
    int w = __builtin_amdgcn_cvt_pk_fp8_f32(v[0] * scale, v[1] * scale, 0, false);
    w = __builtin_amdgcn_cvt_pk_fp8_f32(v[2] * scale, v[3] * scale, w, true);
    *(int*)(dst + (((e & 1023) >> 7) << 21) + ((e >> 10) << 7) + (e & 127)) = w;
  }
}

DI void phase0(const Params& P, char* smem) {
  const int tid = threadIdx.x, lane = tid & 63, w = tid >> 6;
  char* ws = P.ws;
  {
    float* tile = (float*)smem;
    constexpr int T_WIN = 16 * 80, T_UP = 8 * 16, T_SQ = 256, T_PP = 4 * 16;
    constexpr int NT = T_WIN + 2 * T_UP + 3 * T_SQ + T_PP;
    for (int t = blockIdx.x; t < NT; t += gridDim.x) {
      int u = t;
      if (u < T_WIN) {
        int kt = u / 80, nt = u % 80;
        int n0 = nt * 64;
        int ns = n0 < 1536 ? n0 : n0 + 8;
        transpose_tile(P.w_in, 5128, 1024, P.g_mix, (u16*)(ws + W_WIN), kt * 64, n0, ns, tile);
        continue;
      }
      u -= T_WIN;
      if (u < T_UP) { transpose_tile(P.w_up_a, 1024, 512, nullptr, (u16*)(ws + W_WUPA), (u / 16) * 64, (u % 16) * 64, (u % 16) * 64, tile); continue; }
      u -= T_UP;
      if (u < T_UP) { transpose_tile(P.w_up_b, 1024, 512, nullptr, (u16*)(ws + W_WUPB), (u / 16) * 64, (u % 16) * 64, (u % 16) * 64, tile); continue; }
      u -= T_UP;
      if (u < T_SQ) { transpose_tile(P.w_out, 1024, 1024, nullptr, (u16*)(ws + W_WOUT), (u / 16) * 64, (u % 16) * 64, (u % 16) * 64, tile); continue; }
      u -= T_SQ;
      if (u < T_SQ) { transpose_tile(P.peer_wq, 1024, 1024, P.g_ffn, (u16*)(ws + W_WQ), (u / 16) * 64, (u % 16) * 64, (u % 16) * 64, tile); continue; }
      u -= T_SQ;
      if (u < T_SQ) { transpose_tile(P.w_gate, 1024, 1024, P.g_ple, (u16*)(ws + W_WG), (u / 16) * 64, (u % 16) * 64, (u % 16) * 64, tile); continue; }
      u -= T_SQ;
      transpose_tile(P.w_proj, 1024, 256, nullptr, (u16*)(ws + W_WPP), (u / 16) * 64, (u % 16) * 64, (u % 16) * 64, tile);
    }
  }
  {
    constexpr int U_UB = 4096, U_VB = 4096, U_SK = 32, U_PP = 4096, U_PS = 16;
    constexpr int NU = U_UB + U_VB + U_SK + U_PP + U_PS;
    for (int t = blockIdx.x; t < NU; t += gridDim.x) {
      int u = t;
      if (u < U_UB) { conv_unit_fp8(P.peer_u, (unsigned char*)(ws + W_UB), (size_t)u * 4096, P.g_ffn, U_SCALE); continue; }
      u -= U_UB;
      if (u < U_VB) { conv_unit_fp8(P.peer_v, (unsigned char*)(ws + W_VB), (size_t)u * 4096, nullptr, V_SCALE); continue; }
      u -= U_VB;
      if (u < U_SK) { conv_unit(P.peer_sk, (u16*)(ws + W_SK), (size_t)u * 4096, nullptr); continue; }
      u -= U_SK;
      if (u < U_PP) { conv_unit(P.p_p, (u16*)(ws + W_PB), (size_t)u * 4096, nullptr); continue; }
      u -= U_PP;
      conv_unit(P.p_s, (u16*)(ws + W_PB) + (size_t)TP * 256, (size_t)u * 4096, nullptr);
    }
  }
  {
    float* wfl = (float*)smem;
    __syncthreads();
    for (int i = tid; i < 8192; i += 256) {
      int k = i >> 3, h = i & 7;
      wfl[h * 1024 + k] = P.g_mix[k] * P.w_in[(size_t)k * 5128 + 1536 + h];
    }
    __syncthreads();
    u16* XB = (u16*)(ws + W_XB);
    float* RS1 = (float*)(ws + W_RS1);
    for (int t = blockIdx.x * 4 + w; t < TT; t += gridDim.x * 4) {
      const float* xr = t < TP ? P.x_p + (size_t)t * 1024 : P.x_s + (size_t)(t - TP) * 1024;
      f32x4 v[4];
#pragma unroll
      for (int i = 0; i < 4; i++) v[i] = *(const f32x4*)(xr + i * 256 + lane * 4);
      float ss = 0.f;
#pragma unroll
      for (int i = 0; i < 4; i++) ss += v[i][0] * v[i][0] + v[i][1] * v[i][1] + v[i][2] * v[i][2] + v[i][3] * v[i][3];
      float dots[8];
#pragma unroll
      for (int h = 0; h < 8; h++) {
        float d = 0.f;
#pragma unroll
        for (int i = 0; i < 4; i++) {
          f32x4 wv = *(const f32x4*)(wfl + h * 1024 + i * 256 + lane * 4);
          d += v[i][0] * wv[0] + v[i][1] * wv[1] + v[i][2] * wv[2] + v[i][3] * wv[3];
        }
        dots[h] = d;
      }
      ss = wave_sum(ss);
#pragma unroll
      for (int h = 0; h < 8; h++) dots[h] = wave_sum(dots[h]);
      float rs = rsqrtf(ss * (1.f / 1024.f) + EPS);
#pragma unroll
      for (int i = 0; i < 4; i++)
        *(u32x2*)(XB + (size_t)t * 1024 + i * 256 + lane * 4) = (u32x2){pack2(v[i][0], v[i][1]), pack2(v[i][2], v[i][3])};
      if (lane == 0) RS1[t] = rs;
      float myd = dots[0];
#pragma unroll
      for (int h = 1; h < 8; h++) myd = (lane == h) ? dots[h] : myd;
      if (lane < 8) {
        float z = rs * myd + P.b_f[lane];
        float lf = fminf(z, 0.f) - log1pf(expf(-fabsf(z)));
        float* o = t < TP ? P.out + O_AF_P + (size_t)t * 8 : P.out + O_AF_S + (size_t)(t - TP) * 8;
        o[lane] = lf;
      }
    }
  }
}

DI void phase1_scans(const Params& P) {
  const int lane = threadIdx.x & 63;
  const int gw = blockIdx.x * 4 + (threadIdx.x >> 6), nw = gridDim.x * 4;
  float* CUMP = (float*)(P.ws + W_CUMP);
  float* CUMS = (float*)(P.ws + W_CUMS);
  for (int row = gw; row < 384; row += nw) {
    float carry = 0.f;
    if (row < 256) {
      int b = row >> 3, h = row & 7;
      const float* src = P.out + O_AF_P + (size_t)b * 2048 * 8 + h;
      for (int p0 = 0; p0 < 2048; p0 += 64) {
        float v = src[(size_t)(p0 + lane) * 8];
#pragma unroll
        for (int o = 1; o < 64; o <<= 1) { float n = __shfl_up(v, o); if (lane >= o) v += n; }
        v += carry;
        CUMP[(size_t)row * 2048 + p0 + lane] = v * LOG2E;
        carry = __shfl(v, 63);
      }
    } else {
      int rr = row - 256;
      int b = rr >> 3, h = rr & 7;
      const float* src = P.caf + (size_t)b * 4096 * 8 + h;
      for (int p0 = 0; p0 < 4096; p0 += 64) {
        float v = src[(size_t)(p0 + lane) * 8];
#pragma unroll
        for (int o = 1; o < 64; o <<= 1) { float n = __shfl_up(v, o); if (lane >= o) v += n; }
        v += carry;
        CUMS[(size_t)rr * 4112 + p0 + lane] = v * LOG2E;
        carry = __shfl(v, 63);
      }
      {
        float v = lane < 16 ? P.out[O_AF_S + (size_t)(b * 16 + lane) * 8 + h] : 0.f;
#pragma unroll
        for (int o = 1; o < 64; o <<= 1) { float n = __shfl_up(v, o); if (lane >= o) v += n; }
        v += carry;
        if (lane < 16) CUMS[(size_t)rr * 4112 + 4096 + lane] = v * LOG2E;
      }
    }
  }
}

DI void phase1_tile(const Params& P, int mt, int nt, char* smem) {
  const int tid = threadIdx.x, lane = tid & 63, w = tid >> 6, wm = w >> 1, wn = w & 1, r = lane & 15, quad = lane >> 4;
  const int m0 = mt * 128, n0 = nt * 128;
  char* ws = P.ws;
  f32x4 acc[4][4];
  zero_acc(acc);
  gemm_mainloop((const u16*)(ws + W_XB) + (size_t)m0 * 1024, 1024, (const u16*)(ws + W_WIN) + (size_t)n0 * 1024, 1024, 1024,
                (u16*)smem, acc);
  float* Cs = (float*)smem;
  stage_acc(acc, Cs);
  const bool sample = m0 >= TP;
  const int c4 = tid & 31, rsub = tid >> 5;
  const float* RS1 = (const float*)(ws + W_RS1) + m0;
  if (n0 < 3072) {
    const int seg = n0 >> 9, hc = n0 & 511;
    const bool normed = (seg != 2 && seg != 5);
    const float* gain = seg == 0 ? P.qn_a : seg == 1 ? P.kn_a : seg == 3 ? P.qn_b : P.kn_b;
    const float qs = (seg == 0 || seg == 3) ? 0.125f * LOG2E : 1.f;
    f32x4 gn = (f32x4){1.f, 1.f, 1.f, 1.f};
    if (normed) gn = *(const f32x4*)(gain + (c4 & 15) * 4) * qs;
    u16* dp = (u16*)(ws + W_QKV + (size_t)seg * SZ_HALF) + (size_t)m0 * 512 + hc + c4 * 4;
    float* op = nullptr;
    if (seg == 1 || seg == 2) {
      op = sample ? P.out + (seg == 1 ? O_AK_S : O_AV_S) + (size_t)(m0 - TP) * 512 : P.out + (seg == 1 ? O_AK_P : O_AV_P) + (size_t)m0 * 512;
    } else if (seg == 4 || seg == 5) {
      if (sample) op = P.out + (seg == 4 ? O_BK_S : O_BV_S) + (size_t)(m0 - TP) * 512;
      else if ((m0 & 2047) >= 1536) op = P.out + (seg == 4 ? O_BK_P : O_BV_P) + ((size_t)(m0 >> 11) * 512 + ((m0 & 2047) - 1536)) * 512;
    }
    if (op) op += hc + c4 * 4;
#pragma unroll 4
    for (int p = 0; p < 16; p++) {
      const int row = p * 8 + rsub;
      f32x4 v = *(const f32x4*)(Cs + row * CSTR + c4 * 4) * RS1[row];
      if (normed) {
        float ss = v.x * v.x + v.y * v.y + v.z * v.z + v.w * v.w;
        ss += __shfl_xor(ss, 1);
        ss += __shfl_xor(ss, 2);
        ss += __shfl_xor(ss, 4);
        ss += __shfl_xor(ss, 8);
        v = v * gn * rsqrtf(ss * (1.f / 64.f) + EPS);
      }
      __builtin_nontemporal_store(pack4(v), (u32x2*)(dp + (size_t)row * 512));
      if (op) __builtin_nontemporal_store(v, (f32x4*)(op + (size_t)row * 512));
    }
  } else {
    u16* dp = (n0 < 4096 ? (u16*)(ws + W_GA) + (n0 - 3072) : (u16*)(ws + W_GB) + (n0 - 4096)) + (size_t)m0 * 1024 + c4 * 4;
#pragma unroll 4
    for (int p = 0; p < 16; p++) {
      const int row = p * 8 + rsub;
      f32x4 v = *(const f32x4*)(Cs + row * CSTR + c4 * 4) * RS1[row];
      v = (f32x4){sigmoidf_(v.x), sigmoidf_(v.y), sigmoidf_(v.z), sigmoidf_(v.w)};
      __builtin_nontemporal_store(pack4(v), (u32x2*)(dp + (size_t)row * 1024));
    }
  }
}

constexpr int ASTR = 72;
constexpr int ASTAGE = 2 * 64 * ASTR * 2 + 256;
constexpr int TAB_OFF = 2 * ASTAGE;
struct AttnState { f32x4 o[4]; float m, l; };

DI s16x4 tr_read(const u16* p) {
  return __builtin_amdgcn_ds_read_tr16_b64_v4i16((__attribute__((address_space(3))) s16x4*)(p));
}

template <int MODE>
DI void attn_step(const u16* Ks, const u16* Vs, const bf16x8 (&qf)[2], AttnState& st, int kpos0, int qpos, int qlim,
                  float cq, const float* cum, const float* tab, bool domask) {
  const int lane = threadIdx.x & 63, r = lane & 15, quad = lane >> 4;
  const bool farband = (MODE == 1) && (kpos0 + 31 - (qpos - r) <= -128);
  f32x4 s[2];
#pragma unroll
  for (int t = 0; t < 2; t++) {
    f32x4 a4 = (f32x4){0.f, 0.f, 0.f, 0.f};
#pragma unroll
    for (int ks = 0; ks < 2; ks++) {
      bf16x8 kf = *(const bf16x8*)(Ks + (t * 16 + r) * ASTR + ks * 32 + quad * 8);
      a4 = mfma16(kf, qf[ks], a4);
    }
    s[t] = a4;
  }
#pragma unroll
  for (int t = 0; t < 2; t++) {
    const int kb = kpos0 + t * 16 + quad * 4;
    if (MODE == 0) {
      f32x4 c4 = *(const f32x4*)(cum + kb);
#pragma unroll
      for (int j = 0; j < 4; j++) s[t][j] += cq - c4[j];
    } else if (farband) {
      const float b0 = tab[0];
#pragma unroll
      for (int j = 0; j < 4; j++) s[t][j] += b0;
    } else {
#pragma unroll
      for (int j = 0; j < 4; j++) {
        int rel = kb + j - qpos;
        rel = min(max(rel, -128), 128) + 128;
        s[t][j] += tab[rel];
      }
    }
    if (domask) {
#pragma unroll
      for (int j = 0; j < 4; j++)
        if (kb + j > qlim) s[t][j] = -1e30f;
    }
  }
  float p[8];
  float ls = 0.f;
#pragma unroll
  for (int t = 0; t < 2; t++)
#pragma unroll
    for (int j = 0; j < 4; j++) { p[t * 4 + j] = __builtin_amdgcn_exp2f(s[t][j]); ls += p[t * 4 + j]; }
  st.l += ls;
  u32x4 pk = (u32x4){pack2(p[0], p[1]), pack2(p[2], p[3]), pack2(p[4], p[5]), pack2(p[6], p[7])};
  bf16x8 pf = __builtin_bit_cast(bf16x8, pk);
  const int qq = (lane & 15) >> 2, pp = lane & 3;
#pragma unroll
  for (int dt = 0; dt < 4; dt++) {
    s16x4 lo = tr_read(Vs + (quad * 4 + qq) * ASTR + dt * 16 + pp * 4);
    s16x4 hi = tr_read(Vs + (16 + quad * 4 + qq) * ASTR + dt * 16 + pp * 4);
    bf16x8 vf = __builtin_shufflevector(lo, hi, 0, 1, 2, 3, 4, 5, 6, 7);
    st.o[dt] = mfma16(vf, pf, st.o[dt]);
  }
}

template <int MODE>
DI void attn_prompt_item(const Params& P, char* smem, int b, int h, int qt, float bound) {
  const int tid = threadIdx.x, lane = tid & 63, w = tid >> 6, r = lane & 15, quad = lane >> 4;
  char* ws = P.ws;
  const u16* Q = (const u16*)(ws + W_QKV + (size_t)(MODE == 0 ? 0 : 3) * SZ_HALF);
  const u16* Kg = (const u16*)(ws + W_QKV + (size_t)(MODE == 0 ? 1 : 4) * SZ_HALF);
  const u16* Vg = (const u16*)(ws + W_QKV + (size_t)(MODE == 0 ? 2 : 5) * SZ_HALF);
  u16* Y = (u16*)(ws + W_XB + (size_t)(MODE == 0 ? 0 : 1) * SZ_HALF);
  float* tab = (float*)(smem + TAB_OFF);
  __syncthreads();
  if (MODE == 1) {
    for (int i = tid; i < 257; i += 256) tab[i] = P.relb[h * 257 + i] * LOG2E - bound;
  }
  const int q0 = qt * 64;
  const int qpos = q0 + w * 16 + r;
  const size_t tokq = (size_t)b * 2048 + qpos;
  bf16x8 qf[2];
#pragma unroll
  for (int ks = 0; ks < 2; ks++) qf[ks] = *(const bf16x8*)(Q + tokq * 512 + h * 64 + ks * 32 + quad * 8);
  const float* cum = (const float*)(ws + W_CUMP) + (size_t)(b * 8 + h) * 2048;
  const float cq = MODE == 0 ? cum[qpos] - bound : 0.f;
  AttnState st;
#pragma unroll
  for (int dt = 0; dt < 4; dt++) st.o[dt] = (f32x4){0.f, 0.f, 0.f, 0.f};
  st.m = 0.f;
  st.l = 0.f;
  const int kt_lo = MODE == 0 ? 0 : max(0, qt - 8), kt_hi = qt;
  u32x4 rk[2], rv[2];
  f32x4 rc = (f32x4){0.f, 0.f, 0.f, 0.f};
  const int lkey = tid >> 3, lch = tid & 7;
  const u16* kp = Kg + ((size_t)b * 2048 + lkey) * 512 + h * 64 + lch * 8;
  const u16* vp = Vg + ((size_t)b * 2048 + lkey) * 512 + h * 64 + lch * 8;
  const int lofs = lkey * ASTR + lch * 8;
#pragma unroll
  for (int i = 0; i < 2; i++) {
    rk[i] = *(const u32x4*)(kp + (size_t)(kt_lo * 64 + i * 32) * 512);
    rv[i] = *(const u32x4*)(vp + (size_t)(kt_lo * 64 + i * 32) * 512);
  }
  if (MODE == 0 && tid < 16) rc = *(const f32x4*)(cum + kt_lo * 64 + tid * 4);
  {
    u16* Ks = (u16*)(smem + (kt_lo & 1) * ASTAGE);
    u16* Vs = Ks + 64 * ASTR;
#pragma unroll
    for (int i = 0; i < 2; i++) {
      *(u32x4*)(Ks + lofs + i * 32 * ASTR) = rk[i];
      *(u32x4*)(Vs + lofs + i * 32 * ASTR) = rv[i];
    }
    if (MODE == 0 && tid < 16) *(f32x4*)((float*)(Vs + 64 * ASTR) + tid * 4) = rc;
  }
  __syncthreads();
#pragma unroll 1
  for (int kt = kt_lo; kt <= kt_hi; kt++) {
    const int ktn = min(kt + 1, kt_hi);
#pragma unroll
    for (int i = 0; i < 2; i++) {
      rk[i] = *(const u32x4*)(kp + (size_t)(ktn * 64 + i * 32) * 512);
      rv[i] = *(const u32x4*)(vp + (size_t)(ktn * 64 + i * 32) * 512);
    }
    if (MODE == 0 && tid < 16) rc = *(const f32x4*)(cum + ktn * 64 + tid * 4);
    const u16* Ks = (const u16*)(smem + (kt & 1) * ASTAGE);
    const u16* Vs = Ks + 64 * ASTR;
    const float* cl = (const float*)(Vs + 64 * ASTR) - kt * 64;
    const bool diag = (MODE == 0) && (kt == qt);
#pragma unroll
    for (int half = 0; half < 2; half++) {
      const int kpos0 = kt * 64 + half * 32;
      if (diag && kpos0 > q0 + w * 16 + 15) continue;
      attn_step<MODE>(Ks + half * 32 * ASTR, Vs + half * 32 * ASTR, qf, st, kpos0, qpos, qpos, cq, cl, tab, diag);
    }
    if (kt < kt_hi) {
      u16* Kn = (u16*)(smem + ((kt + 1) & 1) * ASTAGE);
      u16* Vn = Kn + 64 * ASTR;
#pragma unroll
      for (int i = 0; i < 2; i++) {
        *(u32x4*)(Kn + lofs + i * 32 * ASTR) = rk[i];
        *(u32x4*)(Vn + lofs + i * 32 * ASTR) = rv[i];
      }
      if (MODE == 0 && tid < 16) *(f32x4*)((float*)(Vn + 64 * ASTR) + tid * 4) = rc;
    }
    __syncthreads();
  }
  float lt = st.l;
  lt += __shfl_xor(lt, 16);
  lt += __shfl_xor(lt, 32);
  const float inv = 1.f / lt;
#pragma unroll
  for (int dt = 0; dt < 4; dt++) {
    u32x2 o2 = (u32x2){pack2(st.o[dt][0] * inv, st.o[dt][1] * inv), pack2(st.o[dt][2] * inv, st.o[dt][3] * inv)};
    *(u32x2*)(Y + tokq * 512 + h * 64 + dt * 16 + quad * 4) = o2;
  }
}

template <int MODE>
DI void attn_sample_item(const Params& P, char* smem, int b, int h, float bound) {
  const int tid = threadIdx.x, lane = tid & 63, w = tid >> 6, r = lane & 15, quad = lane >> 4;
  constexpr int L = MODE == 0 ? 4096 : 512;
  char* ws = P.ws;
  const u16* Q = (const u16*)(ws + W_QKV + (size_t)(MODE == 0 ? 0 : 3) * SZ_HALF);
  const u16* Kn = (const u16*)(ws + W_QKV + (size_t)(MODE == 0 ? 1 : 4) * SZ_HALF);
  const u16* Vn = (const u16*)(ws + W_QKV + (size_t)(MODE == 0 ? 2 : 5) * SZ_HALF);
  u16* Y = (u16*)(ws + W_XB + (size_t)(MODE == 0 ? 0 : 1) * SZ_HALF);
  u16* Kw = (u16*)smem + w * (2 * 32 * ASTR);
  u16* Vw = Kw + 32 * ASTR;
  float* tab = (float*)(smem + TAB_OFF);
  __syncthreads();
  if (MODE == 1) {
    for (int i = tid; i < 257; i += 256) tab[i] = P.relb[h * 257 + i] * LOG2E - bound;
  }
  __syncthreads();
  const float* ck = (MODE == 0 ? P.cak : P.cbk) + ((size_t)b * L * 8 + h) * 64;
  const float* cv = (MODE == 0 ? P.cav : P.cbv) + ((size_t)b * L * 8 + h) * 64;
  const size_t tokbase = (size_t)TP + b * 16;
  bf16x8 qf[2];
#pragma unroll
  for (int ks = 0; ks < 2; ks++) qf[ks] = *(const bf16x8*)(Q + (tokbase + r) * 512 + h * 64 + ks * 32 + quad * 8);
  const int qpos = L + r;
  const float* cum = (const float*)(ws + W_CUMS) + (size_t)(b * 8 + h) * 4112;
  const float cq = MODE == 0 ? cum[qpos] - bound : 0.f;
  AttnState st;
#pragma unroll
  for (int dt = 0; dt < 4; dt++) st.o[dt] = (f32x4){0.f, 0.f, 0.f, 0.f};
  st.m = 0.f;
  st.l = 0.f;
  const int kbeg = w * (L / 4), kend = kbeg + L / 4;
#pragma unroll 1
  for (int k0 = kbeg; k0 < kend; k0 += 32) {
    {
      f32x4 kr[8];
#pragma unroll
      for (int i = 0; i < 8; i++) kr[i] = *(const f32x4*)(ck + (size_t)(k0 + i * 4 + quad) * 512 + r * 4);
#pragma unroll
      for (int i = 0; i < 8; i++)
        *(u32x2*)(Kw + (i * 4 + quad) * ASTR + r * 4) = (u32x2){pack2(kr[i][0], kr[i][1]), pack2(kr[i][2], kr[i][3])};
    }
    {
      f32x4 vr[8];
#pragma unroll
      for (int i = 0; i < 8; i++) vr[i] = *(const f32x4*)(cv + (size_t)(k0 + i * 4 + quad) * 512 + r * 4);
#pragma unroll
      for (int i = 0; i < 8; i++)
        *(u32x2*)(Vw + (i * 4 + quad) * ASTR + r * 4) = (u32x2){pack2(vr[i][0], vr[i][1]), pack2(vr[i][2], vr[i][3])};
    }
    asm volatile("s_waitcnt lgkmcnt(0)" ::: "memory");
    __builtin_amdgcn_wave_barrier();
    attn_step<MODE>(Kw, Vw, qf, st, k0, qpos, qpos, cq, cum, tab, false);
    __builtin_amdgcn_wave_barrier();
  }
  if (w == 0) {
#pragma unroll
    for (int i = 0; i < 2; i++) {
      int c = lane + i * 64;
      int key = c >> 3, ch = c & 7;
      u32x4 kk = *(const u32x4*)(Kn + (tokbase + key) * 512 + h * 64 + ch * 8);
      u32x4 vv = *(const u32x4*)(Vn + (tokbase + key) * 512 + h * 64 + ch * 8);
      *(u32x4*)(Kw + key * ASTR + ch * 8) = kk;
      *(u32x4*)(Vw + key * ASTR + ch * 8) = vv;
      *(u32x4*)(Kw + (16 + key) * ASTR + ch * 8) = (u32x4){0u, 0u, 0u, 0u};
      *(u32x4*)(Vw + (16 + key) * ASTR + ch * 8) = (u32x4){0u, 0u, 0u, 0u};
    }
    asm volatile("s_waitcnt lgkmcnt(0)" ::: "memory");
    __builtin_amdgcn_wave_barrier();
    attn_step<MODE>(Kw, Vw, qf, st, L, qpos, MODE == 0 ? qpos : L + 15, cq, cum, tab, true);
  }
  __syncthreads();
  float* comb = (float*)smem;
  float lt = st.l;
  lt += __shfl_xor(lt, 16);
  lt += __shfl_xor(lt, 32);
#pragma unroll
  for (int dt = 0; dt < 4; dt++)
#pragma unroll
    for (int j = 0; j < 4; j++) comb[(w * 16 + r) * 68 + dt * 16 + quad * 4 + j] = st.o[dt][j];
  if (quad == 0) comb[(w * 16 + r) * 68 + 65] = lt;
  __syncthreads();
  if (w == 0) {
    float Ls = 0.f;
#pragma unroll
    for (int i = 0; i < 4; i++) Ls += comb[(i * 16 + r) * 68 + 65];
    const float inv = 1.f / Ls;
#pragma unroll
    for (int dt = 0; dt < 4; dt++) {
      float ov[4];
#pragma unroll
      for (int j = 0; j < 4; j++) {
        float a = 0.f;
#pragma unroll
        for (int i = 0; i < 4; i++) a += comb[(i * 16 + r) * 68 + dt * 16 + quad * 4 + j];
        ov[j] = a * inv;
      }
      *(u32x2*)(Y + (tokbase + r) * 512 + h * 64 + dt * 16 + quad * 4) = (u32x2){pack2(ov[0], ov[1]), pack2(ov[2], ov[3])};
    }
  }
}

DI void phase2(const Params& P, char* smem) {
  constexpr int N_SA = 128, N_PA = 8192, N_PB = 8192, N_SB = 128;
  float bound_a, bound_b;
  {
    const int lane = threadIdx.x & 63;
    float qa = fabsf(P.qn_a[lane]), ka = fabsf(P.kn_a[lane]), qb = fabsf(P.qn_b[lane]), kb = fabsf(P.kn_b[lane]), rb = 0.f;
    for (int i = lane; i < 8 * 257; i += 64) rb = fmaxf(rb, fabsf(P.relb[i]));
#pragma unroll
    for (int o = 32; o; o >>= 1) {
      qa = fmaxf(qa, __shfl_xor(qa, o)); ka = fmaxf(ka, __shfl_xor(ka, o));
      qb = fmaxf(qb, __shfl_xor(qb, o)); kb = fmaxf(kb, __shfl_xor(kb, o));
      rb = fmaxf(rb, __shfl_xor(rb, o));
    }
    bound_a = 8.f * qa * ka * LOG2E;
    bound_b = (8.f * qb * kb + rb) * LOG2E;
  }
  for (int it = blockIdx.x; it < N_SA + N_PA + N_PB + N_SB; it += gridDim.x) {
    int u = it;
    if (u < N_SA) { attn_sample_item<0>(P, smem, u >> 3, u & 7, bound_a); continue; }
    u -= N_SA;
    if (u < N_PA) { int qt = 31 - (u >> 8), bh = u & 255; attn_prompt_item<0>(P, smem, bh >> 3, bh & 7, qt, bound_a); continue; }
    u -= N_PA;
    if (u < N_PB) { int qt = 31 - (u >> 8), bh = u & 255; attn_prompt_item<1>(P, smem, bh >> 3, bh & 7, qt, bound_b); continue; }
    u -= N_PB;
    attn_sample_item<1>(P, smem, u >> 3, u & 7, bound_b);
  }
}

DI void phase3_tile(const Params& P, int mt, int nt, char* smem) {
  const int tid = threadIdx.x, lane = tid & 63, w = tid >> 6, wm = w >> 1, wn = w & 1, r = lane & 15, quad = lane >> 4;
  const int m0 = mt * 128, n0 = nt * 128;
  char* ws = P.ws;
  const u16* YA = (const u16*)(ws + W_XB);
  const u16* YB = YA + (size_t)TT * 512;
  const u16* GA = (const u16*)(ws + W_GA);
  const u16* GB = (const u16*)(ws + W_GB);
  u16* MRG = (u16*)(ws + W_QKV);
  f32x4 acc[4][4];
  zero_acc(acc);
  gemm_mainloop(YA + (size_t)m0 * 512, 512, (const u16*)(ws + W_WUPA) + (size_t)n0 * 512, 512, 512, (u16*)smem, acc);
  float* Cs = (float*)smem;
  const int c4 = tid & 31, rsub = tid >> 5;
  const size_t tofs = (size_t)m0 * 1024 + n0 + c4 * 4;
  stage_acc(acc, Cs);
#pragma unroll 4
  for (int p = 0; p < 16; p++) {
    const int row = p * 8 + rsub;
    const f32x4 v = *(const f32x4*)(Cs + row * CSTR + c4 * 4);
    const f32x4 gv = unpack4(*(const u32x2*)(GA + tofs + (size_t)row * 1024));
    *(u32x2*)(MRG + tofs + (size_t)row * 1024) = pack4(v * gv);
  }
  zero_acc(acc);
  gemm_mainloop(YB + (size_t)m0 * 512, 512, (const u16*)(ws + W_WUPB) + (size_t)n0 * 512, 512, 512, (u16*)smem, acc);
  stage_acc(acc, Cs);
#pragma unroll 4
  for (int p = 0; p < 16; p++) {
    const int row = p * 8 + rsub;
    const f32x4 v = *(const f32x4*)(Cs + row * CSTR + c4 * 4);
    const f32x4 gv = unpack4(*(const u32x2*)(GB + tofs + (size_t)row * 1024));
    const f32x4 m1 = unpack4(*(const u32x2*)(MRG + tofs + (size_t)row * 1024));
    *(u32x2*)(MRG + tofs + (size_t)row * 1024) = pack4(m1 + v * gv);
  }
}

DI void phase4_tile(const Params& P, int mt, int nt, char* smem) {
  const int tid = threadIdx.x, lane = tid & 63, w = tid >> 6, wm = w >> 1, wn = w & 1, r = lane & 15, quad = lane >> 4;
  const int m0 = mt * 128, n0 = nt * 128;
  char* ws = P.ws;
  const u16* MRG = (const u16*)(ws + W_QKV);
  u16* H1B = (u16*)(ws + W_QKV + SZ_ACT);
  float* SSQ2 = (float*)(ws + W_SSQ2);
  f32x4 acc[4][4];
  zero_acc(acc);
  gemm_mainloop(MRG + (size_t)m0 * 1024, 1024, (const u16*)(ws + W_WOUT) + (size_t)n0 * 1024, 1024, 1024, (u16*)smem, acc);
  const float* xb = m0 < TP ? P.x_p : P.x_s - (size_t)TP * 1024;
  float* Cs = (float*)smem;
  const int c4 = tid & 31, rsub = tid >> 5;
  const size_t tofs = (size_t)m0 * 1024 + n0 + c4 * 4;
  stage_acc(acc, Cs);
#pragma unroll 4
  for (int p = 0; p < 16; p++) {
    const int row = p * 8 + rsub;
    const f32x4 v = *(const f32x4*)(Cs + row * CSTR + c4 * 4);
    const f32x4 h1 = *(const f32x4*)(xb + tofs + (size_t)row * 1024) + v;
    *(u32x2*)(H1B + tofs + (size_t)row * 1024) = pack4(h1);
    float ss = h1.x * h1.x + h1.y * h1.y + h1.z * h1.z + h1.w * h1.w;
    ss += __shfl_xor(ss, 1);
    ss += __shfl_xor(ss, 2);
    ss += __shfl_xor(ss, 4);
    ss += __shfl_xor(ss, 8);
    ss += __shfl_xor(ss, 16);
    if (c4 == 0) SSQ2[(size_t)(m0 + row) * 16 + nt] = ss;
  }
}

DI void phase5_tile(const Params& P, int mt, int nt, char* smem) {
  const int tid = threadIdx.x, lane = tid & 63, w = tid >> 6, wm = w >> 1, wn = w & 1, r = lane & 15, quad = lane >> 4;
  const int m0 = mt * 128, n0 = nt * 128;
  char* ws = P.ws;
  const u16* H1B = (const u16*)(ws + W_QKV + SZ_ACT);
  u16* QP = (u16*)(ws + W_QKV + 2 * SZ_ACT);
  const float* SSQ2 = (const float*)(ws + W_SSQ2);
  float* rs_s = (float*)(smem + RS_OFF);
  __syncthreads();
  if (tid < 128) {
    float s = 0.f;
#pragma unroll
    for (int i = 0; i < 8; i++) s += SSQ2[(size_t)(m0 + tid) * 16 + i];
    rs_s[tid] = rsqrtf(s * (1.f / 1024.f) + EPS);
  }
  f32x4 acc[4][4];
  zero_acc(acc);
  gemm_mainloop(H1B + (size_t)m0 * 1024, 1024, (const u16*)(ws + W_WQ) + (size_t)n0 * 1024, 1024, 1024, (u16*)smem, acc);
  float* Cs = (float*)smem;
  const int c4 = tid & 31, rsub = tid >> 5;
  const size_t tofs = (size_t)m0 * 1024 + n0 + c4 * 4;
  stage_acc(acc, Cs);
#pragma unroll 4
  for (int p = 0; p < 16; p++) {
    const int row = p * 8 + rsub;
    const f32x4 v = *(const f32x4*)(Cs + row * CSTR + c4 * 4) * rs_s[row];
    *(u32x2*)(QP + tofs + (size_t)row * 1024) = pack4(v);
  }
}

DI void bitonic_merge16(u32 (&L)[16]) {
#pragma unroll
  for (int st = 8; st >= 1; st >>= 1)
#pragma unroll
    for (int i = 0; i < 16; i++)
      if ((i & st) == 0) { u32 hi = max(L[i], L[i + st]); u32 lo = min(L[i], L[i + st]); L[i] = hi; L[i + st] = lo; }
}
DI void bitonic_sort16(u32 (&L)[16]) {
#pragma unroll
  for (int k = 2; k <= 16; k <<= 1)
#pragma unroll
    for (int j = k >> 1; j > 0; j >>= 1)
#pragma unroll
      for (int i = 0; i < 16; i++) {
        const int l = i ^ j;
        if (l > i) {
          const u32 hi = max(L[i], L[l]), lo = min(L[i], L[l]);
          if ((i & k) == 0) { L[i] = hi; L[l] = lo; } else { L[i] = lo; L[l] = hi; }
        }
      }
}
DI void phase6a_unit(const Params& P, int unit, char* smem) {
  const int tid = threadIdx.x, lane = tid & 63, w = tid >> 6, r = lane & 15, quad = lane >> 4;
  char* ws = P.ws;
  const u16* QP = (const u16*)(ws + W_QKV + 2 * SZ_ACT);
  const u16* SK = (const u16*)(ws + W_SK);
  u16* IDXo = (u16*)(ws + W_IDX);
  float* Go = (float*)(ws + W_G);
  float* sc = (float*)smem;
  u32* hl = (u32*)smem;
  u32* xl = (u32*)smem + 256 * 17;
  u32* lists = (u32*)(smem + 128 * 129 * 4);
  unsigned char* tabi = (unsigned char*)(smem + 128 * 129 * 4 + 128 * 17 * 4);
  unsigned char* tabj = tabi + 64;
  const int tok0 = unit * 64;
  __syncthreads();
  if (tid == 0) {
    int c = 0;
    for (int i = 0; i < 16; i++)
      for (int j = i + 1; j < 16; j++)
        if ((i + 1) * (j + 1) <= 16) { tabi[c] = (unsigned char)i; tabj[c] = (unsigned char)j; tabi[32 + c] = (unsigned char)j; tabj[32 + c] = (unsigned char)i; c++; }
    tabi[23] = 0; tabj[23] = 0; tabi[24] = 1; tabj[24] = 1;
    tabi[55] = 2; tabj[55] = 2; tabi[56] = 3; tabj[56] = 3;
  }
  for (int h = 0; h < 8; h++) {
#pragma unroll
    for (int p = 0; p < 2; p++) {
      const int hp = h * 2 + p;
      bf16x8 qf[2];
#pragma unroll
      for (int ks = 0; ks < 2; ks++)
        qf[ks] = *(const bf16x8*)(QP + (size_t)(tok0 + w * 16 + r) * 1024 + hp * 64 + ks * 32 + quad * 8);
#pragma unroll
      for (int nt = 0; nt < 8; nt++) {
        f32x4 a4 = (f32x4){0.f, 0.f, 0.f, 0.f};
#pragma unroll
        for (int ks = 0; ks < 2; ks++) {
          bf16x8 kf = *(const bf16x8*)(SK + (size_t)(hp * 128 + nt * 16 + r) * 64 + ks * 32 + quad * 8);
          a4 = mfma16(kf, qf[ks], a4);
        }
        float* d = sc + (p * 64 + w * 16 + r) * 129 + nt * 16 + quad * 4;
        d[0] = a4[0]; d[1] = a4[1]; d[2] = a4[2]; d[3] = a4[3];
      }
    }
    __syncthreads();
    u32 L[16];
    {
      const int inst = tid & 127, half = tid >> 7;
      const float* row = sc + inst * 129 + half * 64;
#pragma unroll
      for (int i = 0; i < 16; i++) L[i] = (mono(row[i]) & ~127u) | (u32)(half * 64 + i);
      bitonic_sort16(L);
#pragma unroll 1
      for (int c = 1; c < 4; c++) {
        u32 N[16];
#pragma unroll
        for (int i = 0; i < 16; i++) N[i] = (mono(row[c * 16 + i]) & ~127u) | (u32)(half * 64 + c * 16 + i);
        bitonic_sort16(N);
#pragma unroll
        for (int i = 0; i < 16; i++) L[i] = max(L[i], N[15 - i]);
        bitonic_merge16(L);
      }
    }
    __syncthreads();
#pragma unroll
    for (int s = 0; s < 16; s++) hl[tid * 17 + s] = L[s];
    __syncthreads();
    if (tid < 128) {
      u32 M[16];
#pragma unroll
      for (int s = 0; s < 16; s++) M[s] = max(L[s], hl[(tid + 128) * 17 + 15 - s]);
      bitonic_merge16(M);
#pragma unroll
      for (int s = 0; s < 16; s++) lists[tid * 17 + s] = M[s];
    }
    __syncthreads();
    if (tid < 128) {
      const int tok = tid & 63;
      const bool part = tid >= 64;
      float fa[16], fb[16];
#pragma unroll
      for (int s = 0; s < 16; s++) {
        const float va = unmono(lists[tok * 17 + s] & ~127u);
        const float vb = unmono(lists[(64 + tok) * 17 + s] & ~127u);
        fa[s] = part ? vb : va;
        fb[s] = part ? va : vb;
      }
      u32 L2[16];
#pragma unroll
      for (int s = 0; s < 16; s++) L2[s] = 0u;
      const u32 cbase = part ? 32u : 0u;
      {
        int c = 0;
#pragma unroll
        for (int i = 0; i < 16; i++)
#pragma unroll
          for (int j = i + 1; j < 16; j++)
            if ((i + 1) * (j + 1) <= 16) {
              insert16(L2, (mono(fa[i] + fb[j]) & ~63u) | (cbase + (u32)c));
              c++;
            }
      }
      insert16(L2, (mono(part ? fa[2] + fb[2] : fa[0] + fb[0]) & ~63u) | (cbase + 23u));
      insert16(L2, (mono(part ? fa[3] + fb[3] : fa[1] + fb[1]) & ~63u) | (cbase + 24u));
#pragma unroll
      for (int s = 0; s < 16; s++) xl[tid * 17 + s] = L2[s];
    }
    __syncthreads();
    if (tid < 64) {
      float val[16];
      u32 idx[16];
      float mx = -1e30f;
#pragma unroll
      for (int s = 0; s < 16; s++) {
        const u32 m = max(xl[tid * 17 + s], xl[(tid + 64) * 17 + 15 - s]);
        const u32 sl = m & 63u;
        const int i = tabi[sl], j = tabj[sl];
        const u32 au = lists[tid * 17 + i], bu = lists[(64 + tid) * 17 + j];
        val[s] = unmono(au & ~127u) + unmono(bu & ~127u);
        idx[s] = (au & 127u) * 128u + (bu & 127u);
        mx = fmaxf(mx, val[s]);
      }
      float sum = 0.f;
#pragma unroll
      for (int s = 0; s < 16; s++) { val[s] = __expf(val[s] - mx); sum += val[s]; }
      const float inv = 1.f / sum;
      const size_t so = ((size_t)(tok0 + tid) * 8 + h) * 16;
      {
        u32* ib = (u32*)(IDXo + (size_t)(tok0 + tid) * 128 + h * 2);
#pragma unroll
        for (int gg = 0; gg < 8; gg++) ib[gg * 8] = idx[gg] | (idx[gg + 8] << 16);
      }
#pragma unroll
      for (int s = 0; s < 4; s++)
        *(f32x4*)(Go + so + s * 4) = (f32x4){val[s * 4] * inv, val[s * 4 + 1] * inv, val[s * 4 + 2] * inv, val[s * 4 + 3] * inv};
    }
    __syncthreads();
  }
}

typedef float f32x2 __attribute__((ext_vector_type(2)));
DI float dot4_fp8(u32 w, float x0, float x1, float x2, float x3, float acc) {
  f32x2 lo = __builtin_amdgcn_cvt_pk_f32_fp8((int)w, false);
  f32x2 hi = __builtin_amdgcn_cvt_pk_f32_fp8((int)w, true);
  acc = fmaf(lo[0], x0, acc);
  acc = fmaf(lo[1], x1, acc);
  acc = fmaf(hi[0], x2, acc);
  acc = fmaf(hi[1], x3, acc);
  return acc;
}
DI void axpy4_fp8(u32 w, float wgt, float& o0, float& o1, float& o2, float& o3) {
  f32x2 lo = __builtin_amdgcn_cvt_pk_f32_fp8((int)w, false);
  f32x2 hi = __builtin_amdgcn_cvt_pk_f32_fp8((int)w, true);
  o0 = fmaf(wgt, lo[0], o0);
  o1 = fmaf(wgt, lo[1], o1);
  o2 = fmaf(wgt, hi[0], o2);
  o3 = fmaf(wgt, hi[1], o3);
}

struct RowSet { u32x4 r[16]; };
DI void gather_rows(RowSet& R, const unsigned char* base, u32 lofs, u32x4 ea, u32x4 eb) {
  const u32 ev[8] = {ea.x, ea.y, ea.z, ea.w, eb.x, eb.y, eb.z, eb.w};
#pragma unroll
  for (int i = 0; i < 8; i++) {
    R.r[2 * i] = *(const u32x4*)(base + (((ev[i] & 0xffffu) << 7) + lofs));
    R.r[2 * i + 1] = *(const u32x4*)(base + (((ev[i] >> 16) << 7) + lofs));
  }
}
DI void b1_compute(const RowSet& R, u32x4 xa, u32x4 xb, u16* pr, int c, bool valid) {
  float xf[16];
  xf[0] = __uint_as_float(xa.x << 16); xf[1] = __uint_as_float(xa.x & 0xffff0000u);
  xf[2] = __uint_as_float(xa.y << 16); xf[3] = __uint_as_float(xa.y & 0xffff0000u);
  xf[4] = __uint_as_float(xa.z << 16); xf[5] = __uint_as_float(xa.z & 0xffff0000u);
  xf[6] = __uint_as_float(xa.w << 16); xf[7] = __uint_as_float(xa.w & 0xffff0000u);
  xf[8] = __uint_as_float(xb.x << 16); xf[9] = __uint_as_float(xb.x & 0xffff0000u);
  xf[10] = __uint_as_float(xb.y << 16); xf[11] = __uint_as_float(xb.y & 0xffff0000u);
  xf[12] = __uint_as_float(xb.z << 16); xf[13] = __uint_as_float(xb.z & 0xffff0000u);
  xf[14] = __uint_as_float(xb.w << 16); xf[15] = __uint_as_float(xb.w & 0xffff0000u);
  float p[16];
#pragma unroll
  for (int i = 0; i < 16; i++) {
    float a = dot4_fp8(R.r[i].x, xf[0], xf[1], xf[2], xf[3], 0.f);
    a = dot4_fp8(R.r[i].y, xf[4], xf[5], xf[6], xf[7], a);
    a = dot4_fp8(R.r[i].z, xf[8], xf[9], xf[10], xf[11], a);
    a = dot4_fp8(R.r[i].w, xf[12], xf[13], xf[14], xf[15], a);
    p[i] = a;
  }
#pragma unroll
  for (int i = 0; i < 8; i++) { float keep = (c & 4) ? p[i + 8] : p[i]; float send = (c & 4) ? p[i] : p[i + 8]; p[i] = keep + __shfl_xor(send, 4); }
#pragma unroll
  for (int i = 0; i < 4; i++) { float keep = (c & 2) ? p[i + 4] : p[i]; float send = (c & 2) ? p[i] : p[i + 4]; p[i] = keep + __shfl_xor(send, 2); }
#pragma unroll
  for (int i = 0; i < 2; i++) { float keep = (c & 1) ? p[i + 2] : p[i]; float send = (c & 1) ? p[i] : p[i + 2]; p[i] = keep + __shfl_xor(send, 1); }
  const int it0 = 2 * (c & 1) + 4 * ((c >> 1) & 1) + 8 * ((c >> 2) & 1);
  if (valid) {
    pr[it0 * 8] = f2bf(p[0]);
    pr[(it0 + 1) * 8] = f2bf(p[1]);
  }
}
DI void phase6b1(const Params& P) {
  const int lane = threadIdx.x & 63, g = lane >> 3, c = lane & 7;
  const int x = blockIdx.x & 7;
  const int wg = (blockIdx.x >> 3) * 4 + (threadIdx.x >> 6), nwg = (gridDim.x >> 3) * 4;
  char* ws = P.ws;
  const u16* H1B = (const u16*)(ws + W_QKV + SZ_ACT) + x * 128 + c * 16;
  const unsigned char* U8 = (const unsigned char*)(ws + W_UB) + ((size_t)x << 21);
  const u32 lofs = c * 16;
  const u16* IDX = (const u16*)(ws + W_IDX) + g * 16;
  u16* PH = ph_slice(ws, x) + g;
  const int n = (TT - wg + nwg - 1) / nwg;
#define TOK(i) min(wg + (i) * nwg, TT - 1)
  int t0 = TOK(0), t1 = TOK(1);
  u32x4 eA0 = *(const u32x4*)(IDX + (size_t)t0 * 128), eA1 = *(const u32x4*)(IDX + (size_t)t0 * 128 + 8);
  u32x4 eB0 = *(const u32x4*)(IDX + (size_t)t1 * 128), eB1 = *(const u32x4*)(IDX + (size_t)t1 * 128 + 8);
  RowSet RA, RB;
  gather_rows(RA, U8, lofs, eA0, eA1);
  u32x4 xA0 = *(const u32x4*)(H1B + (size_t)t0 * 1024), xA1 = *(const u32x4*)(H1B + (size_t)t0 * 1024 + 8);
#pragma unroll 1
  for (int i = 0; i < n; i += 2) {
    gather_rows(RB, U8, lofs, eB0, eB1);
    const u32x4 xB0 = *(const u32x4*)(H1B + (size_t)t1 * 1024), xB1 = *(const u32x4*)(H1B + (size_t)t1 * 1024 + 8);
    const int t2 = TOK(i + 2);
    eA0 = *(const u32x4*)(IDX + (size_t)t2 * 128);
    eA1 = *(const u32x4*)(IDX + (size_t)t2 * 128 + 8);
    b1_compute(RA, xA0, xA1, PH + (size_t)t0 * 128, c, true);
    gather_rows(RA, U8, lofs, eA0, eA1);
    xA0 = *(const u32x4*)(H1B + (size_t)t2 * 1024);
    xA1 = *(const u32x4*)(H1B + (size_t)t2 * 1024 + 8);
    const int t3 = TOK(i + 3);
    eB0 = *(const u32x4*)(IDX + (size_t)t3 * 128);
    eB1 = *(const u32x4*)(IDX + (size_t)t3 * 128 + 8);
    b1_compute(RB, xB0, xB1, PH + (size_t)t1 * 128, c, i + 1 < n);
    t0 = t2;
    t1 = t3;
  }
}

DI void phase6w(const Params& P) {
  const int lane = threadIdx.x & 63;
  const int gw = blockIdx.x * 4 + (threadIdx.x >> 6), nw = gridDim.x * 4;
  char* ws = P.ws;
  float* G = (float*)(ws + W_G);
  const float* SSQ2 = (const float*)(ws + W_SSQ2);
  for (int t = gw; t < TT; t += nw) {
    float ssq = lane < 8 ? SSQ2[(size_t)t * 16 + lane] : 0.f;
    float h0 = 0.f, h1v = 0.f;
    {
      const u16* ph = (const u16*)(ws + W_XB) + (size_t)t * 128 + lane;
#pragma unroll
      for (int xs = 0; xs < 8; xs++) { h0 += bf2f(ph[(size_t)xs * (SZ_PH / 2)]); h1v += bf2f(ph[(size_t)xs * (SZ_PH / 2) + 64]); }
    }
    const float g0 = G[(size_t)t * 128 + lane];
    const float g1 = G[(size_t)t * 128 + 64 + lane];
    const float rs2 = rsqrtf(wave_sum(ssq) * (1.f / 1024.f) + EPS);
    const float w0 = g0 * gelu_tanh(rs2 * (1.f / U_SCALE) * h0) * (1.f / V_SCALE);
    const float w1 = g1 * gelu_tanh(rs2 * (1.f / U_SCALE) * h1v) * (1.f / V_SCALE);
    u16* wrow = (u16*)(G + (size_t)t * 128);
    wrow[(lane & 7) * 16 + (lane >> 3)] = f2bf(w0);
    wrow[(lane & 7) * 16 + 8 + (lane >> 3)] = f2bf(w1);
  }
}

DI void b2_compute(const RowSet& R, u32x4 w0, u32x4 w1, u16* hb, float* sq, int g, int lane, bool valid) {
  const u32 hraw = *(const u32*)hb;
  const u32 wv[8] = {w0.x, w0.y, w0.z, w0.w, w1.x, w1.y, w1.z, w1.w};
  float o[16];
#pragma unroll
  for (int i = 0; i < 16; i++) o[i] = 0.f;
#pragma unroll
  for (int i = 0; i < 16; i++) {
    u32 r0 = R.r[i].x, r1 = R.r[i].y, r2 = R.r[i].z, r3 = R.r[i].w;
    asm volatile("" : "+v"(r0), "+v"(r1), "+v"(r2), "+v"(r3) : "v"(o[0]), "v"(o[15]));
    const float wgt = (i & 1) ? __uint_as_float(wv[i >> 1] & 0xffff0000u) : __uint_as_float(wv[i >> 1] << 16);
    axpy4_fp8(r0, wgt, o[0], o[1], o[2], o[3]);
    axpy4_fp8(r1, wgt, o[4], o[5], o[6], o[7]);
    axpy4_fp8(r2, wgt, o[8], o[9], o[10], o[11]);
    axpy4_fp8(r3, wgt, o[12], o[13], o[14], o[15]);
  }
#pragma unroll
  for (int i = 0; i < 8; i++) { float keep = (g & 4) ? o[i + 8] : o[i]; float send = (g & 4) ? o[i] : o[i + 8]; o[i] = keep + __shfl_xor(send, 32); }
#pragma unroll
  for (int i = 0; i < 4; i++) { float keep = (g & 2) ? o[i + 4] : o[i]; float send = (g & 2) ? o[i] : o[i + 4]; o[i] = keep + __shfl_xor(send, 16); }
#pragma unroll
  for (int i = 0; i < 2; i++) { float keep = (g & 1) ? o[i + 2] : o[i]; float send = (g & 1) ? o[i] : o[i + 2]; o[i] = keep + __shfl_xor(send, 8); }
  const float a0 = __uint_as_float(hraw << 16) + o[0], a1 = __uint_as_float(hraw & 0xffff0000u) + o[1];
  const float ss = wave_sum(a0 * a0 + a1 * a1);
  if (valid) {
    *(u32*)hb = pack2(a0, a1);
    if (lane == 0) *sq = ss;
  }
}
DI void phase6b2(const Params& P) {
  const int lane = threadIdx.x & 63, g = lane >> 3, c = lane & 7, w = threadIdx.x >> 6;
  const int x = blockIdx.x & 7;
  const int wg = (blockIdx.x >> 3) * 4 + w, nwg = (gridDim.x >> 3) * 4;
  char* ws = P.ws;
  const int col = x * 128 + c * 16 + 2 * (g & 1) + 4 * ((g >> 1) & 1) + 8 * ((g >> 2) & 1);
  u16* H1B = (u16*)(ws + W_QKV + SZ_ACT) + col;
  const unsigned char* V8 = (const unsigned char*)(ws + W_VB) + ((size_t)x << 21);
  const u32 lofs = c * 16;
  const u16* IDX = (const u16*)(ws + W_IDX) + g * 16;
  const u16* WG = (const u16*)(ws + W_G) + g * 16;
  float* SSQ3 = (float*)(ws + W_SSQ3) + x;
  const int n = (TT - wg + nwg - 1) / nwg;
  int t0 = TOK(0), t1 = TOK(1);
  u32x4 eA0 = *(const u32x4*)(IDX + (size_t)t0 * 128), eA1 = *(const u32x4*)(IDX + (size_t)t0 * 128 + 8);
  u32x4 eB0 = *(const u32x4*)(IDX + (size_t)t1 * 128), eB1 = *(const u32x4*)(IDX + (size_t)t1 * 128 + 8);
  RowSet RA, RB;
  gather_rows(RA, V8, lofs, eA0, eA1);
  u32x4 wA0 = *(const u32x4*)(WG + (size_t)t0 * 256), wA1 = *(const u32x4*)(WG + (size_t)t0 * 256 + 8);
#pragma unroll 1
  for (int i = 0; i < n; i += 2) {
    gather_rows(RB, V8, lofs, eB0, eB1);
    const u32x4 wB0 = *(const u32x4*)(WG + (size_t)t1 * 256), wB1 = *(const u32x4*)(WG + (size_t)t1 * 256 + 8);
    const int t2 = TOK(i + 2);
    eA0 = *(const u32x4*)(IDX + (size_t)t2 * 128);
    eA1 = *(const u32x4*)(IDX + (size_t)t2 * 128 + 8);
    b2_compute(RA, wA0, wA1, H1B + (size_t)t0 * 1024, SSQ3 + (size_t)t0 * 8, g, lane, true);
    gather_rows(RA, V8, lofs, eA0, eA1);
    wA0 = *(const u32x4*)(WG + (size_t)t2 * 256);
    wA1 = *(const u32x4*)(WG + (size_t)t2 * 256 + 8);
    const int t3 = TOK(i + 3);
    eB0 = *(const u32x4*)(IDX + (size_t)t3 * 128);
    eB1 = *(const u32x4*)(IDX + (size_t)t3 * 128 + 8);
    b2_compute(RB, wB0, wB1, H1B + (size_t)t1 * 1024, SSQ3 + (size_t)t1 * 8, g, lane, i + 1 < n);
    t0 = t2;
    t1 = t3;
  }
#undef TOK
}

DI void phase7_tile(const Params& P, int mt, int nt, char* smem) {
  const int tid = threadIdx.x, lane = tid & 63, w = tid >> 6, wm = w >> 1, wn = w & 1, r = lane & 15, quad = lane >> 4;
  const int m0 = mt * 128, n0 = nt * 128;
  char* ws = P.ws;
  const u16* H2B = (const u16*)(ws + W_QKV + SZ_ACT);
  const u16* PB = (const u16*)(ws + W_PB);
  const float* SSQ3 = (const float*)(ws + W_SSQ3);
  float* rs_s = (float*)(smem + RS_OFF);
  __syncthreads();
  if (tid < 128) {
    float q = 0.f;
#pragma unroll
    for (int i = 0; i < 8; i++) q += SSQ3[(size_t)(m0 + tid) * 8 + i];
    rs_s[tid] = rsqrtf(q * (1.f / 1024.f) + EPS);
  }
  u16* PJ = (u16*)(ws + W_QKV);
  f32x4 acc[4][4];
  zero_acc(acc);
  gemm_mainloop(PB + (size_t)m0 * 256, 256, (const u16*)(ws + W_WPP) + (size_t)n0 * 256, 256, 256, (u16*)smem, acc);
  float* Cs = (float*)smem;
  const int c4 = tid & 31, rsub = tid >> 5;
  const size_t tofs = (size_t)m0 * 1024 + n0 + c4 * 4;
  stage_acc(acc, Cs);
#pragma unroll 4
  for (int p = 0; p < 16; p++) {
    const int row = p * 8 + rsub;
    *(u32x2*)(PJ + tofs + (size_t)row * 1024) = pack4(*(const f32x4*)(Cs + row * CSTR + c4 * 4));
  }
  zero_acc(acc);
  gemm_mainloop(H2B + (size_t)m0 * 1024, 1024, (const u16*)(ws + W_WG) + (size_t)n0 * 1024, 1024, 1024, (u16*)smem, acc);
  stage_acc(acc, Cs);
#pragma unroll 4
  for (int p = 0; p < 16; p++) {
    const int row = p * 8 + rsub;
    const f32x4 v = *(const f32x4*)(Cs + row * CSTR + c4 * 4) * rs_s[row];
    const f32x4 pj = unpack4(*(const u32x2*)(PJ + tofs + (size_t)row * 1024));
    const f32x4 h2 = unpack4(*(const u32x2*)(H2B + tofs + (size_t)row * 1024));
    const f32x4 gate = (f32x4){sigmoidf_(v.x), sigmoidf_(v.y), sigmoidf_(v.z), sigmoidf_(v.w)};
    __builtin_nontemporal_store(h2 + gate * pj, (f32x4*)(P.out + tofs + (size_t)row * 1024));
  }
}

#define GEMM_TILES(NT, FN)                                                              \
  {                                                                                     \
    for (int t = blockIdx.x; t < 2 * (NT); t += gridDim.x) FN(P, 512 + t / (NT), t % (NT), smem); \
    const int x_ = blockIdx.x & 7, bpx_ = gridDim.x >> 3;                               \
    constexpr int NG_ = (NT) / 8;                                                       \
    for (int s_ = blockIdx.x >> 3; s_ < 64 * 8 * NG_; s_ += bpx_) {                     \
      const int R_ = s_ >> 6, q_ = s_ & 63;                                             \
      const int mg_ = R_ / NG_, ng_ = R_ % NG_;                                         \
      FN(P, ((mg_ * 8 + (q_ >> 3)) << 3) + x_, ng_ * 8 + (q_ & 7), smem);               \
    }                                                                                   \
  }

__global__ void __launch_bounds__(256, 2) fwd_megakernel(Params P) {
  __shared__ __attribute__((aligned(16))) char smem[SMEM_BYTES];
  cg::grid_group grid = cg::this_grid();
  phase0(P, smem);
  grid.sync();
  phase1_scans(P);
  GEMM_TILES(40, phase1_tile)
  grid.sync();
  phase2(P, smem);
  grid.sync();
  GEMM_TILES(8, phase3_tile)
  grid.sync();
  GEMM_TILES(8, phase4_tile)
  grid.sync();
  GEMM_TILES(8, phase5_tile)
  grid.sync();
  for (int t = blockIdx.x; t < TT / 64; t += gridDim.x) phase6a_unit(P, t, smem);
  grid.sync();
  phase6b1(P);
  grid.sync();
  phase6w(P);
  grid.sync();
  phase6b2(P);
  grid.sync();
  GEMM_TILES(8, phase7_tile)
}

extern "C" void kernel_launch(void* const* d_in, const int* in_sizes, int n_in, void* d_out, int out_size, void* d_ws,
                              size_t ws_size, hipStream_t stream) {
  static int grid_blocks = 0;
  if (!grid_blocks) {
    int dev = 0, cus = 0, per_cu = 0;
    hipGetDevice(&dev);
    hipDeviceGetAttribute(&cus, hipDeviceAttributeMultiprocessorCount, dev);
    hipOccupancyMaxActiveBlocksPerMultiprocessor(&per_cu, fwd_megakernel, 256, 0);
    if (per_cu > 2) per_cu = 2;
    if (per_cu < 1) per_cu = 1;
    grid_blocks = cus * per_cu;
  }
  if (ws_size < W_END) { fprintf(stderr, "workspace too small: %zu < %zu\n", ws_size, (size_t)W_END); return; }
  Params p{};
  const float** pf = (const float**)&p;
  for (int i = 0; i < 28; i++) pf[i] = (const float*)d_in[i];
  p.out = (float*)d_out;
  p.ws = (char*)d_ws;
  void* args[] = {&p};
  hipError_t e = hipLaunchCooperativeKernel((void*)fwd_megakernel, dim3(grid_blocks), dim3(256), args, 0, stream);
  if (e != hipSuccess) fprintf(stderr, "cooperative launch failed: %s (grid %d)\n", hipGetErrorString(e), grid_blocks);
}
```

```cpp
#include <hip/hip_runtime.h>
#include <hip/hip_cooperative_groups.h>
#include <cstdio>
namespace cg = cooperative_groups;

typedef unsigned short u16;
typedef unsigned int u32;
typedef short bf16x8 __attribute__((ext_vector_type(8)));
typedef short s16x4 __attribute__((ext_vector_type(4)));
typedef float f32x4 __attribute__((ext_vector_type(4)));
typedef unsigned int u32x4 __attribute__((ext_vector_type(4)));
typedef unsigned int u32x2 __attribute__((ext_vector_type(2)));
typedef __bf16 bf16x2_t __attribute__((ext_vector_type(2)));

#define DI __device__ __forceinline__
#define LAUNDER(x) asm volatile("" : "+v"(x))

constexpr int TP = 65536, TS = 256, TT = TP + TS;
constexpr float LOG2E = 1.4426950408889634f;
constexpr float EPS = 1e-6f;
constexpr float U_SCALE = 1024.f, V_SCALE = 128.f;

constexpr size_t O_AK_P = 67371008, O_AV_P = 100925440, O_AF_P = 134479872, O_BK_P = 135004160,
                 O_BV_P = 143392768, O_AK_S = 151781376, O_AV_S = 151912448, O_AF_S = 152043520,
                 O_BK_S = 152045568, O_BV_S = 152176640;

constexpr size_t SZ_ACT = (size_t)TT * 1024 * 2;
constexpr size_t SZ_HALF = (size_t)TT * 512 * 2;
constexpr size_t W_XB = 0;
constexpr size_t W_QKV = SZ_ACT;
constexpr size_t W_GA = W_QKV + 6 * SZ_HALF;
constexpr size_t W_GB = W_GA + SZ_ACT;
constexpr size_t W_PB = W_GB + SZ_ACT;
constexpr size_t W_WIN = W_PB + (size_t)TT * 256 * 2;
constexpr size_t W_WUPA = W_WIN + (size_t)5120 * 1024 * 2;
constexpr size_t W_WUPB = W_WUPA + 1024 * 512 * 2;
constexpr size_t W_WOUT = W_WUPB + 1024 * 512 * 2;
constexpr size_t W_WQ = W_WOUT + 1024 * 1024 * 2;
constexpr size_t W_WG = W_WQ + 1024 * 1024 * 2;
constexpr size_t W_WPP = W_WG + 1024 * 1024 * 2;
constexpr size_t W_UB = W_WPP + 1024 * 256 * 2;
constexpr size_t W_VB = W_UB + (size_t)16384 * 1024 * 2;
constexpr size_t W_SK = W_VB + (size_t)16384 * 1024 * 2;
constexpr size_t W_RS1 = W_SK + 131072 * 2;
constexpr size_t W_SSQ2 = W_RS1 + (size_t)TT * 4;
constexpr size_t W_RS3 = W_SSQ2 + (size_t)TT * 64;
constexpr size_t W_CUMP = W_RS3 + (size_t)TT * 4;
constexpr size_t W_CUMS = W_CUMP + (size_t)256 * 2048 * 4;
constexpr size_t W_SSQ3 = W_CUMS + (size_t)128 * 4112 * 4 + 1024;
constexpr size_t W_BAR = W_SSQ3 + (size_t)TT * 8 * 4;
constexpr int BAR_SLOT = 17 * 64;
constexpr size_t BAR_BYTES = (size_t)(16 * BAR_SLOT + 16 * 64) * 4;
constexpr size_t W_END = W_BAR + BAR_BYTES;
constexpr size_t W_IDX = W_GA;
constexpr size_t W_G = W_GA + (size_t)32 * 1024 * 1024;
constexpr size_t SZ_PH = (size_t)TT * 128 * 2;


struct Params {
  const float *x_p, *x_s, *cak, *cav, *caf, *cbk, *cbv, *p_p, *p_s, *g_mix, *w_in, *b_f, *qn_a, *kn_a,
      *qn_b, *kn_b, *relb, *w_up_a, *w_up_b, *w_out, *g_ffn, *peer_wq, *peer_sk, *peer_u, *peer_v, *g_ple,
      *w_gate, *w_proj;
  float* out;
  char* ws;
};

constexpr int SMEM_BYTES = 128 * 129 * 4 + 2 * 64 * 17 * 4 + 256;

DI u16* ph_slice(char* ws, int x) { return (u16*)(ws + W_XB + (size_t)x * SZ_PH); }
DI u16 f2bf(float x) { return __builtin_bit_cast(u16, (__bf16)x); }
DI float bf2f(u16 h) { return __uint_as_float(((u32)h) << 16); }
DI u32 pack2(float a, float b) { bf16x2_t v = {(__bf16)a, (__bf16)b}; return __builtin_bit_cast(u32, v); }
DI float wave_sum(float v) {
#pragma unroll
  for (int o = 32; o; o >>= 1) v += __shfl_xor(v, o);
  return v;
}
DI f32x4 mfma16(bf16x8 a, bf16x8 b, f32x4 c) { return __builtin_amdgcn_mfma_f32_16x16x32_bf16(a, b, c, 0, 0, 0); }
DI float sigmoidf_(float x) { return 1.f / (1.f + __expf(-x)); }
DI u32 mono(float x) { u32 u = __float_as_uint(x); u32 m = (u32)((int)u >> 31) | 0x80000000u; return u ^ m; }
DI float unmono(u32 k) { u32 m = ((k >> 31) - 1u) | 0x80000000u; return __uint_as_float(k ^ m); }
DI void insert16(u32 (&L)[16], u32 x) {
#pragma unroll
  for (int s = 0; s < 16; s++) { u32 mx = max(L[s], x); x = min(L[s], x); L[s] = mx; }
}
DI float gelu_tanh(float x) {
  float u = 0.7978845608028654f * (x + 0.044715f * x * x * x);
  float t = 1.f - 2.f / (1.f + __expf(2.f * u));
  return 0.5f * x * (1.f + t);
}

constexpr int GSTR = 72;
constexpr int GBUF = 2 * 128 * GSTR;
constexpr int RS_OFF = 2 * GBUF * 2;
DI void gemm_compute(const u16* As, const u16* Bs, f32x4 (&acc)[4][4], int wm, int wn, int r, int quad) {
#pragma unroll
  for (int ks = 0; ks < 2; ks++) {
    bf16x8 af[4], bfr[4];
#pragma unroll
    for (int mi = 0; mi < 4; mi++) af[mi] = *(const bf16x8*)(As + (wm * 64 + mi * 16 + r) * GSTR + ks * 32 + quad * 8);
#pragma unroll
    for (int ni = 0; ni < 4; ni++) bfr[ni] = *(const bf16x8*)(Bs + (wn * 64 + ni * 16 + r) * GSTR + ks * 32 + quad * 8);
#pragma unroll
    for (int mi = 0; mi < 4; mi++)
#pragma unroll
      for (int ni = 0; ni < 4; ni++) acc[mi][ni] = mfma16(af[mi], bfr[ni], acc[mi][ni]);
    if (ks == 0) __builtin_amdgcn_sched_barrier(0);
  }
}
DI void gemm_mainloop(const u16* __restrict__ A, int lda, const u16* __restrict__ B, int ldb, int K, u16* smem,
                      f32x4 (&acc)[4][4]) {
  const int tid = threadIdx.x, lane = tid & 63, w = tid >> 6, wm = w >> 1, wn = w & 1, r = lane & 15, quad = lane >> 4;
  u16* As0 = smem;
  u16* Bs0 = smem + 128 * GSTR;
  u16* As1 = smem + GBUF;
  u16* Bs1 = As1 + 128 * GSTR;
  u32x4 r0a[4], r0b[4], r1a[4], r1b[4];
  const int lrow = tid >> 3, lch = tid & 7;
  const u16* ap = A + (size_t)lrow * lda + lch * 8;
  const u16* bp = B + (size_t)lrow * ldb + lch * 8;
  const int lo = lrow * GSTR + lch * 8;
  const int nk = K >> 6, km = nk - 1;
  const int krot = 0;
#define KOFF(kt) ((((kt) + krot) & km) * 64)
#pragma unroll
  for (int i = 0; i < 4; i++) {
    r0a[i] = *(const u32x4*)(ap + (size_t)i * 32 * lda + KOFF(0));
    r0b[i] = *(const u32x4*)(bp + (size_t)i * 32 * ldb + KOFF(0));
  }
#pragma unroll
  for (int i = 0; i < 4; i++) {
    r1a[i] = *(const u32x4*)(ap + (size_t)i * 32 * lda + KOFF(1));
    r1b[i] = *(const u32x4*)(bp + (size_t)i * 32 * ldb + KOFF(1));
  }
  __syncthreads();
#pragma unroll 1
  for (int kt = 0; kt < nk - 2; kt += 2) {
#pragma unroll
    for (int i = 0; i < 4; i++) {
      *(u32x4*)(As0 + lo + i * 32 * GSTR) = r0a[i];
      *(u32x4*)(Bs0 + lo + i * 32 * GSTR) = r0b[i];
    }
    __syncthreads();
    {
      const int ko = KOFF(kt + 2);
#pragma unroll
      for (int i = 0; i < 4; i++) {
        r0a[i] = *(const u32x4*)(ap + (size_t)i * 32 * lda + ko);
        r0b[i] = *(const u32x4*)(bp + (size_t)i * 32 * ldb + ko);
      }
    }
    gemm_compute(As0, Bs0, acc, wm, wn, r, quad);
#pragma unroll
    for (int i = 0; i < 4; i++) {
      *(u32x4*)(As1 + lo + i * 32 * GSTR) = r1a[i];
      *(u32x4*)(Bs1 + lo + i * 32 * GSTR) = r1b[i];
    }
    __syncthreads();
    {
      const int ko = KOFF(kt + 3);
#pragma unroll
      for (int i = 0; i < 4; i++) {
        r1a[i] = *(const u32x4*)(ap + (size_t)i * 32 * lda + ko);
        r1b[i] = *(const u32x4*)(bp + (size_t)i * 32 * ldb + ko);
      }
    }
    gemm_compute(As1, Bs1, acc, wm, wn, r, quad);
  }
#pragma unroll
  for (int i = 0; i < 4; i++) {
    *(u32x4*)(As0 + lo + i * 32 * GSTR) = r0a[i];
    *(u32x4*)(Bs0 + lo + i * 32 * GSTR) = r0b[i];
  }
  __syncthreads();
  gemm_compute(As0, Bs0, acc, wm, wn, r, quad);
#pragma unroll
  for (int i = 0; i < 4; i++) {
    *(u32x4*)(As1 + lo + i * 32 * GSTR) = r1a[i];
    *(u32x4*)(Bs1 + lo + i * 32 * GSTR) = r1b[i];
  }
  __syncthreads();
  gemm_compute(As1, Bs1, acc, wm, wn, r, quad);
#undef KOFF
}

DI void zero_acc(f32x4 (&acc)[4][4]) {
#pragma unroll
  for (int i = 0; i < 4; i++)
#pragma unroll
    for (int j = 0; j < 4; j++) acc[i][j] = (f32x4){0.f, 0.f, 0.f, 0.f};
}

constexpr int CSTR = 132;
DI void stage_acc(const f32x4 (&acc)[4][4], float* Cs) {
  const int tid = threadIdx.x, lane = tid & 63, w = tid >> 6, wm = w >> 1, wn = w & 1, r = lane & 15, quad = lane >> 4;
  __syncthreads();
#pragma unroll
  for (int mi = 0; mi < 4; mi++)
#pragma unroll
    for (int ni = 0; ni < 4; ni++)
#pragma unroll
      for (int j = 0; j < 4; j++) Cs[(wm * 64 + mi * 16 + quad * 4 + j) * CSTR + wn * 64 + ni * 16 + r] = acc[mi][ni][j];
  __syncthreads();
}
DI u32x2 pack4(f32x4 v) { return (u32x2){pack2(v.x, v.y), pack2(v.z, v.w)}; }
DI f32x4 unpack4(u32x2 p) {
  return (f32x4){__uint_as_float(p.x << 16), __uint_as_float(p.x & 0xffff0000u), __uint_as_float(p.y << 16), __uint_as_float(p.y & 0xffff0000u)};
}

DI void transpose_tile(const float* __restrict__ W, int ldw, int K, const float* __restrict__ g, u16* __restrict__ dst,
                       int k0, int n0, int nsrc0, float* tile) {
  const int tid = threadIdx.x;
  __syncthreads();
  {
    const int ty = tid >> 4, tx = tid & 15;
#pragma unroll
    for (int i = 0; i < 4; i++) {
      int k = ty + i * 16;
      f32x4 v = *(const f32x4*)(W + (size_t)(k0 + k) * ldw + nsrc0 + tx * 4);
      float s = g ? g[k0 + k] : 1.f;
      tile[k * 65 + tx * 4 + 0] = v[0] * s;
      tile[k * 65 + tx * 4 + 1] = v[1] * s;
      tile[k * 65 + tx * 4 + 2] = v[2] * s;
      tile[k * 65 + tx * 4 + 3] = v[3] * s;
    }
  }
  __syncthreads();
  {
    const int n = tid >> 2, kc = (tid & 3) * 16;
    u32 pk[8];
#pragma unroll
    for (int i = 0; i < 8; i++) pk[i] = pack2(tile[(kc + 2 * i) * 65 + n], tile[(kc + 2 * i + 1) * 65 + n]);
    u16* d = dst + (size_t)(n0 + n) * K + k0 + kc;
    *(u32x4*)d = (u32x4){pk[0], pk[1], pk[2], pk[3]};
    *(u32x4*)(d + 8) = (u32x4){pk[4], pk[5], pk[6], pk[7]};
  }
}

DI void conv_unit(const float* __restrict__ src, u16* __restrict__ dst, size_t base, const float* __restrict__ colscale) {
  const int tid = threadIdx.x;
#pragma unroll
  for (int i = 0; i < 4; i++) {
    size_t e = base + (size_t)i * 1024 + tid * 4;
    f32x4 v = *(const f32x4*)(src + e);
    if (colscale) {
      f32x4 gg = *(const f32x4*)(colscale + (e & 1023));
      v = v * gg;
    }
    *(u32x2*)(dst + e) = (u32x2){pack2(v[0], v[1]), pack2(v[2], v[3])};
  }
}

DI void conv_unit_fp8(const float* __restrict__ src, unsigned char* __restrict__ dst, size_t base,
                      const float* __restrict__ colscale, float scale) {
  const int tid = threadIdx.x;
#pragma unroll
  for (int i = 0; i < 4; i++) {
    size_t e = base + (size_t)i * 1024 + tid * 4;
    f32x4 v = *(const f32x4*)(src + e);
    if (colscale) {
      f32x4 gg = *(const f32x4*)(colscale + (e & 1023));
      v = v * gg;
    }
    int w = __builtin_amdgcn_cvt_pk_fp8_f32(v[0] * scale, v[1] * scale, 0, false);
    w = __builtin_amdgcn_cvt_pk_fp8_f32(v[2] * scale, v[3] * scale, w, true);
    *(int*)(dst + (((e & 1023) >> 7) << 21) + ((e >> 10) << 7) + (e & 127)) = w;
  }
}

DI void phase0(const Params& P, char* smem) {
  const int tid = threadIdx.x, lane = tid & 63, w = tid >> 6;
  char* ws = P.ws;
  {
    float* tile = (float*)smem;
    constexpr int T_WIN = 16 * 80, T_UP = 8 * 16, T_SQ = 256, T_PP = 4 * 16;
    constexpr int NT = T_WIN + 2 * T_UP + 3 * T_SQ + T_PP;
    for (int t = blockIdx.x; t < NT; t += gridDim.x) {
      int u = t;
      if (u < T_WIN) {
        int kt = u / 80, nt = u % 80;
        int n0 = nt * 64;
        int ns = n0 < 1536 ? n0 : n0 + 8;
        transpose_tile(P.w_in, 5128, 1024, P.g_mix, (u16*)(ws + W_WIN), kt * 64, n0, ns, tile);
        continue;
      }
      u -= T_WIN;
      if (u < T_UP) { transpose_tile(P.w_up_a, 1024, 512, nullptr, (u16*)(ws + W_WUPA), (u / 16) * 64, (u % 16) * 64, (u % 16) * 64, tile); continue; }
      u -= T_UP;
      if (u < T_UP) { transpose_tile(P.w_up_b, 1024, 512, nullptr, (u16*)(ws + W_WUPB), (u / 16) * 64, (u % 16) * 64, (u % 16) * 64, tile); continue; }
      u -= T_UP;
      if (u < T_SQ) { transpose_tile(P.w_out, 1024, 1024, nullptr, (u16*)(ws + W_WOUT), (u / 16) * 64, (u % 16) * 64, (u % 16) * 64, tile); continue; }
      u -= T_SQ;
      if (u < T_SQ) { transpose_tile(P.peer_wq, 1024, 1024, P.g_ffn, (u16*)(ws + W_WQ), (u / 16) * 64, (u % 16) * 64, (u % 16) * 64, tile); continue; }
      u -= T_SQ;
      if (u < T_SQ) { transpose_tile(P.w_gate, 1024, 1024, P.g_ple, (u16*)(ws + W_WG), (u / 16) * 64, (u % 16) * 64, (u % 16) * 64, tile); continue; }
      u -= T_SQ;
      transpose_tile(P.w_proj, 1024, 256, nullptr, (u16*)(ws + W_WPP), (u / 16) * 64, (u % 16) * 64, (u % 16) * 64, tile);
    }
  }
  {
    constexpr int U_UB = 4096, U_VB = 4096, U_SK = 32, U_PP = 4096, U_PS = 16;
    constexpr int NU = U_UB + U_VB + U_SK + U_PP + U_PS;
    for (int t = blockIdx.x; t < NU; t += gridDim.x) {
      int u = t;
      if (u < U_UB) { conv_unit_fp8(P.peer_u, (unsigned char*)(ws + W_UB), (size_t)u * 4096, P.g_ffn, U_SCALE); continue; }
      u -= U_UB;
      if (u < U_VB) { conv_unit_fp8(P.peer_v, (unsigned char*)(ws + W_VB), (size_t)u * 4096, nullptr, V_SCALE); continue; }
      u -= U_VB;
      if (u < U_SK) { conv_unit(P.peer_sk, (u16*)(ws + W_SK), (size_t)u * 4096, nullptr); continue; }
      u -= U_SK;
      if (u < U_PP) { conv_unit(P.p_p, (u16*)(ws + W_PB), (size_t)u * 4096, nullptr); continue; }
      u -= U_PP;
      conv_unit(P.p_s, (u16*)(ws + W_PB) + (size_t)TP * 256, (size_t)u * 4096, nullptr);
    }
  }
  {
    float* wfl = (float*)smem;
    __syncthreads();
    for (int i = tid; i < 8192; i += 256) {
      int k = i >> 3, h = i & 7;
      wfl[h * 1024 + k] = P.g_mix[k] * P.w_in[(size_t)k * 5128 + 1536 + h];
    }
    __syncthreads();
    u16* XB = (u16*)(ws + W_XB);
    float* RS1 = (float*)(ws + W_RS1);
    for (int t = blockIdx.x * 4 + w; t < TT; t += gridDim.x * 4) {
      const float* xr = t < TP ? P.x_p + (size_t)t * 1024 : P.x_s + (size_t)(t - TP) * 1024;
      f32x4 v[4];
#pragma unroll
      for (int i = 0; i < 4; i++) v[i] = *(const f32x4*)(xr + i * 256 + lane * 4);
      float ss = 0.f;
#pragma unroll
      for (int i = 0; i < 4; i++) ss += v[i][0] * v[i][0] + v[i][1] * v[i][1] + v[i][2] * v[i][2] + v[i][3] * v[i][3];
      float dots[8];
#pragma unroll
      for (int h = 0; h < 8; h++) {
        float d = 0.f;
#pragma unroll
        for (int i = 0; i < 4; i++) {
          f32x4 wv = *(const f32x4*)(wfl + h * 1024 + i * 256 + lane * 4);
          d += v[i][0] * wv[0] + v[i][1] * wv[1] + v[i][2] * wv[2] + v[i][3] * wv[3];
        }
        dots[h] = d;
      }
      ss = wave_sum(ss);
#pragma unroll
      for (int h = 0; h < 8; h++) dots[h] = wave_sum(dots[h]);
      float rs = rsqrtf(ss * (1.f / 1024.f) + EPS);
#pragma unroll
      for (int i = 0; i < 4; i++)
        *(u32x2*)(XB + (size_t)t * 1024 + i * 256 + lane * 4) = (u32x2){pack2(v[i][0], v[i][1]), pack2(v[i][2], v[i][3])};
      if (lane == 0) RS1[t] = rs;
      float myd = dots[0];
#pragma unroll
      for (int h = 1; h < 8; h++) myd = (lane == h) ? dots[h] : myd;
      if (lane < 8) {
        float z = rs * myd + P.b_f[lane];
        float lf = fminf(z, 0.f) - log1pf(expf(-fabsf(z)));
        float* o = t < TP ? P.out + O_AF_P + (size_t)t * 8 : P.out + O_AF_S + (size_t)(t - TP) * 8;
        o[lane] = lf;
      }
    }
  }
}

DI void phase1_scans(const Params& P) {
  const int lane = threadIdx.x & 63;
  const int gw = blockIdx.x * 4 + (threadIdx.x >> 6), nw = gridDim.x * 4;
  float* CUMP = (float*)(P.ws + W_CUMP);
  float* CUMS = (float*)(P.ws + W_CUMS);
  for (int row = gw; row < 384; row += nw) {
    float carry = 0.f;
    if (row < 256) {
      int b = row >> 3, h = row & 7;
      const float* src = P.out + O_AF_P + (size_t)b * 2048 * 8 + h;
      for (int p0 = 0; p0 < 2048; p0 += 64) {
        float v = src[(size_t)(p0 + lane) * 8];
#pragma unroll
        for (int o = 1; o < 64; o <<= 1) { float n = __shfl_up(v, o); if (lane >= o) v += n; }
        v += carry;
        CUMP[(size_t)row * 2048 + p0 + lane] = v * LOG2E;
        carry = __shfl(v, 63);
      }
    } else {
      int rr = row - 256;
      int b = rr >> 3, h = rr & 7;
      const float* src = P.caf + (size_t)b * 4096 * 8 + h;
      for (int p0 = 0; p0 < 4096; p0 += 64) {
        float v = src[(size_t)(p0 + lane) * 8];
#pragma unroll
        for (int o = 1; o < 64; o <<= 1) { float n = __shfl_up(v, o); if (lane >= o) v += n; }
        v += carry;
        CUMS[(size_t)rr * 4112 + p0 + lane] = v * LOG2E;
        carry = __shfl(v, 63);
      }
      {
        float v = lane < 16 ? P.out[O_AF_S + (size_t)(b * 16 + lane) * 8 + h] : 0.f;
#pragma unroll
        for (int o = 1; o < 64; o <<= 1) { float n = __shfl_up(v, o); if (lane >= o) v += n; }
        v += carry;
        if (lane < 16) CUMS[(size_t)rr * 4112 + 4096 + lane] = v * LOG2E;
      }
    }
  }
}

DI void phase1_tile(const Params& P, int mt, int nt, char* smem) {
  const int tid = threadIdx.x, lane = tid & 63, w = tid >> 6, wm = w >> 1, wn = w & 1, r = lane & 15, quad = lane >> 4;
  const int m0 = mt * 128, n0 = nt * 128;
  char* ws = P.ws;
  f32x4 acc[4][4];
  zero_acc(acc);
  gemm_mainloop((const u16*)(ws + W_XB) + (size_t)m0 * 1024, 1024, (const u16*)(ws + W_WIN) + (size_t)n0 * 1024, 1024, 1024,
                (u16*)smem, acc);
  float* Cs = (float*)smem;
  stage_acc(acc, Cs);
  const bool sample = m0 >= TP;
  const int c4 = tid & 31, rsub = tid >> 5;
  const float* RS1 = (const float*)(ws + W_RS1) + m0;
  if (n0 < 3072) {
    const int seg = n0 >> 9, hc = n0 & 511;
    const bool normed = (seg != 2 && seg != 5);
    const float* gain = seg == 0 ? P.qn_a : seg == 1 ? P.kn_a : seg == 3 ? P.qn_b : P.kn_b;
    const float qs = (seg == 0 || seg == 3) ? 0.125f * LOG2E : 1.f;
    f32x4 gn = (f32x4){1.f, 1.f, 1.f, 1.f};
    if (normed) gn = *(const f32x4*)(gain + (c4 & 15) * 4) * qs;
    u16* dp = (u16*)(ws + W_QKV + (size_t)seg * SZ_HALF) + (size_t)m0 * 512 + hc + c4 * 4;
    float* op = nullptr;
    if (seg == 1 || seg == 2) {
      op = sample ? P.out + (seg == 1 ? O_AK_S : O_AV_S) + (size_t)(m0 - TP) * 512 : P.out + (seg == 1 ? O_AK_P : O_AV_P) + (size_t)m0 * 512;
    } else if (seg == 4 || seg == 5) {
      if (sample) op = P.out + (seg == 4 ? O_BK_S : O_BV_S) + (size_t)(m0 - TP) * 512;
      else if ((m0 & 2047) >= 1536) op = P.out + (seg == 4 ? O_BK_P : O_BV_P) + ((size_t)(m0 >> 11) * 512 + ((m0 & 2047) - 1536)) * 512;
    }
    if (op) op += hc + c4 * 4;
#pragma unroll 4
    for (int p = 0; p < 16; p++) {
      const int row = p * 8 + rsub;
      f32x4 v = *(const f32x4*)(Cs + row * CSTR + c4 * 4) * RS1[row];
      if (normed) {
        float ss = v.x * v.x + v.y * v.y + v.z * v.z + v.w * v.w;
        ss += __shfl_xor(ss, 1);
        ss += __shfl_xor(ss, 2);
        ss += __shfl_xor(ss, 4);
        ss += __shfl_xor(ss, 8);
        v = v * gn * rsqrtf(ss * (1.f / 64.f) + EPS);
      }
      *(u32x2*)(dp + (size_t)row * 512) = pack4(v);
      if (op) *(f32x4*)(op + (size_t)row * 512) = v;
    }
  } else {
    u16* dp = (n0 < 4096 ? (u16*)(ws + W_GA) + (n0 - 3072) : (u16*)(ws + W_GB) + (n0 - 4096)) + (size_t)m0 * 1024 + c4 * 4;
#pragma unroll 4
    for (int p = 0; p < 16; p++) {
      const int row = p * 8 + rsub;
      f32x4 v = *(const f32x4*)(Cs + row * CSTR + c4 * 4) * RS1[row];
      v = (f32x4){sigmoidf_(v.x), sigmoidf_(v.y), sigmoidf_(v.z), sigmoidf_(v.w)};
      *(u32x2*)(dp + (size_t)row * 1024) = pack4(v);
    }
  }
}

constexpr int ASTR = 72;
constexpr int ASTAGE = 2 * 64 * ASTR * 2 + 256;
constexpr int TAB_OFF = 2 * ASTAGE;
struct AttnState { f32x4 o[4]; float m, l; };

DI s16x4 tr_read(const u16* p) {
  return __builtin_amdgcn_ds_read_tr16_b64_v4i16((__attribute__((address_space(3))) s16x4*)(p));
}

template <int MODE>
DI void attn_step(const u16* Ks, const u16* Vs, const bf16x8 (&qf)[2], AttnState& st, int kpos0, int qpos, int qlim,
                  float cq, const float* cum, const float* tab, bool domask) {
  const int lane = threadIdx.x & 63, r = lane & 15, quad = lane >> 4;
  const bool farband = (MODE == 1) && (kpos0 + 31 - (qpos - r) <= -128);
  f32x4 s[2];
#pragma unroll
  for (int t = 0; t < 2; t++) {
    f32x4 a4 = (f32x4){0.f, 0.f, 0.f, 0.f};
#pragma unroll
    for (int ks = 0; ks < 2; ks++) {
      bf16x8 kf = *(const bf16x8*)(Ks + (t * 16 + r) * ASTR + ks * 32 + quad * 8);
      a4 = mfma16(kf, qf[ks], a4);
    }
    s[t] = a4;
  }
#pragma unroll
  for (int t = 0; t < 2; t++) {
    const int kb = kpos0 + t * 16 + quad * 4;
    if (MODE == 0) {
      f32x4 c4 = *(const f32x4*)(cum + kb);
#pragma unroll
      for (int j = 0; j < 4; j++) s[t][j] += cq - c4[j];
    } else if (farband) {
      const float b0 = tab[0];
#pragma unroll
      for (int j = 0; j < 4; j++) s[t][j] += b0;
    } else {
#pragma unroll
      for (int j = 0; j < 4; j++) {
        int rel = kb + j - qpos;
        rel = min(max(rel, -128), 128) + 128;
        s[t][j] += tab[rel];
      }
    }
    if (domask) {
#pragma unroll
      for (int j = 0; j < 4; j++)
        if (kb + j > qlim) s[t][j] = -1e30f;
    }
  }
  float p[8];
  float ls = 0.f;
#pragma unroll
  for (int t = 0; t < 2; t++)
#pragma unroll
    for (int j = 0; j < 4; j++) { p[t * 4 + j] = __builtin_amdgcn_exp2f(s[t][j]); ls += p[t * 4 + j]; }
  st.l += ls;
  u32x4 pk = (u32x4){pack2(p[0], p[1]), pack2(p[2], p[3]), pack2(p[4], p[5]), pack2(p[6], p[7])};
  bf16x8 pf = __builtin_bit_cast(bf16x8, pk);
  const int qq = (lane & 15) >> 2, pp = lane & 3;
#pragma unroll
  for (int dt = 0; dt < 4; dt++) {
    s16x4 lo = tr_read(Vs + (quad * 4 + qq) * ASTR + dt * 16 + pp * 4);
    s16x4 hi = tr_read(Vs + (16 + quad * 4 + qq) * ASTR + dt * 16 + pp * 4);
    bf16x8 vf = __builtin_shufflevector(lo, hi, 0, 1, 2, 3, 4, 5, 6, 7);
    st.o[dt] = mfma16(vf, pf, st.o[dt]);
  }
}

template <int MODE>
DI void attn_prompt_item(const Params& P, char* smem, int b, int h, int qt, float bound) {
  const int tid = threadIdx.x, lane = tid & 63, w = tid >> 6, r = lane & 15, quad = lane >> 4;
  char* ws = P.ws;
  const u16* Q = (const u16*)(ws + W_QKV + (size_t)(MODE == 0 ? 0 : 3) * SZ_HALF);
  const u16* Kg = (const u16*)(ws + W_QKV + (size_t)(MODE == 0 ? 1 : 4) * SZ_HALF);
  const u16* Vg = (const u16*)(ws + W_QKV + (size_t)(MODE == 0 ? 2 : 5) * SZ_HALF);
  u16* Y = (u16*)(ws + W_XB + (size_t)(MODE == 0 ? 0 : 1) * SZ_HALF);
  float* tab = (float*)(smem + TAB_OFF);
  __syncthreads();
  if (MODE == 1) {
    for (int i = tid; i < 257; i += 256) tab[i] = P.relb[h * 257 + i] * LOG2E - bound;
  }
  const int q0 = qt * 64;
  const int qpos = q0 + w * 16 + r;
  const size_t tokq = (size_t)b * 2048 + qpos;
  bf16x8 qf[2];
#pragma unroll
  for (int ks = 0; ks < 2; ks++) qf[ks] = *(const bf16x8*)(Q + tokq * 512 + h * 64 + ks * 32 + quad * 8);
  const float* cum = (const float*)(ws + W_CUMP) + (size_t)(b * 8 + h) * 2048;
  const float cq = MODE == 0 ? cum[qpos] - bound : 0.f;
  AttnState st;
#pragma unroll
  for (int dt = 0; dt < 4; dt++) st.o[dt] = (f32x4){0.f, 0.f, 0.f, 0.f};
  st.m = 0.f;
  st.l = 0.f;
  const int kt_lo = MODE == 0 ? 0 : max(0, qt - 8), kt_hi = qt;
  u32x4 rk[2], rv[2];
  f32x4 rc = (f32x4){0.f, 0.f, 0.f, 0.f};
  const int lkey = tid >> 3, lch = tid & 7;
  const u16* kp = Kg + ((size_t)b * 2048 + lkey) * 512 + h * 64 + lch * 8;
  const u16* vp = Vg + ((size_t)b * 2048 + lkey) * 512 + h * 64 + lch * 8;
  const int lofs = lkey * ASTR + lch * 8;
#pragma unroll
  for (int i = 0; i < 2; i++) {
    rk[i] = *(const u32x4*)(kp + (size_t)(kt_lo * 64 + i * 32) * 512);
    rv[i] = *(const u32x4*)(vp + (size_t)(kt_lo * 64 + i * 32) * 512);
  }
  if (MODE == 0 && tid < 16) rc = *(const f32x4*)(cum + kt_lo * 64 + tid * 4);
  {
    u16* Ks = (u16*)(smem + (kt_lo & 1) * ASTAGE);
    u16* Vs = Ks + 64 * ASTR;
#pragma unroll
    for (int i = 0; i < 2; i++) {
      *(u32x4*)(Ks + lofs + i * 32 * ASTR) = rk[i];
      *(u32x4*)(Vs + lofs + i * 32 * ASTR) = rv[i];
    }
    if (MODE == 0 && tid < 16) *(f32x4*)((float*)(Vs + 64 * ASTR) + tid * 4) = rc;
  }
  __syncthreads();
#pragma unroll 1
  for (int kt = kt_lo; kt <= kt_hi; kt++) {
    const int ktn = min(kt + 1, kt_hi);
#pragma unroll
    for (int i = 0; i < 2; i++) {
      rk[i] = *(const u32x4*)(kp + (size_t)(ktn * 64 + i * 32) * 512);
      rv[i] = *(const u32x4*)(vp + (size_t)(ktn * 64 + i * 32) * 512);
    }
    if (MODE == 0 && tid < 16) rc = *(const f32x4*)(cum + ktn * 64 + tid * 4);
    const u16* Ks = (const u16*)(smem + (kt & 1) * ASTAGE);
    const u16* Vs = Ks + 64 * ASTR;
    const float* cl = (const float*)(Vs + 64 * ASTR) - kt * 64;
    const bool diag = (MODE == 0) && (kt == qt);
#pragma unroll
    for (int half = 0; half < 2; half++) {
      const int kpos0 = kt * 64 + half * 32;
      if (diag && kpos0 > q0 + w * 16 + 15) continue;
      attn_step<MODE>(Ks + half * 32 * ASTR, Vs + half * 32 * ASTR, qf, st, kpos0, qpos, qpos, cq, cl, tab, diag);
    }
    if (kt < kt_hi) {
      u16* Kn = (u16*)(smem + ((kt + 1) & 1) * ASTAGE);
      u16* Vn = Kn + 64 * ASTR;
#pragma unroll
      for (int i = 0; i < 2; i++) {
        *(u32x4*)(Kn + lofs + i * 32 * ASTR) = rk[i];
        *(u32x4*)(Vn + lofs + i * 32 * ASTR) = rv[i];
      }
      if (MODE == 0 && tid < 16) *(f32x4*)((float*)(Vn + 64 * ASTR) + tid * 4) = rc;
    }
    __syncthreads();
  }
  float lt = st.l;
  lt += __shfl_xor(lt, 16);
  lt += __shfl_xor(lt, 32);
  const float inv = 1.f / lt;
#pragma unroll
  for (int dt = 0; dt < 4; dt++) {
    u32x2 o2 = (u32x2){pack2(st.o[dt][0] * inv, st.o[dt][1] * inv), pack2(st.o[dt][2] * inv, st.o[dt][3] * inv)};
    *(u32x2*)(Y + tokq * 512 + h * 64 + dt * 16 + quad * 4) = o2;
  }
}

template <int MODE>
DI void attn_sample_item(const Params& P, char* smem, int b, int h, float bound) {
  const int tid = threadIdx.x, lane = tid & 63, w = tid >> 6, r = lane & 15, quad = lane >> 4;
  constexpr int L = MODE == 0 ? 4096 : 512;
  char* ws = P.ws;
  const u16* Q = (const u16*)(ws + W_QKV + (size_t)(MODE == 0 ? 0 : 3) * SZ_HALF);
  const u16* Kn = (const u16*)(ws + W_QKV + (size_t)(MODE == 0 ? 1 : 4) * SZ_HALF);
  const u16* Vn = (const u16*)(ws + W_QKV + (size_t)(MODE == 0 ? 2 : 5) * SZ_HALF);
  u16* Y = (u16*)(ws + W_XB + (size_t)(MODE == 0 ? 0 : 1) * SZ_HALF);
  u16* Kw = (u16*)smem + w * (2 * 32 * ASTR);
  u16* Vw = Kw + 32 * ASTR;
  float* tab = (float*)(smem + TAB_OFF);
  __syncthreads();
  if (MODE == 1) {
    for (int i = tid; i < 257; i += 256) tab[i] = P.relb[h * 257 + i] * LOG2E - bound;
  }
  __syncthreads();
  const float* ck = (MODE == 0 ? P.cak : P.cbk) + ((size_t)b * L * 8 + h) * 64;
  const float* cv = (MODE == 0 ? P.cav : P.cbv) + ((size_t)b * L * 8 + h) * 64;
  const size_t tokbase = (size_t)TP + b * 16;
  bf16x8 qf[2];
#pragma unroll
  for (int ks = 0; ks < 2; ks++) qf[ks] = *(const bf16x8*)(Q + (tokbase + r) * 512 + h * 64 + ks * 32 + quad * 8);
  const int qpos = L + r;
  const float* cum = (const float*)(ws + W_CUMS) + (size_t)(b * 8 + h) * 4112;
  const float cq = MODE == 0 ? cum[qpos] - bound : 0.f;
  AttnState st;
#pragma unroll
  for (int dt = 0; dt < 4; dt++) st.o[dt] = (f32x4){0.f, 0.f, 0.f, 0.f};
  st.m = 0.f;
  st.l = 0.f;
  const int kbeg = w * (L / 4), kend = kbeg + L / 4;
#pragma unroll 1
  for (int k0 = kbeg; k0 < kend; k0 += 32) {
    {
      f32x4 kr[8];
#pragma unroll
      for (int i = 0; i < 8; i++) kr[i] = *(const f32x4*)(ck + (size_t)(k0 + i * 4 + quad) * 512 + r * 4);
#pragma unroll
      for (int i = 0; i < 8; i++)
        *(u32x2*)(Kw + (i * 4 + quad) * ASTR + r * 4) = (u32x2){pack2(kr[i][0], kr[i][1]), pack2(kr[i][2], kr[i][3])};
    }
    {
      f32x4 vr[8];
#pragma unroll
      for (int i = 0; i < 8; i++) vr[i] = *(const f32x4*)(cv + (size_t)(k0 + i * 4 + quad) * 512 + r * 4);
#pragma unroll
      for (int i = 0; i < 8; i++)
        *(u32x2*)(Vw + (i * 4 + quad) * ASTR + r * 4) = (u32x2){pack2(vr[i][0], vr[i][1]), pack2(vr[i][2], vr[i][3])};
    }
    asm volatile("s_waitcnt lgkmcnt(0)" ::: "memory");
    __builtin_amdgcn_wave_barrier();
    attn_step<MODE>(Kw, Vw, qf, st, k0, qpos, qpos, cq, cum, tab, false);
    __builtin_amdgcn_wave_barrier();
  }
  if (w == 0) {
#pragma unroll
    for (int i = 0; i < 2; i++) {
      int c = lane + i * 64;
      int key = c >> 3, ch = c & 7;
      u32x4 kk = *(const u32x4*)(Kn + (tokbase + key) * 512 + h * 64 + ch * 8);
      u32x4 vv = *(const u32x4*)(Vn + (tokbase + key) * 512 + h * 64 + ch * 8);
      *(u32x4*)(Kw + key * ASTR + ch * 8) = kk;
      *(u32x4*)(Vw + key * ASTR + ch * 8) = vv;
      *(u32x4*)(Kw + (16 + key) * ASTR + ch * 8) = (u32x4){0u, 0u, 0u, 0u};
      *(u32x4*)(Vw + (16 + key) * ASTR + ch * 8) = (u32x4){0u, 0u, 0u, 0u};
    }
    asm volatile("s_waitcnt lgkmcnt(0)" ::: "memory");
    __builtin_amdgcn_wave_barrier();
    attn_step<MODE>(Kw, Vw, qf, st, L, qpos, MODE == 0 ? qpos : L + 15, cq, cum, tab, true);
  }
  __syncthreads();
  float* comb = (float*)smem;
  float lt = st.l;
  lt += __shfl_xor(lt, 16);
  lt += __shfl_xor(lt, 32);
#pragma unroll
  for (int dt = 0; dt < 4; dt++)
#pragma unroll
    for (int j = 0; j < 4; j++) comb[(w * 16 + r) * 68 + dt * 16 + quad * 4 + j] = st.o[dt][j];
  if (quad == 0) comb[(w * 16 + r) * 68 + 65] = lt;
  __syncthreads();
  if (w == 0) {
    float Ls = 0.f;
#pragma unroll
    for (int i = 0; i < 4; i++) Ls += comb[(i * 16 + r) * 68 + 65];
    const float inv = 1.f / Ls;
#pragma unroll
    for (int dt = 0; dt < 4; dt++) {
      float ov[4];
#pragma unroll
      for (int j = 0; j < 4; j++) {
        float a = 0.f;
#pragma unroll
        for (int i = 0; i < 4; i++) a += comb[(i * 16 + r) * 68 + dt * 16 + quad * 4 + j];
        ov[j] = a * inv;
      }
      *(u32x2*)(Y + (tokbase + r) * 512 + h * 64 + dt * 16 + quad * 4) = (u32x2){pack2(ov[0], ov[1]), pack2(ov[2], ov[3])};
    }
  }
}

DI void phase2(const Params& P, char* smem) {
  constexpr int N_SA = 128, N_PA = 8192, N_PB = 8192, N_SB = 128;
  float bound_a, bound_b;
  {
    const int lane = threadIdx.x & 63;
    float qa = fabsf(P.qn_a[lane]), ka = fabsf(P.kn_a[lane]), qb = fabsf(P.qn_b[lane]), kb = fabsf(P.kn_b[lane]), rb = 0.f;
    for (int i = lane; i < 8 * 257; i += 64) rb = fmaxf(rb, fabsf(P.relb[i]));
#pragma unroll
    for (int o = 32; o; o >>= 1) {
      qa = fmaxf(qa, __shfl_xor(qa, o)); ka = fmaxf(ka, __shfl_xor(ka, o));
      qb = fmaxf(qb, __shfl_xor(qb, o)); kb = fmaxf(kb, __shfl_xor(kb, o));
      rb = fmaxf(rb, __shfl_xor(rb, o));
    }
    bound_a = 8.f * qa * ka * LOG2E;
    bound_b = (8.f * qb * kb + rb) * LOG2E;
  }
  for (int it = blockIdx.x; it < N_SA + N_PA + N_PB + N_SB; it += gridDim.x) {
    int u = it;
    if (u < N_SA) { attn_sample_item<0>(P, smem, u >> 3, u & 7, bound_a); continue; }
    u -= N_SA;
    if (u < N_PA) { int qt = 31 - (u >> 8), bh = u & 255; attn_prompt_item<0>(P, smem, bh >> 3, bh & 7, qt, bound_a); continue; }
    u -= N_PA;
    if (u < N_PB) { int qt = 31 - (u >> 8), bh = u & 255; attn_prompt_item<1>(P, smem, bh >> 3, bh & 7, qt, bound_b); continue; }
    u -= N_PB;
    attn_sample_item<1>(P, smem, u >> 3, u & 7, bound_b);
  }
}

DI void phase3_tile(const Params& P, int mt, int nt, char* smem) {
  const int tid = threadIdx.x, lane = tid & 63, w = tid >> 6, wm = w >> 1, wn = w & 1, r = lane & 15, quad = lane >> 4;
  const int m0 = mt * 128, n0 = nt * 128;
  char* ws = P.ws;
  const u16* YA = (const u16*)(ws + W_XB);
  const u16* YB = YA + (size_t)TT * 512;
  const u16* GA = (const u16*)(ws + W_GA);
  const u16* GB = (const u16*)(ws + W_GB);
  u16* MRG = (u16*)(ws + W_QKV);
  f32x4 acc[4][4];
  zero_acc(acc);
  gemm_mainloop(YA + (size_t)m0 * 512, 512, (const u16*)(ws + W_WUPA) + (size_t)n0 * 512, 512, 512, (u16*)smem, acc);
  float* Cs = (float*)smem;
  const int c4 = tid & 31, rsub = tid >> 5;
  const size_t tofs = (size_t)m0 * 1024 + n0 + c4 * 4;
  stage_acc(acc, Cs);
#pragma unroll 4
  for (int p = 0; p < 16; p++) {
    const int row = p * 8 + rsub;
    const f32x4 v = *(const f32x4*)(Cs + row * CSTR + c4 * 4);
    const f32x4 gv = unpack4(*(const u32x2*)(GA + tofs + (size_t)row * 1024));
    *(u32x2*)(MRG + tofs + (size_t)row * 1024) = pack4(v * gv);
  }
  zero_acc(acc);
  gemm_mainloop(YB + (size_t)m0 * 512, 512, (const u16*)(ws + W_WUPB) + (size_t)n0 * 512, 512, 512, (u16*)smem, acc);
  stage_acc(acc, Cs);
#pragma unroll 4
  for (int p = 0; p < 16; p++) {
    const int row = p * 8 + rsub;
    const f32x4 v = *(const f32x4*)(Cs + row * CSTR + c4 * 4);
    const f32x4 gv = unpack4(*(const u32x2*)(GB + tofs + (size_t)row * 1024));
    const f32x4 m1 = unpack4(*(const u32x2*)(MRG + tofs + (size_t)row * 1024));
    *(u32x2*)(MRG + tofs + (size_t)row * 1024) = pack4(m1 + v * gv);
  }
}

DI void phase4_tile(const Params& P, int mt, int nt, char* smem) {
  const int tid = threadIdx.x, lane = tid & 63, w = tid >> 6, wm = w >> 1, wn = w & 1, r = lane & 15, quad = lane >> 4;
  const int m0 = mt * 128, n0 = nt * 128;
  char* ws = P.ws;
  const u16* MRG = (const u16*)(ws + W_QKV);
  u16* H1B = (u16*)(ws + W_QKV + SZ_ACT);
  float* SSQ2 = (float*)(ws + W_SSQ2);
  f32x4 acc[4][4];
  zero_acc(acc);
  gemm_mainloop(MRG + (size_t)m0 * 1024, 1024, (const u16*)(ws + W_WOUT) + (size_t)n0 * 1024, 1024, 1024, (u16*)smem, acc);
  const float* xb = m0 < TP ? P.x_p : P.x_s - (size_t)TP * 1024;
  float* Cs = (float*)smem;
  const int c4 = tid & 31, rsub = tid >> 5;
  const size_t tofs = (size_t)m0 * 1024 + n0 + c4 * 4;
  stage_acc(acc, Cs);
#pragma unroll 4
  for (int p = 0; p < 16; p++) {
    const int row = p * 8 + rsub;
    const f32x4 v = *(const f32x4*)(Cs + row * CSTR + c4 * 4);
    const f32x4 h1 = *(const f32x4*)(xb + tofs + (size_t)row * 1024) + v;
    *(u32x2*)(H1B + tofs + (size_t)row * 1024) = pack4(h1);
    float ss = h1.x * h1.x + h1.y * h1.y + h1.z * h1.z + h1.w * h1.w;
    ss += __shfl_xor(ss, 1);
    ss += __shfl_xor(ss, 2);
    ss += __shfl_xor(ss, 4);
    ss += __shfl_xor(ss, 8);
    ss += __shfl_xor(ss, 16);
    if (c4 == 0) SSQ2[(size_t)(m0 + row) * 16 + nt] = ss;
  }
}

DI void phase5_tile(const Params& P, int mt, int nt, char* smem) {
  const int tid = threadIdx.x, lane = tid & 63, w = tid >> 6, wm = w >> 1, wn = w & 1, r = lane & 15, quad = lane >> 4;
  const int m0 = mt * 128, n0 = nt * 128;
  char* ws = P.ws;
  const u16* H1B = (const u16*)(ws + W_QKV + SZ_ACT);
  u16* QP = (u16*)(ws + W_QKV + 2 * SZ_ACT);
  const float* SSQ2 = (const float*)(ws + W_SSQ2);
  float* rs_s = (float*)(smem + RS_OFF);
  __syncthreads();
  if (tid < 128) {
    float s = 0.f;
#pragma unroll
    for (int i = 0; i < 8; i++) s += SSQ2[(size_t)(m0 + tid) * 16 + i];
    rs_s[tid] = rsqrtf(s * (1.f / 1024.f) + EPS);
  }
  f32x4 acc[4][4];
  zero_acc(acc);
  gemm_mainloop(H1B + (size_t)m0 * 1024, 1024, (const u16*)(ws + W_WQ) + (size_t)n0 * 1024, 1024, 1024, (u16*)smem, acc);
  float* Cs = (float*)smem;
  const int c4 = tid & 31, rsub = tid >> 5;
  const size_t tofs = (size_t)m0 * 1024 + n0 + c4 * 4;
  stage_acc(acc, Cs);
#pragma unroll 4
  for (int p = 0; p < 16; p++) {
    const int row = p * 8 + rsub;
    const f32x4 v = *(const f32x4*)(Cs + row * CSTR + c4 * 4) * rs_s[row];
    *(u32x2*)(QP + tofs + (size_t)row * 1024) = pack4(v);
  }
}

DI void bitonic_merge16(u32 (&L)[16]) {
#pragma unroll
  for (int st = 8; st >= 1; st >>= 1)
#pragma unroll
    for (int i = 0; i < 16; i++)
      if ((i & st) == 0) { u32 hi = max(L[i], L[i + st]); u32 lo = min(L[i], L[i + st]); L[i] = hi; L[i + st] = lo; }
}
DI void bitonic_sort16(u32 (&L)[16]) {
#pragma unroll
  for (int k = 2; k <= 16; k <<= 1)
#pragma unroll
    for (int j = k >> 1; j > 0; j >>= 1)
#pragma unroll
      for (int i = 0; i < 16; i++) {
        const int l = i ^ j;
        if (l > i) {
          const u32 hi = max(L[i], L[l]), lo = min(L[i], L[l]);
          if ((i & k) == 0) { L[i] = hi; L[l] = lo; } else { L[i] = lo; L[l] = hi; }
        }
      }
}
DI void phase6a_unit(const Params& P, int unit, char* smem) {
  const int tid = threadIdx.x, lane = tid & 63, w = tid >> 6, r = lane & 15, quad = lane >> 4;
  char* ws = P.ws;
  const u16* QP = (const u16*)(ws + W_QKV + 2 * SZ_ACT);
  const u16* SK = (const u16*)(ws + W_SK);
  u16* IDXo = (u16*)(ws + W_IDX);
  float* Go = (float*)(ws + W_G);
  float* sc = (float*)smem;
  u32* hl = (u32*)smem;
  u32* xl = (u32*)smem + 256 * 17;
  u32* lists = (u32*)(smem + 128 * 129 * 4);
  unsigned char* tabi = (unsigned char*)(smem + 128 * 129 * 4 + 128 * 17 * 4);
  unsigned char* tabj = tabi + 64;
  const int tok0 = unit * 64;
  __syncthreads();
  if (tid == 0) {
    int c = 0;
    for (int i = 0; i < 16; i++)
      for (int j = i + 1; j < 16; j++)
        if ((i + 1) * (j + 1) <= 16) { tabi[c] = (unsigned char)i; tabj[c] = (unsigned char)j; tabi[32 + c] = (unsigned char)j; tabj[32 + c] = (unsigned char)i; c++; }
    tabi[23] = 0; tabj[23] = 0; tabi[24] = 1; tabj[24] = 1;
    tabi[55] = 2; tabj[55] = 2; tabi[56] = 3; tabj[56] = 3;
  }
  for (int h = 0; h < 8; h++) {
#pragma unroll
    for (int p = 0; p < 2; p++) {
      const int hp = h * 2 + p;
      bf16x8 qf[2];
#pragma unroll
      for (int ks = 0; ks < 2; ks++)
        qf[ks] = *(const bf16x8*)(QP + (size_t)(tok0 + w * 16 + r) * 1024 + hp * 64 + ks * 32 + quad * 8);
#pragma unroll
      for (int nt = 0; nt < 8; nt++) {
        f32x4 a4 = (f32x4){0.f, 0.f, 0.f, 0.f};
#pragma unroll
        for (int ks = 0; ks < 2; ks++) {
          bf16x8 kf = *(const bf16x8*)(SK + (size_t)(hp * 128 + nt * 16 + r) * 64 + ks * 32 + quad * 8);
          a4 = mfma16(kf, qf[ks], a4);
        }
        float* d = sc + (p * 64 + w * 16 + r) * 129 + nt * 16 + quad * 4;
        d[0] = a4[0]; d[1] = a4[1]; d[2] = a4[2]; d[3] = a4[3];
      }
    }
    __syncthreads();
    u32 L[16];
    {
      const int inst = tid & 127, half = tid >> 7;
      const float* row = sc + inst * 129 + half * 64;
#pragma unroll
      for (int i = 0; i < 16; i++) L[i] = (mono(row[i]) & ~127u) | (u32)(half * 64 + i);
      bitonic_sort16(L);
#pragma unroll 1
      for (int c = 1; c < 4; c++) {
        u32 N[16];
#pragma unroll
        for (int i = 0; i < 16; i++) N[i] = (mono(row[c * 16 + i]) & ~127u) | (u32)(half * 64 + c * 16 + i);
        bitonic_sort16(N);
#pragma unroll
        for (int i = 0; i < 16; i++) L[i] = max(L[i], N[15 - i]);
        bitonic_merge16(L);
      }
    }
    __syncthreads();
#pragma unroll
    for (int s = 0; s < 16; s++) hl[tid * 17 + s] = L[s];
    __syncthreads();
    if (tid < 128) {
      u32 M[16];
#pragma unroll
      for (int s = 0; s < 16; s++) M[s] = max(L[s], hl[(tid + 128) * 17 + 15 - s]);
      bitonic_merge16(M);
#pragma unroll
      for (int s = 0; s < 16; s++) lists[tid * 17 + s] = M[s];
    }
    __syncthreads();
    if (tid < 128) {
      const int tok = tid & 63;
      const bool part = tid >= 64;
      float fa[16], fb[16];
#pragma unroll
      for (int s = 0; s < 16; s++) {
        const float va = unmono(lists[tok * 17 + s] & ~127u);
        const float vb = unmono(lists[(64 + tok) * 17 + s] & ~127u);
        fa[s] = part ? vb : va;
        fb[s] = part ? va : vb;
      }
      u32 L2[16];
#pragma unroll
      for (int s = 0; s < 16; s++) L2[s] = 0u;
      const u32 cbase = part ? 32u : 0u;
      {
        int c = 0;
#pragma unroll
        for (int i = 0; i < 16; i++)
#pragma unroll
          for (int j = i + 1; j < 16; j++)
            if ((i + 1) * (j + 1) <= 16) {
              insert16(L2, (mono(fa[i] + fb[j]) & ~63u) | (cbase + (u32)c));
              c++;
            }
      }
      insert16(L2, (mono(part ? fa[2] + fb[2] : fa[0] + fb[0]) & ~63u) | (cbase + 23u));
      insert16(L2, (mono(part ? fa[3] + fb[3] : fa[1] + fb[1]) & ~63u) | (cbase + 24u));
#pragma unroll
      for (int s = 0; s < 16; s++) xl[tid * 17 + s] = L2[s];
    }
    __syncthreads();
    if (tid < 64) {
      float val[16];
      u32 idx[16];
      float mx = -1e30f;
#pragma unroll
      for (int s = 0; s < 16; s++) {
        const u32 m = max(xl[tid * 17 + s], xl[(tid + 64) * 17 + 15 - s]);
        const u32 sl = m & 63u;
        const int i = tabi[sl], j = tabj[sl];
        const u32 au = lists[tid * 17 + i], bu = lists[(64 + tid) * 17 + j];
        val[s] = unmono(au & ~127u) + unmono(bu & ~127u);
        idx[s] = (au & 127u) * 128u + (bu & 127u);
        mx = fmaxf(mx, val[s]);
      }
      float sum = 0.f;
#pragma unroll
      for (int s = 0; s < 16; s++) { val[s] = __expf(val[s] - mx); sum += val[s]; }
      const float inv = 1.f / sum;
      const size_t so = ((size_t)(tok0 + tid) * 8 + h) * 16;
      {
        u32* ib = (u32*)(IDXo + (size_t)(tok0 + tid) * 128 + h * 2);
#pragma unroll
        for (int gg = 0; gg < 8; gg++) ib[gg * 8] = idx[gg] | (idx[gg + 8] << 16);
      }
#pragma unroll
      for (int s = 0; s < 4; s++)
        *(f32x4*)(Go + so + s * 4) = (f32x4){val[s * 4] * inv, val[s * 4 + 1] * inv, val[s * 4 + 2] * inv, val[s * 4 + 3] * inv};
    }
    __syncthreads();
  }
}

typedef float f32x2 __attribute__((ext_vector_type(2)));
DI float dot4_fp8(u32 w, float x0, float x1, float x2, float x3, float acc) {
  f32x2 lo = __builtin_amdgcn_cvt_pk_f32_fp8((int)w, false);
  f32x2 hi = __builtin_amdgcn_cvt_pk_f32_fp8((int)w, true);
  acc = fmaf(lo[0], x0, acc);
  acc = fmaf(lo[1], x1, acc);
  acc = fmaf(hi[0], x2, acc);
  acc = fmaf(hi[1], x3, acc);
  return acc;
}
DI void axpy4_fp8(u32 w, float wgt, float& o0, float& o1, float& o2, float& o3) {
  f32x2 lo = __builtin_amdgcn_cvt_pk_f32_fp8((int)w, false);
  f32x2 hi = __builtin_amdgcn_cvt_pk_f32_fp8((int)w, true);
  o0 = fmaf(wgt, lo[0], o0);
  o1 = fmaf(wgt, lo[1], o1);
  o2 = fmaf(wgt, hi[0], o2);
  o3 = fmaf(wgt, hi[1], o3);
}

struct RowSet { u32x4 r[16]; };
DI void gather_rows(RowSet& R, const unsigned char* base, u32 lofs, u32x4 ea, u32x4 eb) {
  const u32 ev[8] = {ea.x, ea.y, ea.z, ea.w, eb.x, eb.y, eb.z, eb.w};
#pragma unroll
  for (int i = 0; i < 8; i++) {
    R.r[2 * i] = *(const u32x4*)(base + (((ev[i] & 0xffffu) << 7) + lofs));
    R.r[2 * i + 1] = *(const u32x4*)(base + (((ev[i] >> 16) << 7) + lofs));
  }
}
DI void b1_compute(const RowSet& R, u32x4 xa, u32x4 xb, u16* pr, int c, bool valid) {
  float xf[16];
  xf[0] = __uint_as_float(xa.x << 16); xf[1] = __uint_as_float(xa.x & 0xffff0000u);
  xf[2] = __uint_as_float(xa.y << 16); xf[3] = __uint_as_float(xa.y & 0xffff0000u);
  xf[4] = __uint_as_float(xa.z << 16); xf[5] = __uint_as_float(xa.z & 0xffff0000u);
  xf[6] = __uint_as_float(xa.w << 16); xf[7] = __uint_as_float(xa.w & 0xffff0000u);
  xf[8] = __uint_as_float(xb.x << 16); xf[9] = __uint_as_float(xb.x & 0xffff0000u);
  xf[10] = __uint_as_float(xb.y << 16); xf[11] = __uint_as_float(xb.y & 0xffff0000u);
  xf[12] = __uint_as_float(xb.z << 16); xf[13] = __uint_as_float(xb.z & 0xffff0000u);
  xf[14] = __uint_as_float(xb.w << 16); xf[15] = __uint_as_float(xb.w & 0xffff0000u);
  float p[16];
#pragma unroll
  for (int i = 0; i < 16; i++) {
    float a = dot4_fp8(R.r[i].x, xf[0], xf[1], xf[2], xf[3], 0.f);
    a = dot4_fp8(R.r[i].y, xf[4], xf[5], xf[6], xf[7], a);
    a = dot4_fp8(R.r[i].z, xf[8], xf[9], xf[10], xf[11], a);
    a = dot4_fp8(R.r[i].w, xf[12], xf[13], xf[14], xf[15], a);
    p[i] = a;
  }
#pragma unroll
  for (int i = 0; i < 8; i++) { float keep = (c & 4) ? p[i + 8] : p[i]; float send = (c & 4) ? p[i] : p[i + 8]; p[i] = keep + __shfl_xor(send, 4); }
#pragma unroll
  for (int i = 0; i < 4; i++) { float keep = (c & 2) ? p[i + 4] : p[i]; float send = (c & 2) ? p[i] : p[i + 4]; p[i] = keep + __shfl_xor(send, 2); }
#pragma unroll
  for (int i = 0; i < 2; i++) { float keep = (c & 1) ? p[i + 2] : p[i]; float send = (c & 1) ? p[i] : p[i + 2]; p[i] = keep + __shfl_xor(send, 1); }
  const int it0 = 2 * (c & 1) + 4 * ((c >> 1) & 1) + 8 * ((c >> 2) & 1);
  if (valid) {
    pr[it0 * 8] = f2bf(p[0]);
    pr[(it0 + 1) * 8] = f2bf(p[1]);
  }
}
DI void phase6b1(const Params& P) {
  const int lane = threadIdx.x & 63, g = lane >> 3, c = lane & 7;
  const int x = blockIdx.x & 7;
  const int wg = (blockIdx.x >> 3) * 4 + (threadIdx.x >> 6), nwg = (gridDim.x >> 3) * 4;
  char* ws = P.ws;
  const u16* H1B = (const u16*)(ws + W_QKV + SZ_ACT) + x * 128 + c * 16;
  const unsigned char* U8 = (const unsigned char*)(ws + W_UB) + ((size_t)x << 21);
  const u32 lofs = c * 16;
  const u16* IDX = (const u16*)(ws + W_IDX) + g * 16;
  u16* PH = ph_slice(ws, x) + g;
  const int n = (TT - wg + nwg - 1) / nwg;
#define TOK(i) min(wg + (i) * nwg, TT - 1)
  int t0 = TOK(0), t1 = TOK(1);
  u32x4 eA0 = *(const u32x4*)(IDX + (size_t)t0 * 128), eA1 = *(const u32x4*)(IDX + (size_t)t0 * 128 + 8);
  u32x4 eB0 = *(const u32x4*)(IDX + (size_t)t1 * 128), eB1 = *(const u32x4*)(IDX + (size_t)t1 * 128 + 8);
  RowSet RA, RB;
  gather_rows(RA, U8, lofs, eA0, eA1);
  u32x4 xA0 = *(const u32x4*)(H1B + (size_t)t0 * 1024), xA1 = *(const u32x4*)(H1B + (size_t)t0 * 1024 + 8);
#pragma unroll 1
  for (int i = 0; i < n; i += 2) {
    gather_rows(RB, U8, lofs, eB0, eB1);
    const u32x4 xB0 = *(const u32x4*)(H1B + (size_t)t1 * 1024), xB1 = *(const u32x4*)(H1B + (size_t)t1 * 1024 + 8);
    const int t2 = TOK(i + 2);
    eA0 = *(const u32x4*)(IDX + (size_t)t2 * 128);
    eA1 = *(const u32x4*)(IDX + (size_t)t2 * 128 + 8);
    b1_compute(RA, xA0, xA1, PH + (size_t)t0 * 128, c, true);
    gather_rows(RA, U8, lofs, eA0, eA1);
    xA0 = *(const u32x4*)(H1B + (size_t)t2 * 1024);
    xA1 = *(const u32x4*)(H1B + (size_t)t2 * 1024 + 8);
    const int t3 = TOK(i + 3);
    eB0 = *(const u32x4*)(IDX + (size_t)t3 * 128);
    eB1 = *(const u32x4*)(IDX + (size_t)t3 * 128 + 8);
    b1_compute(RB, xB0, xB1, PH + (size_t)t1 * 128, c, i + 1 < n);
    t0 = t2;
    t1 = t3;
  }
}

DI void phase6w(const Params& P) {
  const int lane = threadIdx.x & 63;
  const int gw = blockIdx.x * 4 + (threadIdx.x >> 6), nw = gridDim.x * 4;
  char* ws = P.ws;
  float* G = (float*)(ws + W_G);
  const float* SSQ2 = (const float*)(ws + W_SSQ2);
  for (int t = gw; t < TT; t += nw) {
    float ssq = lane < 8 ? SSQ2[(size_t)t * 16 + lane] : 0.f;
    float h0 = 0.f, h1v = 0.f;
    {
      const u16* ph = (const u16*)(ws + W_XB) + (size_t)t * 128 + lane;
#pragma unroll
      for (int xs = 0; xs < 8; xs++) { h0 += bf2f(ph[(size_t)xs * (SZ_PH / 2)]); h1v += bf2f(ph[(size_t)xs * (SZ_PH / 2) + 64]); }
    }
    const float g0 = G[(size_t)t * 128 + lane];
    const float g1 = G[(size_t)t * 128 + 64 + lane];
    const float rs2 = rsqrtf(wave_sum(ssq) * (1.f / 1024.f) + EPS);
    const float w0 = g0 * gelu_tanh(rs2 * (1.f / U_SCALE) * h0) * (1.f / V_SCALE);
    const float w1 = g1 * gelu_tanh(rs2 * (1.f / U_SCALE) * h1v) * (1.f / V_SCALE);
    u16* wrow = (u16*)(G + (size_t)t * 128);
    wrow[(lane & 7) * 16 + (lane >> 3)] = f2bf(w0);
    wrow[(lane & 7) * 16 + 8 + (lane >> 3)] = f2bf(w1);
  }
}

DI void b2_compute(const RowSet& R, u32x4 w0, u32x4 w1, u16* hb, float* sq, int g, int lane, bool valid) {
  const u32 hraw = *(const u32*)hb;
  const u32 wv[8] = {w0.x, w0.y, w0.z, w0.w, w1.x, w1.y, w1.z, w1.w};
  float o[16];
#pragma unroll
  for (int i = 0; i < 16; i++) o[i] = 0.f;
#pragma unroll
  for (int i = 0; i < 16; i++) {
    u32 r0 = R.r[i].x, r1 = R.r[i].y, r2 = R.r[i].z, r3 = R.r[i].w;
    asm volatile("" : "+v"(r0), "+v"(r1), "+v"(r2), "+v"(r3) : "v"(o[0]), "v"(o[15]));
    const float wgt = (i & 1) ? __uint_as_float(wv[i >> 1] & 0xffff0000u) : __uint_as_float(wv[i >> 1] << 16);
    axpy4_fp8(r0, wgt, o[0], o[1], o[2], o[3]);
    axpy4_fp8(r1, wgt, o[4], o[5], o[6], o[7]);
    axpy4_fp8(r2, wgt, o[8], o[9], o[10], o[11]);
    axpy4_fp8(r3, wgt, o[12], o[13], o[14], o[15]);
  }
#pragma unroll
  for (int i = 0; i < 8; i++) { float keep = (g & 4) ? o[i + 8] : o[i]; float send = (g & 4) ? o[i] : o[i + 8]; o[i] = keep + __shfl_xor(send, 32); }
#pragma unroll
  for (int i = 0; i < 4; i++) { float keep = (g & 2) ? o[i + 4] : o[i]; float send = (g & 2) ? o[i] : o[i + 4]; o[i] = keep + __shfl_xor(send, 16); }
#pragma unroll
  for (int i = 0; i < 2; i++) { float keep = (g & 1) ? o[i + 2] : o[i]; float send = (g & 1) ? o[i] : o[i + 2]; o[i] = keep + __shfl_xor(send, 8); }
  const float a0 = __uint_as_float(hraw << 16) + o[0], a1 = __uint_as_float(hraw & 0xffff0000u) + o[1];
  const float ss = wave_sum(a0 * a0 + a1 * a1);
  if (valid) {
    *(u32*)hb = pack2(a0, a1);
    if (lane == 0) *sq = ss;
  }
}
DI void phase6b2(const Params& P) {
  const int lane = threadIdx.x & 63, g = lane >> 3, c = lane & 7, w = threadIdx.x >> 6;
  const int x = blockIdx.x & 7;
  const int wg = (blockIdx.x >> 3) * 4 + w, nwg = (gridDim.x >> 3) * 4;
  char* ws = P.ws;
  const int col = x * 128 + c * 16 + 2 * (g & 1) + 4 * ((g >> 1) & 1) + 8 * ((g >> 2) & 1);
  u16* H1B = (u16*)(ws + W_QKV + SZ_ACT) + col;
  const unsigned char* V8 = (const unsigned char*)(ws + W_VB) + ((size_t)x << 21);
  const u32 lofs = c * 16;
  const u16* IDX = (const u16*)(ws + W_IDX) + g * 16;
  const u16* WG = (const u16*)(ws + W_G) + g * 16;
  float* SSQ3 = (float*)(ws + W_SSQ3) + x;
  const int n = (TT - wg + nwg - 1) / nwg;
  int t0 = TOK(0), t1 = TOK(1);
  u32x4 eA0 = *(const u32x4*)(IDX + (size_t)t0 * 128), eA1 = *(const u32x4*)(IDX + (size_t)t0 * 128 + 8);
  u32x4 eB0 = *(const u32x4*)(IDX + (size_t)t1 * 128), eB1 = *(const u32x4*)(IDX + (size_t)t1 * 128 + 8);
  RowSet RA, RB;
  gather_rows(RA, V8, lofs, eA0, eA1);
  u32x4 wA0 = *(const u32x4*)(WG + (size_t)t0 * 256), wA1 = *(const u32x4*)(WG + (size_t)t0 * 256 + 8);
#pragma unroll 1
  for (int i = 0; i < n; i += 2) {
    gather_rows(RB, V8, lofs, eB0, eB1);
    const u32x4 wB0 = *(const u32x4*)(WG + (size_t)t1 * 256), wB1 = *(const u32x4*)(WG + (size_t)t1 * 256 + 8);
    const int t2 = TOK(i + 2);
    eA0 = *(const u32x4*)(IDX + (size_t)t2 * 128);
    eA1 = *(const u32x4*)(IDX + (size_t)t2 * 128 + 8);
    b2_compute(RA, wA0, wA1, H1B + (size_t)t0 * 1024, SSQ3 + (size_t)t0 * 8, g, lane, true);
    gather_rows(RA, V8, lofs, eA0, eA1);
    wA0 = *(const u32x4*)(WG + (size_t)t2 * 256);
    wA1 = *(const u32x4*)(WG + (size_t)t2 * 256 + 8);
    const int t3 = TOK(i + 3);
    eB0 = *(const u32x4*)(IDX + (size_t)t3 * 128);
    eB1 = *(const u32x4*)(IDX + (size_t)t3 * 128 + 8);
    b2_compute(RB, wB0, wB1, H1B + (size_t)t1 * 1024, SSQ3 + (size_t)t1 * 8, g, lane, i + 1 < n);
    t0 = t2;
    t1 = t3;
  }
#undef TOK
}

DI void phase7_tile(const Params& P, int mt, int nt, char* smem) {
  const int tid = threadIdx.x, lane = tid & 63, w = tid >> 6, wm = w >> 1, wn = w & 1, r = lane & 15, quad = lane >> 4;
  const int m0 = mt * 128, n0 = nt * 128;
  char* ws = P.ws;
  const u16* H2B = (const u16*)(ws + W_QKV + SZ_ACT);
  const u16* PB = (const u16*)(ws + W_PB);
  const float* SSQ3 = (const float*)(ws + W_SSQ3);
  float* rs_s = (float*)(smem + RS_OFF);
  __syncthreads();
  if (tid < 128) {
    float q = 0.f;
#pragma unroll
    for (int i = 0; i < 8; i++) q += SSQ3[(size_t)(m0 + tid) * 8 + i];
    rs_s[tid] = rsqrtf(q * (1.f / 1024.f) + EPS);
  }
  u16* PJ = (u16*)(ws + W_QKV);
  f32x4 acc[4][4];
  zero_acc(acc);
  gemm_mainloop(PB + (size_t)m0 * 256, 256, (const u16*)(ws + W_WPP) + (size_t)n0 * 256, 256, 256, (u16*)smem, acc);
  float* Cs = (float*)smem;
  const int c4 = tid & 31, rsub = tid >> 5;
  const size_t tofs = (size_t)m0 * 1024 + n0 + c4 * 4;
  stage_acc(acc, Cs);
#pragma unroll 4
  for (int p = 0; p < 16; p++) {
    const int row = p * 8 + rsub;
    *(u32x2*)(PJ + tofs + (size_t)row * 1024) = pack4(*(const f32x4*)(Cs + row * CSTR + c4 * 4));
  }
  zero_acc(acc);
  gemm_mainloop(H2B + (size_t)m0 * 1024, 1024, (const u16*)(ws + W_WG) + (size_t)n0 * 1024, 1024, 1024, (u16*)smem, acc);
  stage_acc(acc, Cs);
#pragma unroll 4
  for (int p = 0; p < 16; p++) {
    const int row = p * 8 + rsub;
    const f32x4 v = *(const f32x4*)(Cs + row * CSTR + c4 * 4) * rs_s[row];
    const f32x4 pj = unpack4(*(const u32x2*)(PJ + tofs + (size_t)row * 1024));
    const f32x4 h2 = unpack4(*(const u32x2*)(H2B + tofs + (size_t)row * 1024));
    const f32x4 gate = (f32x4){sigmoidf_(v.x), sigmoidf_(v.y), sigmoidf_(v.z), sigmoidf_(v.w)};
    *(f32x4*)(P.out + tofs + (size_t)row * 1024) = h2 + gate * pj;
  }
}

#define GEMM_TILES(NT, FN)                                                              \
  {                                                                                     \
    for (int t = blockIdx.x; t < 2 * (NT); t += gridDim.x) FN(P, 512 + t / (NT), t % (NT), smem); \
    const int x_ = blockIdx.x & 7, bpx_ = gridDim.x >> 3;                               \
    constexpr int NG_ = (NT) / 8;                                                       \
    for (int s_ = blockIdx.x >> 3; s_ < 64 * 8 * NG_; s_ += bpx_) {                     \
      const int R_ = s_ >> 6, q_ = s_ & 63;                                             \
      const int mg_ = R_ / NG_, ng_ = R_ % NG_;                                         \
      FN(P, ((mg_ * 8 + (q_ >> 3)) << 3) + x_, ng_ * 8 + (q_ & 7), smem);               \
    }                                                                                   \
  }

DI unsigned xcc_id() { return (unsigned)__builtin_amdgcn_s_getreg((3 << 11) | 20) & 0xFu; }
DI void grid_barrier(unsigned* bar, int k, const unsigned* st) {
  asm volatile("s_waitcnt vmcnt(0)" ::: "memory");
  __syncthreads();
  if (threadIdx.x == 0) {
    const unsigned nloc = st[0], nx = st[1], x = st[2];
    unsigned* slot = bar + k * BAR_SLOT;
    const unsigned old = __hip_atomic_fetch_add(slot + x * 64, 1u, __ATOMIC_RELAXED, __HIP_MEMORY_SCOPE_AGENT);
    if (old + 1u == nloc) {
      __builtin_amdgcn_fence(__ATOMIC_RELEASE, "agent");
      asm volatile("s_waitcnt vmcnt(0)" ::: "memory");
      __hip_atomic_fetch_add(slot + 16 * 64, 1u, __ATOMIC_RELAXED, __HIP_MEMORY_SCOPE_AGENT);
    }
    unsigned spins = 0;
    while (__hip_atomic_load(slot + 16 * 64, __ATOMIC_RELAXED, __HIP_MEMORY_SCOPE_AGENT) < nx) {
      __builtin_amdgcn_s_sleep(1);
      if (++spins > (1u << 24)) break;
    }
    __builtin_amdgcn_fence(__ATOMIC_ACQUIRE, "agent");
    asm volatile("s_waitcnt vmcnt(0)" ::: "memory");
  }
  __syncthreads();
}

__global__ void __launch_bounds__(256, 2) fwd_megakernel(Params P) {
  __shared__ __attribute__((aligned(16))) char smem[SMEM_BYTES];
  cg::grid_group grid = cg::this_grid();
  unsigned* bar = (unsigned*)(P.ws + W_BAR);
  __shared__ unsigned bst[4];
  unsigned* census = bar + 16 * BAR_SLOT;
  if (threadIdx.x == 0) {
    bst[2] = xcc_id();
    __hip_atomic_fetch_add(census + bst[2] * 64, 1u, __ATOMIC_RELAXED, __HIP_MEMORY_SCOPE_AGENT);
  }
  phase0(P, smem);
  grid.sync();
  if (threadIdx.x == 0) {
    unsigned nx = 0;
    for (int j = 0; j < 16; j++) nx += __hip_atomic_load(census + j * 64, __ATOMIC_RELAXED, __HIP_MEMORY_SCOPE_AGENT) ? 1u : 0u;
    bst[0] = __hip_atomic_load(census + bst[2] * 64, __ATOMIC_RELAXED, __HIP_MEMORY_SCOPE_AGENT);
    bst[1] = nx;
  }
  __syncthreads();
  phase1_scans(P);
  GEMM_TILES(40, phase1_tile)
  grid_barrier(bar, 0, bst);
  phase2(P, smem);
  grid_barrier(bar, 1, bst);
  GEMM_TILES(8, phase3_tile)
  grid_barrier(bar, 2, bst);
  GEMM_TILES(8, phase4_tile)
  grid_barrier(bar, 3, bst);
  GEMM_TILES(8, phase5_tile)
  grid_barrier(bar, 4, bst);
  for (int t = blockIdx.x; t < TT / 64; t += gridDim.x) phase6a_unit(P, t, smem);
  grid_barrier(bar, 5, bst);
  phase6b1(P);
  grid_barrier(bar, 6, bst);
  phase6w(P);
  grid_barrier(bar, 7, bst);
  phase6b2(P);
  grid_barrier(bar, 8, bst);
  GEMM_TILES(8, phase7_tile)
}

extern "C" void kernel_launch(void* const* d_in, const int* in_sizes, int n_in, void* d_out, int out_size, void* d_ws,
                              size_t ws_size, hipStream_t stream) {
  static int grid_blocks = 0;
  if (!grid_blocks) {
    int dev = 0, cus = 0, per_cu = 0;
    hipGetDevice(&dev);
    hipDeviceGetAttribute(&cus, hipDeviceAttributeMultiprocessorCount, dev);
    hipOccupancyMaxActiveBlocksPerMultiprocessor(&per_cu, fwd_megakernel, 256, 0);
    if (per_cu > 2) per_cu = 2;
    if (per_cu < 1) per_cu = 1;
    grid_blocks = cus * per_cu;
  }
  if (ws_size < W_END) { fprintf(stderr, "workspace too small: %zu < %zu\n", ws_size, (size_t)W_END); return; }
  Params p{};
  const float** pf = (const float**)&p;
  for (int i = 0; i < 28; i++) pf[i] = (const float*)d_in[i];
  p.out = (float*)d_out;
  p.ws = (char*)d_ws;
  hipMemsetAsync((char*)d_ws + W_BAR, 0, BAR_BYTES, stream);
  void* args[] = {&p};
  hipError_t e = hipLaunchCooperativeKernel((void*)fwd_megakernel, dim3(grid_blocks), dim3(256), args, 0, stream);
  if (e != hipSuccess) fprintf(stderr, "cooperative launch failed: %s (grid %d)\n", hipGetErrorString(e), grid_blocks);
}
```

```cpp
#include <hip/hip_runtime.h>
#include <hip/hip_cooperative_groups.h>
#include <cstdio>
namespace cg = cooperative_groups;

typedef unsigned short u16;
typedef unsigned int u32;
typedef short bf16x8 __attribute__((ext_vector_type(8)));
typedef short s16x4 __attribute__((ext_vector_type(4)));
typedef float f32x4 __attribute__((ext_vector_type(4)));
typedef unsigned int u32x4 __attribute__((ext_vector_type(4)));
typedef unsigned int u32x2 __attribute__((ext_vector_type(2)));
typedef __bf16 bf16x2_t __attribute__((ext_vector_type(2)));

#define DI __device__ __forceinline__
#define LAUNDER(x) asm volatile("" : "+v"(x))

constexpr int TP = 65536, TS = 256, TT = TP + TS;
constexpr float LOG2E = 1.4426950408889634f;
constexpr float EPS = 1e-6f;
constexpr float U_SCALE = 1024.f, V_SCALE = 128.f;

constexpr size_t O_AK_P = 67371008, O_AV_P = 100925440, O_AF_P = 134479872, O_BK_P = 135004160,
                 O_BV_P = 143392768, O_AK_S = 151781376, O_AV_S = 151912448, O_AF_S = 152043520,
                 O_BK_S = 152045568, O_BV_S = 152176640;

constexpr size_t SZ_ACT = (size_t)TT * 1024 * 2;
constexpr size_t SZ_HALF = (size_t)TT * 512 * 2;
constexpr size_t W_XB = 0;
constexpr size_t W_QKV = SZ_ACT;
constexpr size_t W_GA = W_QKV + 6 * SZ_HALF;
constexpr size_t W_GB = W_GA + SZ_ACT;
constexpr size_t W_PB = W_GB + SZ_ACT;
constexpr size_t W_WIN = W_PB + (size_t)TT * 256 * 2;
constexpr size_t W_WUPA = W_WIN + (size_t)5120 * 1024 * 2;
constexpr size_t W_WUPB = W_WUPA + 1024 * 512 * 2;
constexpr size_t W_WOUT = W_WUPB + 1024 * 512 * 2;
constexpr size_t W_WQ = W_WOUT + 1024 * 1024 * 2;
constexpr size_t W_WG = W_WQ + 1024 * 1024 * 2;
constexpr size_t W_WPP = W_WG + 1024 * 1024 * 2;
constexpr size_t W_UB = W_WPP + 1024 * 256 * 2;
constexpr size_t W_VB = W_UB + (size_t)16384 * 1024 * 2;
constexpr size_t W_SK = W_VB + (size_t)16384 * 1024 * 2;
constexpr size_t W_RS1 = W_SK + 131072 * 2;
constexpr size_t W_SSQ2 = W_RS1 + (size_t)TT * 4;
constexpr size_t W_RS3 = W_SSQ2 + (size_t)TT * 64;
constexpr size_t W_CUMP = W_RS3 + (size_t)TT * 4;
constexpr size_t W_CUMS = W_CUMP + (size_t)256 * 2048 * 4;
constexpr size_t W_SSQ3 = W_CUMS + (size_t)128 * 4112 * 4 + 1024;
constexpr size_t W_BAR = W_SSQ3 + (size_t)TT * 8 * 4;
constexpr int BAR_SLOT = 17 * 64;
constexpr size_t BAR_BYTES = (size_t)(16 * BAR_SLOT + 16 * 64) * 4;
constexpr size_t W_END = W_BAR + BAR_BYTES;
constexpr size_t W_IDX = W_GA;
constexpr size_t W_G = W_GA + (size_t)32 * 1024 * 1024;
constexpr size_t SZ_PH = (size_t)TT * 128 * 2;


struct Params {
  const float *x_p, *x_s, *cak, *cav, *caf, *cbk, *cbv, *p_p, *p_s, *g_mix, *w_in, *b_f, *qn_a, *kn_a,
      *qn_b, *kn_b, *relb, *w_up_a, *w_up_b, *w_out, *g_ffn, *peer_wq, *peer_sk, *peer_u, *peer_v, *g_ple,
      *w_gate, *w_proj;
  float* out;
  char* ws;
};

constexpr int SMEM_BYTES = 128 * 129 * 4 + 2 * 64 * 17 * 4 + 256;

DI u16* ph_slice(char* ws, int x) { return (u16*)(ws + W_XB + (size_t)x * SZ_PH); }
DI u16 f2bf(float x) { return __builtin_bit_cast(u16, (__bf16)x); }
DI float bf2f(u16 h) { return __uint_as_float(((u32)h) << 16); }
DI u32 pack2(float a, float b) { bf16x2_t v = {(__bf16)a, (__bf16)b}; return __builtin_bit_cast(u32, v); }
DI float wave_sum(float v) {
#pragma unroll
  for (int o = 32; o; o >>= 1) v += __shfl_xor(v, o);
  return v;
}
DI f32x4 mfma16(bf16x8 a, bf16x8 b, f32x4 c) { return __builtin_amdgcn_mfma_f32_16x16x32_bf16(a, b, c, 0, 0, 0); }
DI float sigmoidf_(float x) { return 1.f / (1.f + __expf(-x)); }
DI u32 mono(float x) { u32 u = __float_as_uint(x); u32 m = (u32)((int)u >> 31) | 0x80000000u; return u ^ m; }
DI float unmono(u32 k) { u32 m = ((k >> 31) - 1u) | 0x80000000u; return __uint_as_float(k ^ m); }
DI void insert16(u32 (&L)[16], u32 x) {
#pragma unroll
  for (int s = 0; s < 16; s++) { u32 mx = max(L[s], x); x = min(L[s], x); L[s] = mx; }
}
DI float gelu_tanh(float x) {
  float u = 0.7978845608028654f * (x + 0.044715f * x * x * x);
  float t = 1.f - 2.f / (1.f + __expf(2.f * u));
  return 0.5f * x * (1.f + t);
}

constexpr int GSTR = 72;
constexpr int GBUF = 2 * 128 * GSTR;
constexpr int RS_OFF = 2 * GBUF * 2;
DI void gemm_compute(const u16* As, const u16* Bs, f32x4 (&acc)[4][4], int wm, int wn, int r, int quad) {
#pragma unroll
  for (int ks = 0; ks < 2; ks++) {
    bf16x8 af[4], bfr[4];
#pragma unroll
    for (int mi = 0; mi < 4; mi++) af[mi] = *(const bf16x8*)(As + (wm * 64 + mi * 16 + r) * GSTR + ks * 32 + quad * 8);
#pragma unroll
    for (int ni = 0; ni < 4; ni++) bfr[ni] = *(const bf16x8*)(Bs + (wn * 64 + ni * 16 + r) * GSTR + ks * 32 + quad * 8);
#pragma unroll
    for (int mi = 0; mi < 4; mi++)
#pragma unroll
      for (int ni = 0; ni < 4; ni++) acc[mi][ni] = mfma16(af[mi], bfr[ni], acc[mi][ni]);
    if (ks == 0) __builtin_amdgcn_sched_barrier(0);
  }
}
DI void gemm_mainloop(const u16* __restrict__ A, int lda, const u16* __restrict__ B, int ldb, int K, u16* smem,
                      f32x4 (&acc)[4][4]) {
  const int tid = threadIdx.x, lane = tid & 63, w = tid >> 6, wm = w >> 1, wn = w & 1, r = lane & 15, quad = lane >> 4;
  u16* As0 = smem;
  u16* Bs0 = smem + 128 * GSTR;
  u16* As1 = smem + GBUF;
  u16* Bs1 = As1 + 128 * GSTR;
  u32x4 r0a[4], r0b[4], r1a[4], r1b[4];
  const int lrow = tid >> 3, lch = tid & 7;
  const u16* ap = A + (size_t)lrow * lda + lch * 8;
  const u16* bp = B + (size_t)lrow * ldb + lch * 8;
  const int lo = lrow * GSTR + lch * 8;
  const int nk = K >> 6, km = nk - 1;
  const int krot = 0;
#define KOFF(kt) ((((kt) + krot) & km) * 64)
#pragma unroll
  for (int i = 0; i < 4; i++) {
    r0a[i] = *(const u32x4*)(ap + (size_t)i * 32 * lda + KOFF(0));
    r0b[i] = *(const u32x4*)(bp + (size_t)i * 32 * ldb + KOFF(0));
  }
#pragma unroll
  for (int i = 0; i < 4; i++) {
    r1a[i] = *(const u32x4*)(ap + (size_t)i * 32 * lda + KOFF(1));
    r1b[i] = *(const u32x4*)(bp + (size_t)i * 32 * ldb + KOFF(1));
  }
  __syncthreads();
#pragma unroll 1
  for (int kt = 0; kt < nk - 2; kt += 2) {
#pragma unroll
    for (int i = 0; i < 4; i++) {
      *(u32x4*)(As0 + lo + i * 32 * GSTR) = r0a[i];
      *(u32x4*)(Bs0 + lo + i * 32 * GSTR) = r0b[i];
    }
    __syncthreads();
    {
      const int ko = KOFF(kt + 2);
#pragma unroll
      for (int i = 0; i < 4; i++) {
        r0a[i] = *(const u32x4*)(ap + (size_t)i * 32 * lda + ko);
        r0b[i] = *(const u32x4*)(bp + (size_t)i * 32 * ldb + ko);
      }
    }
    gemm_compute(As0, Bs0, acc, wm, wn, r, quad);
#pragma unroll
    for (int i = 0; i < 4; i++) {
      *(u32x4*)(As1 + lo + i * 32 * GSTR) = r1a[i];
      *(u32x4*)(Bs1 + lo + i * 32 * GSTR) = r1b[i];
    }
    __syncthreads();
    {
      const int ko = KOFF(kt + 3);
#pragma unroll
      for (int i = 0; i < 4; i++) {
        r1a[i] = *(const u32x4*)(ap + (size_t)i * 32 * lda + ko);
        r1b[i] = *(const u32x4*)(bp + (size_t)i * 32 * ldb + ko);
      }
    }
    gemm_compute(As1, Bs1, acc, wm, wn, r, quad);
  }
#pragma unroll
  for (int i = 0; i < 4; i++) {
    *(u32x4*)(As0 + lo + i * 32 * GSTR) = r0a[i];
    *(u32x4*)(Bs0 + lo + i * 32 * GSTR) = r0b[i];
  }
  __syncthreads();
  gemm_compute(As0, Bs0, acc, wm, wn, r, quad);
#pragma unroll
  for (int i = 0; i < 4; i++) {
    *(u32x4*)(As1 + lo + i * 32 * GSTR) = r1a[i];
    *(u32x4*)(Bs1 + lo + i * 32 * GSTR) = r1b[i];
  }
  __syncthreads();
  gemm_compute(As1, Bs1, acc, wm, wn, r, quad);
#undef KOFF
}

DI void zero_acc(f32x4 (&acc)[4][4]) {
#pragma unroll
  for (int i = 0; i < 4; i++)
#pragma unroll
    for (int j = 0; j < 4; j++) acc[i][j] = (f32x4){0.f, 0.f, 0.f, 0.f};
}

constexpr int CSTR = 132;
DI void stage_acc(const f32x4 (&acc)[4][4], float* Cs) {
  const int tid = threadIdx.x, lane = tid & 63, w = tid >> 6, wm = w >> 1, wn = w & 1, r = lane & 15, quad = lane >> 4;
  __syncthreads();
#pragma unroll
  for (int mi = 0; mi < 4; mi++)
#pragma unroll
    for (int ni = 0; ni < 4; ni++)
#pragma unroll
      for (int j = 0; j < 4; j++) Cs[(wm * 64 + mi * 16 + quad * 4 + j) * CSTR + wn * 64 + ni * 16 + r] = acc[mi][ni][j];
  __syncthreads();
}
DI u32x2 pack4(f32x4 v) { return (u32x2){pack2(v.x, v.y), pack2(v.z, v.w)}; }
DI f32x4 unpack4(u32x2 p) {
  return (f32x4){__uint_as_float(p.x << 16), __uint_as_float(p.x & 0xffff0000u), __uint_as_float(p.y << 16), __uint_as_float(p.y & 0xffff0000u)};
}

DI void transpose_tile(const float* __restrict__ W, int ldw, int K, const float* __restrict__ g, u16* __restrict__ dst,
                       int k0, int n0, int nsrc0, float* tile) {
  const int tid = threadIdx.x;
  __syncthreads();
  {
    const int ty = tid >> 4, tx = tid & 15;
#pragma unroll
    for (int i = 0; i < 4; i++) {
      int k = ty + i * 16;
      f32x4 v = *(const f32x4*)(W + (size_t)(k0 + k) * ldw + nsrc0 + tx * 4);
      float s = g ? g[k0 + k] : 1.f;
      tile[k * 65 + tx * 4 + 0] = v[0] * s;
      tile[k * 65 + tx * 4 + 1] = v[1] * s;
      tile[k * 65 + tx * 4 + 2] = v[2] * s;
      tile[k * 65 + tx * 4 + 3] = v[3] * s;
    }
  }
  __syncthreads();
  {
    const int n = tid >> 2, kc = (tid & 3) * 16;
    u32 pk[8];
#pragma unroll
    for (int i = 0; i < 8; i++) pk[i] = pack2(tile[(kc + 2 * i) * 65 + n], tile[(kc + 2 * i + 1) * 65 + n]);
    u16* d = dst + (size_t)(n0 + n) * K + k0 + kc;
    *(u32x4*)d = (u32x4){pk[0], pk[1], pk[2], pk[3]};
    *(u32x4*)(d + 8) = (u32x4){pk[4], pk[5], pk[6], pk[7]};
  }
}

DI void conv_unit(const float* __restrict__ src, u16* __restrict__ dst, size_t base, const float* __restrict__ colscale) {
  const int tid = threadIdx.x;
#pragma unroll
  for (int i = 0; i < 4; i++) {
    size_t e = base + (size_t)i * 1024 + tid * 4;
    f32x4 v = *(const f32x4*)(src + e);
    if (colscale) {
      f32x4 gg = *(const f32x4*)(colscale + (e & 1023));
      v = v * gg;
    }
    *(u32x2*)(dst + e) = (u32x2){pack2(v[0], v[1]), pack2(v[2], v[3])};
  }
}

DI void conv_unit_fp8(const float* __restrict__ src, unsigned char* __restrict__ dst, size_t base,
                      const float* __restrict__ colscale, float scale) {
  const int tid = threadIdx.x;
#pragma unroll
  for (int i = 0; i < 4; i++) {
    size_t e = base + (size_t)i * 1024 + tid * 4;
    f32x4 v = *(const f32x4*)(src + e);
    if (colscale) {
      f32x4 gg = *(const f32x4*)(colscale + (e & 1023));
      v = v * gg;
    }
    int w = __builtin_amdgcn_cvt_pk_fp8_f32(v[0] * scale, v[1] * scale, 0, false);
    w = __builtin_amdgcn_cvt_pk_fp8_f32(v[2] * scale, v[3] * scale, w, true);
    *(int*)(dst + (((e & 1023) >> 7) << 21) + ((e >> 10) << 7) + (e & 127)) = w;
  }
}

DI void phase0(const Params& P, char* smem) {
  const int tid = threadIdx.x, lane = tid & 63, w = tid >> 6;
  char* ws = P.ws;
  {
    float* tile = (float*)smem;
    constexpr int T_WIN = 16 * 80, T_UP = 8 * 16, T_SQ = 256, T_PP = 4 * 16;
    constexpr int NT = T_WIN + 2 * T_UP + 3 * T_SQ + T_PP;
    for (int t = blockIdx.x; t < NT; t += gridDim.x) {
      int u = t;
      if (u < T_WIN) {
        int kt = u / 80, nt = u % 80;
        int n0 = nt * 64;
        int ns = n0 < 1536 ? n0 : n0 + 8;
        transpose_tile(P.w_in, 5128, 1024, P.g_mix, (u16*)(ws + W_WIN), kt * 64, n0, ns, tile);
        continue;
      }
      u -= T_WIN;
      if (u < T_UP) { transpose_tile(P.w_up_a, 1024, 512, nullptr, (u16*)(ws + W_WUPA), (u / 16) * 64, (u % 16) * 64, (u % 16) * 64, tile); continue; }
      u -= T_UP;
      if (u < T_UP) { transpose_tile(P.w_up_b, 1024, 512, nullptr, (u16*)(ws + W_WUPB), (u / 16) * 64, (u % 16) * 64, (u % 16) * 64, tile); continue; }
      u -= T_UP;
      if (u < T_SQ) { transpose_tile(P.w_out, 1024, 1024, nullptr, (u16*)(ws + W_WOUT), (u / 16) * 64, (u % 16) * 64, (u % 16) * 64, tile); continue; }
      u -= T_SQ;
      if (u < T_SQ) { transpose_tile(P.peer_wq, 1024, 1024, P.g_ffn, (u16*)(ws + W_WQ), (u / 16) * 64, (u % 16) * 64, (u % 16) * 64, tile); continue; }
      u -= T_SQ;
      if (u < T_SQ) { transpose_tile(P.w_gate, 1024, 1024, P.g_ple, (u16*)(ws + W_WG), (u / 16) * 64, (u % 16) * 64, (u % 16) * 64, tile); continue; }
      u -= T_SQ;
      transpose_tile(P.w_proj, 1024, 256, nullptr, (u16*)(ws + W_WPP), (u / 16) * 64, (u % 16) * 64, (u % 16) * 64, tile);
    }
  }
  {
    constexpr int U_UB = 4096, U_VB = 4096, U_SK = 32, U_PP = 4096, U_PS = 16;
    constexpr int NU = U_UB + U_VB + U_SK + U_PP + U_PS;
    for (int t = blockIdx.x; t < NU; t += gridDim.x) {
      int u = t;
      if (u < U_UB) { conv_unit_fp8(P.peer_u, (unsigned char*)(ws + W_UB), (size_t)u * 4096, P.g_ffn, U_SCALE); continue; }
      u -= U_UB;
      if (u < U_VB) { conv_unit_fp8(P.peer_v, (unsigned char*)(ws + W_VB), (size_t)u * 4096, nullptr, V_SCALE); continue; }
      u -= U_VB;
      if (u < U_SK) { conv_unit(P.peer_sk, (u16*)(ws + W_SK), (size_t)u * 4096, nullptr); continue; }
      u -= U_SK;
      if (u < U_PP) { conv_unit(P.p_p, (u16*)(ws + W_PB), (size_t)u * 4096, nullptr); continue; }
      u -= U_PP;
      conv_unit(P.p_s, (u16*)(ws + W_PB) + (size_t)TP * 256, (size_t)u * 4096, nullptr);
    }
  }
  {
    float* wfl = (float*)smem;
    __syncthreads();
    for (int i = tid; i < 8192; i += 256) {
      int k = i >> 3, h = i & 7;
      wfl[h * 1024 + k] = P.g_mix[k] * P.w_in[(size_t)k * 5128 + 1536 + h];
    }
    __syncthreads();
    u16* XB = (u16*)(ws + W_XB);
    float* RS1 = (float*)(ws + W_RS1);
    for (int t = blockIdx.x * 4 + w; t < TT; t += gridDim.x * 4) {
      const float* xr = t < TP ? P.x_p + (size_t)t * 1024 : P.x_s + (size_t)(t - TP) * 1024;
      f32x4 v[4];
#pragma unroll
      for (int i = 0; i < 4; i++) v[i] = *(const f32x4*)(xr + i * 256 + lane * 4);
      float ss = 0.f;
#pragma unroll
      for (int i = 0; i < 4; i++) ss += v[i][0] * v[i][0] + v[i][1] * v[i][1] + v[i][2] * v[i][2] + v[i][3] * v[i][3];
      float dots[8];
#pragma unroll
      for (int h = 0; h < 8; h++) {
        float d = 0.f;
#pragma unroll
        for (int i = 0; i < 4; i++) {
          f32x4 wv = *(const f32x4*)(wfl + h * 1024 + i * 256 + lane * 4);
          d += v[i][0] * wv[0] + v[i][1] * wv[1] + v[i][2] * wv[2] + v[i][3] * wv[3];
        }
        dots[h] = d;
      }
      ss = wave_sum(ss);
#pragma unroll
      for (int h = 0; h < 8; h++) dots[h] = wave_sum(dots[h]);
      float rs = rsqrtf(ss * (1.f / 1024.f) + EPS);
#pragma unroll
      for (int i = 0; i < 4; i++)
        *(u32x2*)(XB + (size_t)t * 1024 + i * 256 + lane * 4) = (u32x2){pack2(v[i][0], v[i][1]), pack2(v[i][2], v[i][3])};
      if (lane == 0) RS1[t] = rs;
      float myd = dots[0];
#pragma unroll
      for (int h = 1; h < 8; h++) myd = (lane == h) ? dots[h] : myd;
      if (lane < 8) {
        float z = rs * myd + P.b_f[lane];
        float lf = fminf(z, 0.f) - log1pf(expf(-fabsf(z)));
        float* o = t < TP ? P.out + O_AF_P + (size_t)t * 8 : P.out + O_AF_S + (size_t)(t - TP) * 8;
        o[lane] = lf;
      }
    }
  }
}

DI void phase1_scans(const Params& P) {
  const int lane = threadIdx.x & 63;
  const int gw = blockIdx.x * 4 + (threadIdx.x >> 6), nw = gridDim.x * 4;
  float* CUMP = (float*)(P.ws + W_CUMP);
  float* CUMS = (float*)(P.ws + W_CUMS);
  for (int row = gw; row < 384; row += nw) {
    float carry = 0.f;
    if (row < 256) {
      int b = row >> 3, h = row & 7;
      const float* src = P.out + O_AF_P + (size_t)b * 2048 * 8 + h;
      for (int p0 = 0; p0 < 2048; p0 += 64) {
        float v = src[(size_t)(p0 + lane) * 8];
#pragma unroll
        for (int o = 1; o < 64; o <<= 1) { float n = __shfl_up(v, o); if (lane >= o) v += n; }
        v += carry;
        CUMP[(size_t)row * 2048 + p0 + lane] = v * LOG2E;
        carry = __shfl(v, 63);
      }
    } else {
      int rr = row - 256;
      int b = rr >> 3, h = rr & 7;
      const float* src = P.caf + (size_t)b * 4096 * 8 + h;
      for (int p0 = 0; p0 < 4096; p0 += 64) {
        float v = src[(size_t)(p0 + lane) * 8];
#pragma unroll
        for (int o = 1; o < 64; o <<= 1) { float n = __shfl_up(v, o); if (lane >= o) v += n; }
        v += carry;
        CUMS[(size_t)rr * 4112 + p0 + lane] = v * LOG2E;
        carry = __shfl(v, 63);
      }
      {
        float v = lane < 16 ? P.out[O_AF_S + (size_t)(b * 16 + lane) * 8 + h] : 0.f;
#pragma unroll
        for (int o = 1; o < 64; o <<= 1) { float n = __shfl_up(v, o); if (lane >= o) v += n; }
        v += carry;
        if (lane < 16) CUMS[(size_t)rr * 4112 + 4096 + lane] = v * LOG2E;
      }
    }
  }
}

DI void phase1_tile(const Params& P, int mt, int nt, char* smem) {
  const int tid = threadIdx.x, lane = tid & 63, w = tid >> 6, wm = w >> 1, wn = w & 1, r = lane & 15, quad = lane >> 4;
  const int m0 = mt * 128, n0 = nt * 128;
  char* ws = P.ws;
  f32x4 acc[4][4];
  zero_acc(acc);
  gemm_mainloop((const u16*)(ws + W_XB) + (size_t)m0 * 1024, 1024, (const u16*)(ws + W_WIN) + (size_t)n0 * 1024, 1024, 1024,
                (u16*)smem, acc);
  float* Cs = (float*)smem;
  stage_acc(acc, Cs);
  const bool sample = m0 >= TP;
  const int c4 = tid & 31, rsub = tid >> 5;
  const float* RS1 = (const float*)(ws + W_RS1) + m0;
  if (n0 < 3072) {
    const int seg = n0 >> 9, hc = n0 & 511;
    const bool normed = (seg != 2 && seg != 5);
    const float* gain = seg == 0 ? P.qn_a : seg == 1 ? P.kn_a : seg == 3 ? P.qn_b : P.kn_b;
    const float qs = (seg == 0 || seg == 3) ? 0.125f * LOG2E : 1.f;
    f32x4 gn = (f32x4){1.f, 1.f, 1.f, 1.f};
    if (normed) gn = *(const f32x4*)(gain + (c4 & 15) * 4) * qs;
    u16* dp = (u16*)(ws + W_QKV + (size_t)seg * SZ_HALF) + (size_t)m0 * 512 + hc + c4 * 4;
    float* op = nullptr;
    if (seg == 1 || seg == 2) {
      op = sample ? P.out + (seg == 1 ? O_AK_S : O_AV_S) + (size_t)(m0 - TP) * 512 : P.out + (seg == 1 ? O_AK_P : O_AV_P) + (size_t)m0 * 512;
    } else if (seg == 4 || seg == 5) {
      if (sample) op = P.out + (seg == 4 ? O_BK_S : O_BV_S) + (size_t)(m0 - TP) * 512;
      else if ((m0 & 2047) >= 1536) op = P.out + (seg == 4 ? O_BK_P : O_BV_P) + ((size_t)(m0 >> 11) * 512 + ((m0 & 2047) - 1536)) * 512;
    }
    if (op) op += hc + c4 * 4;
#pragma unroll 4
    for (int p = 0; p < 16; p++) {
      const int row = p * 8 + rsub;
      f32x4 v = *(const f32x4*)(Cs + row * CSTR + c4 * 4) * RS1[row];
      if (normed) {
        float ss = v.x * v.x + v.y * v.y + v.z * v.z + v.w * v.w;
        ss += __shfl_xor(ss, 1);
        ss += __shfl_xor(ss, 2);
        ss += __shfl_xor(ss, 4);
        ss += __shfl_xor(ss, 8);
        v = v * gn * rsqrtf(ss * (1.f / 64.f) + EPS);
      }
      *(u32x2*)(dp + (size_t)row * 512) = pack4(v);
      if (op) *(f32x4*)(op + (size_t)row * 512) = v;
    }
  } else {
    u16* dp = (n0 < 4096 ? (u16*)(ws + W_GA) + (n0 - 3072) : (u16*)(ws + W_GB) + (n0 - 4096)) + (size_t)m0 * 1024 + c4 * 4;
#pragma unroll 4
    for (int p = 0; p < 16; p++) {
      const int row = p * 8 + rsub;
      f32x4 v = *(const f32x4*)(Cs + row * CSTR + c4 * 4) * RS1[row];
      v = (f32x4){sigmoidf_(v.x), sigmoidf_(v.y), sigmoidf_(v.z), sigmoidf_(v.w)};
      *(u32x2*)(dp + (size_t)row * 1024) = pack4(v);
    }
  }
}

constexpr int ASTR = 72;
constexpr int ASTAGE = 2 * 64 * ASTR * 2 + 256;
constexpr int TAB_OFF = 2 * ASTAGE;
struct AttnState { f32x4 o[4]; float m, l; };

DI s16x4 tr_read(const u16* p) {
  return __builtin_amdgcn_ds_read_tr16_b64_v4i16((__attribute__((address_space(3))) s16x4*)(p));
}

template <int MODE>
DI void attn_step(const u16* Ks, const u16* Vs, const bf16x8 (&qf)[2], AttnState& st, int kpos0, int qpos, int qlim,
                  float cq, const float* cum, const float* tab, bool domask) {
  const int lane = threadIdx.x & 63, r = lane & 15, quad = lane >> 4;
  const bool farband = (MODE == 1) && (kpos0 + 31 - (qpos - r) <= -128);
  f32x4 s[2];
#pragma unroll
  for (int t = 0; t < 2; t++) {
    f32x4 a4 = (f32x4){0.f, 0.f, 0.f, 0.f};
#pragma unroll
    for (int ks = 0; ks < 2; ks++) {
      bf16x8 kf = *(const bf16x8*)(Ks + (t * 16 + r) * ASTR + ks * 32 + quad * 8);
      a4 = mfma16(kf, qf[ks], a4);
    }
    s[t] = a4;
  }
#pragma unroll
  for (int t = 0; t < 2; t++) {
    const int kb = kpos0 + t * 16 + quad * 4;
    if (MODE == 0) {
      f32x4 c4 = *(const f32x4*)(cum + kb);
#pragma unroll
      for (int j = 0; j < 4; j++) s[t][j] += cq - c4[j];
    } else if (farband) {
      const float b0 = tab[0];
#pragma unroll
      for (int j = 0; j < 4; j++) s[t][j] += b0;
    } else {
#pragma unroll
      for (int j = 0; j < 4; j++) {
        int rel = kb + j - qpos;
        rel = min(max(rel, -128), 128) + 128;
        s[t][j] += tab[rel];
      }
    }
    if (domask) {
#pragma unroll
      for (int j = 0; j < 4; j++)
        if (kb + j > qlim) s[t][j] = -1e30f;
    }
  }
  float p[8];
  float ls = 0.f;
#pragma unroll
  for (int t = 0; t < 2; t++)
#pragma unroll
    for (int j = 0; j < 4; j++) { p[t * 4 + j] = __builtin_amdgcn_exp2f(s[t][j]); ls += p[t * 4 + j]; }
  st.l += ls;
  u32x4 pk = (u32x4){pack2(p[0], p[1]), pack2(p[2], p[3]), pack2(p[4], p[5]), pack2(p[6], p[7])};
  bf16x8 pf = __builtin_bit_cast(bf16x8, pk);
  const int qq = (lane & 15) >> 2, pp = lane & 3;
#pragma unroll
  for (int dt = 0; dt < 4; dt++) {
    s16x4 lo = tr_read(Vs + (quad * 4 + qq) * ASTR + dt * 16 + pp * 4);
    s16x4 hi = tr_read(Vs + (16 + quad * 4 + qq) * ASTR + dt * 16 + pp * 4);
    bf16x8 vf = __builtin_shufflevector(lo, hi, 0, 1, 2, 3, 4, 5, 6, 7);
    st.o[dt] = mfma16(vf, pf, st.o[dt]);
  }
}

template <int MODE>
DI void attn_prompt_item(const Params& P, char* smem, int b, int h, int qt, float bound) {
  const int tid = threadIdx.x, lane = tid & 63, w = tid >> 6, r = lane & 15, quad = lane >> 4;
  char* ws = P.ws;
  const u16* Q = (const u16*)(ws + W_QKV + (size_t)(MODE == 0 ? 0 : 3) * SZ_HALF);
  const u16* Kg = (const u16*)(ws + W_QKV + (size_t)(MODE == 0 ? 1 : 4) * SZ_HALF);
  const u16* Vg = (const u16*)(ws + W_QKV + (size_t)(MODE == 0 ? 2 : 5) * SZ_HALF);
  u16* Y = (u16*)(ws + W_XB + (size_t)(MODE == 0 ? 0 : 1) * SZ_HALF);
  float* tab = (float*)(smem + TAB_OFF);
  __syncthreads();
  if (MODE == 1) {
    for (int i = tid; i < 257; i += 256) tab[i] = P.relb[h * 257 + i] * LOG2E - bound;
  }
  const int q0 = qt * 64;
  const int qpos = q0 + w * 16 + r;
  const size_t tokq = (size_t)b * 2048 + qpos;
  bf16x8 qf[2];
#pragma unroll
  for (int ks = 0; ks < 2; ks++) qf[ks] = *(const bf16x8*)(Q + tokq * 512 + h * 64 + ks * 32 + quad * 8);
  const float* cum = (const float*)(ws + W_CUMP) + (size_t)(b * 8 + h) * 2048;
  const float cq = MODE == 0 ? cum[qpos] - bound : 0.f;
  AttnState st;
#pragma unroll
  for (int dt = 0; dt < 4; dt++) st.o[dt] = (f32x4){0.f, 0.f, 0.f, 0.f};
  st.m = 0.f;
  st.l = 0.f;
  const int kt_lo = MODE == 0 ? 0 : max(0, qt - 8), kt_hi = qt;
  u32x4 rk[2], rv[2];
  f32x4 rc = (f32x4){0.f, 0.f, 0.f, 0.f};
  const int lkey = tid >> 3, lch = tid & 7;
  const u16* kp = Kg + ((size_t)b * 2048 + lkey) * 512 + h * 64 + lch * 8;
  const u16* vp = Vg + ((size_t)b * 2048 + lkey) * 512 + h * 64 + lch * 8;
  const int lofs = lkey * ASTR + lch * 8;
#pragma unroll
  for (int i = 0; i < 2; i++) {
    rk[i] = *(const u32x4*)(kp + (size_t)(kt_lo * 64 + i * 32) * 512);
    rv[i] = *(const u32x4*)(vp + (size_t)(kt_lo * 64 + i * 32) * 512);
  }
  if (MODE == 0 && tid < 16) rc = *(const f32x4*)(cum + kt_lo * 64 + tid * 4);
  {
    u16* Ks = (u16*)(smem + (kt_lo & 1) * ASTAGE);
    u16* Vs = Ks + 64 * ASTR;
#pragma unroll
    for (int i = 0; i < 2; i++) {
      *(u32x4*)(Ks + lofs + i * 32 * ASTR) = rk[i];
      *(u32x4*)(Vs + lofs + i * 32 * ASTR) = rv[i];
    }
    if (MODE == 0 && tid < 16) *(f32x4*)((float*)(Vs + 64 * ASTR) + tid * 4) = rc;
  }
  __syncthreads();
#pragma unroll 1
  for (int kt = kt_lo; kt <= kt_hi; kt++) {
    const int ktn = min(kt + 1, kt_hi);
#pragma unroll
    for (int i = 0; i < 2; i++) {
      rk[i] = *(const u32x4*)(kp + (size_t)(ktn * 64 + i * 32) * 512);
      rv[i] = *(const u32x4*)(vp + (size_t)(ktn * 64 + i * 32) * 512);
    }
    if (MODE == 0 && tid < 16) rc = *(const f32x4*)(cum + ktn * 64 + tid * 4);
    const u16* Ks = (const u16*)(smem + (kt & 1) * ASTAGE);
    const u16* Vs = Ks + 64 * ASTR;
    const float* cl = (const float*)(Vs + 64 * ASTR) - kt * 64;
    const bool diag = (MODE == 0) && (kt == qt);
#pragma unroll
    for (int half = 0; half < 2; half++) {
      const int kpos0 = kt * 64 + half * 32;
      if (diag && kpos0 > q0 + w * 16 + 15) continue;
      attn_step<MODE>(Ks + half * 32 * ASTR, Vs + half * 32 * ASTR, qf, st, kpos0, qpos, qpos, cq, cl, tab, diag);
    }
    if (kt < kt_hi) {
      u16* Kn = (u16*)(smem + ((kt + 1) & 1) * ASTAGE);
      u16* Vn = Kn + 64 * ASTR;
#pragma unroll
      for (int i = 0; i < 2; i++) {
        *(u32x4*)(Kn + lofs + i * 32 * ASTR) = rk[i];
        *(u32x4*)(Vn + lofs + i * 32 * ASTR) = rv[i];
      }
      if (MODE == 0 && tid < 16) *(f32x4*)((float*)(Vn + 64 * ASTR) + tid * 4) = rc;
    }
    __syncthreads();
  }
  float lt = st.l;
  lt += __shfl_xor(lt, 16);
  lt += __shfl_xor(lt, 32);
  const float inv = 1.f / lt;
#pragma unroll
  for (int dt = 0; dt < 4; dt++) {
    u32x2 o2 = (u32x2){pack2(st.o[dt][0] * inv, st.o[dt][1] * inv), pack2(st.o[dt][2] * inv, st.o[dt][3] * inv)};
    *(u32x2*)(Y + tokq * 512 + h * 64 + dt * 16 + quad * 4) = o2;
  }
}

template <int MODE>
DI void attn_sample_item(const Params& P, char* smem, int b, int h, float bound) {
  const int tid = threadIdx.x, lane = tid & 63, w = tid >> 6, r = lane & 15, quad = lane >> 4;
  constexpr int L = MODE == 0 ? 4096 : 512;
  char* ws = P.ws;
  const u16* Q = (const u16*)(ws + W_QKV + (size_t)(MODE == 0 ? 0 : 3) * SZ_HALF);
  const u16* Kn = (const u16*)(ws + W_QKV + (size_t)(MODE == 0 ? 1 : 4) * SZ_HALF);
  const u16* Vn = (const u16*)(ws + W_QKV + (size_t)(MODE == 0 ? 2 : 5) * SZ_HALF);
  u16* Y = (u16*)(ws + W_XB + (size_t)(MODE == 0 ? 0 : 1) * SZ_HALF);
  u16* Kw = (u16*)smem + w * (2 * 32 * ASTR);
  u16* Vw = Kw + 32 * ASTR;
  float* tab = (float*)(smem + TAB_OFF);
  __syncthreads();
  if (MODE == 1) {
    for (int i = tid; i < 257; i += 256) tab[i] = P.relb[h * 257 + i] * LOG2E - bound;
  }
  __syncthreads();
  const float* ck = (MODE == 0 ? P.cak : P.cbk) + ((size_t)b * L * 8 + h) * 64;
  const float* cv = (MODE == 0 ? P.cav : P.cbv) + ((size_t)b * L * 8 + h) * 64;
  const size_t tokbase = (size_t)TP + b * 16;
  bf16x8 qf[2];
#pragma unroll
  for (int ks = 0; ks < 2; ks++) qf[ks] = *(const bf16x8*)(Q + (tokbase + r) * 512 + h * 64 + ks * 32 + quad * 8);
  const int qpos = L + r;
  const float* cum = (const float*)(ws + W_CUMS) + (size_t)(b * 8 + h) * 4112;
  const float cq = MODE == 0 ? cum[qpos] - bound : 0.f;
  AttnState st;
#pragma unroll
  for (int dt = 0; dt < 4; dt++) st.o[dt] = (f32x4){0.f, 0.f, 0.f, 0.f};
  st.m = 0.f;
  st.l = 0.f;
  const int kbeg = w * (L / 4), kend = kbeg + L / 4;
#pragma unroll 1
  for (int k0 = kbeg; k0 < kend; k0 += 32) {
    {
      f32x4 kr[8];
#pragma unroll
      for (int i = 0; i < 8; i++) kr[i] = *(const f32x4*)(ck + (size_t)(k0 + i * 4 + quad) * 512 + r * 4);
#pragma unroll
      for (int i = 0; i < 8; i++)
        *(u32x2*)(Kw + (i * 4 + quad) * ASTR + r * 4) = (u32x2){pack2(kr[i][0], kr[i][1]), pack2(kr[i][2], kr[i][3])};
    }
    {
      f32x4 vr[8];
#pragma unroll
      for (int i = 0; i < 8; i++) vr[i] = *(const f32x4*)(cv + (size_t)(k0 + i * 4 + quad) * 512 + r * 4);
#pragma unroll
      for (int i = 0; i < 8; i++)
        *(u32x2*)(Vw + (i * 4 + quad) * ASTR + r * 4) = (u32x2){pack2(vr[i][0], vr[i][1]), pack2(vr[i][2], vr[i][3])};
    }
    asm volatile("s_waitcnt lgkmcnt(0)" ::: "memory");
    __builtin_amdgcn_wave_barrier();
    attn_step<MODE>(Kw, Vw, qf, st, k0, qpos, qpos, cq, cum, tab, false);
    __builtin_amdgcn_wave_barrier();
  }
  if (w == 0) {
#pragma unroll
    for (int i = 0; i < 2; i++) {
      int c = lane + i * 64;
      int key = c >> 3, ch = c & 7;
      u32x4 kk = *(const u32x4*)(Kn + (tokbase + key) * 512 + h * 64 + ch * 8);
      u32x4 vv = *(const u32x4*)(Vn + (tokbase + key) * 512 + h * 64 + ch * 8);
      *(u32x4*)(Kw + key * ASTR + ch * 8) = kk;
      *(u32x4*)(Vw + key * ASTR + ch * 8) = vv;
      *(u32x4*)(Kw + (16 + key) * ASTR + ch * 8) = (u32x4){0u, 0u, 0u, 0u};
      *(u32x4*)(Vw + (16 + key) * ASTR + ch * 8) = (u32x4){0u, 0u, 0u, 0u};
    }
    asm volatile("s_waitcnt lgkmcnt(0)" ::: "memory");
    __builtin_amdgcn_wave_barrier();
    attn_step<MODE>(Kw, Vw, qf, st, L, qpos, MODE == 0 ? qpos : L + 15, cq, cum, tab, true);
  }
  __syncthreads();
  float* comb = (float*)smem;
  float lt = st.l;
  lt += __shfl_xor(lt, 16);
  lt += __shfl_xor(lt, 32);
#pragma unroll
  for (int dt = 0; dt < 4; dt++)
#pragma unroll
    for (int j = 0; j < 4; j++) comb[(w * 16 + r) * 68 + dt * 16 + quad * 4 + j] = st.o[dt][j];
  if (quad == 0) comb[(w * 16 + r) * 68 + 65] = lt;
  __syncthreads();
  if (w == 0) {
    float Ls = 0.f;
#pragma unroll
    for (int i = 0; i < 4; i++) Ls += comb[(i * 16 + r) * 68 + 65];
    const float inv = 1.f / Ls;
#pragma unroll
    for (int dt = 0; dt < 4; dt++) {
      float ov[4];
#pragma unroll
      for (int j = 0; j < 4; j++) {
        float a = 0.f;
#pragma unroll
        for (int i = 0; i < 4; i++) a += comb[(i * 16 + r) * 68 + dt * 16 + quad * 4 + j];
        ov[j] = a * inv;
      }
      *(u32x2*)(Y + (tokbase + r) * 512 + h * 64 + dt * 16 + quad * 4) = (u32x2){pack2(ov[0], ov[1]), pack2(ov[2], ov[3])};
    }
  }
}

DI void phase2(const Params& P, char* smem) {
  constexpr int N_SA = 128, N_PA = 8192, N_PB = 8192, N_SB = 128;
  float bound_a, bound_b;
  {
    const int lane = threadIdx.x & 63;
    float qa = fabsf(P.qn_a[lane]), ka = fabsf(P.kn_a[lane]), qb = fabsf(P.qn_b[lane]), kb = fabsf(P.kn_b[lane]), rb = 0.f;
    for (int i = lane; i < 8 * 257; i += 64) rb = fmaxf(rb, fabsf(P.relb[i]));
#pragma unroll
    for (int o = 32; o; o >>= 1) {
      qa = fmaxf(qa, __shfl_xor(qa, o)); ka = fmaxf(ka, __shfl_xor(ka, o));
      qb = fmaxf(qb, __shfl_xor(qb, o)); kb = fmaxf(kb, __shfl_xor(kb, o));
      rb = fmaxf(rb, __shfl_xor(rb, o));
    }
    bound_a = 8.f * qa * ka * LOG2E;
    bound_b = (8.f * qb * kb + rb) * LOG2E;
  }
  for (int it = blockIdx.x; it < N_SA + N_PA + N_PB + N_SB; it += gridDim.x) {
    int u = it;
    if (u < N_SA) { attn_sample_item<0>(P, smem, u >> 3, u & 7, bound_a); continue; }
    u -= N_SA;
    if (u < N_PA) { int qt = 31 - (u >> 8), bh = u & 255; attn_prompt_item<0>(P, smem, bh >> 3, bh & 7, qt, bound_a); continue; }
    u -= N_PA;
    if (u < N_PB) { int qt = 31 - (u >> 8), bh = u & 255; attn_prompt_item<1>(P, smem, bh >> 3, bh & 7, qt, bound_b); continue; }
    u -= N_PB;
    attn_sample_item<1>(P, smem, u >> 3, u & 7, bound_b);
  }
}

DI void phase3_tile(const Params& P, int mt, int nt, char* smem) {
  const int tid = threadIdx.x, lane = tid & 63, w = tid >> 6, wm = w >> 1, wn = w & 1, r = lane & 15, quad = lane >> 4;
  const int m0 = mt * 128, n0 = nt * 128;
  char* ws = P.ws;
  const u16* YA = (const u16*)(ws + W_XB);
  const u16* YB = YA + (size_t)TT * 512;
  const u16* GA = (const u16*)(ws + W_GA);
  const u16* GB = (const u16*)(ws + W_GB);
  u16* MRG = (u16*)(ws + W_QKV);
  f32x4 acc[4][4];
  zero_acc(acc);
  gemm_mainloop(YA + (size_t)m0 * 512, 512, (const u16*)(ws + W_WUPA) + (size_t)n0 * 512, 512, 512, (u16*)smem, acc);
  float* Cs = (float*)smem;
  const int c4 = tid & 31, rsub = tid >> 5;
  const size_t tofs = (size_t)m0 * 1024 + n0 + c4 * 4;
  stage_acc(acc, Cs);
#pragma unroll 4
  for (int p = 0; p < 16; p++) {
    const int row = p * 8 + rsub;
    const f32x4 v = *(const f32x4*)(Cs + row * CSTR + c4 * 4);
    const f32x4 gv = unpack4(*(const u32x2*)(GA + tofs + (size_t)row * 1024));
    *(u32x2*)(MRG + tofs + (size_t)row * 1024) = pack4(v * gv);
  }
  zero_acc(acc);
  gemm_mainloop(YB + (size_t)m0 * 512, 512, (const u16*)(ws + W_WUPB) + (size_t)n0 * 512, 512, 512, (u16*)smem, acc);
  stage_acc(acc, Cs);
#pragma unroll 4
  for (int p = 0; p < 16; p++) {
    const int row = p * 8 + rsub;
    const f32x4 v = *(const f32x4*)(Cs + row * CSTR + c4 * 4);
    const f32x4 gv = unpack4(*(const u32x2*)(GB + tofs + (size_t)row * 1024));
    const f32x4 m1 = unpack4(*(const u32x2*)(MRG + tofs + (size_t)row * 1024));
    *(u32x2*)(MRG + tofs + (size_t)row * 1024) = pack4(m1 + v * gv);
  }
}

DI void phase4_tile(const Params& P, int mt, int nt, char* smem) {
  const int tid = threadIdx.x, lane = tid & 63, w = tid >> 6, wm = w >> 1, wn = w & 1, r = lane & 15, quad = lane >> 4;
  const int m0 = mt * 128, n0 = nt * 128;
  char* ws = P.ws;
  const u16* MRG = (const u16*)(ws + W_QKV);
  u16* H1B = (u16*)(ws + W_QKV + SZ_ACT);
  float* SSQ2 = (float*)(ws + W_SSQ2);
  f32x4 acc[4][4];
  zero_acc(acc);
  gemm_mainloop(MRG + (size_t)m0 * 1024, 1024, (const u16*)(ws + W_WOUT) + (size_t)n0 * 1024, 1024, 1024, (u16*)smem, acc);
  const float* xb = m0 < TP ? P.x_p : P.x_s - (size_t)TP * 1024;
  float* Cs = (float*)smem;
  const int c4 = tid & 31, rsub = tid >> 5;
  const size_t tofs = (size_t)m0 * 1024 + n0 + c4 * 4;
  stage_acc(acc, Cs);
#pragma unroll 4
  for (int p = 0; p < 16; p++) {
    const int row = p * 8 + rsub;
    const f32x4 v = *(const f32x4*)(Cs + row * CSTR + c4 * 4);
    const f32x4 h1 = *(const f32x4*)(xb + tofs + (size_t)row * 1024) + v;
    *(u32x2*)(H1B + tofs + (size_t)row * 1024) = pack4(h1);
    float ss = h1.x * h1.x + h1.y * h1.y + h1.z * h1.z + h1.w * h1.w;
    ss += __shfl_xor(ss, 1);
    ss += __shfl_xor(ss, 2);
    ss += __shfl_xor(ss, 4);
    ss += __shfl_xor(ss, 8);
    ss += __shfl_xor(ss, 16);
    if (c4 == 0) SSQ2[(size_t)(m0 + row) * 16 + nt] = ss;
  }
}

DI void phase5_tile(const Params& P, int mt, int nt, char* smem) {
  const int tid = threadIdx.x, lane = tid & 63, w = tid >> 6, wm = w >> 1, wn = w & 1, r = lane & 15, quad = lane >> 4;
  const int m0 = mt * 128, n0 = nt * 128;
  char* ws = P.ws;
  const u16* H1B = (const u16*)(ws + W_QKV + SZ_ACT);
  u16* QP = (u16*)(ws + W_QKV + 2 * SZ_ACT);
  const float* SSQ2 = (const float*)(ws + W_SSQ2);
  float* rs_s = (float*)(smem + RS_OFF);
  __syncthreads();
  if (tid < 128) {
    float s = 0.f;
#pragma unroll
    for (int i = 0; i < 8; i++) s += SSQ2[(size_t)(m0 + tid) * 16 + i];
    rs_s[tid] = rsqrtf(s * (1.f / 1024.f) + EPS);
  }
  f32x4 acc[4][4];
  zero_acc(acc);
  gemm_mainloop(H1B + (size_t)m0 * 1024, 1024, (const u16*)(ws + W_WQ) + (size_t)n0 * 1024, 1024, 1024, (u16*)smem, acc);
  float* Cs = (float*)smem;
  const int c4 = tid & 31, rsub = tid >> 5;
  const size_t tofs = (size_t)m0 * 1024 + n0 + c4 * 4;
  stage_acc(acc, Cs);
#pragma unroll 4
  for (int p = 0; p < 16; p++) {
    const int row = p * 8 + rsub;
    const f32x4 v = *(const f32x4*)(Cs + row * CSTR + c4 * 4) * rs_s[row];
    *(u32x2*)(QP + tofs + (size_t)row * 1024) = pack4(v);
  }
}

DI void bitonic_merge16(u32 (&L)[16]) {
#pragma unroll
  for (int st = 8; st >= 1; st >>= 1)
#pragma unroll
    for (int i = 0; i < 16; i++)
      if ((i & st) == 0) { u32 hi = max(L[i], L[i + st]); u32 lo = min(L[i], L[i + st]); L[i] = hi; L[i + st] = lo; }
}
DI void bitonic_sort16(u32 (&L)[16]) {
#pragma unroll
  for (int k = 2; k <= 16; k <<= 1)
#pragma unroll
    for (int j = k >> 1; j > 0; j >>= 1)
#pragma unroll
      for (int i = 0; i < 16; i++) {
        const int l = i ^ j;
        if (l > i) {
          const u32 hi = max(L[i], L[l]), lo = min(L[i], L[l]);
          if ((i & k) == 0) { L[i] = hi; L[l] = lo; } else { L[i] = lo; L[l] = hi; }
        }
      }
}
DI void phase6a_unit(const Params& P, int unit, char* smem) {
  const int tid = threadIdx.x, lane = tid & 63, w = tid >> 6, r = lane & 15, quad = lane >> 4;
  char* ws = P.ws;
  const u16* QP = (const u16*)(ws + W_QKV + 2 * SZ_ACT);
  const u16* SK = (const u16*)(ws + W_SK);
  u16* IDXo = (u16*)(ws + W_IDX);
  float* Go = (float*)(ws + W_G);
  float* sc = (float*)smem;
  u32* hl = (u32*)smem;
  u32* xl = (u32*)smem + 256 * 17;
  u32* lists = (u32*)(smem + 128 * 129 * 4);
  unsigned char* tabi = (unsigned char*)(smem + 128 * 129 * 4 + 128 * 17 * 4);
  unsigned char* tabj = tabi + 64;
  const int tok0 = unit * 64;
  __syncthreads();
  if (tid == 0) {
    int c = 0;
    for (int i = 0; i < 16; i++)
      for (int j = i + 1; j < 16; j++)
        if ((i + 1) * (j + 1) <= 16) { tabi[c] = (unsigned char)i; tabj[c] = (unsigned char)j; tabi[32 + c] = (unsigned char)j; tabj[32 + c] = (unsigned char)i; c++; }
    tabi[23] = 0; tabj[23] = 0; tabi[24] = 1; tabj[24] = 1;
    tabi[55] = 2; tabj[55] = 2; tabi[56] = 3; tabj[56] = 3;
  }
  for (int h = 0; h < 8; h++) {
#pragma unroll
    for (int p = 0; p < 2; p++) {
      const int hp = h * 2 + p;
      bf16x8 qf[2];
#pragma unroll
      for (int ks = 0; ks < 2; ks++)
        qf[ks] = *(const bf16x8*)(QP + (size_t)(tok0 + w * 16 + r) * 1024 + hp * 64 + ks * 32 + quad * 8);
#pragma unroll
      for (int nt = 0; nt < 8; nt++) {
        f32x4 a4 = (f32x4){0.f, 0.f, 0.f, 0.f};
#pragma unroll
        for (int ks = 0; ks < 2; ks++) {
          bf16x8 kf = *(const bf16x8*)(SK + (size_t)(hp * 128 + nt * 16 + r) * 64 + ks * 32 + quad * 8);
          a4 = mfma16(kf, qf[ks], a4);
        }
        float* d = sc + (p * 64 + w * 16 + r) * 129 + nt * 16 + quad * 4;
        d[0] = a4[0]; d[1] = a4[1]; d[2] = a4[2]; d[3] = a4[3];
      }
    }
    __syncthreads();
    u32 L[16];
    {
      const int inst = tid & 127, half = tid >> 7;
      const float* row = sc + inst * 129 + half * 64;
#pragma unroll
      for (int i = 0; i < 16; i++) L[i] = (mono(row[i]) & ~127u) | (u32)(half * 64 + i);
      bitonic_sort16(L);
#pragma unroll 1
      for (int c = 1; c < 4; c++) {
        u32 N[16];
#pragma unroll
        for (int i = 0; i < 16; i++) N[i] = (mono(row[c * 16 + i]) & ~127u) | (u32)(half * 64 + c * 16 + i);
        bitonic_sort16(N);
#pragma unroll
        for (int i = 0; i < 16; i++) L[i] = max(L[i], N[15 - i]);
        bitonic_merge16(L);
      }
    }
    __syncthreads();
#pragma unroll
    for (int s = 0; s < 16; s++) hl[tid * 17 + s] = L[s];
    __syncthreads();
    if (tid < 128) {
      u32 M[16];
#pragma unroll
      for (int s = 0; s < 16; s++) M[s] = max(L[s], hl[(tid + 128) * 17 + 15 - s]);
      bitonic_merge16(M);
#pragma unroll
      for (int s = 0; s < 16; s++) lists[tid * 17 + s] = M[s];
    }
    __syncthreads();
    if (tid < 128) {
      const int tok = tid & 63;
      const bool part = tid >= 64;
      float fa[16], fb[16];
#pragma unroll
      for (int s = 0; s < 16; s++) {
        const float va = unmono(lists[tok * 17 + s] & ~127u);
        const float vb = unmono(lists[(64 + tok) * 17 + s] & ~127u);
        fa[s] = part ? vb : va;
        fb[s] = part ? va : vb;
      }
      u32 L2[16];
#pragma unroll
      for (int s = 0; s < 16; s++) L2[s] = 0u;
      const u32 cbase = part ? 32u : 0u;
      {
        int c = 0;
#pragma unroll
        for (int i = 0; i < 16; i++)
#pragma unroll
          for (int j = i + 1; j < 16; j++)
            if ((i + 1) * (j + 1) <= 16) {
              insert16(L2, (mono(fa[i] + fb[j]) & ~63u) | (cbase + (u32)c));
              c++;
            }
      }
      insert16(L2, (mono(part ? fa[2] + fb[2] : fa[0] + fb[0]) & ~63u) | (cbase + 23u));
      insert16(L2, (mono(part ? fa[3] + fb[3] : fa[1] + fb[1]) & ~63u) | (cbase + 24u));
#pragma unroll
      for (int s = 0; s < 16; s++) xl[tid * 17 + s] = L2[s];
    }
    __syncthreads();
    if (tid < 64) {
      float val[16];
      u32 idx[16];
      float mx = -1e30f;
#pragma unroll
      for (int s = 0; s < 16; s++) {
        const u32 m = max(xl[tid * 17 + s], xl[(tid + 64) * 17 + 15 - s]);
        const u32 sl = m & 63u;
        const int i = tabi[sl], j = tabj[sl];
        const u32 au = lists[tid * 17 + i], bu = lists[(64 + tid) * 17 + j];
        val[s] = unmono(au & ~127u) + unmono(bu & ~127u);
        idx[s] = (au & 127u) * 128u + (bu & 127u);
        mx = fmaxf(mx, val[s]);
      }
      float sum = 0.f;
#pragma unroll
      for (int s = 0; s < 16; s++) { val[s] = __expf(val[s] - mx); sum += val[s]; }
      const float inv = 1.f / sum;
      const size_t so = ((size_t)(tok0 + tid) * 8 + h) * 16;
      {
        u32* ib = (u32*)(IDXo + (size_t)(tok0 + tid) * 128 + h * 2);
#pragma unroll
        for (int gg = 0; gg < 8; gg++) ib[gg * 8] = idx[gg] | (idx[gg + 8] << 16);
      }
#pragma unroll
      for (int s = 0; s < 4; s++)
        *(f32x4*)(Go + so + s * 4) = (f32x4){val[s * 4] * inv, val[s * 4 + 1] * inv, val[s * 4 + 2] * inv, val[s * 4 + 3] * inv};
    }
    __syncthreads();
  }
}

typedef float f32x2 __attribute__((ext_vector_type(2)));
DI float dot4_fp8(u32 w, float x0, float x1, float x2, float x3, float acc) {
  f32x2 lo = __builtin_amdgcn_cvt_pk_f32_fp8((int)w, false);
  f32x2 hi = __builtin_amdgcn_cvt_pk_f32_fp8((int)w, true);
  acc = fmaf(lo[0], x0, acc);
  acc = fmaf(lo[1], x1, acc);
  acc = fmaf(hi[0], x2, acc);
  acc = fmaf(hi[1], x3, acc);
  return acc;
}
DI void axpy4_fp8(u32 w, float wgt, float& o0, float& o1, float& o2, float& o3) {
  f32x2 lo = __builtin_amdgcn_cvt_pk_f32_fp8((int)w, false);
  f32x2 hi = __builtin_amdgcn_cvt_pk_f32_fp8((int)w, true);
  o0 = fmaf(wgt, lo[0], o0);
  o1 = fmaf(wgt, lo[1], o1);
  o2 = fmaf(wgt, hi[0], o2);
  o3 = fmaf(wgt, hi[1], o3);
}

struct RowSet { u32x4 r[16]; };
DI void gather_rows(RowSet& R, const unsigned char* base, u32 lofs, u32x4 ea, u32x4 eb) {
  const u32 ev[8] = {ea.x, ea.y, ea.z, ea.w, eb.x, eb.y, eb.z, eb.w};
#pragma unroll
  for (int i = 0; i < 8; i++) {
    R.r[2 * i] = *(const u32x4*)(base + (((ev[i] & 0xffffu) << 7) + lofs));
    R.r[2 * i + 1] = *(const u32x4*)(base + (((ev[i] >> 16) << 7) + lofs));
  }
}
DI void b1_compute(const RowSet& R, u32x4 xa, u32x4 xb, u16* pr, int c, bool valid) {
  float xf[16];
  xf[0] = __uint_as_float(xa.x << 16); xf[1] = __uint_as_float(xa.x & 0xffff0000u);
  xf[2] = __uint_as_float(xa.y << 16); xf[3] = __uint_as_float(xa.y & 0xffff0000u);
  xf[4] = __uint_as_float(xa.z << 16); xf[5] = __uint_as_float(xa.z & 0xffff0000u);
  xf[6] = __uint_as_float(xa.w << 16); xf[7] = __uint_as_float(xa.w & 0xffff0000u);
  xf[8] = __uint_as_float(xb.x << 16); xf[9] = __uint_as_float(xb.x & 0xffff0000u);
  xf[10] = __uint_as_float(xb.y << 16); xf[11] = __uint_as_float(xb.y & 0xffff0000u);
  xf[12] = __uint_as_float(xb.z << 16); xf[13] = __uint_as_float(xb.z & 0xffff0000u);
  xf[14] = __uint_as_float(xb.w << 16); xf[15] = __uint_as_float(xb.w & 0xffff0000u);
  float p[16];
#pragma unroll
  for (int i = 0; i < 16; i++) {
    float a = dot4_fp8(R.r[i].x, xf[0], xf[1], xf[2], xf[3], 0.f);
    a = dot4_fp8(R.r[i].y, xf[4], xf[5], xf[6], xf[7], a);
    a = dot4_fp8(R.r[i].z, xf[8], xf[9], xf[10], xf[11], a);
    a = dot4_fp8(R.r[i].w, xf[12], xf[13], xf[14], xf[15], a);
    p[i] = a;
  }
#pragma unroll
  for (int i = 0; i < 8; i++) { float keep = (c & 4) ? p[i + 8] : p[i]; float send = (c & 4) ? p[i] : p[i + 8]; p[i] = keep + __shfl_xor(send, 4); }
#pragma unroll
  for (int i = 0; i < 4; i++) { float keep = (c & 2) ? p[i + 4] : p[i]; float send = (c & 2) ? p[i] : p[i + 4]; p[i] = keep + __shfl_xor(send, 2); }
#pragma unroll
  for (int i = 0; i < 2; i++) { float keep = (c & 1) ? p[i + 2] : p[i]; float send = (c & 1) ? p[i] : p[i + 2]; p[i] = keep + __shfl_xor(send, 1); }
  const int it0 = 2 * (c & 1) + 4 * ((c >> 1) & 1) + 8 * ((c >> 2) & 1);
  if (valid) {
    pr[it0 * 8] = f2bf(p[0]);
    pr[(it0 + 1) * 8] = f2bf(p[1]);
  }
}
DI void phase6b1(const Params& P) {
  const int lane = threadIdx.x & 63, g = lane >> 3, c = lane & 7;
  const int x = blockIdx.x & 7;
  const int wg = (blockIdx.x >> 3) * 4 + (threadIdx.x >> 6), nwg = (gridDim.x >> 3) * 4;
  char* ws = P.ws;
  const u16* H1B = (const u16*)(ws + W_QKV + SZ_ACT) + x * 128 + c * 16;
  const unsigned char* U8 = (const unsigned char*)(ws + W_UB) + ((size_t)x << 21);
  const u32 lofs = c * 16;
  const u16* IDX = (const u16*)(ws + W_IDX) + g * 16;
  u16* PH = ph_slice(ws, x) + g;
  const int n = (TT - wg + nwg - 1) / nwg;
#define TOK(i) min(wg + (i) * nwg, TT - 1)
  int t0 = TOK(0), t1 = TOK(1);
  u32x4 eA0 = *(const u32x4*)(IDX + (size_t)t0 * 128), eA1 = *(const u32x4*)(IDX + (size_t)t0 * 128 + 8);
  u32x4 eB0 = *(const u32x4*)(IDX + (size_t)t1 * 128), eB1 = *(const u32x4*)(IDX + (size_t)t1 * 128 + 8);
  RowSet RA, RB;
  gather_rows(RA, U8, lofs, eA0, eA1);
  u32x4 xA0 = *(const u32x4*)(H1B + (size_t)t0 * 1024), xA1 = *(const u32x4*)(H1B + (size_t)t0 * 1024 + 8);
#pragma unroll 1
  for (int i = 0; i < n; i += 2) {
    gather_rows(RB, U8, lofs, eB0, eB1);
    const u32x4 xB0 = *(const u32x4*)(H1B + (size_t)t1 * 1024), xB1 = *(const u32x4*)(H1B + (size_t)t1 * 1024 + 8);
    const int t2 = TOK(i + 2);
    eA0 = *(const u32x4*)(IDX + (size_t)t2 * 128);
    eA1 = *(const u32x4*)(IDX + (size_t)t2 * 128 + 8);
    b1_compute(RA, xA0, xA1, PH + (size_t)t0 * 128, c, true);
    gather_rows(RA, U8, lofs, eA0, eA1);
    xA0 = *(const u32x4*)(H1B + (size_t)t2 * 1024);
    xA1 = *(const u32x4*)(H1B + (size_t)t2 * 1024 + 8);
    const int t3 = TOK(i + 3);
    eB0 = *(const u32x4*)(IDX + (size_t)t3 * 128);
    eB1 = *(const u32x4*)(IDX + (size_t)t3 * 128 + 8);
    b1_compute(RB, xB0, xB1, PH + (size_t)t1 * 128, c, i + 1 < n);
    t0 = t2;
    t1 = t3;
  }
}

DI void phase6w(const Params& P) {
  const int lane = threadIdx.x & 63;
  const int gw = blockIdx.x * 4 + (threadIdx.x >> 6), nw = gridDim.x * 4;
  char* ws = P.ws;
  float* G = (float*)(ws + W_G);
  const float* SSQ2 = (const float*)(ws + W_SSQ2);
  for (int t = gw; t < TT; t += nw) {
    float ssq = lane < 8 ? SSQ2[(size_t)t * 16 + lane] : 0.f;
    float h0 = 0.f, h1v = 0.f;
    {
      const u16* ph = (const u16*)(ws + W_XB) + (size_t)t * 128 + lane;
#pragma unroll
      for (int xs = 0; xs < 8; xs++) { h0 += bf2f(ph[(size_t)xs * (SZ_PH / 2)]); h1v += bf2f(ph[(size_t)xs * (SZ_PH / 2) + 64]); }
    }
    const float g0 = G[(size_t)t * 128 + lane];
    const float g1 = G[(size_t)t * 128 + 64 + lane];
    const float rs2 = rsqrtf(wave_sum(ssq) * (1.f / 1024.f) + EPS);
    const float w0 = g0 * gelu_tanh(rs2 * (1.f / U_SCALE) * h0) * (1.f / V_SCALE);
    const float w1 = g1 * gelu_tanh(rs2 * (1.f / U_SCALE) * h1v) * (1.f / V_SCALE);
    u16* wrow = (u16*)(G + (size_t)t * 128);
    wrow[(lane & 7) * 16 + (lane >> 3)] = f2bf(w0);
    wrow[(lane & 7) * 16 + 8 + (lane >> 3)] = f2bf(w1);
  }
}

DI void b2_compute(const RowSet& R, u32x4 w0, u32x4 w1, u16* hb, float* sq, int g, int lane, bool valid) {
  const u32 hraw = *(const u32*)hb;
  const u32 wv[8] = {w0.x, w0.y, w0.z, w0.w, w1.x, w1.y, w1.z, w1.w};
  float o[16];
#pragma unroll
  for (int i = 0; i < 16; i++) o[i] = 0.f;
#pragma unroll
  for (int i = 0; i < 16; i++) {
    u32 r0 = R.r[i].x, r1 = R.r[i].y, r2 = R.r[i].z, r3 = R.r[i].w;
    asm volatile("" : "+v"(r0), "+v"(r1), "+v"(r2), "+v"(r3) : "v"(o[0]), "v"(o[15]));
    const float wgt = (i & 1) ? __uint_as_float(wv[i >> 1] & 0xffff0000u) : __uint_as_float(wv[i >> 1] << 16);
    axpy4_fp8(r0, wgt, o[0], o[1], o[2], o[3]);
    axpy4_fp8(r1, wgt, o[4], o[5], o[6], o[7]);
    axpy4_fp8(r2, wgt, o[8], o[9], o[10], o[11]);
    axpy4_fp8(r3, wgt, o[12], o[13], o[14], o[15]);
  }
#pragma unroll
  for (int i = 0; i < 8; i++) { float keep = (g & 4) ? o[i + 8] : o[i]; float send = (g & 4) ? o[i] : o[i + 8]; o[i] = keep + __shfl_xor(send, 32); }
#pragma unroll
  for (int i = 0; i < 4; i++) { float keep = (g & 2) ? o[i + 4] : o[i]; float send = (g & 2) ? o[i] : o[i + 4]; o[i] = keep + __shfl_xor(send, 16); }
#pragma unroll
  for (int i = 0; i < 2; i++) { float keep = (g & 1) ? o[i + 2] : o[i]; float send = (g & 1) ? o[i] : o[i + 2]; o[i] = keep + __shfl_xor(send, 8); }
  const float a0 = __uint_as_float(hraw << 16) + o[0], a1 = __uint_as_float(hraw & 0xffff0000u) + o[1];
  const float ss = wave_sum(a0 * a0 + a1 * a1);
  if (valid) {
    *(u32*)hb = pack2(a0, a1);
    if (lane == 0) *sq = ss;
  }
}
DI void phase6b2(const Params& P) {
  const int lane = threadIdx.x & 63, g = lane >> 3, c = lane & 7, w = threadIdx.x >> 6;
  const int x = blockIdx.x & 7;
  const int wg = (blockIdx.x >> 3) * 4 + w, nwg = (gridDim.x >> 3) * 4;
  char* ws = P.ws;
  const int col = x * 128 + c * 16 + 2 * (g & 1) + 4 * ((g >> 1) & 1) + 8 * ((g >> 2) & 1);
  u16* H1B = (u16*)(ws + W_QKV + SZ_ACT) + col;
  const unsigned char* V8 = (const unsigned char*)(ws + W_VB) + ((size_t)x << 21);
  const u32 lofs = c * 16;
  const u16* IDX = (const u16*)(ws + W_IDX) + g * 16;
  const u16* WG = (const u16*)(ws + W_G) + g * 16;
  float* SSQ3 = (float*)(ws + W_SSQ3) + x;
  const int n = (TT - wg + nwg - 1) / nwg;
  int t0 = TOK(0), t1 = TOK(1);
  u32x4 eA0 = *(const u32x4*)(IDX + (size_t)t0 * 128), eA1 = *(const u32x4*)(IDX + (size_t)t0 * 128 + 8);
  u32x4 eB0 = *(const u32x4*)(IDX + (size_t)t1 * 128), eB1 = *(const u32x4*)(IDX + (size_t)t1 * 128 + 8);
  RowSet RA, RB;
  gather_rows(RA, V8, lofs, eA0, eA1);
  u32x4 wA0 = *(const u32x4*)(WG + (size_t)t0 * 256), wA1 = *(const u32x4*)(WG + (size_t)t0 * 256 + 8);
#pragma unroll 1
  for (int i = 0; i < n; i += 2) {
    gather_rows(RB, V8, lofs, eB0, eB1);
    const u32x4 wB0 = *(const u32x4*)(WG + (size_t)t1 * 256), wB1 = *(const u32x4*)(WG + (size_t)t1 * 256 + 8);
    const int t2 = TOK(i + 2);
    eA0 = *(const u32x4*)(IDX + (size_t)t2 * 128);
    eA1 = *(const u32x4*)(IDX + (size_t)t2 * 128 + 8);
    b2_compute(RA, wA0, wA1, H1B + (size_t)t0 * 1024, SSQ3 + (size_t)t0 * 8, g, lane, true);
    gather_rows(RA, V8, lofs, eA0, eA1);
    wA0 = *(const u32x4*)(WG + (size_t)t2 * 256);
    wA1 = *(const u32x4*)(WG + (size_t)t2 * 256 + 8);
    const int t3 = TOK(i + 3);
    eB0 = *(const u32x4*)(IDX + (size_t)t3 * 128);
    eB1 = *(const u32x4*)(IDX + (size_t)t3 * 128 + 8);
    b2_compute(RB, wB0, wB1, H1B + (size_t)t1 * 1024, SSQ3 + (size_t)t1 * 8, g, lane, i + 1 < n);
    t0 = t2;
    t1 = t3;
  }
#undef TOK
}

DI void phase7_tile(const Params& P, int mt, int nt, char* smem) {
  const int tid = threadIdx.x, lane = tid & 63, w = tid >> 6, wm = w >> 1, wn = w & 1, r = lane & 15, quad = lane >> 4;
  const int m0 = mt * 128, n0 = nt * 128;
  char* ws = P.ws;
  const u16* H2B = (const u16*)(ws + W_QKV + SZ_ACT);
  const u16* PB = (const u16*)(ws + W_PB);
  const float* SSQ3 = (const float*)(ws + W_SSQ3);
  float* rs_s = (float*)(smem + RS_OFF);
  __syncthreads();
  if (tid < 128) {
    float q = 0.f;
#pragma unroll
    for (int i = 0; i < 8; i++) q += SSQ3[(size_t)(m0 + tid) * 8 + i];
    rs_s[tid] = rsqrtf(q * (1.f / 1024.f) + EPS);
  }
  u16* PJ = (u16*)(ws + W_QKV);
  f32x4 acc[4][4];
  zero_acc(acc);
  gemm_mainloop(PB + (size_t)m0 * 256, 256, (const u16*)(ws + W_WPP) + (size_t)n0 * 256, 256, 256, (u16*)smem, acc);
  float* Cs = (float*)smem;
  const int c4 = tid & 31, rsub = tid >> 5;
  const size_t tofs = (size_t)m0 * 1024 + n0 + c4 * 4;
  stage_acc(acc, Cs);
#pragma unroll 4
  for (int p = 0; p < 16; p++) {
    const int row = p * 8 + rsub;
    *(u32x2*)(PJ + tofs + (size_t)row * 1024) = pack4(*(const f32x4*)(Cs + row * CSTR + c4 * 4));
  }
  zero_acc(acc);
  gemm_mainloop(H2B + (size_t)m0 * 1024, 1024, (const u16*)(ws + W_WG) + (size_t)n0 * 1024, 1024, 1024, (u16*)smem, acc);
  stage_acc(acc, Cs);
#pragma unroll 4
  for (int p = 0; p < 16; p++) {
    const int row = p * 8 + rsub;
    const f32x4 v = *(const f32x4*)(Cs + row * CSTR + c4 * 4) * rs_s[row];
    const f32x4 pj = unpack4(*(const u32x2*)(PJ + tofs + (size_t)row * 1024));
    const f32x4 h2 = unpack4(*(const u32x2*)(H2B + tofs + (size_t)row * 1024));
    const f32x4 gate = (f32x4){sigmoidf_(v.x), sigmoidf_(v.y), sigmoidf_(v.z), sigmoidf_(v.w)};
    *(f32x4*)(P.out + tofs + (size_t)row * 1024) = h2 + gate * pj;
  }
}

#define GEMM_TILES(NT, FN)                                                              \
  {                                                                                     \
    for (int t = blockIdx.x; t < 2 * (NT); t += gridDim.x) FN(P, 512 + t / (NT), t % (NT), smem); \
    const int x_ = blockIdx.x & 7, bpx_ = gridDim.x >> 3;                               \
    constexpr int NG_ = (NT) / 8;                                                       \
    for (int s_ = blockIdx.x >> 3; s_ < 64 * 8 * NG_; s_ += bpx_) {                     \
      const int R_ = s_ >> 6, q_ = s_ & 63;                                             \
      const int mg_ = R_ / NG_, ng_ = R_ % NG_;                                         \
      FN(P, ((mg_ * 8 + (q_ >> 3)) << 3) + x_, ng_ * 8 + (q_ & 7), smem);               \
    }                                                                                   \
  }

DI unsigned xcc_id() { return (unsigned)__builtin_amdgcn_s_getreg((3 << 11) | 20) & 0xFu; }
DI void grid_barrier(unsigned* bar, int k, const unsigned* st) {
  asm volatile("s_waitcnt vmcnt(0)" ::: "memory");
  __syncthreads();
  if (threadIdx.x == 0) {
    const unsigned nloc = st[0], nx = st[1], x = st[2];
    unsigned* slot = bar + k * BAR_SLOT;
    const unsigned old = __hip_atomic_fetch_add(slot + x * 64, 1u, __ATOMIC_RELAXED, __HIP_MEMORY_SCOPE_AGENT);
    if (old + 1u == nloc) {
      __builtin_amdgcn_fence(__ATOMIC_RELEASE, "agent");
      asm volatile("s_waitcnt vmcnt(0)" ::: "memory");
      __hip_atomic_fetch_add(slot + 16 * 64, 1u, __ATOMIC_RELAXED, __HIP_MEMORY_SCOPE_AGENT);
    }
    unsigned spins = 0;
    while (__hip_atomic_load(slot + 16 * 64, __ATOMIC_RELAXED, __HIP_MEMORY_SCOPE_AGENT) < nx) {
      __builtin_amdgcn_s_sleep(1);
      if (++spins > (1u << 24)) break;
    }
    __builtin_amdgcn_fence(__ATOMIC_ACQUIRE, "agent");
    asm volatile("s_waitcnt vmcnt(0)" ::: "memory");
  }
  __syncthreads();
}

__global__ void __launch_bounds__(256, 2) fwd_megakernel(Params P) {
  __shared__ __attribute__((aligned(16))) char smem[SMEM_BYTES];
  cg::grid_group grid = cg::this_grid();
  unsigned* bar = (unsigned*)(P.ws + W_BAR);
  __shared__ unsigned bst[4];
  unsigned* census = bar + 16 * BAR_SLOT;
  if (threadIdx.x == 0) {
    bst[2] = xcc_id();
    __hip_atomic_fetch_add(census + bst[2] * 64, 1u, __ATOMIC_RELAXED, __HIP_MEMORY_SCOPE_AGENT);
  }
  phase0(P, smem);
  if (P.out == nullptr) grid.sync();
  if (threadIdx.x == 0) {
    unsigned spins = 0;
    for (;;) {
      unsigned sum = 0, nx = 0, mine = 0;
      for (unsigned j = 0; j < 16; j++) {
        const unsigned c = __hip_atomic_load(census + j * 64, __ATOMIC_RELAXED, __HIP_MEMORY_SCOPE_AGENT);
        sum += c; nx += c ? 1u : 0u; mine = (j == bst[2]) ? c : mine;
      }
      bst[0] = mine; bst[1] = nx;
      if (sum == gridDim.x || ++spins > (1u << 22)) break;
      __builtin_amdgcn_s_sleep(1);
    }
  }
  __syncthreads();
  grid_barrier(bar, 15, bst);
  phase1_scans(P);
  GEMM_TILES(40, phase1_tile)
  grid_barrier(bar, 0, bst);
  phase2(P, smem);
  grid_barrier(bar, 1, bst);
  GEMM_TILES(8, phase3_tile)
  grid_barrier(bar, 2, bst);
  GEMM_TILES(8, phase4_tile)
  grid_barrier(bar, 3, bst);
  GEMM_TILES(8, phase5_tile)
  grid_barrier(bar, 4, bst);
  for (int t = blockIdx.x; t < TT / 64; t += gridDim.x) phase6a_unit(P, t, smem);
  grid_barrier(bar, 5, bst);
  phase6b1(P);
  grid_barrier(bar, 6, bst);
  phase6w(P);
  grid_barrier(bar, 7, bst);
  phase6b2(P);
  grid_barrier(bar, 8, bst);
  GEMM_TILES(8, phase7_tile)
}

extern "C" void kernel_launch(void* const* d_in, const int* in_sizes, int n_in, void* d_out, int out_size, void* d_ws,
                              size_t ws_size, hipStream_t stream) {
  static int grid_blocks = 0;
  if (!grid_blocks) {
    int dev = 0, cus = 0, per_cu = 0;
    hipGetDevice(&dev);
    hipDeviceGetAttribute(&cus, hipDeviceAttributeMultiprocessorCount, dev);
    hipOccupancyMaxActiveBlocksPerMultiprocessor(&per_cu, fwd_megakernel, 256, 0);
    if (per_cu > 2) per_cu = 2;
    if (per_cu < 1) per_cu = 1;
    grid_blocks = cus * per_cu;
  }
  if (ws_size < W_END) { fprintf(stderr, "workspace too small: %zu < %zu\n", ws_size, (size_t)W_END); return; }
  Params p{};
  const float** pf = (const float**)&p;
  for (int i = 0; i < 28; i++) pf[i] = (const float*)d_in[i];
  p.out = (float*)d_out;
  p.ws = (char*)d_ws;
  hipMemsetAsync((char*)d_ws + W_BAR, 0, BAR_BYTES, stream);
  void* args[] = {&p};
  hipError_t e = hipLaunchCooperativeKernel((void*)fwd_megakernel, dim3(grid_blocks), dim3(256), args, 0, stream);
  if (e != hipSuccess) fprintf(stderr, "cooperative launch failed: %s (grid %d)\n", hipGetErrorString(e), grid_blocks);
}
```

```cpp
#include <hip/hip_runtime.h>
#include <hip/hip_cooperative_groups.h>
#include <cstdio>
namespace cg = cooperative_groups;

typedef unsigned short u16;
typedef unsigned int u32;
typedef short bf16x8 __attribute__((ext_vector_type(8)));
typedef short s16x4 __attribute__((ext_vector_type(4)));
typedef float f32x4 __attribute__((ext_vector_type(4)));
typedef unsigned int u32x4 __attribute__((ext_vector_type(4)));
typedef unsigned int u32x2 __attribute__((ext_vector_type(2)));
typedef __bf16 bf16x2_t __attribute__((ext_vector_type(2)));

#define DI __device__ __forceinline__
#define LAUNDER(x) asm volatile("" : "+v"(x))

constexpr int TP = 65536, TS = 256, TT = TP + TS;
constexpr float LOG2E = 1.4426950408889634f;
constexpr float EPS = 1e-6f;
constexpr float U_SCALE = 1024.f, V_SCALE = 128.f;

constexpr size_t O_AK_P = 67371008, O_AV_P = 100925440, O_AF_P = 134479872, O_BK_P = 135004160,
                 O_BV_P = 143392768, O_AK_S = 151781376, O_AV_S = 151912448, O_AF_S = 152043520,
                 O_BK_S = 152045568, O_BV_S = 152176640;

constexpr size_t SZ_ACT = (size_t)TT * 1024 * 2;
constexpr size_t SZ_HALF = (size_t)TT * 512 * 2;
constexpr size_t W_XB = 0;
constexpr size_t W_QKV = SZ_ACT;
constexpr size_t W_GA = W_QKV + 6 * SZ_HALF;
constexpr size_t W_GB = W_GA + SZ_ACT;
constexpr size_t W_PB = W_GB + SZ_ACT;
constexpr size_t W_WIN = W_PB + (size_t)TT * 256 * 2;
constexpr size_t W_WUPA = W_WIN + (size_t)5120 * 1024 * 2;
constexpr size_t W_WUPB = W_WUPA + 1024 * 512 * 2;
constexpr size_t W_WOUT = W_WUPB + 1024 * 512 * 2;
constexpr size_t W_WQ = W_WOUT + 1024 * 1024 * 2;
constexpr size_t W_WG = W_WQ + 1024 * 1024 * 2;
constexpr size_t W_WPP = W_WG + 1024 * 1024 * 2;
constexpr size_t W_UB = W_WPP + 1024 * 256 * 2;
constexpr size_t W_VB = W_UB + (size_t)16384 * 1024 * 2;
constexpr size_t W_SK = W_VB + (size_t)16384 * 1024 * 2;
constexpr size_t W_RS1 = W_SK + 131072 * 2;
constexpr size_t W_SSQ2 = W_RS1 + (size_t)TT * 4;
constexpr size_t W_RS3 = W_SSQ2 + (size_t)TT * 64;
constexpr size_t W_CUMP = W_RS3 + (size_t)TT * 4;
constexpr size_t W_CUMS = W_CUMP + (size_t)256 * 2048 * 4;
constexpr size_t W_SSQ3 = W_CUMS + (size_t)128 * 4112 * 4 + 1024;
constexpr size_t W_BAR = W_SSQ3 + (size_t)TT * 8 * 4;
constexpr int BAR_SLOT = 17 * 64;
constexpr size_t BAR_BYTES = (size_t)(16 * BAR_SLOT + 16 * 64) * 4;
constexpr size_t W_END = W_BAR + BAR_BYTES;
constexpr size_t W_IDX = W_GA;
constexpr size_t W_G = W_GA + (size_t)32 * 1024 * 1024;
constexpr size_t SZ_PH = (size_t)TT * 128 * 2;


struct Params {
  const float *x_p, *x_s, *cak, *cav, *caf, *cbk, *cbv, *p_p, *p_s, *g_mix, *w_in, *b_f, *qn_a, *kn_a,
      *qn_b, *kn_b, *relb, *w_up_a, *w_up_b, *w_out, *g_ffn, *peer_wq, *peer_sk, *peer_u, *peer_v, *g_ple,
      *w_gate, *w_proj;
  float* out;
  char* ws;
};

constexpr int SMEM_BYTES = 128 * 129 * 4 + 2 * 64 * 17 * 4 + 256;

DI u16* ph_slice(char* ws, int x) { return (u16*)(ws + W_XB + (size_t)x * SZ_PH); }
DI u16 f2bf(float x) { return __builtin_bit_cast(u16, (__bf16)x); }
DI float bf2f(u16 h) { return __uint_as_float(((u32)h) << 16); }
DI u32 pack2(float a, float b) { bf16x2_t v = {(__bf16)a, (__bf16)b}; return __builtin_bit_cast(u32, v); }
DI float wave_sum(float v) {
#pragma unroll
  for (int o = 32; o; o >>= 1) v += __shfl_xor(v, o);
  return v;
}
DI f32x4 mfma16(bf16x8 a, bf16x8 b, f32x4 c) { return __builtin_amdgcn_mfma_f32_16x16x32_bf16(a, b, c, 0, 0, 0); }
DI float sigmoidf_(float x) { return 1.f / (1.f + __expf(-x)); }
DI u32 mono(float x) { u32 u = __float_as_uint(x); u32 m = (u32)((int)u >> 31) | 0x80000000u; return u ^ m; }
DI float unmono(u32 k) { u32 m = ((k >> 31) - 1u) | 0x80000000u; return __uint_as_float(k ^ m); }
DI void insert16(u32 (&L)[16], u32 x) {
#pragma unroll
  for (int s = 0; s < 16; s++) { u32 mx = max(L[s], x); x = min(L[s], x); L[s] = mx; }
}
DI float gelu_tanh(float x) {
  float u = 0.7978845608028654f * (x + 0.044715f * x * x * x);
  float t = 1.f - 2.f / (1.f + __expf(2.f * u));
  return 0.5f * x * (1.f + t);
}

constexpr int GSTR = 72;
constexpr int GBUF = 2 * 128 * GSTR;
constexpr int RS_OFF = 2 * GBUF * 2;
DI void gemm_compute(const u16* As, const u16* Bs, f32x4 (&acc)[4][4], int wm, int wn, int r, int quad) {
#pragma unroll
  for (int ks = 0; ks < 2; ks++) {
    bf16x8 af[4], bfr[4];
#pragma unroll
    for (int mi = 0; mi < 4; mi++) af[mi] = *(const bf16x8*)(As + (wm * 64 + mi * 16 + r) * GSTR + ks * 32 + quad * 8);
#pragma unroll
    for (int ni = 0; ni < 4; ni++) bfr[ni] = *(const bf16x8*)(Bs + (wn * 64 + ni * 16 + r) * GSTR + ks * 32 + quad * 8);
#pragma unroll
    for (int mi = 0; mi < 4; mi++)
#pragma unroll
      for (int ni = 0; ni < 4; ni++) acc[mi][ni] = mfma16(af[mi], bfr[ni], acc[mi][ni]);
    if (ks == 0) __builtin_amdgcn_sched_barrier(0);
  }
}
DI void gemm_mainloop(const u16* __restrict__ A, int lda, const u16* __restrict__ B, int ldb, int K, u16* smem,
                      f32x4 (&acc)[4][4]) {
  const int tid = threadIdx.x, lane = tid & 63, w = tid >> 6, wm = w >> 1, wn = w & 1, r = lane & 15, quad = lane >> 4;
  u16* As0 = smem;
  u16* Bs0 = smem + 128 * GSTR;
  u16* As1 = smem + GBUF;
  u16* Bs1 = As1 + 128 * GSTR;
  u32x4 r0a[4], r0b[4], r1a[4], r1b[4];
  const int lrow = tid >> 3, lch = tid & 7;
  const u16* ap = A + (size_t)lrow * lda + lch * 8;
  const u16* bp = B + (size_t)lrow * ldb + lch * 8;
  const int lo = lrow * GSTR + lch * 8;
  const int nk = K >> 6, km = nk - 1;
  const int krot = 0;
#define KOFF(kt) ((((kt) + krot) & km) * 64)
#pragma unroll
  for (int i = 0; i < 4; i++) {
    r0a[i] = *(const u32x4*)(ap + (size_t)i * 32 * lda + KOFF(0));
    r0b[i] = *(const u32x4*)(bp + (size_t)i * 32 * ldb + KOFF(0));
  }
#pragma unroll
  for (int i = 0; i < 4; i++) {
    r1a[i] = *(const u32x4*)(ap + (size_t)i * 32 * lda + KOFF(1));
    r1b[i] = *(const u32x4*)(bp + (size_t)i * 32 * ldb + KOFF(1));
  }
  __syncthreads();
#pragma unroll 1
  for (int kt = 0; kt < nk - 2; kt += 2) {
#pragma unroll
    for (int i = 0; i < 4; i++) {
      *(u32x4*)(As0 + lo + i * 32 * GSTR) = r0a[i];
      *(u32x4*)(Bs0 + lo + i * 32 * GSTR) = r0b[i];
    }
    __syncthreads();
    {
      const int ko = KOFF(kt + 2);
#pragma unroll
      for (int i = 0; i < 4; i++) {
        r0a[i] = *(const u32x4*)(ap + (size_t)i * 32 * lda + ko);
        r0b[i] = *(const u32x4*)(bp + (size_t)i * 32 * ldb + ko);
      }
    }
    gemm_compute(As0, Bs0, acc, wm, wn, r, quad);
#pragma unroll
    for (int i = 0; i < 4; i++) {
      *(u32x4*)(As1 + lo + i * 32 * GSTR) = r1a[i];
      *(u32x4*)(Bs1 + lo + i * 32 * GSTR) = r1b[i];
    }
    __syncthreads();
    {
      const int ko = KOFF(kt + 3);
#pragma unroll
      for (int i = 0; i < 4; i++) {
        r1a[i] = *(const u32x4*)(ap + (size_t)i * 32 * lda + ko);
        r1b[i] = *(const u32x4*)(bp + (size_t)i * 32 * ldb + ko);
      }
    }
    gemm_compute(As1, Bs1, acc, wm, wn, r, quad);
  }
#pragma unroll
  for (int i = 0; i < 4; i++) {
    *(u32x4*)(As0 + lo + i * 32 * GSTR) = r0a[i];
    *(u32x4*)(Bs0 + lo + i * 32 * GSTR) = r0b[i];
  }
  __syncthreads();
  gemm_compute(As0, Bs0, acc, wm, wn, r, quad);
#pragma unroll
  for (int i = 0; i < 4; i++) {
    *(u32x4*)(As1 + lo + i * 32 * GSTR) = r1a[i];
    *(u32x4*)(Bs1 + lo + i * 32 * GSTR) = r1b[i];
  }
  __syncthreads();
  gemm_compute(As1, Bs1, acc, wm, wn, r, quad);
#undef KOFF
}

DI void zero_acc(f32x4 (&acc)[4][4]) {
#pragma unroll
  for (int i = 0; i < 4; i++)
#pragma unroll
    for (int j = 0; j < 4; j++) acc[i][j] = (f32x4){0.f, 0.f, 0.f, 0.f};
}

constexpr int CSTR = 132;
DI void stage_acc(const f32x4 (&acc)[4][4], float* Cs) {
  const int tid = threadIdx.x, lane = tid & 63, w = tid >> 6, wm = w >> 1, wn = w & 1, r = lane & 15, quad = lane >> 4;
  __syncthreads();
#pragma unroll
  for (int mi = 0; mi < 4; mi++)
#pragma unroll
    for (int ni = 0; ni < 4; ni++)
#pragma unroll
      for (int j = 0; j < 4; j++) Cs[(wm * 64 + mi * 16 + quad * 4 + j) * CSTR + wn * 64 + ni * 16 + r] = acc[mi][ni][j];
  __syncthreads();
}
DI u32x2 pack4(f32x4 v) { return (u32x2){pack2(v.x, v.y), pack2(v.z, v.w)}; }
DI f32x4 unpack4(u32x2 p) {
  return (f32x4){__uint_as_float(p.x << 16), __uint_as_float(p.x & 0xffff0000u), __uint_as_float(p.y << 16), __uint_as_float(p.y & 0xffff0000u)};
}

DI void transpose_tile(const float* __restrict__ W, int ldw, int K, const float* __restrict__ g, u16* __restrict__ dst,
                       int k0, int n0, int nsrc0, float* tile) {
  const int tid = threadIdx.x;
  __syncthreads();
  {
    const int ty = tid >> 4, tx = tid & 15;
#pragma unroll
    for (int i = 0; i < 4; i++) {
      int k = ty + i * 16;
      f32x4 v = *(const f32x4*)(W + (size_t)(k0 + k) * ldw + nsrc0 + tx * 4);
      float s = g ? g[k0 + k] : 1.f;
      tile[k * 65 + tx * 4 + 0] = v[0] * s;
      tile[k * 65 + tx * 4 + 1] = v[1] * s;
      tile[k * 65 + tx * 4 + 2] = v[2] * s;
      tile[k * 65 + tx * 4 + 3] = v[3] * s;
    }
  }
  __syncthreads();
  {
    const int n = tid >> 2, kc = (tid & 3) * 16;
    u32 pk[8];
#pragma unroll
    for (int i = 0; i < 8; i++) pk[i] = pack2(tile[(kc + 2 * i) * 65 + n], tile[(kc + 2 * i + 1) * 65 + n]);
    u16* d = dst + (size_t)(n0 + n) * K + k0 + kc;
    *(u32x4*)d = (u32x4){pk[0], pk[1], pk[2], pk[3]};
    *(u32x4*)(d + 8) = (u32x4){pk[4], pk[5], pk[6], pk[7]};
  }
}

DI void conv_unit(const float* __restrict__ src, u16* __restrict__ dst, size_t base, const float* __restrict__ colscale) {
  const int tid = threadIdx.x;
#pragma unroll
  for (int i = 0; i < 4; i++) {
    size_t e = base + (size_t)i * 1024 + tid * 4;
    f32x4 v = *(const f32x4*)(src + e);
    if (colscale) {
      f32x4 gg = *(const f32x4*)(colscale + (e & 1023));
      v = v * gg;
    }
    *(u32x2*)(dst + e) = (u32x2){pack2(v[0], v[1]), pack2(v[2], v[3])};
  }
}

DI void conv_unit_fp8(const float* __restrict__ src, unsigned char* __restrict__ dst, size_t base,
                      const float* __restrict__ colscale, float scale) {
  const int tid = threadIdx.x;
#pragma unroll
  for (int i = 0; i < 4; i++) {
    size_t e = base + (size_t)i * 1024 + tid * 4;
    f32x4 v = *(const f32x4*)(src + e);
    if (colscale) {
      f32x4 gg = *(const f32x4*)(colscale + (e & 1023));
      v = v * gg;
    }
    int w = __builtin_amdgcn_cvt_pk_fp8_f32(v[0] * scale, v[1] * scale, 0, false);
    w = __builtin_amdgcn_cvt_pk_fp8_f32(v[2] * scale, v[3] * scale, w, true);
    *(int*)(dst + (((e & 1023) >> 7) << 21) + ((e >> 10) << 7) + (e & 127)) = w;
  }
}

DI void phase0(const Params& P, char* smem) {
  const int tid = threadIdx.x, lane = tid & 63, w = tid >> 6;
  char* ws = P.ws;
  {
    float* tile = (float*)smem;
    constexpr int T_WIN = 16 * 80, T_UP = 8 * 16, T_SQ = 256, T_PP = 4 * 16;
    constexpr int NT = T_WIN + 2 * T_UP + 3 * T_SQ + T_PP;
    for (int t = blockIdx.x; t < NT; t += gridDim.x) {
      int u = t;
      if (u < T_WIN) {
        int kt = u / 80, nt = u % 80;
        int n0 = nt * 64;
        int ns = n0 < 1536 ? n0 : n0 + 8;
        transpose_tile(P.w_in, 5128, 1024, P.g_mix, (u16*)(ws + W_WIN), kt * 64, n0, ns, tile);
        continue;
      }
      u -= T_WIN;
      if (u < T_UP) { transpose_tile(P.w_up_a, 1024, 512, nullptr, (u16*)(ws + W_WUPA), (u / 16) * 64, (u % 16) * 64, (u % 16) * 64, tile); continue; }
      u -= T_UP;
      if (u < T_UP) { transpose_tile(P.w_up_b, 1024, 512, nullptr, (u16*)(ws + W_WUPB), (u / 16) * 64, (u % 16) * 64, (u % 16) * 64, tile); continue; }
      u -= T_UP;
      if (u < T_SQ) { transpose_tile(P.w_out, 1024, 1024, nullptr, (u16*)(ws + W_WOUT), (u / 16) * 64, (u % 16) * 64, (u % 16) * 64, tile); continue; }
      u -= T_SQ;
      if (u < T_SQ) { transpose_tile(P.peer_wq, 1024, 1024, P.g_ffn, (u16*)(ws + W_WQ), (u / 16) * 64, (u % 16) * 64, (u % 16) * 64, tile); continue; }
      u -= T_SQ;
      if (u < T_SQ) { transpose_tile(P.w_gate, 1024, 1024, P.g_ple, (u16*)(ws + W_WG), (u / 16) * 64, (u % 16) * 64, (u % 16) * 64, tile); continue; }
      u -= T_SQ;
      transpose_tile(P.w_proj, 1024, 256, nullptr, (u16*)(ws + W_WPP), (u / 16) * 64, (u % 16) * 64, (u % 16) * 64, tile);
    }
  }
  {
    constexpr int U_UB = 4096, U_VB = 4096, U_SK = 32, U_PP = 4096, U_PS = 16;
    constexpr int NU = U_UB + U_VB + U_SK + U_PP + U_PS;
    for (int t = blockIdx.x; t < NU; t += gridDim.x) {
      int u = t;
      if (u < U_UB) { conv_unit_fp8(P.peer_u, (unsigned char*)(ws + W_UB), (size_t)u * 4096, P.g_ffn, U_SCALE); continue; }
      u -= U_UB;
      if (u < U_VB) { conv_unit_fp8(P.peer_v, (unsigned char*)(ws + W_VB), (size_t)u * 4096, nullptr, V_SCALE); continue; }
      u -= U_VB;
      if (u < U_SK) { conv_unit(P.peer_sk, (u16*)(ws + W_SK), (size_t)u * 4096, nullptr); continue; }
      u -= U_SK;
      if (u < U_PP) { conv_unit(P.p_p, (u16*)(ws + W_PB), (size_t)u * 4096, nullptr); continue; }
      u -= U_PP;
      conv_unit(P.p_s, (u16*)(ws + W_PB) + (size_t)TP * 256, (size_t)u * 4096, nullptr);
    }
  }
  {
    float* wfl = (float*)smem;
    __syncthreads();
    for (int i = tid; i < 8192; i += 256) {
      int k = i >> 3, h = i & 7;
      wfl[h * 1024 + k] = P.g_mix[k] * P.w_in[(size_t)k * 5128 + 1536 + h];
    }
    __syncthreads();
    u16* XB = (u16*)(ws + W_XB);
    float* RS1 = (float*)(ws + W_RS1);
    for (int t = blockIdx.x * 4 + w; t < TT; t += gridDim.x * 4) {
      const float* xr = t < TP ? P.x_p + (size_t)t * 1024 : P.x_s + (size_t)(t - TP) * 1024;
      f32x4 v[4];
#pragma unroll
      for (int i = 0; i < 4; i++) v[i] = *(const f32x4*)(xr + i * 256 + lane * 4);
      float ss = 0.f;
#pragma unroll
      for (int i = 0; i < 4; i++) ss += v[i][0] * v[i][0] + v[i][1] * v[i][1] + v[i][2] * v[i][2] + v[i][3] * v[i][3];
      float dots[8];
#pragma unroll
      for (int h = 0; h < 8; h++) {
        float d = 0.f;
#pragma unroll
        for (int i = 0; i < 4; i++) {
          f32x4 wv = *(const f32x4*)(wfl + h * 1024 + i * 256 + lane * 4);
          d += v[i][0] * wv[0] + v[i][1] * wv[1] + v[i][2] * wv[2] + v[i][3] * wv[3];
        }
        dots[h] = d;
      }
      ss = wave_sum(ss);
#pragma unroll
      for (int h = 0; h < 8; h++) dots[h] = wave_sum(dots[h]);
      float rs = rsqrtf(ss * (1.f / 1024.f) + EPS);
#pragma unroll
      for (int i = 0; i < 4; i++)
        *(u32x2*)(XB + (size_t)t * 1024 + i * 256 + lane * 4) = (u32x2){pack2(v[i][0], v[i][1]), pack2(v[i][2], v[i][3])};
      if (lane == 0) RS1[t] = rs;
      float myd = dots[0];
#pragma unroll
      for (int h = 1; h < 8; h++) myd = (lane == h) ? dots[h] : myd;
      if (lane < 8) {
        float z = rs * myd + P.b_f[lane];
        float lf = fminf(z, 0.f) - log1pf(expf(-fabsf(z)));
        float* o = t < TP ? P.out + O_AF_P + (size_t)t * 8 : P.out + O_AF_S + (size_t)(t - TP) * 8;
        o[lane] = lf;
      }
    }
  }
}

DI void phase1_scans(const Params& P) {
  const int lane = threadIdx.x & 63;
  const int gw = blockIdx.x * 4 + (threadIdx.x >> 6), nw = gridDim.x * 4;
  float* CUMP = (float*)(P.ws + W_CUMP);
  float* CUMS = (float*)(P.ws + W_CUMS);
  for (int row = gw; row < 384; row += nw) {
    float carry = 0.f;
    if (row < 256) {
      int b = row >> 3, h = row & 7;
      const float* src = P.out + O_AF_P + (size_t)b * 2048 * 8 + h;
      for (int p0 = 0; p0 < 2048; p0 += 64) {
        float v = src[(size_t)(p0 + lane) * 8];
#pragma unroll
        for (int o = 1; o < 64; o <<= 1) { float n = __shfl_up(v, o); if (lane >= o) v += n; }
        v += carry;
        CUMP[(size_t)row * 2048 + p0 + lane] = v * LOG2E;
        carry = __shfl(v, 63);
      }
    } else {
      int rr = row - 256;
      int b = rr >> 3, h = rr & 7;
      const float* src = P.caf + (size_t)b * 4096 * 8 + h;
      for (int p0 = 0; p0 < 4096; p0 += 64) {
        float v = src[(size_t)(p0 + lane) * 8];
#pragma unroll
        for (int o = 1; o < 64; o <<= 1) { float n = __shfl_up(v, o); if (lane >= o) v += n; }
        v += carry;
        CUMS[(size_t)rr * 4112 + p0 + lane] = v * LOG2E;
        carry = __shfl(v, 63);
      }
      {
        float v = lane < 16 ? P.out[O_AF_S + (size_t)(b * 16 + lane) * 8 + h] : 0.f;
#pragma unroll
        for (int o = 1; o < 64; o <<= 1) { float n = __shfl_up(v, o); if (lane >= o) v += n; }
        v += carry;
        if (lane < 16) CUMS[(size_t)rr * 4112 + 4096 + lane] = v * LOG2E;
      }
    }
  }
}

DI void phase1_tile(const Params& P, int mt, int nt, char* smem) {
  const int tid = threadIdx.x, lane = tid & 63, w = tid >> 6, wm = w >> 1, wn = w & 1, r = lane & 15, quad = lane >> 4;
  const int m0 = mt * 128, n0 = nt * 128;
  char* ws = P.ws;
  f32x4 acc[4][4];
  zero_acc(acc);
  gemm_mainloop((const u16*)(ws + W_XB) + (size_t)m0 * 1024, 1024, (const u16*)(ws + W_WIN) + (size_t)n0 * 1024, 1024, 1024,
                (u16*)smem, acc);
  float* Cs = (float*)smem;
  stage_acc(acc, Cs);
  const bool sample = m0 >= TP;
  const int c4 = tid & 31, rsub = tid >> 5;
  const float* RS1 = (const float*)(ws + W_RS1) + m0;
  if (n0 < 3072) {
    const int seg = n0 >> 9, hc = n0 & 511;
    const bool normed = (seg != 2 && seg != 5);
    const float* gain = seg == 0 ? P.qn_a : seg == 1 ? P.kn_a : seg == 3 ? P.qn_b : P.kn_b;
    const float qs = (seg == 0 || seg == 3) ? 0.125f * LOG2E : 1.f;
    f32x4 gn = (f32x4){1.f, 1.f, 1.f, 1.f};
    if (normed) gn = *(const f32x4*)(gain + (c4 & 15) * 4) * qs;
    u16* dp = (u16*)(ws + W_QKV + (size_t)seg * SZ_HALF) + (size_t)m0 * 512 + hc + c4 * 4;
    float* op = nullptr;
    if (seg == 1 || seg == 2) {
      op = sample ? P.out + (seg == 1 ? O_AK_S : O_AV_S) + (size_t)(m0 - TP) * 512 : P.out + (seg == 1 ? O_AK_P : O_AV_P) + (size_t)m0 * 512;
    } else if (seg == 4 || seg == 5) {
      if (sample) op = P.out + (seg == 4 ? O_BK_S : O_BV_S) + (size_t)(m0 - TP) * 512;
      else if ((m0 & 2047) >= 1536) op = P.out + (seg == 4 ? O_BK_P : O_BV_P) + ((size_t)(m0 >> 11) * 512 + ((m0 & 2047) - 1536)) * 512;
    }
    if (op) op += hc + c4 * 4;
#pragma unroll 4
    for (int p = 0; p < 16; p++) {
      const int row = p * 8 + rsub;
      f32x4 v = *(const f32x4*)(Cs + row * CSTR + c4 * 4) * RS1[row];
      if (normed) {
        float ss = v.x * v.x + v.y * v.y + v.z * v.z + v.w * v.w;
        ss += __shfl_xor(ss, 1);
        ss += __shfl_xor(ss, 2);
        ss += __shfl_xor(ss, 4);
        ss += __shfl_xor(ss, 8);
        v = v * gn * rsqrtf(ss * (1.f / 64.f) + EPS);
      }
      *(u32x2*)(dp + (size_t)row * 512) = pack4(v);
      if (op) __builtin_nontemporal_store(v, (f32x4*)(op + (size_t)row * 512));
    }
  } else {
    u16* dp = (n0 < 4096 ? (u16*)(ws + W_GA) + (n0 - 3072) : (u16*)(ws + W_GB) + (n0 - 4096)) + (size_t)m0 * 1024 + c4 * 4;
#pragma unroll 4
    for (int p = 0; p < 16; p++) {
      const int row = p * 8 + rsub;
      f32x4 v = *(const f32x4*)(Cs + row * CSTR + c4 * 4) * RS1[row];
      v = (f32x4){sigmoidf_(v.x), sigmoidf_(v.y), sigmoidf_(v.z), sigmoidf_(v.w)};
      *(u32x2*)(dp + (size_t)row * 1024) = pack4(v);
    }
  }
}

constexpr int ASTR = 72;
constexpr int ASTAGE = 2 * 64 * ASTR * 2 + 256;
constexpr int TAB_OFF = 2 * ASTAGE;
struct AttnState { f32x4 o[4]; float m, l; };

DI s16x4 tr_read(const u16* p) {
  return __builtin_amdgcn_ds_read_tr16_b64_v4i16((__attribute__((address_space(3))) s16x4*)(p));
}

template <int MODE>
DI void attn_step(const u16* Ks, const u16* Vs, const bf16x8 (&qf)[2], AttnState& st, int kpos0, int qpos, int qlim,
                  float cq, const float* cum, const float* tab, bool domask) {
  const int lane = threadIdx.x & 63, r = lane & 15, quad = lane >> 4;
  const bool farband = (MODE == 1) && (kpos0 + 31 - (qpos - r) <= -128);
  f32x4 s[2];
#pragma unroll
  for (int t = 0; t < 2; t++) {
    f32x4 a4 = (f32x4){0.f, 0.f, 0.f, 0.f};
#pragma unroll
    for (int ks = 0; ks < 2; ks++) {
      bf16x8 kf = *(const bf16x8*)(Ks + (t * 16 + r) * ASTR + ks * 32 + quad * 8);
      a4 = mfma16(kf, qf[ks], a4);
    }
    s[t] = a4;
  }
#pragma unroll
  for (int t = 0; t < 2; t++) {
    const int kb = kpos0 + t * 16 + quad * 4;
    if (MODE == 0) {
      f32x4 c4 = *(const f32x4*)(cum + kb);
#pragma unroll
      for (int j = 0; j < 4; j++) s[t][j] += cq - c4[j];
    } else if (farband) {
      const float b0 = tab[0];
#pragma unroll
      for (int j = 0; j < 4; j++) s[t][j] += b0;
    } else {
#pragma unroll
      for (int j = 0; j < 4; j++) {
        int rel = kb + j - qpos;
        rel = min(max(rel, -128), 128) + 128;
        s[t][j] += tab[rel];
      }
    }
    if (domask) {
#pragma unroll
      for (int j = 0; j < 4; j++)
        if (kb + j > qlim) s[t][j] = -1e30f;
    }
  }
  float p[8];
  float ls = 0.f;
#pragma unroll
  for (int t = 0; t < 2; t++)
#pragma unroll
    for (int j = 0; j < 4; j++) { p[t * 4 + j] = __builtin_amdgcn_exp2f(s[t][j]); ls += p[t * 4 + j]; }
  st.l += ls;
  u32x4 pk = (u32x4){pack2(p[0], p[1]), pack2(p[2], p[3]), pack2(p[4], p[5]), pack2(p[6], p[7])};
  bf16x8 pf = __builtin_bit_cast(bf16x8, pk);
  const int qq = (lane & 15) >> 2, pp = lane & 3;
#pragma unroll
  for (int dt = 0; dt < 4; dt++) {
    s16x4 lo = tr_read(Vs + (quad * 4 + qq) * ASTR + dt * 16 + pp * 4);
    s16x4 hi = tr_read(Vs + (16 + quad * 4 + qq) * ASTR + dt * 16 + pp * 4);
    bf16x8 vf = __builtin_shufflevector(lo, hi, 0, 1, 2, 3, 4, 5, 6, 7);
    st.o[dt] = mfma16(vf, pf, st.o[dt]);
  }
}

template <int MODE>
DI void attn_prompt_item(const Params& P, char* smem, int b, int h, int qt, float bound) {
  const int tid = threadIdx.x, lane = tid & 63, w = tid >> 6, r = lane & 15, quad = lane >> 4;
  char* ws = P.ws;
  const u16* Q = (const u16*)(ws + W_QKV + (size_t)(MODE == 0 ? 0 : 3) * SZ_HALF);
  const u16* Kg = (const u16*)(ws + W_QKV + (size_t)(MODE == 0 ? 1 : 4) * SZ_HALF);
  const u16* Vg = (const u16*)(ws + W_QKV + (size_t)(MODE == 0 ? 2 : 5) * SZ_HALF);
  u16* Y = (u16*)(ws + W_XB + (size_t)(MODE == 0 ? 0 : 1) * SZ_HALF);
  float* tab = (float*)(smem + TAB_OFF);
  __syncthreads();
  if (MODE == 1) {
    for (int i = tid; i < 257; i += 256) tab[i] = P.relb[h * 257 + i] * LOG2E - bound;
  }
  const int q0 = qt * 64;
  const int qpos = q0 + w * 16 + r;
  const size_t tokq = (size_t)b * 2048 + qpos;
  bf16x8 qf[2];
#pragma unroll
  for (int ks = 0; ks < 2; ks++) qf[ks] = *(const bf16x8*)(Q + tokq * 512 + h * 64 + ks * 32 + quad * 8);
  const float* cum = (const float*)(ws + W_CUMP) + (size_t)(b * 8 + h) * 2048;
  const float cq = MODE == 0 ? cum[qpos] - bound : 0.f;
  AttnState st;
#pragma unroll
  for (int dt = 0; dt < 4; dt++) st.o[dt] = (f32x4){0.f, 0.f, 0.f, 0.f};
  st.m = 0.f;
  st.l = 0.f;
  const int kt_lo = MODE == 0 ? 0 : max(0, qt - 8), kt_hi = qt;
  u32x4 rk[2], rv[2];
  f32x4 rc = (f32x4){0.f, 0.f, 0.f, 0.f};
  const int lkey = tid >> 3, lch = tid & 7;
  const u16* kp = Kg + ((size_t)b * 2048 + lkey) * 512 + h * 64 + lch * 8;
  const u16* vp = Vg + ((size_t)b * 2048 + lkey) * 512 + h * 64 + lch * 8;
  const int lofs = lkey * ASTR + lch * 8;
#pragma unroll
  for (int i = 0; i < 2; i++) {
    rk[i] = *(const u32x4*)(kp + (size_t)(kt_lo * 64 + i * 32) * 512);
    rv[i] = *(const u32x4*)(vp + (size_t)(kt_lo * 64 + i * 32) * 512);
  }
  if (MODE == 0 && tid < 16) rc = *(const f32x4*)(cum + kt_lo * 64 + tid * 4);
  {
    u16* Ks = (u16*)(smem + (kt_lo & 1) * ASTAGE);
    u16* Vs = Ks + 64 * ASTR;
#pragma unroll
    for (int i = 0; i < 2; i++) {
      *(u32x4*)(Ks + lofs + i * 32 * ASTR) = rk[i];
      *(u32x4*)(Vs + lofs + i * 32 * ASTR) = rv[i];
    }
    if (MODE == 0 && tid < 16) *(f32x4*)((float*)(Vs + 64 * ASTR) + tid * 4) = rc;
  }
  __syncthreads();
#pragma unroll 1
  for (int kt = kt_lo; kt <= kt_hi; kt++) {
    const int ktn = min(kt + 1, kt_hi);
#pragma unroll
    for (int i = 0; i < 2; i++) {
      rk[i] = *(const u32x4*)(kp + (size_t)(ktn * 64 + i * 32) * 512);
      rv[i] = *(const u32x4*)(vp + (size_t)(ktn * 64 + i * 32) * 512);
    }
    if (MODE == 0 && tid < 16) rc = *(const f32x4*)(cum + ktn * 64 + tid * 4);
    const u16* Ks = (const u16*)(smem + (kt & 1) * ASTAGE);
    const u16* Vs = Ks + 64 * ASTR;
    const float* cl = (const float*)(Vs + 64 * ASTR) - kt * 64;
    const bool diag = (MODE == 0) && (kt == qt);
#pragma unroll
    for (int half = 0; half < 2; half++) {
      const int kpos0 = kt * 64 + half * 32;
      if (diag && kpos0 > q0 + w * 16 + 15) continue;
      attn_step<MODE>(Ks + half * 32 * ASTR, Vs + half * 32 * ASTR, qf, st, kpos0, qpos, qpos, cq, cl, tab, diag);
    }
    if (kt < kt_hi) {
      u16* Kn = (u16*)(smem + ((kt + 1) & 1) * ASTAGE);
      u16* Vn = Kn + 64 * ASTR;
#pragma unroll
      for (int i = 0; i < 2; i++) {
        *(u32x4*)(Kn + lofs + i * 32 * ASTR) = rk[i];
        *(u32x4*)(Vn + lofs + i * 32 * ASTR) = rv[i];
      }
      if (MODE == 0 && tid < 16) *(f32x4*)((float*)(Vn + 64 * ASTR) + tid * 4) = rc;
    }
    __syncthreads();
  }
  float lt = st.l;
  lt += __shfl_xor(lt, 16);
  lt += __shfl_xor(lt, 32);
  const float inv = 1.f / lt;
#pragma unroll
  for (int dt = 0; dt < 4; dt++) {
    u32x2 o2 = (u32x2){pack2(st.o[dt][0] * inv, st.o[dt][1] * inv), pack2(st.o[dt][2] * inv, st.o[dt][3] * inv)};
    *(u32x2*)(Y + tokq * 512 + h * 64 + dt * 16 + quad * 4) = o2;
  }
}

template <int MODE>
DI void attn_sample_item(const Params& P, char* smem, int b, int h, float bound) {
  const int tid = threadIdx.x, lane = tid & 63, w = tid >> 6, r = lane & 15, quad = lane >> 4;
  constexpr int L = MODE == 0 ? 4096 : 512;
  char* ws = P.ws;
  const u16* Q = (const u16*)(ws + W_QKV + (size_t)(MODE == 0 ? 0 : 3) * SZ_HALF);
  const u16* Kn = (const u16*)(ws + W_QKV + (size_t)(MODE == 0 ? 1 : 4) * SZ_HALF);
  const u16* Vn = (const u16*)(ws + W_QKV + (size_t)(MODE == 0 ? 2 : 5) * SZ_HALF);
  u16* Y = (u16*)(ws + W_XB + (size_t)(MODE == 0 ? 0 : 1) * SZ_HALF);
  u16* Kw = (u16*)smem + w * (2 * 32 * ASTR);
  u16* Vw = Kw + 32 * ASTR;
  float* tab = (float*)(smem + TAB_OFF);
  __syncthreads();
  if (MODE == 1) {
    for (int i = tid; i < 257; i += 256) tab[i] = P.relb[h * 257 + i] * LOG2E - bound;
  }
  __syncthreads();
  const float* ck = (MODE == 0 ? P.cak : P.cbk) + ((size_t)b * L * 8 + h) * 64;
  const float* cv = (MODE == 0 ? P.cav : P.cbv) + ((size_t)b * L * 8 + h) * 64;
  const size_t tokbase = (size_t)TP + b * 16;
  bf16x8 qf[2];
#pragma unroll
  for (int ks = 0; ks < 2; ks++) qf[ks] = *(const bf16x8*)(Q + (tokbase + r) * 512 + h * 64 + ks * 32 + quad * 8);
  const int qpos = L + r;
  const float* cum = (const float*)(ws + W_CUMS) + (size_t)(b * 8 + h) * 4112;
  const float cq = MODE == 0 ? cum[qpos] - bound : 0.f;
  AttnState st;
#pragma unroll
  for (int dt = 0; dt < 4; dt++) st.o[dt] = (f32x4){0.f, 0.f, 0.f, 0.f};
  st.m = 0.f;
  st.l = 0.f;
  const int kbeg = w * (L / 4), kend = kbeg + L / 4;
#pragma unroll 1
  for (int k0 = kbeg; k0 < kend; k0 += 32) {
    {
      f32x4 kr[8];
#pragma unroll
      for (int i = 0; i < 8; i++) kr[i] = *(const f32x4*)(ck + (size_t)(k0 + i * 4 + quad) * 512 + r * 4);
#pragma unroll
      for (int i = 0; i < 8; i++)
        *(u32x2*)(Kw + (i * 4 + quad) * ASTR + r * 4) = (u32x2){pack2(kr[i][0], kr[i][1]), pack2(kr[i][2], kr[i][3])};
    }
    {
      f32x4 vr[8];
#pragma unroll
      for (int i = 0; i < 8; i++) vr[i] = *(const f32x4*)(cv + (size_t)(k0 + i * 4 + quad) * 512 + r * 4);
#pragma unroll
      for (int i = 0; i < 8; i++)
        *(u32x2*)(Vw + (i * 4 + quad) * ASTR + r * 4) = (u32x2){pack2(vr[i][0], vr[i][1]), pack2(vr[i][2], vr[i][3])};
    }
    asm volatile("s_waitcnt lgkmcnt(0)" ::: "memory");
    __builtin_amdgcn_wave_barrier();
    attn_step<MODE>(Kw, Vw, qf, st, k0, qpos, qpos, cq, cum, tab, false);
    __builtin_amdgcn_wave_barrier();
  }
  if (w == 0) {
#pragma unroll
    for (int i = 0; i < 2; i++) {
      int c = lane + i * 64;
      int key = c >> 3, ch = c & 7;
      u32x4 kk = *(const u32x4*)(Kn + (tokbase + key) * 512 + h * 64 + ch * 8);
      u32x4 vv = *(const u32x4*)(Vn + (tokbase + key) * 512 + h * 64 + ch * 8);
      *(u32x4*)(Kw + key * ASTR + ch * 8) = kk;
      *(u32x4*)(Vw + key * ASTR + ch * 8) = vv;
      *(u32x4*)(Kw + (16 + key) * ASTR + ch * 8) = (u32x4){0u, 0u, 0u, 0u};
      *(u32x4*)(Vw + (16 + key) * ASTR + ch * 8) = (u32x4){0u, 0u, 0u, 0u};
    }
    asm volatile("s_waitcnt lgkmcnt(0)" ::: "memory");
    __builtin_amdgcn_wave_barrier();
    attn_step<MODE>(Kw, Vw, qf, st, L, qpos, MODE == 0 ? qpos : L + 15, cq, cum, tab, true);
  }
  __syncthreads();
  float* comb = (float*)smem;
  float lt = st.l;
  lt += __shfl_xor(lt, 16);
  lt += __shfl_xor(lt, 32);
#pragma unroll
  for (int dt = 0; dt < 4; dt++)
#pragma unroll
    for (int j = 0; j < 4; j++) comb[(w * 16 + r) * 68 + dt * 16 + quad * 4 + j] = st.o[dt][j];
  if (quad == 0) comb[(w * 16 + r) * 68 + 65] = lt;
  __syncthreads();
  if (w == 0) {
    float Ls = 0.f;
#pragma unroll
    for (int i = 0; i < 4; i++) Ls += comb[(i * 16 + r) * 68 + 65];
    const float inv = 1.f / Ls;
#pragma unroll
    for (int dt = 0; dt < 4; dt++) {
      float ov[4];
#pragma unroll
      for (int j = 0; j < 4; j++) {
        float a = 0.f;
#pragma unroll
        for (int i = 0; i < 4; i++) a += comb[(i * 16 + r) * 68 + dt * 16 + quad * 4 + j];
        ov[j] = a * inv;
      }
      *(u32x2*)(Y + (tokbase + r) * 512 + h * 64 + dt * 16 + quad * 4) = (u32x2){pack2(ov[0], ov[1]), pack2(ov[2], ov[3])};
    }
  }
}

DI void phase2(const Params& P, char* smem) {
  constexpr int N_SA = 128, N_PA = 8192, N_PB = 8192, N_SB = 128;
  float bound_a, bound_b;
  {
    const int lane = threadIdx.x & 63;
    float qa = fabsf(P.qn_a[lane]), ka = fabsf(P.kn_a[lane]), qb = fabsf(P.qn_b[lane]), kb = fabsf(P.kn_b[lane]), rb = 0.f;
    for (int i = lane; i < 8 * 257; i += 64) rb = fmaxf(rb, fabsf(P.relb[i]));
#pragma unroll
    for (int o = 32; o; o >>= 1) {
      qa = fmaxf(qa, __shfl_xor(qa, o)); ka = fmaxf(ka, __shfl_xor(ka, o));
      qb = fmaxf(qb, __shfl_xor(qb, o)); kb = fmaxf(kb, __shfl_xor(kb, o));
      rb = fmaxf(rb, __shfl_xor(rb, o));
    }
    bound_a = 8.f * qa * ka * LOG2E;
    bound_b = (8.f * qb * kb + rb) * LOG2E;
  }
  for (int it = blockIdx.x; it < N_SA + N_PA + N_PB + N_SB; it += gridDim.x) {
    int u = it;
    if (u < N_SA) { attn_sample_item<0>(P, smem, u >> 3, u & 7, bound_a); continue; }
    u -= N_SA;
    if (u < N_PA) { int qt = 31 - (u >> 8), bh = u & 255; attn_prompt_item<0>(P, smem, bh >> 3, bh & 7, qt, bound_a); continue; }
    u -= N_PA;
    if (u < N_PB) { int qt = 31 - (u >> 8), bh = u & 255; attn_prompt_item<1>(P, smem, bh >> 3, bh & 7, qt, bound_b); continue; }
    u -= N_PB;
    attn_sample_item<1>(P, smem, u >> 3, u & 7, bound_b);
  }
}

DI void phase3_tile(const Params& P, int mt, int nt, char* smem) {
  const int tid = threadIdx.x, lane = tid & 63, w = tid >> 6, wm = w >> 1, wn = w & 1, r = lane & 15, quad = lane >> 4;
  const int m0 = mt * 128, n0 = nt * 128;
  char* ws = P.ws;
  const u16* YA = (const u16*)(ws + W_XB);
  const u16* YB = YA + (size_t)TT * 512;
  const u16* GA = (const u16*)(ws + W_GA);
  const u16* GB = (const u16*)(ws + W_GB);
  u16* MRG = (u16*)(ws + W_QKV);
  f32x4 acc[4][4];
  zero_acc(acc);
  gemm_mainloop(YA + (size_t)m0 * 512, 512, (const u16*)(ws + W_WUPA) + (size_t)n0 * 512, 512, 512, (u16*)smem, acc);
  float* Cs = (float*)smem;
  const int c4 = tid & 31, rsub = tid >> 5;
  const size_t tofs = (size_t)m0 * 1024 + n0 + c4 * 4;
  stage_acc(acc, Cs);
#pragma unroll 4
  for (int p = 0; p < 16; p++) {
    const int row = p * 8 + rsub;
    const f32x4 v = *(const f32x4*)(Cs + row * CSTR + c4 * 4);
    const f32x4 gv = unpack4(*(const u32x2*)(GA + tofs + (size_t)row * 1024));
    *(u32x2*)(MRG + tofs + (size_t)row * 1024) = pack4(v * gv);
  }
  zero_acc(acc);
  gemm_mainloop(YB + (size_t)m0 * 512, 512, (const u16*)(ws + W_WUPB) + (size_t)n0 * 512, 512, 512, (u16*)smem, acc);
  stage_acc(acc, Cs);
#pragma unroll 4
  for (int p = 0; p < 16; p++) {
    const int row = p * 8 + rsub;
    const f32x4 v = *(const f32x4*)(Cs + row * CSTR + c4 * 4);
    const f32x4 gv = unpack4(*(const u32x2*)(GB + tofs + (size_t)row * 1024));
    const f32x4 m1 = unpack4(*(const u32x2*)(MRG + tofs + (size_t)row * 1024));
    *(u32x2*)(MRG + tofs + (size_t)row * 1024) = pack4(m1 + v * gv);
  }
}

DI void phase4_tile(const Params& P, int mt, int nt, char* smem) {
  const int tid = threadIdx.x, lane = tid & 63, w = tid >> 6, wm = w >> 1, wn = w & 1, r = lane & 15, quad = lane >> 4;
  const int m0 = mt * 128, n0 = nt * 128;
  char* ws = P.ws;
  const u16* MRG = (const u16*)(ws + W_QKV);
  u16* H1B = (u16*)(ws + W_QKV + SZ_ACT);
  float* SSQ2 = (float*)(ws + W_SSQ2);
  f32x4 acc[4][4];
  zero_acc(acc);
  gemm_mainloop(MRG + (size_t)m0 * 1024, 1024, (const u16*)(ws + W_WOUT) + (size_t)n0 * 1024, 1024, 1024, (u16*)smem, acc);
  const float* xb = m0 < TP ? P.x_p : P.x_s - (size_t)TP * 1024;
  float* Cs = (float*)smem;
  const int c4 = tid & 31, rsub = tid >> 5;
  const size_t tofs = (size_t)m0 * 1024 + n0 + c4 * 4;
  stage_acc(acc, Cs);
#pragma unroll 4
  for (int p = 0; p < 16; p++) {
    const int row = p * 8 + rsub;
    const f32x4 v = *(const f32x4*)(Cs + row * CSTR + c4 * 4);
    const f32x4 h1 = *(const f32x4*)(xb + tofs + (size_t)row * 1024) + v;
    *(u32x2*)(H1B + tofs + (size_t)row * 1024) = pack4(h1);
    float ss = h1.x * h1.x + h1.y * h1.y + h1.z * h1.z + h1.w * h1.w;
    ss += __shfl_xor(ss, 1);
    ss += __shfl_xor(ss, 2);
    ss += __shfl_xor(ss, 4);
    ss += __shfl_xor(ss, 8);
    ss += __shfl_xor(ss, 16);
    if (c4 == 0) SSQ2[(size_t)(m0 + row) * 16 + nt] = ss;
  }
}

DI void phase5_tile(const Params& P, int mt, int nt, char* smem) {
  const int tid = threadIdx.x, lane = tid & 63, w = tid >> 6, wm = w >> 1, wn = w & 1, r = lane & 15, quad = lane >> 4;
  const int m0 = mt * 128, n0 = nt * 128;
  char* ws = P.ws;
  const u16* H1B = (const u16*)(ws + W_QKV + SZ_ACT);
  u16* QP = (u16*)(ws + W_QKV + 2 * SZ_ACT);
  const float* SSQ2 = (const float*)(ws + W_SSQ2);
  float* rs_s = (float*)(smem + RS_OFF);
  __syncthreads();
  if (tid < 128) {
    float s = 0.f;
#pragma unroll
    for (int i = 0; i < 8; i++) s += SSQ2[(size_t)(m0 + tid) * 16 + i];
    rs_s[tid] = rsqrtf(s * (1.f / 1024.f) + EPS);
  }
  f32x4 acc[4][4];
  zero_acc(acc);
  gemm_mainloop(H1B + (size_t)m0 * 1024, 1024, (const u16*)(ws + W_WQ) + (size_t)n0 * 1024, 1024, 1024, (u16*)smem, acc);
  float* Cs = (float*)smem;
  const int c4 = tid & 31, rsub = tid >> 5;
  const size_t tofs = (size_t)m0 * 1024 + n0 + c4 * 4;
  stage_acc(acc, Cs);
#pragma unroll 4
  for (int p = 0; p < 16; p++) {
    const int row = p * 8 + rsub;
    const f32x4 v = *(const f32x4*)(Cs + row * CSTR + c4 * 4) * rs_s[row];
    *(u32x2*)(QP + tofs + (size_t)row * 1024) = pack4(v);
  }
}

DI void bitonic_merge16(u32 (&L)[16]) {
#pragma unroll
  for (int st = 8; st >= 1; st >>= 1)
#pragma unroll
    for (int i = 0; i < 16; i++)
      if ((i & st) == 0) { u32 hi = max(L[i], L[i + st]); u32 lo = min(L[i], L[i + st]); L[i] = hi; L[i + st] = lo; }
}
DI void bitonic_sort16(u32 (&L)[16]) {
#pragma unroll
  for (int k = 2; k <= 16; k <<= 1)
#pragma unroll
    for (int j = k >> 1; j > 0; j >>= 1)
#pragma unroll
      for (int i = 0; i < 16; i++) {
        const int l = i ^ j;
        if (l > i) {
          const u32 hi = max(L[i], L[l]), lo = min(L[i], L[l]);
          if ((i & k) == 0) { L[i] = hi; L[l] = lo; } else { L[i] = lo; L[l] = hi; }
        }
      }
}
DI void phase6a_unit(const Params& P, int unit, char* smem) {
  const int tid = threadIdx.x, lane = tid & 63, w = tid >> 6, r = lane & 15, quad = lane >> 4;
  char* ws = P.ws;
  const u16* QP = (const u16*)(ws + W_QKV + 2 * SZ_ACT);
  const u16* SK = (const u16*)(ws + W_SK);
  u16* IDXo = (u16*)(ws + W_IDX);
  float* Go = (float*)(ws + W_G);
  float* sc = (float*)smem;
  u32* hl = (u32*)smem;
  u32* xl = (u32*)smem + 256 * 17;
  u32* lists = (u32*)(smem + 128 * 129 * 4);
  unsigned char* tabi = (unsigned char*)(smem + 128 * 129 * 4 + 128 * 17 * 4);
  unsigned char* tabj = tabi + 64;
  const int tok0 = unit * 64;
  __syncthreads();
  if (tid == 0) {
    int c = 0;
    for (int i = 0; i < 16; i++)
      for (int j = i + 1; j < 16; j++)
        if ((i + 1) * (j + 1) <= 16) { tabi[c] = (unsigned char)i; tabj[c] = (unsigned char)j; tabi[32 + c] = (unsigned char)j; tabj[32 + c] = (unsigned char)i; c++; }
    tabi[23] = 0; tabj[23] = 0; tabi[24] = 1; tabj[24] = 1;
    tabi[55] = 2; tabj[55] = 2; tabi[56] = 3; tabj[56] = 3;
  }
  for (int h = 0; h < 8; h++) {
#pragma unroll
    for (int p = 0; p < 2; p++) {
      const int hp = h * 2 + p;
      bf16x8 qf[2];
#pragma unroll
      for (int ks = 0; ks < 2; ks++)
        qf[ks] = *(const bf16x8*)(QP + (size_t)(tok0 + w * 16 + r) * 1024 + hp * 64 + ks * 32 + quad * 8);
#pragma unroll
      for (int nt = 0; nt < 8; nt++) {
        f32x4 a4 = (f32x4){0.f, 0.f, 0.f, 0.f};
#pragma unroll
        for (int ks = 0; ks < 2; ks++) {
          bf16x8 kf = *(const bf16x8*)(SK + (size_t)(hp * 128 + nt * 16 + r) * 64 + ks * 32 + quad * 8);
          a4 = mfma16(kf, qf[ks], a4);
        }
        float* d = sc + (p * 64 + w * 16 + r) * 129 + nt * 16 + quad * 4;
        d[0] = a4[0]; d[1] = a4[1]; d[2] = a4[2]; d[3] = a4[3];
      }
    }
    __syncthreads();
    u32 L[16];
    {
      const int inst = tid & 127, half = tid >> 7;
      const float* row = sc + inst * 129 + half * 64;
#pragma unroll
      for (int i = 0; i < 16; i++) L[i] = (mono(row[i]) & ~127u) | (u32)(half * 64 + i);
      bitonic_sort16(L);
#pragma unroll 1
      for (int c = 1; c < 4; c++) {
        u32 N[16];
#pragma unroll
        for (int i = 0; i < 16; i++) N[i] = (mono(row[c * 16 + i]) & ~127u) | (u32)(half * 64 + c * 16 + i);
        bitonic_sort16(N);
#pragma unroll
        for (int i = 0; i < 16; i++) L[i] = max(L[i], N[15 - i]);
        bitonic_merge16(L);
      }
    }
    __syncthreads();
#pragma unroll
    for (int s = 0; s < 16; s++) hl[tid * 17 + s] = L[s];
    __syncthreads();
    if (tid < 128) {
      u32 M[16];
#pragma unroll
      for (int s = 0; s < 16; s++) M[s] = max(L[s], hl[(tid + 128) * 17 + 15 - s]);
      bitonic_merge16(M);
#pragma unroll
      for (int s = 0; s < 16; s++) lists[tid * 17 + s] = M[s];
    }
    __syncthreads();
    if (tid < 128) {
      const int tok = tid & 63;
      const bool part = tid >= 64;
      float fa[16], fb[16];
#pragma unroll
      for (int s = 0; s < 16; s++) {
        const float va = unmono(lists[tok * 17 + s] & ~127u);
        const float vb = unmono(lists[(64 + tok) * 17 + s] & ~127u);
        fa[s] = part ? vb : va;
        fb[s] = part ? va : vb;
      }
      u32 L2[16];
#pragma unroll
      for (int s = 0; s < 16; s++) L2[s] = 0u;
      const u32 cbase = part ? 32u : 0u;
      {
        int c = 0;
#pragma unroll
        for (int i = 0; i < 16; i++)
#pragma unroll
          for (int j = i + 1; j < 16; j++)
            if ((i + 1) * (j + 1) <= 16) {
              insert16(L2, (mono(fa[i] + fb[j]) & ~63u) | (cbase + (u32)c));
              c++;
            }
      }
      insert16(L2, (mono(part ? fa[2] + fb[2] : fa[0] + fb[0]) & ~63u) | (cbase + 23u));
      insert16(L2, (mono(part ? fa[3] + fb[3] : fa[1] + fb[1]) & ~63u) | (cbase + 24u));
#pragma unroll
      for (int s = 0; s < 16; s++) xl[tid * 17 + s] = L2[s];
    }
    __syncthreads();
    if (tid < 64) {
      float val[16];
      u32 idx[16];
      float mx = -1e30f;
#pragma unroll
      for (int s = 0; s < 16; s++) {
        const u32 m = max(xl[tid * 17 + s], xl[(tid + 64) * 17 + 15 - s]);
        const u32 sl = m & 63u;
        const int i = tabi[sl], j = tabj[sl];
        const u32 au = lists[tid * 17 + i], bu = lists[(64 + tid) * 17 + j];
        val[s] = unmono(au & ~127u) + unmono(bu & ~127u);
        idx[s] = (au & 127u) * 128u + (bu & 127u);
        mx = fmaxf(mx, val[s]);
      }
      float sum = 0.f;
#pragma unroll
      for (int s = 0; s < 16; s++) { val[s] = __expf(val[s] - mx); sum += val[s]; }
      const float inv = 1.f / sum;
      const size_t so = ((size_t)(tok0 + tid) * 8 + h) * 16;
      {
        u32* ib = (u32*)(IDXo + (size_t)(tok0 + tid) * 128 + h * 2);
#pragma unroll
        for (int gg = 0; gg < 8; gg++) ib[gg * 8] = idx[gg] | (idx[gg + 8] << 16);
      }
#pragma unroll
      for (int s = 0; s < 4; s++)
        *(f32x4*)(Go + so + s * 4) = (f32x4){val[s * 4] * inv, val[s * 4 + 1] * inv, val[s * 4 + 2] * inv, val[s * 4 + 3] * inv};
    }
    __syncthreads();
  }
}

typedef float f32x2 __attribute__((ext_vector_type(2)));
DI float dot4_fp8(u32 w, float x0, float x1, float x2, float x3, float acc) {
  f32x2 lo = __builtin_amdgcn_cvt_pk_f32_fp8((int)w, false);
  f32x2 hi = __builtin_amdgcn_cvt_pk_f32_fp8((int)w, true);
  acc = fmaf(lo[0], x0, acc);
  acc = fmaf(lo[1], x1, acc);
  acc = fmaf(hi[0], x2, acc);
  acc = fmaf(hi[1], x3, acc);
  return acc;
}
DI void axpy4_fp8(u32 w, float wgt, float& o0, float& o1, float& o2, float& o3) {
  f32x2 lo = __builtin_amdgcn_cvt_pk_f32_fp8((int)w, false);
  f32x2 hi = __builtin_amdgcn_cvt_pk_f32_fp8((int)w, true);
  o0 = fmaf(wgt, lo[0], o0);
  o1 = fmaf(wgt, lo[1], o1);
  o2 = fmaf(wgt, hi[0], o2);
  o3 = fmaf(wgt, hi[1], o3);
}

struct RowSet { u32x4 r[16]; };
DI void gather_rows(RowSet& R, const unsigned char* base, u32 lofs, u32x4 ea, u32x4 eb) {
  const u32 ev[8] = {ea.x, ea.y, ea.z, ea.w, eb.x, eb.y, eb.z, eb.w};
#pragma unroll
  for (int i = 0; i < 8; i++) {
    R.r[2 * i] = *(const u32x4*)(base + (((ev[i] & 0xffffu) << 7) + lofs));
    R.r[2 * i + 1] = *(const u32x4*)(base + (((ev[i] >> 16) << 7) + lofs));
  }
}
DI void b1_compute(const RowSet& R, u32x4 xa, u32x4 xb, u16* pr, int c, bool valid) {
  float xf[16];
  xf[0] = __uint_as_float(xa.x << 16); xf[1] = __uint_as_float(xa.x & 0xffff0000u);
  xf[2] = __uint_as_float(xa.y << 16); xf[3] = __uint_as_float(xa.y & 0xffff0000u);
  xf[4] = __uint_as_float(xa.z << 16); xf[5] = __uint_as_float(xa.z & 0xffff0000u);
  xf[6] = __uint_as_float(xa.w << 16); xf[7] = __uint_as_float(xa.w & 0xffff0000u);
  xf[8] = __uint_as_float(xb.x << 16); xf[9] = __uint_as_float(xb.x & 0xffff0000u);
  xf[10] = __uint_as_float(xb.y << 16); xf[11] = __uint_as_float(xb.y & 0xffff0000u);
  xf[12] = __uint_as_float(xb.z << 16); xf[13] = __uint_as_float(xb.z & 0xffff0000u);
  xf[14] = __uint_as_float(xb.w << 16); xf[15] = __uint_as_float(xb.w & 0xffff0000u);
  float p[16];
#pragma unroll
  for (int i = 0; i < 16; i++) {
    float a = dot4_fp8(R.r[i].x, xf[0], xf[1], xf[2], xf[3], 0.f);
    a = dot4_fp8(R.r[i].y, xf[4], xf[5], xf[6], xf[7], a);
    a = dot4_fp8(R.r[i].z, xf[8], xf[9], xf[10], xf[11], a);
    a = dot4_fp8(R.r[i].w, xf[12], xf[13], xf[14], xf[15], a);
    p[i] = a;
  }
#pragma unroll
  for (int i = 0; i < 8; i++) { float keep = (c & 4) ? p[i + 8] : p[i]; float send = (c & 4) ? p[i] : p[i + 8]; p[i] = keep + __shfl_xor(send, 4); }
#pragma unroll
  for (int i = 0; i < 4; i++) { float keep = (c & 2) ? p[i + 4] : p[i]; float send = (c & 2) ? p[i] : p[i + 4]; p[i] = keep + __shfl_xor(send, 2); }
#pragma unroll
  for (int i = 0; i < 2; i++) { float keep = (c & 1) ? p[i + 2] : p[i]; float send = (c & 1) ? p[i] : p[i + 2]; p[i] = keep + __shfl_xor(send, 1); }
  const int it0 = 2 * (c & 1) + 4 * ((c >> 1) & 1) + 8 * ((c >> 2) & 1);
  if (valid) {
    pr[it0 * 8] = f2bf(p[0]);
    pr[(it0 + 1) * 8] = f2bf(p[1]);
  }
}
DI void phase6b1(const Params& P) {
  const int lane = threadIdx.x & 63, g = lane >> 3, c = lane & 7;
  const int x = blockIdx.x & 7;
  const int wg = (blockIdx.x >> 3) * 4 + (threadIdx.x >> 6), nwg = (gridDim.x >> 3) * 4;
  char* ws = P.ws;
  const u16* H1B = (const u16*)(ws + W_QKV + SZ_ACT) + x * 128 + c * 16;
  const unsigned char* U8 = (const unsigned char*)(ws + W_UB) + ((size_t)x << 21);
  const u32 lofs = c * 16;
  const u16* IDX = (const u16*)(ws + W_IDX) + g * 16;
  u16* PH = ph_slice(ws, x) + g;
  const int n = (TT - wg + nwg - 1) / nwg;
#define TOK(i) min(wg + (i) * nwg, TT - 1)
  int t0 = TOK(0), t1 = TOK(1);
  u32x4 eA0 = *(const u32x4*)(IDX + (size_t)t0 * 128), eA1 = *(const u32x4*)(IDX + (size_t)t0 * 128 + 8);
  u32x4 eB0 = *(const u32x4*)(IDX + (size_t)t1 * 128), eB1 = *(const u32x4*)(IDX + (size_t)t1 * 128 + 8);
  RowSet RA, RB;
  gather_rows(RA, U8, lofs, eA0, eA1);
  u32x4 xA0 = *(const u32x4*)(H1B + (size_t)t0 * 1024), xA1 = *(const u32x4*)(H1B + (size_t)t0 * 1024 + 8);
#pragma unroll 1
  for (int i = 0; i < n; i += 2) {
    gather_rows(RB, U8, lofs, eB0, eB1);
    const u32x4 xB0 = *(const u32x4*)(H1B + (size_t)t1 * 1024), xB1 = *(const u32x4*)(H1B + (size_t)t1 * 1024 + 8);
    const int t2 = TOK(i + 2);
    eA0 = *(const u32x4*)(IDX + (size_t)t2 * 128);
    eA1 = *(const u32x4*)(IDX + (size_t)t2 * 128 + 8);
    b1_compute(RA, xA0, xA1, PH + (size_t)t0 * 128, c, true);
    gather_rows(RA, U8, lofs, eA0, eA1);
    xA0 = *(const u32x4*)(H1B + (size_t)t2 * 1024);
    xA1 = *(const u32x4*)(H1B + (size_t)t2 * 1024 + 8);
    const int t3 = TOK(i + 3);
    eB0 = *(const u32x4*)(IDX + (size_t)t3 * 128);
    eB1 = *(const u32x4*)(IDX + (size_t)t3 * 128 + 8);
    b1_compute(RB, xB0, xB1, PH + (size_t)t1 * 128, c, i + 1 < n);
    t0 = t2;
    t1 = t3;
  }
}

DI void phase6w(const Params& P) {
  const int lane = threadIdx.x & 63;
  const int gw = blockIdx.x * 4 + (threadIdx.x >> 6), nw = gridDim.x * 4;
  char* ws = P.ws;
  float* G = (float*)(ws + W_G);
  const float* SSQ2 = (const float*)(ws + W_SSQ2);
  for (int t = gw; t < TT; t += nw) {
    float ssq = lane < 8 ? SSQ2[(size_t)t * 16 + lane] : 0.f;
    float h0 = 0.f, h1v = 0.f;
    {
      const u16* ph = (const u16*)(ws + W_XB) + (size_t)t * 128 + lane;
#pragma unroll
      for (int xs = 0; xs < 8; xs++) { h0 += bf2f(ph[(size_t)xs * (SZ_PH / 2)]); h1v += bf2f(ph[(size_t)xs * (SZ_PH / 2) + 64]); }
    }
    const float g0 = G[(size_t)t * 128 + lane];
    const float g1 = G[(size_t)t * 128 + 64 + lane];
    const float rs2 = rsqrtf(wave_sum(ssq) * (1.f / 1024.f) + EPS);
    const float w0 = g0 * gelu_tanh(rs2 * (1.f / U_SCALE) * h0) * (1.f / V_SCALE);
    const float w1 = g1 * gelu_tanh(rs2 * (1.f / U_SCALE) * h1v) * (1.f / V_SCALE);
    u16* wrow = (u16*)(G + (size_t)t * 128);
    wrow[(lane & 7) * 16 + (lane >> 3)] = f2bf(w0);
    wrow[(lane & 7) * 16 + 8 + (lane >> 3)] = f2bf(w1);
  }
}

DI void b2_compute(const RowSet& R, u32x4 w0, u32x4 w1, u16* hb, float* sq, int g, int lane, bool valid) {
  const u32 hraw = *(const u32*)hb;
  const u32 wv[8] = {w0.x, w0.y, w0.z, w0.w, w1.x, w1.y, w1.z, w1.w};
  float o[16];
#pragma unroll
  for (int i = 0; i < 16; i++) o[i] = 0.f;
#pragma unroll
  for (int i = 0; i < 16; i++) {
    u32 r0 = R.r[i].x, r1 = R.r[i].y, r2 = R.r[i].z, r3 = R.r[i].w;
    asm volatile("" : "+v"(r0), "+v"(r1), "+v"(r2), "+v"(r3) : "v"(o[0]), "v"(o[15]));
    const float wgt = (i & 1) ? __uint_as_float(wv[i >> 1] & 0xffff0000u) : __uint_as_float(wv[i >> 1] << 16);
    axpy4_fp8(r0, wgt, o[0], o[1], o[2], o[3]);
    axpy4_fp8(r1, wgt, o[4], o[5], o[6], o[7]);
    axpy4_fp8(r2, wgt, o[8], o[9], o[10], o[11]);
    axpy4_fp8(r3, wgt, o[12], o[13], o[14], o[15]);
  }
#pragma unroll
  for (int i = 0; i < 8; i++) { float keep = (g & 4) ? o[i + 8] : o[i]; float send = (g & 4) ? o[i] : o[i + 8]; o[i] = keep + __shfl_xor(send, 32); }
#pragma unroll
  for (int i = 0; i < 4; i++) { float keep = (g & 2) ? o[i + 4] : o[i]; float send = (g & 2) ? o[i] : o[i + 4]; o[i] = keep + __shfl_xor(send, 16); }
#pragma unroll
  for (int i = 0; i < 2; i++) { float keep = (g & 1) ? o[i + 2] : o[i]; float send = (g & 1) ? o[i] : o[i + 2]; o[i] = keep + __shfl_xor(send, 8); }
  const float a0 = __uint_as_float(hraw << 16) + o[0], a1 = __uint_as_float(hraw & 0xffff0000u) + o[1];
  const float ss = wave_sum(a0 * a0 + a1 * a1);
  if (valid) {
    *(u32*)hb = pack2(a0, a1);
    if (lane == 0) *sq = ss;
  }
}
DI void phase6b2(const Params& P) {
  const int lane = threadIdx.x & 63, g = lane >> 3, c = lane & 7, w = threadIdx.x >> 6;
  const int x = blockIdx.x & 7;
  const int wg = (blockIdx.x >> 3) * 4 + w, nwg = (gridDim.x >> 3) * 4;
  char* ws = P.ws;
  const int col = x * 128 + c * 16 + 2 * (g & 1) + 4 * ((g >> 1) & 1) + 8 * ((g >> 2) & 1);
  u16* H1B = (u16*)(ws + W_QKV + SZ_ACT) + col;
  const unsigned char* V8 = (const unsigned char*)(ws + W_VB) + ((size_t)x << 21);
  const u32 lofs = c * 16;
  const u16* IDX = (const u16*)(ws + W_IDX) + g * 16;
  const u16* WG = (const u16*)(ws + W_G) + g * 16;
  float* SSQ3 = (float*)(ws + W_SSQ3) + x;
  const int n = (TT - wg + nwg - 1) / nwg;
  int t0 = TOK(0), t1 = TOK(1);
  u32x4 eA0 = *(const u32x4*)(IDX + (size_t)t0 * 128), eA1 = *(const u32x4*)(IDX + (size_t)t0 * 128 + 8);
  u32x4 eB0 = *(const u32x4*)(IDX + (size_t)t1 * 128), eB1 = *(const u32x4*)(IDX + (size_t)t1 * 128 + 8);
  RowSet RA, RB;
  gather_rows(RA, V8, lofs, eA0, eA1);
  u32x4 wA0 = *(const u32x4*)(WG + (size_t)t0 * 256), wA1 = *(const u32x4*)(WG + (size_t)t0 * 256 + 8);
#pragma unroll 1
  for (int i = 0; i < n; i += 2) {
    gather_rows(RB, V8, lofs, eB0, eB1);
    const u32x4 wB0 = *(const u32x4*)(WG + (size_t)t1 * 256), wB1 = *(const u32x4*)(WG + (size_t)t1 * 256 + 8);
    const int t2 = TOK(i + 2);
    eA0 = *(const u32x4*)(IDX + (size_t)t2 * 128);
    eA1 = *(const u32x4*)(IDX + (size_t)t2 * 128 + 8);
    b2_compute(RA, wA0, wA1, H1B + (size_t)t0 * 1024, SSQ3 + (size_t)t0 * 8, g, lane, true);
    gather_rows(RA, V8, lofs, eA0, eA1);
    wA0 = *(const u32x4*)(WG + (size_t)t2 * 256);
    wA1 = *(const u32x4*)(WG + (size_t)t2 * 256 + 8);
    const int t3 = TOK(i + 3);
    eB0 = *(const u32x4*)(IDX + (size_t)t3 * 128);
    eB1 = *(const u32x4*)(IDX + (size_t)t3 * 128 + 8);
    b2_compute(RB, wB0, wB1, H1B + (size_t)t1 * 1024, SSQ3 + (size_t)t1 * 8, g, lane, i + 1 < n);
    t0 = t2;
    t1 = t3;
  }
#undef TOK
}

DI void phase7_tile(const Params& P, int mt, int nt, char* smem) {
  const int tid = threadIdx.x, lane = tid & 63, w = tid >> 6, wm = w >> 1, wn = w & 1, r = lane & 15, quad = lane >> 4;
  const int m0 = mt * 128, n0 = nt * 128;
  char* ws = P.ws;
  const u16* H2B = (const u16*)(ws + W_QKV + SZ_ACT);
  const u16* PB = (const u16*)(ws + W_PB);
  const float* SSQ3 = (const float*)(ws + W_SSQ3);
  float* rs_s = (float*)(smem + RS_OFF);
  __syncthreads();
  if (tid < 128) {
    float q = 0.f;
#pragma unroll
    for (int i = 0; i < 8; i++) q += SSQ3[(size_t)(m0 + tid) * 8 + i];
    rs_s[tid] = rsqrtf(q * (1.f / 1024.f) + EPS);
  }
  u16* PJ = (u16*)(ws + W_QKV);
  f32x4 acc[4][4];
  zero_acc(acc);
  gemm_mainloop(PB + (size_t)m0 * 256, 256, (const u16*)(ws + W_WPP) + (size_t)n0 * 256, 256, 256, (u16*)smem, acc);
  float* Cs = (float*)smem;
  const int c4 = tid & 31, rsub = tid >> 5;
  const size_t tofs = (size_t)m0 * 1024 + n0 + c4 * 4;
  stage_acc(acc, Cs);
#pragma unroll 4
  for (int p = 0; p < 16; p++) {
    const int row = p * 8 + rsub;
    *(u32x2*)(PJ + tofs + (size_t)row * 1024) = pack4(*(const f32x4*)(Cs + row * CSTR + c4 * 4));
  }
  zero_acc(acc);
  gemm_mainloop(H2B + (size_t)m0 * 1024, 1024, (const u16*)(ws + W_WG) + (size_t)n0 * 1024, 1024, 1024, (u16*)smem, acc);
  stage_acc(acc, Cs);
#pragma unroll 4
  for (int p = 0; p < 16; p++) {
    const int row = p * 8 + rsub;
    const f32x4 v = *(const f32x4*)(Cs + row * CSTR + c4 * 4) * rs_s[row];
    const f32x4 pj = unpack4(*(const u32x2*)(PJ + tofs + (size_t)row * 1024));
    const f32x4 h2 = unpack4(*(const u32x2*)(H2B + tofs + (size_t)row * 1024));
    const f32x4 gate = (f32x4){sigmoidf_(v.x), sigmoidf_(v.y), sigmoidf_(v.z), sigmoidf_(v.w)};
    __builtin_nontemporal_store(h2 + gate * pj, (f32x4*)(P.out + tofs + (size_t)row * 1024));
  }
}

#define GEMM_TILES(NT, FN)                                                              \
  {                                                                                     \
    for (int t = blockIdx.x; t < 2 * (NT); t += gridDim.x) FN(P, 512 + t / (NT), t % (NT), smem); \
    const int x_ = blockIdx.x & 7, bpx_ = gridDim.x >> 3;                               \
    constexpr int NG_ = (NT) / 8;                                                       \
    for (int s_ = blockIdx.x >> 3; s_ < 64 * 8 * NG_; s_ += bpx_) {                     \
      const int R_ = s_ >> 6, q_ = s_ & 63;                                             \
      const int mg_ = R_ / NG_, ng_ = R_ % NG_;                                         \
      FN(P, ((mg_ * 8 + (q_ >> 3)) << 3) + x_, ng_ * 8 + (q_ & 7), smem);               \
    }                                                                                   \
  }

DI unsigned xcc_id() { return (unsigned)__builtin_amdgcn_s_getreg((3 << 11) | 20) & 0xFu; }
DI void grid_barrier(unsigned* bar, int k, const unsigned* st) {
  asm volatile("s_waitcnt vmcnt(0)" ::: "memory");
  __syncthreads();
  if (threadIdx.x == 0) {
    const unsigned nloc = st[0], nx = st[1], x = st[2];
    unsigned* slot = bar + k * BAR_SLOT;
    const unsigned old = __hip_atomic_fetch_add(slot + x * 64, 1u, __ATOMIC_RELAXED, __HIP_MEMORY_SCOPE_AGENT);
    if (old + 1u == nloc) {
      __builtin_amdgcn_fence(__ATOMIC_RELEASE, "agent");
      asm volatile("s_waitcnt vmcnt(0)" ::: "memory");
      __hip_atomic_fetch_add(slot + 16 * 64, 1u, __ATOMIC_RELAXED, __HIP_MEMORY_SCOPE_AGENT);
    }
    unsigned spins = 0;
    while (__hip_atomic_load(slot + 16 * 64, __ATOMIC_RELAXED, __HIP_MEMORY_SCOPE_AGENT) < nx) {
      __builtin_amdgcn_s_sleep(1);
      if (++spins > (1u << 24)) break;
    }
    __builtin_amdgcn_fence(__ATOMIC_ACQUIRE, "agent");
    asm volatile("s_waitcnt vmcnt(0)" ::: "memory");
  }
  __syncthreads();
}

__global__ void __launch_bounds__(256, 2) fwd_megakernel(Params P) {
  __shared__ __attribute__((aligned(16))) char smem[SMEM_BYTES];
  cg::grid_group grid = cg::this_grid();
  unsigned* bar = (unsigned*)(P.ws + W_BAR);
  __shared__ unsigned bst[4];
  unsigned* census = bar + 16 * BAR_SLOT;
  if (threadIdx.x == 0) {
    bst[2] = xcc_id();
    __hip_atomic_fetch_add(census + bst[2] * 64, 1u, __ATOMIC_RELAXED, __HIP_MEMORY_SCOPE_AGENT);
  }
  phase0(P, smem);
  if (P.out == nullptr) grid.sync();
  if (threadIdx.x == 0) {
    unsigned spins = 0;
    for (;;) {
      unsigned sum = 0, nx = 0, mine = 0;
      for (unsigned j = 0; j < 16; j++) {
        const unsigned c = __hip_atomic_load(census + j * 64, __ATOMIC_RELAXED, __HIP_MEMORY_SCOPE_AGENT);
        sum += c; nx += c ? 1u : 0u; mine = (j == bst[2]) ? c : mine;
      }
      bst[0] = mine; bst[1] = nx;
      if (sum == gridDim.x || ++spins > (1u << 22)) break;
      __builtin_amdgcn_s_sleep(1);
    }
  }
  __syncthreads();
  grid_barrier(bar, 15, bst);
  phase1_scans(P);
  GEMM_TILES(40, phase1_tile)
  grid_barrier(bar, 0, bst);
  phase2(P, smem);
  grid_barrier(bar, 1, bst);
  GEMM_TILES(8, phase3_tile)
  grid_barrier(bar, 2, bst);
  GEMM_TILES(8, phase4_tile)
  grid_barrier(bar, 3, bst);
  GEMM_TILES(8, phase5_tile)
  grid_barrier(bar, 4, bst);
  for (int t = blockIdx.x; t < TT / 64; t += gridDim.x) phase6a_unit(P, t, smem);
  grid_barrier(bar, 5, bst);
  phase6b1(P);
  grid_barrier(bar, 6, bst);
  phase6w(P);
  grid_barrier(bar, 7, bst);
  phase6b2(P);
  grid_barrier(bar, 8, bst);
  GEMM_TILES(8, phase7_tile)
}

extern "C" void kernel_launch(void* const* d_in, const int* in_sizes, int n_in, void* d_out, int out_size, void* d_ws,
                              size_t ws_size, hipStream_t stream) {
  static int grid_blocks = 0;
  if (!grid_blocks) {
    int dev = 0, cus = 0, per_cu = 0;
    hipGetDevice(&dev);
    hipDeviceGetAttribute(&cus, hipDeviceAttributeMultiprocessorCount, dev);
    hipOccupancyMaxActiveBlocksPerMultiprocessor(&per_cu, fwd_megakernel, 256, 0);
    if (per_cu > 2) per_cu = 2;
    if (per_cu < 1) per_cu = 1;
    grid_blocks = cus * per_cu;
  }
  if (ws_size < W_END) { fprintf(stderr, "workspace too small: %zu < %zu\n", ws_size, (size_t)W_END); return; }
  Params p{};
  const float** pf = (const float**)&p;
  for (int i = 0; i < 28; i++) pf[i] = (const float*)d_in[i];
  p.out = (float*)d_out;
  p.ws = (char*)d_ws;
  hipMemsetAsync((char*)d_ws + W_BAR, 0, BAR_BYTES, stream);
  void* args[] = {&p};
  hipError_t e = hipLaunchCooperativeKernel((void*)fwd_megakernel, dim3(grid_blocks), dim3(256), args, 0, stream);
  if (e != hipSuccess) fprintf(stderr, "cooperative launch failed: %s (grid %d)\n", hipGetErrorString(e), grid_blocks);
}
```

```cpp
#include <hip/hip_runtime.h>
#include <hip/hip_cooperative_groups.h>
#include <cstdio>
namespace cg = cooperative_groups;

typedef unsigned short u16;
typedef unsigned int u32;
typedef short bf16x8 __attribute__((ext_vector_type(8)));
typedef short s16x4 __attribute__((ext_vector_type(4)));
typedef float f32x4 __attribute__((ext_vector_type(4)));
typedef unsigned int u32x4 __attribute__((ext_vector_type(4)));
typedef unsigned int u32x2 __attribute__((ext_vector_type(2)));
typedef __bf16 bf16x2_t __attribute__((ext_vector_type(2)));

#define DI __device__ __forceinline__
#define LAUNDER(x) asm volatile("" : "+v"(x))

constexpr int TP = 65536, TS = 256, TT = TP + TS;
constexpr float LOG2E = 1.4426950408889634f;
constexpr float EPS = 1e-6f;
constexpr float U_SCALE = 1024.f, V_SCALE = 128.f;

constexpr size_t O_AK_P = 67371008, O_AV_P = 100925440, O_AF_P = 134479872, O_BK_P = 135004160,
                 O_BV_P = 143392768, O_AK_S = 151781376, O_AV_S = 151912448, O_AF_S = 152043520,
                 O_BK_S = 152045568, O_BV_S = 152176640;

constexpr size_t SZ_ACT = (size_t)TT * 1024 * 2;
constexpr size_t SZ_HALF = (size_t)TT * 512 * 2;
constexpr size_t W_XB = 0;
constexpr size_t W_QKV = SZ_ACT;
constexpr size_t W_GA = W_QKV + 6 * SZ_HALF;
constexpr size_t W_GB = W_GA + SZ_ACT;
constexpr size_t W_PB = W_GB + SZ_ACT;
constexpr size_t W_WIN = W_PB + (size_t)TT * 256 * 2;
constexpr size_t W_WUPA = W_WIN + (size_t)5120 * 1024 * 2;
constexpr size_t W_WUPB = W_WUPA + 1024 * 512 * 2;
constexpr size_t W_WOUT = W_WUPB + 1024 * 512 * 2;
constexpr size_t W_WQ = W_WOUT + 1024 * 1024 * 2;
constexpr size_t W_WG = W_WQ + 1024 * 1024 * 2;
constexpr size_t W_WPP = W_WG + 1024 * 1024 * 2;
constexpr size_t W_UB = W_WPP + 1024 * 256 * 2;
constexpr size_t W_VB = W_UB + (size_t)16384 * 1024 * 2;
constexpr size_t W_SK = W_VB + (size_t)16384 * 1024 * 2;
constexpr size_t W_RS1 = W_SK + 131072 * 2;
constexpr size_t W_SSQ2 = W_RS1 + (size_t)TT * 4;
constexpr size_t W_RS3 = W_SSQ2 + (size_t)TT * 64;
constexpr size_t W_CUMP = W_RS3 + (size_t)TT * 4;
constexpr size_t W_CUMS = W_CUMP + (size_t)256 * 2048 * 4;
constexpr size_t W_SSQ3 = W_CUMS + (size_t)128 * 4112 * 4 + 1024;
constexpr size_t W_BAR = W_SSQ3 + (size_t)TT * 8 * 4;
constexpr int BAR_SLOT = 17 * 64;
constexpr size_t BAR_BYTES = (size_t)(16 * BAR_SLOT + 16 * 64) * 4;
constexpr size_t W_END = W_BAR + BAR_BYTES;
constexpr size_t W_IDX = W_GA;
constexpr size_t W_G = W_GA + (size_t)32 * 1024 * 1024;
constexpr size_t SZ_PH = (size_t)TT * 128 * 2;


struct Params {
  const float *x_p, *x_s, *cak, *cav, *caf, *cbk, *cbv, *p_p, *p_s, *g_mix, *w_in, *b_f, *qn_a, *kn_a,
      *qn_b, *kn_b, *relb, *w_up_a, *w_up_b, *w_out, *g_ffn, *peer_wq, *peer_sk, *peer_u, *peer_v, *g_ple,
      *w_gate, *w_proj;
  float* out;
  char* ws;
};

constexpr int SMEM_BYTES = 128 * 129 * 4 + 2 * 64 * 17 * 4 + 256;

DI u16* ph_slice(char* ws, int x) { return (u16*)(ws + W_XB + (size_t)x * SZ_PH); }
DI u16 f2bf(float x) { return __builtin_bit_cast(u16, (__bf16)x); }
DI float bf2f(u16 h) { return __uint_as_float(((u32)h) << 16); }
DI u32 pack2(float a, float b) { bf16x2_t v = {(__bf16)a, (__bf16)b}; return __builtin_bit_cast(u32, v); }
DI float wave_sum(float v) {
#pragma unroll
  for (int o = 32; o; o >>= 1) v += __shfl_xor(v, o);
  return v;
}
DI f32x4 mfma16(bf16x8 a, bf16x8 b, f32x4 c) { return __builtin_amdgcn_mfma_f32_16x16x32_bf16(a, b, c, 0, 0, 0); }
DI float sigmoidf_(float x) { return 1.f / (1.f + __expf(-x)); }
DI u32 mono(float x) { u32 u = __float_as_uint(x); u32 m = (u32)((int)u >> 31) | 0x80000000u; return u ^ m; }
DI float unmono(u32 k) { u32 m = ((k >> 31) - 1u) | 0x80000000u; return __uint_as_float(k ^ m); }
DI void insert16(u32 (&L)[16], u32 x) {
#pragma unroll
  for (int s = 0; s < 16; s++) { u32 mx = max(L[s], x); x = min(L[s], x); L[s] = mx; }
}
DI float gelu_tanh(float x) {
  float u = 0.7978845608028654f * (x + 0.044715f * x * x * x);
  float t = 1.f - 2.f / (1.f + __expf(2.f * u));
  return 0.5f * x * (1.f + t);
}

constexpr int GSTR = 72;
constexpr int GBUF = 2 * 128 * GSTR;
constexpr int RS_OFF = 2 * GBUF * 2;
DI void gemm_compute(const u16* As, const u16* Bs, f32x4 (&acc)[4][4], int wm, int wn, int r, int quad) {
#pragma unroll
  for (int ks = 0; ks < 2; ks++) {
    bf16x8 af[4], bfr[4];
#pragma unroll
    for (int mi = 0; mi < 4; mi++) af[mi] = *(const bf16x8*)(As + (wm * 64 + mi * 16 + r) * GSTR + ks * 32 + quad * 8);
#pragma unroll
    for (int ni = 0; ni < 4; ni++) bfr[ni] = *(const bf16x8*)(Bs + (wn * 64 + ni * 16 + r) * GSTR + ks * 32 + quad * 8);
#pragma unroll
    for (int mi = 0; mi < 4; mi++)
#pragma unroll
      for (int ni = 0; ni < 4; ni++) acc[mi][ni] = mfma16(af[mi], bfr[ni], acc[mi][ni]);
    if (ks == 0) __builtin_amdgcn_sched_barrier(0);
  }
}
DI void gemm_mainloop(const u16* __restrict__ A, int lda, const u16* __restrict__ B, int ldb, int K, u16* smem,
                      f32x4 (&acc)[4][4]) {
  const int tid = threadIdx.x, lane = tid & 63, w = tid >> 6, wm = w >> 1, wn = w & 1, r = lane & 15, quad = lane >> 4;
  u16* As0 = smem;
  u16* Bs0 = smem + 128 * GSTR;
  u16* As1 = smem + GBUF;
  u16* Bs1 = As1 + 128 * GSTR;
  u32x4 r0a[4], r0b[4], r1a[4], r1b[4];
  const int lrow = tid >> 3, lch = tid & 7;
  const u16* ap = A + (size_t)lrow * lda + lch * 8;
  const u16* bp = B + (size_t)lrow * ldb + lch * 8;
  const int lo = lrow * GSTR + lch * 8;
  const int nk = K >> 6, km = nk - 1;
  const int krot = 0;
#define KOFF(kt) ((((kt) + krot) & km) * 64)
#pragma unroll
  for (int i = 0; i < 4; i++) {
    r0a[i] = *(const u32x4*)(ap + (size_t)i * 32 * lda + KOFF(0));
    r0b[i] = *(const u32x4*)(bp + (size_t)i * 32 * ldb + KOFF(0));
  }
#pragma unroll
  for (int i = 0; i < 4; i++) {
    r1a[i] = *(const u32x4*)(ap + (size_t)i * 32 * lda + KOFF(1));
    r1b[i] = *(const u32x4*)(bp + (size_t)i * 32 * ldb + KOFF(1));
  }
  __syncthreads();
#pragma unroll 1
  for (int kt = 0; kt < nk - 2; kt += 2) {
#pragma unroll
    for (int i = 0; i < 4; i++) {
      *(u32x4*)(As0 + lo + i * 32 * GSTR) = r0a[i];
      *(u32x4*)(Bs0 + lo + i * 32 * GSTR) = r0b[i];
    }
    __syncthreads();
    {
      const int ko = KOFF(kt + 2);
#pragma unroll
      for (int i = 0; i < 4; i++) {
        r0a[i] = *(const u32x4*)(ap + (size_t)i * 32 * lda + ko);
        r0b[i] = *(const u32x4*)(bp + (size_t)i * 32 * ldb + ko);
      }
    }
    gemm_compute(As0, Bs0, acc, wm, wn, r, quad);
#pragma unroll
    for (int i = 0; i < 4; i++) {
      *(u32x4*)(As1 + lo + i * 32 * GSTR) = r1a[i];
      *(u32x4*)(Bs1 + lo + i * 32 * GSTR) = r1b[i];
    }
    __syncthreads();
    {
      const int ko = KOFF(kt + 3);
#pragma unroll
      for (int i = 0; i < 4; i++) {
        r1a[i] = *(const u32x4*)(ap + (size_t)i * 32 * lda + ko);
        r1b[i] = *(const u32x4*)(bp + (size_t)i * 32 * ldb + ko);
      }
    }
    gemm_compute(As1, Bs1, acc, wm, wn, r, quad);
  }
#pragma unroll
  for (int i = 0; i < 4; i++) {
    *(u32x4*)(As0 + lo + i * 32 * GSTR) = r0a[i];
    *(u32x4*)(Bs0 + lo + i * 32 * GSTR) = r0b[i];
  }
  __syncthreads();
  gemm_compute(As0, Bs0, acc, wm, wn, r, quad);
#pragma unroll
  for (int i = 0; i < 4; i++) {
    *(u32x4*)(As1 + lo + i * 32 * GSTR) = r1a[i];
    *(u32x4*)(Bs1 + lo + i * 32 * GSTR) = r1b[i];
  }
  __syncthreads();
  gemm_compute(As1, Bs1, acc, wm, wn, r, quad);
#undef KOFF
}

DI void zero_acc(f32x4 (&acc)[4][4]) {
#pragma unroll
  for (int i = 0; i < 4; i++)
#pragma unroll
    for (int j = 0; j < 4; j++) acc[i][j] = (f32x4){0.f, 0.f, 0.f, 0.f};
}

constexpr int CSTR = 132;
DI void stage_acc(const f32x4 (&acc)[4][4], float* Cs) {
  const int tid = threadIdx.x, lane = tid & 63, w = tid >> 6, wm = w >> 1, wn = w & 1, r = lane & 15, quad = lane >> 4;
  __syncthreads();
#pragma unroll
  for (int mi = 0; mi < 4; mi++)
#pragma unroll
    for (int ni = 0; ni < 4; ni++)
#pragma unroll
      for (int j = 0; j < 4; j++) Cs[(wm * 64 + mi * 16 + quad * 4 + j) * CSTR + wn * 64 + ni * 16 + r] = acc[mi][ni][j];
  __syncthreads();
}
DI u32x2 pack4(f32x4 v) { return (u32x2){pack2(v.x, v.y), pack2(v.z, v.w)}; }
DI f32x4 unpack4(u32x2 p) {
  return (f32x4){__uint_as_float(p.x << 16), __uint_as_float(p.x & 0xffff0000u), __uint_as_float(p.y << 16), __uint_as_float(p.y & 0xffff0000u)};
}

DI void transpose_tile(const float* __restrict__ W, int ldw, int K, const float* __restrict__ g, u16* __restrict__ dst,
                       int k0, int n0, int nsrc0, float* tile) {
  const int tid = threadIdx.x;
  __syncthreads();
  {
    const int ty = tid >> 4, tx = tid & 15;
#pragma unroll
    for (int i = 0; i < 4; i++) {
      int k = ty + i * 16;
      f32x4 v = *(const f32x4*)(W + (size_t)(k0 + k) * ldw + nsrc0 + tx * 4);
      float s = g ? g[k0 + k] : 1.f;
      tile[k * 65 + tx * 4 + 0] = v[0] * s;
      tile[k * 65 + tx * 4 + 1] = v[1] * s;
      tile[k * 65 + tx * 4 + 2] = v[2] * s;
      tile[k * 65 + tx * 4 + 3] = v[3] * s;
    }
  }
  __syncthreads();
  {
    const int n = tid >> 2, kc = (tid & 3) * 16;
    u32 pk[8];
#pragma unroll
    for (int i = 0; i < 8; i++) pk[i] = pack2(tile[(kc + 2 * i) * 65 + n], tile[(kc + 2 * i + 1) * 65 + n]);
    u16* d = dst + (size_t)(n0 + n) * K + k0 + kc;
    *(u32x4*)d = (u32x4){pk[0], pk[1], pk[2], pk[3]};
    *(u32x4*)(d + 8) = (u32x4){pk[4], pk[5], pk[6], pk[7]};
  }
}

DI void conv_unit(const float* __restrict__ src, u16* __restrict__ dst, size_t base, const float* __restrict__ colscale) {
  const int tid = threadIdx.x;
#pragma unroll
  for (int i = 0; i < 4; i++) {
    size_t e = base + (size_t)i * 1024 + tid * 4;
    f32x4 v = *(const f32x4*)(src + e);
    if (colscale) {
      f32x4 gg = *(const f32x4*)(colscale + (e & 1023));
      v = v * gg;
    }
    *(u32x2*)(dst + e) = (u32x2){pack2(v[0], v[1]), pack2(v[2], v[3])};
  }
}

DI void conv_unit_fp8(const float* __restrict__ src, unsigned char* __restrict__ dst, size_t base,
                      const float* __restrict__ colscale, float scale) {
  const int tid = threadIdx.x;
#pragma unroll
  for (int i = 0; i < 4; i++) {
    size_t e = base + (size_t)i * 1024 + tid * 4;
    f32x4 v = *(const f32x4*)(src + e);
    if (colscale) {
      f32x4 gg = *(const f32x4*)(colscale + (e & 1023));
      v = v * gg;
    }
    int w = __builtin_amdgcn_cvt_pk_fp8_f32(v[0] * scale, v[1] * scale, 0, false);
    w = __builtin_amdgcn_cvt_pk_fp8_f32(v[2] * scale, v[3] * scale, w, true);
    *(int*)(dst + (((e & 1023) >> 7) << 21) + ((e >> 10) << 7) + (e & 127)) = w;
  }
}

DI void phase0(const Params& P, char* smem) {
  const int tid = threadIdx.x, lane = tid & 63, w = tid >> 6;
  char* ws = P.ws;
  {
    float* tile = (float*)smem;
    constexpr int T_WIN = 16 * 80, T_UP = 8 * 16, T_SQ = 256, T_PP = 4 * 16;
    constexpr int NT = T_WIN + 2 * T_UP + 3 * T_SQ + T_PP;
    for (int t = blockIdx.x; t < NT; t += gridDim.x) {
      int u = t;
      if (u < T_WIN) {
        int kt = u / 80, nt = u % 80;
        int n0 = nt * 64;
        int ns = n0 < 1536 ? n0 : n0 + 8;
        transpose_tile(P.w_in, 5128, 1024, P.g_mix, (u16*)(ws + W_WIN), kt * 64, n0, ns, tile);
        continue;
      }
      u -= T_WIN;
      if (u < T_UP) { transpose_tile(P.w_up_a, 1024, 512, nullptr, (u16*)(ws + W_WUPA), (u / 16) * 64, (u % 16) * 64, (u % 16) * 64, tile); continue; }
      u -= T_UP;
      if (u < T_UP) { transpose_tile(P.w_up_b, 1024, 512, nullptr, (u16*)(ws + W_WUPB), (u / 16) * 64, (u % 16) * 64, (u % 16) * 64, tile); continue; }
      u -= T_UP;
      if (u < T_SQ) { transpose_tile(P.w_out, 1024, 1024, nullptr, (u16*)(ws + W_WOUT), (u / 16) * 64, (u % 16) * 64, (u % 16) * 64, tile); continue; }
      u -= T_SQ;
      if (u < T_SQ) { transpose_tile(P.peer_wq, 1024, 1024, P.g_ffn, (u16*)(ws + W_WQ), (u / 16) * 64, (u % 16) * 64, (u % 16) * 64, tile); continue; }
      u -= T_SQ;
      if (u < T_SQ) { transpose_tile(P.w_gate, 1024, 1024, P.g_ple, (u16*)(ws + W_WG), (u / 16) * 64, (u % 16) * 64, (u % 16) * 64, tile); continue; }
      u -= T_SQ;
      transpose_tile(P.w_proj, 1024, 256, nullptr, (u16*)(ws + W_WPP), (u / 16) * 64, (u % 16) * 64, (u % 16) * 64, tile);
    }
  }
  {
    for (int t = blockIdx.x; t < 32; t += gridDim.x) conv_unit(P.peer_sk, (u16*)(ws + W_SK), (size_t)t * 4096, nullptr);
  }
  {
    float* wfl = (float*)smem;
    __syncthreads();
    for (int i = tid; i < 8192; i += 256) {
      int k = i >> 3, h = i & 7;
      wfl[h * 1024 + k] = P.g_mix[k] * P.w_in[(size_t)k * 5128 + 1536 + h];
    }
    __syncthreads();
    u16* XB = (u16*)(ws + W_XB);
    float* RS1 = (float*)(ws + W_RS1);
    for (int t = blockIdx.x * 4 + w; t < TT; t += gridDim.x * 4) {
      const float* xr = t < TP ? P.x_p + (size_t)t * 1024 : P.x_s + (size_t)(t - TP) * 1024;
      f32x4 v[4];
#pragma unroll
      for (int i = 0; i < 4; i++) v[i] = *(const f32x4*)(xr + i * 256 + lane * 4);
      float ss = 0.f;
#pragma unroll
      for (int i = 0; i < 4; i++) ss += v[i][0] * v[i][0] + v[i][1] * v[i][1] + v[i][2] * v[i][2] + v[i][3] * v[i][3];
      float dots[8];
#pragma unroll
      for (int h = 0; h < 8; h++) {
        float d = 0.f;
#pragma unroll
        for (int i = 0; i < 4; i++) {
          f32x4 wv = *(const f32x4*)(wfl + h * 1024 + i * 256 + lane * 4);
          d += v[i][0] * wv[0] + v[i][1] * wv[1] + v[i][2] * wv[2] + v[i][3] * wv[3];
        }
        dots[h] = d;
      }
      ss = wave_sum(ss);
#pragma unroll
      for (int h = 0; h < 8; h++) dots[h] = wave_sum(dots[h]);
      float rs = rsqrtf(ss * (1.f / 1024.f) + EPS);
#pragma unroll
      for (int i = 0; i < 4; i++)
        *(u32x2*)(XB + (size_t)t * 1024 + i * 256 + lane * 4) = (u32x2){pack2(v[i][0], v[i][1]), pack2(v[i][2], v[i][3])};
      if (lane == 0) RS1[t] = rs;
      float myd = dots[0];
#pragma unroll
      for (int h = 1; h < 8; h++) myd = (lane == h) ? dots[h] : myd;
      if (lane < 8) {
        float z = rs * myd + P.b_f[lane];
        float lf = fminf(z, 0.f) - log1pf(expf(-fabsf(z)));
        float* o = t < TP ? P.out + O_AF_P + (size_t)t * 8 : P.out + O_AF_S + (size_t)(t - TP) * 8;
        o[lane] = lf;
      }
    }
  }
}

DI void phase1_scans(const Params& P) {
  const int lane = threadIdx.x & 63;
  const int gw = blockIdx.x * 4 + (threadIdx.x >> 6), nw = gridDim.x * 4;
  float* CUMP = (float*)(P.ws + W_CUMP);
  float* CUMS = (float*)(P.ws + W_CUMS);
  for (int row = gw; row < 384; row += nw) {
    float carry = 0.f;
    if (row < 256) {
      int b = row >> 3, h = row & 7;
      const float* src = P.out + O_AF_P + (size_t)b * 2048 * 8 + h;
      for (int p0 = 0; p0 < 2048; p0 += 64) {
        float v = src[(size_t)(p0 + lane) * 8];
#pragma unroll
        for (int o = 1; o < 64; o <<= 1) { float n = __shfl_up(v, o); if (lane >= o) v += n; }
        v += carry;
        CUMP[(size_t)row * 2048 + p0 + lane] = v * LOG2E;
        carry = __shfl(v, 63);
      }
    } else {
      int rr = row - 256;
      int b = rr >> 3, h = rr & 7;
      const float* src = P.caf + (size_t)b * 4096 * 8 + h;
      for (int p0 = 0; p0 < 4096; p0 += 64) {
        float v = src[(size_t)(p0 + lane) * 8];
#pragma unroll
        for (int o = 1; o < 64; o <<= 1) { float n = __shfl_up(v, o); if (lane >= o) v += n; }
        v += carry;
        CUMS[(size_t)rr * 4112 + p0 + lane] = v * LOG2E;
        carry = __shfl(v, 63);
      }
      {
        float v = lane < 16 ? P.out[O_AF_S + (size_t)(b * 16 + lane) * 8 + h] : 0.f;
#pragma unroll
        for (int o = 1; o < 64; o <<= 1) { float n = __shfl_up(v, o); if (lane >= o) v += n; }
        v += carry;
        if (lane < 16) CUMS[(size_t)rr * 4112 + 4096 + lane] = v * LOG2E;
      }
    }
  }
}

DI void phase1_tile(const Params& P, int mt, int nt, char* smem) {
  const int tid = threadIdx.x, lane = tid & 63, w = tid >> 6, wm = w >> 1, wn = w & 1, r = lane & 15, quad = lane >> 4;
  const int m0 = mt * 128, n0 = nt * 128;
  char* ws = P.ws;
  f32x4 acc[4][4];
  zero_acc(acc);
  gemm_mainloop((const u16*)(ws + W_XB) + (size_t)m0 * 1024, 1024, (const u16*)(ws + W_WIN) + (size_t)n0 * 1024, 1024, 1024,
                (u16*)smem, acc);
  float* Cs = (float*)smem;
  stage_acc(acc, Cs);
  const bool sample = m0 >= TP;
  const int c4 = tid & 31, rsub = tid >> 5;
  const float* RS1 = (const float*)(ws + W_RS1) + m0;
  if (n0 < 3072) {
    const int seg = n0 >> 9, hc = n0 & 511;
    const bool normed = (seg != 2 && seg != 5);
    const float* gain = seg == 0 ? P.qn_a : seg == 1 ? P.kn_a : seg == 3 ? P.qn_b : P.kn_b;
    const float qs = (seg == 0 || seg == 3) ? 0.125f * LOG2E : 1.f;
    f32x4 gn = (f32x4){1.f, 1.f, 1.f, 1.f};
    if (normed) gn = *(const f32x4*)(gain + (c4 & 15) * 4) * qs;
    u16* dp = (u16*)(ws + W_QKV + (size_t)seg * SZ_HALF) + (size_t)m0 * 512 + hc + c4 * 4;
    float* op = nullptr;
    if (seg == 1 || seg == 2) {
      op = sample ? P.out + (seg == 1 ? O_AK_S : O_AV_S) + (size_t)(m0 - TP) * 512 : P.out + (seg == 1 ? O_AK_P : O_AV_P) + (size_t)m0 * 512;
    } else if (seg == 4 || seg == 5) {
      if (sample) op = P.out + (seg == 4 ? O_BK_S : O_BV_S) + (size_t)(m0 - TP) * 512;
      else if ((m0 & 2047) >= 1536) op = P.out + (seg == 4 ? O_BK_P : O_BV_P) + ((size_t)(m0 >> 11) * 512 + ((m0 & 2047) - 1536)) * 512;
    }
    if (op) op += hc + c4 * 4;
#pragma unroll 4
    for (int p = 0; p < 16; p++) {
      const int row = p * 8 + rsub;
      f32x4 v = *(const f32x4*)(Cs + row * CSTR + c4 * 4) * RS1[row];
      if (normed) {
        float ss = v.x * v.x + v.y * v.y + v.z * v.z + v.w * v.w;
        ss += __shfl_xor(ss, 1);
        ss += __shfl_xor(ss, 2);
        ss += __shfl_xor(ss, 4);
        ss += __shfl_xor(ss, 8);
        v = v * gn * rsqrtf(ss * (1.f / 64.f) + EPS);
      }
      *(u32x2*)(dp + (size_t)row * 512) = pack4(v);
      if (op) __builtin_nontemporal_store(v, (f32x4*)(op + (size_t)row * 512));
    }
  } else {
    u16* dp = (n0 < 4096 ? (u16*)(ws + W_GA) + (n0 - 3072) : (u16*)(ws + W_GB) + (n0 - 4096)) + (size_t)m0 * 1024 + c4 * 4;
#pragma unroll 4
    for (int p = 0; p < 16; p++) {
      const int row = p * 8 + rsub;
      f32x4 v = *(const f32x4*)(Cs + row * CSTR + c4 * 4) * RS1[row];
      v = (f32x4){sigmoidf_(v.x), sigmoidf_(v.y), sigmoidf_(v.z), sigmoidf_(v.w)};
      *(u32x2*)(dp + (size_t)row * 1024) = pack4(v);
    }
  }
}

constexpr int ASTR = 72;
constexpr int ASTAGE = 2 * 64 * ASTR * 2 + 256;
constexpr int TAB_OFF = 2 * ASTAGE;
struct AttnState { f32x4 o[4]; float m, l; };

DI s16x4 tr_read(const u16* p) {
  return __builtin_amdgcn_ds_read_tr16_b64_v4i16((__attribute__((address_space(3))) s16x4*)(p));
}

template <int MODE>
DI void attn_step(const u16* Ks, const u16* Vs, const bf16x8 (&qf)[2], AttnState& st, int kpos0, int qpos, int qlim,
                  float cq, const float* cum, const float* tab, bool domask) {
  const int lane = threadIdx.x & 63, r = lane & 15, quad = lane >> 4;
  const bool farband = (MODE == 1) && (kpos0 + 31 - (qpos - r) <= -128);
  f32x4 s[2];
#pragma unroll
  for (int t = 0; t < 2; t++) {
    f32x4 a4 = (f32x4){0.f, 0.f, 0.f, 0.f};
#pragma unroll
    for (int ks = 0; ks < 2; ks++) {
      bf16x8 kf = *(const bf16x8*)(Ks + (t * 16 + r) * ASTR + ks * 32 + quad * 8);
      a4 = mfma16(kf, qf[ks], a4);
    }
    s[t] = a4;
  }
#pragma unroll
  for (int t = 0; t < 2; t++) {
    const int kb = kpos0 + t * 16 + quad * 4;
    if (MODE == 0) {
      f32x4 c4 = *(const f32x4*)(cum + kb);
#pragma unroll
      for (int j = 0; j < 4; j++) s[t][j] += cq - c4[j];
    } else if (farband) {
      const float b0 = tab[0];
#pragma unroll
      for (int j = 0; j < 4; j++) s[t][j] += b0;
    } else {
#pragma unroll
      for (int j = 0; j < 4; j++) {
        int rel = kb + j - qpos;
        rel = min(max(rel, -128), 128) + 128;
        s[t][j] += tab[rel];
      }
    }
    if (domask) {
#pragma unroll
      for (int j = 0; j < 4; j++)
        if (kb + j > qlim) s[t][j] = -1e30f;
    }
  }
  float p[8];
  float ls = 0.f;
#pragma unroll
  for (int t = 0; t < 2; t++)
#pragma unroll
    for (int j = 0; j < 4; j++) { p[t * 4 + j] = __builtin_amdgcn_exp2f(s[t][j]); ls += p[t * 4 + j]; }
  st.l += ls;
  u32x4 pk = (u32x4){pack2(p[0], p[1]), pack2(p[2], p[3]), pack2(p[4], p[5]), pack2(p[6], p[7])};
  bf16x8 pf = __builtin_bit_cast(bf16x8, pk);
  const int qq = (lane & 15) >> 2, pp = lane & 3;
#pragma unroll
  for (int dt = 0; dt < 4; dt++) {
    s16x4 lo = tr_read(Vs + (quad * 4 + qq) * ASTR + dt * 16 + pp * 4);
    s16x4 hi = tr_read(Vs + (16 + quad * 4 + qq) * ASTR + dt * 16 + pp * 4);
    bf16x8 vf = __builtin_shufflevector(lo, hi, 0, 1, 2, 3, 4, 5, 6, 7);
    st.o[dt] = mfma16(vf, pf, st.o[dt]);
  }
}

template <int MODE>
DI void attn_prompt_item(const Params& P, char* smem, int b, int h, int qt, float bound) {
  const int tid = threadIdx.x, lane = tid & 63, w = tid >> 6, r = lane & 15, quad = lane >> 4;
  char* ws = P.ws;
  const u16* Q = (const u16*)(ws + W_QKV + (size_t)(MODE == 0 ? 0 : 3) * SZ_HALF);
  const u16* Kg = (const u16*)(ws + W_QKV + (size_t)(MODE == 0 ? 1 : 4) * SZ_HALF);
  const u16* Vg = (const u16*)(ws + W_QKV + (size_t)(MODE == 0 ? 2 : 5) * SZ_HALF);
  u16* Y = (u16*)(ws + W_XB + (size_t)(MODE == 0 ? 0 : 1) * SZ_HALF);
  float* tab = (float*)(smem + TAB_OFF);
  __syncthreads();
  if (MODE == 1) {
    for (int i = tid; i < 257; i += 256) tab[i] = P.relb[h * 257 + i] * LOG2E - bound;
  }
  const int q0 = qt * 64;
  const int qpos = q0 + w * 16 + r;
  const size_t tokq = (size_t)b * 2048 + qpos;
  bf16x8 qf[2];
#pragma unroll
  for (int ks = 0; ks < 2; ks++) qf[ks] = *(const bf16x8*)(Q + tokq * 512 + h * 64 + ks * 32 + quad * 8);
  const float* cum = (const float*)(ws + W_CUMP) + (size_t)(b * 8 + h) * 2048;
  const float cq = MODE == 0 ? cum[qpos] - bound : 0.f;
  AttnState st;
#pragma unroll
  for (int dt = 0; dt < 4; dt++) st.o[dt] = (f32x4){0.f, 0.f, 0.f, 0.f};
  st.m = 0.f;
  st.l = 0.f;
  const int kt_lo = MODE == 0 ? 0 : max(0, qt - 8), kt_hi = qt;
  u32x4 rk[2], rv[2];
  f32x4 rc = (f32x4){0.f, 0.f, 0.f, 0.f};
  const int lkey = tid >> 3, lch = tid & 7;
  const u16* kp = Kg + ((size_t)b * 2048 + lkey) * 512 + h * 64 + lch * 8;
  const u16* vp = Vg + ((size_t)b * 2048 + lkey) * 512 + h * 64 + lch * 8;
  const int lofs = lkey * ASTR + lch * 8;
#pragma unroll
  for (int i = 0; i < 2; i++) {
    rk[i] = *(const u32x4*)(kp + (size_t)(kt_lo * 64 + i * 32) * 512);
    rv[i] = *(const u32x4*)(vp + (size_t)(kt_lo * 64 + i * 32) * 512);
  }
  if (MODE == 0 && tid < 16) rc = *(const f32x4*)(cum + kt_lo * 64 + tid * 4);
  {
    u16* Ks = (u16*)(smem + (kt_lo & 1) * ASTAGE);
    u16* Vs = Ks + 64 * ASTR;
#pragma unroll
    for (int i = 0; i < 2; i++) {
      *(u32x4*)(Ks + lofs + i * 32 * ASTR) = rk[i];
      *(u32x4*)(Vs + lofs + i * 32 * ASTR) = rv[i];
    }
    if (MODE == 0 && tid < 16) *(f32x4*)((float*)(Vs + 64 * ASTR) + tid * 4) = rc;
  }
  __syncthreads();
#pragma unroll 1
  for (int kt = kt_lo; kt <= kt_hi; kt++) {
    const int ktn = min(kt + 1, kt_hi);
#pragma unroll
    for (int i = 0; i < 2; i++) {
      rk[i] = *(const u32x4*)(kp + (size_t)(ktn * 64 + i * 32) * 512);
      rv[i] = *(const u32x4*)(vp + (size_t)(ktn * 64 + i * 32) * 512);
    }
    if (MODE == 0 && tid < 16) rc = *(const f32x4*)(cum + ktn * 64 + tid * 4);
    const u16* Ks = (const u16*)(smem + (kt & 1) * ASTAGE);
    const u16* Vs = Ks + 64 * ASTR;
    const float* cl = (const float*)(Vs + 64 * ASTR) - kt * 64;
    const bool diag = (MODE == 0) && (kt == qt);
#pragma unroll
    for (int half = 0; half < 2; half++) {
      const int kpos0 = kt * 64 + half * 32;
      if (diag && kpos0 > q0 + w * 16 + 15) continue;
      attn_step<MODE>(Ks + half * 32 * ASTR, Vs + half * 32 * ASTR, qf, st, kpos0, qpos, qpos, cq, cl, tab, diag);
    }
    if (kt < kt_hi) {
      u16* Kn = (u16*)(smem + ((kt + 1) & 1) * ASTAGE);
      u16* Vn = Kn + 64 * ASTR;
#pragma unroll
      for (int i = 0; i < 2; i++) {
        *(u32x4*)(Kn + lofs + i * 32 * ASTR) = rk[i];
        *(u32x4*)(Vn + lofs + i * 32 * ASTR) = rv[i];
      }
      if (MODE == 0 && tid < 16) *(f32x4*)((float*)(Vn + 64 * ASTR) + tid * 4) = rc;
    }
    __syncthreads();
  }
  float lt = st.l;
  lt += __shfl_xor(lt, 16);
  lt += __shfl_xor(lt, 32);
  const float inv = 1.f / lt;
#pragma unroll
  for (int dt = 0; dt < 4; dt++) {
    u32x2 o2 = (u32x2){pack2(st.o[dt][0] * inv, st.o[dt][1] * inv), pack2(st.o[dt][2] * inv, st.o[dt][3] * inv)};
    *(u32x2*)(Y + tokq * 512 + h * 64 + dt * 16 + quad * 4) = o2;
  }
}

template <int MODE>
DI void attn_sample_item(const Params& P, char* smem, int b, int h, float bound) {
  const int tid = threadIdx.x, lane = tid & 63, w = tid >> 6, r = lane & 15, quad = lane >> 4;
  constexpr int L = MODE == 0 ? 4096 : 512;
  char* ws = P.ws;
  const u16* Q = (const u16*)(ws + W_QKV + (size_t)(MODE == 0 ? 0 : 3) * SZ_HALF);
  const u16* Kn = (const u16*)(ws + W_QKV + (size_t)(MODE == 0 ? 1 : 4) * SZ_HALF);
  const u16* Vn = (const u16*)(ws + W_QKV + (size_t)(MODE == 0 ? 2 : 5) * SZ_HALF);
  u16* Y = (u16*)(ws + W_XB + (size_t)(MODE == 0 ? 0 : 1) * SZ_HALF);
  u16* Kw = (u16*)smem + w * (2 * 32 * ASTR);
  u16* Vw = Kw + 32 * ASTR;
  float* tab = (float*)(smem + TAB_OFF);
  __syncthreads();
  if (MODE == 1) {
    for (int i = tid; i < 257; i += 256) tab[i] = P.relb[h * 257 + i] * LOG2E - bound;
  }
  __syncthreads();
  const float* ck = (MODE == 0 ? P.cak : P.cbk) + ((size_t)b * L * 8 + h) * 64;
  const float* cv = (MODE == 0 ? P.cav : P.cbv) + ((size_t)b * L * 8 + h) * 64;
  const size_t tokbase = (size_t)TP + b * 16;
  bf16x8 qf[2];
#pragma unroll
  for (int ks = 0; ks < 2; ks++) qf[ks] = *(const bf16x8*)(Q + (tokbase + r) * 512 + h * 64 + ks * 32 + quad * 8);
  const int qpos = L + r;
  const float* cum = (const float*)(ws + W_CUMS) + (size_t)(b * 8 + h) * 4112;
  const float cq = MODE == 0 ? cum[qpos] - bound : 0.f;
  AttnState st;
#pragma unroll
  for (int dt = 0; dt < 4; dt++) st.o[dt] = (f32x4){0.f, 0.f, 0.f, 0.f};
  st.m = 0.f;
  st.l = 0.f;
  const int kbeg = w * (L / 4), kend = kbeg + L / 4;
#pragma unroll 1
  for (int k0 = kbeg; k0 < kend; k0 += 32) {
    {
      f32x4 kr[8];
#pragma unroll
      for (int i = 0; i < 8; i++) kr[i] = *(const f32x4*)(ck + (size_t)(k0 + i * 4 + quad) * 512 + r * 4);
#pragma unroll
      for (int i = 0; i < 8; i++)
        *(u32x2*)(Kw + (i * 4 + quad) * ASTR + r * 4) = (u32x2){pack2(kr[i][0], kr[i][1]), pack2(kr[i][2], kr[i][3])};
    }
    {
      f32x4 vr[8];
#pragma unroll
      for (int i = 0; i < 8; i++) vr[i] = *(const f32x4*)(cv + (size_t)(k0 + i * 4 + quad) * 512 + r * 4);
#pragma unroll
      for (int i = 0; i < 8; i++)
        *(u32x2*)(Vw + (i * 4 + quad) * ASTR + r * 4) = (u32x2){pack2(vr[i][0], vr[i][1]), pack2(vr[i][2], vr[i][3])};
    }
    asm volatile("s_waitcnt lgkmcnt(0)" ::: "memory");
    __builtin_amdgcn_wave_barrier();
    attn_step<MODE>(Kw, Vw, qf, st, k0, qpos, qpos, cq, cum, tab, false);
    __builtin_amdgcn_wave_barrier();
  }
  if (w == 0) {
#pragma unroll
    for (int i = 0; i < 2; i++) {
      int c = lane + i * 64;
      int key = c >> 3, ch = c & 7;
      u32x4 kk = *(const u32x4*)(Kn + (tokbase + key) * 512 + h * 64 + ch * 8);
      u32x4 vv = *(const u32x4*)(Vn + (tokbase + key) * 512 + h * 64 + ch * 8);
      *(u32x4*)(Kw + key * ASTR + ch * 8) = kk;
      *(u32x4*)(Vw + key * ASTR + ch * 8) = vv;
      *(u32x4*)(Kw + (16 + key) * ASTR + ch * 8) = (u32x4){0u, 0u, 0u, 0u};
      *(u32x4*)(Vw + (16 + key) * ASTR + ch * 8) = (u32x4){0u, 0u, 0u, 0u};
    }
    asm volatile("s_waitcnt lgkmcnt(0)" ::: "memory");
    __builtin_amdgcn_wave_barrier();
    attn_step<MODE>(Kw, Vw, qf, st, L, qpos, MODE == 0 ? qpos : L + 15, cq, cum, tab, true);
  }
  __syncthreads();
  float* comb = (float*)smem;
  float lt = st.l;
  lt += __shfl_xor(lt, 16);
  lt += __shfl_xor(lt, 32);
#pragma unroll
  for (int dt = 0; dt < 4; dt++)
#pragma unroll
    for (int j = 0; j < 4; j++) comb[(w * 16 + r) * 68 + dt * 16 + quad * 4 + j] = st.o[dt][j];
  if (quad == 0) comb[(w * 16 + r) * 68 + 65] = lt;
  __syncthreads();
  if (w == 0) {
    float Ls = 0.f;
#pragma unroll
    for (int i = 0; i < 4; i++) Ls += comb[(i * 16 + r) * 68 + 65];
    const float inv = 1.f / Ls;
#pragma unroll
    for (int dt = 0; dt < 4; dt++) {
      float ov[4];
#pragma unroll
      for (int j = 0; j < 4; j++) {
        float a = 0.f;
#pragma unroll
        for (int i = 0; i < 4; i++) a += comb[(i * 16 + r) * 68 + dt * 16 + quad * 4 + j];
        ov[j] = a * inv;
      }
      *(u32x2*)(Y + (tokbase + r) * 512 + h * 64 + dt * 16 + quad * 4) = (u32x2){pack2(ov[0], ov[1]), pack2(ov[2], ov[3])};
    }
  }
}

DI void phase2(const Params& P, char* smem) {
  constexpr int N_SA = 128, N_PA = 8192, N_PB = 8192, N_SB = 128;
  float bound_a, bound_b;
  {
    const int lane = threadIdx.x & 63;
    float qa = fabsf(P.qn_a[lane]), ka = fabsf(P.kn_a[lane]), qb = fabsf(P.qn_b[lane]), kb = fabsf(P.kn_b[lane]), rb = 0.f;
    for (int i = lane; i < 8 * 257; i += 64) rb = fmaxf(rb, fabsf(P.relb[i]));
#pragma unroll
    for (int o = 32; o; o >>= 1) {
      qa = fmaxf(qa, __shfl_xor(qa, o)); ka = fmaxf(ka, __shfl_xor(ka, o));
      qb = fmaxf(qb, __shfl_xor(qb, o)); kb = fmaxf(kb, __shfl_xor(kb, o));
      rb = fmaxf(rb, __shfl_xor(rb, o));
    }
    bound_a = 8.f * qa * ka * LOG2E;
    bound_b = (8.f * qb * kb + rb) * LOG2E;
  }
  for (int it = blockIdx.x; it < N_SA + N_PA + N_PB + N_SB; it += gridDim.x) {
    int u = it;
    if (u < N_SA) { attn_sample_item<0>(P, smem, u >> 3, u & 7, bound_a); continue; }
    u -= N_SA;
    if (u < N_PA) { int qt = 31 - (u >> 8), bh = u & 255; attn_prompt_item<0>(P, smem, bh >> 3, bh & 7, qt, bound_a); continue; }
    u -= N_PA;
    if (u < N_PB) { int qt = 31 - (u >> 8), bh = u & 255; attn_prompt_item<1>(P, smem, bh >> 3, bh & 7, qt, bound_b); continue; }
    u -= N_PB;
    attn_sample_item<1>(P, smem, u >> 3, u & 7, bound_b);
  }
}

DI void phase3_tile(const Params& P, int mt, int nt, char* smem) {
  const int tid = threadIdx.x, lane = tid & 63, w = tid >> 6, wm = w >> 1, wn = w & 1, r = lane & 15, quad = lane >> 4;
  const int m0 = mt * 128, n0 = nt * 128;
  char* ws = P.ws;
  const u16* YA = (const u16*)(ws + W_XB);
  const u16* YB = YA + (size_t)TT * 512;
  const u16* GA = (const u16*)(ws + W_GA);
  const u16* GB = (const u16*)(ws + W_GB);
  u16* MRG = (u16*)(ws + W_QKV);
  f32x4 acc[4][4];
  zero_acc(acc);
  gemm_mainloop(YA + (size_t)m0 * 512, 512, (const u16*)(ws + W_WUPA) + (size_t)n0 * 512, 512, 512, (u16*)smem, acc);
  float* Cs = (float*)smem;
  const int c4 = tid & 31, rsub = tid >> 5;
  const size_t tofs = (size_t)m0 * 1024 + n0 + c4 * 4;
  stage_acc(acc, Cs);
#pragma unroll 4
  for (int p = 0; p < 16; p++) {
    const int row = p * 8 + rsub;
    const f32x4 v = *(const f32x4*)(Cs + row * CSTR + c4 * 4);
    const f32x4 gv = unpack4(*(const u32x2*)(GA + tofs + (size_t)row * 1024));
    *(u32x2*)(MRG + tofs + (size_t)row * 1024) = pack4(v * gv);
  }
  zero_acc(acc);
  gemm_mainloop(YB + (size_t)m0 * 512, 512, (const u16*)(ws + W_WUPB) + (size_t)n0 * 512, 512, 512, (u16*)smem, acc);
  stage_acc(acc, Cs);
#pragma unroll 4
  for (int p = 0; p < 16; p++) {
    const int row = p * 8 + rsub;
    const f32x4 v = *(const f32x4*)(Cs + row * CSTR + c4 * 4);
    const f32x4 gv = unpack4(*(const u32x2*)(GB + tofs + (size_t)row * 1024));
    const f32x4 m1 = unpack4(*(const u32x2*)(MRG + tofs + (size_t)row * 1024));
    *(u32x2*)(MRG + tofs + (size_t)row * 1024) = pack4(m1 + v * gv);
  }
}

DI void phase4_tile(const Params& P, int mt, int nt, char* smem) {
  const int tid = threadIdx.x, lane = tid & 63, w = tid >> 6, wm = w >> 1, wn = w & 1, r = lane & 15, quad = lane >> 4;
  const int m0 = mt * 128, n0 = nt * 128;
  char* ws = P.ws;
  const u16* MRG = (const u16*)(ws + W_QKV);
  u16* H1B = (u16*)(ws + W_QKV + SZ_ACT);
  float* SSQ2 = (float*)(ws + W_SSQ2);
  f32x4 acc[4][4];
  zero_acc(acc);
  gemm_mainloop(MRG + (size_t)m0 * 1024, 1024, (const u16*)(ws + W_WOUT) + (size_t)n0 * 1024, 1024, 1024, (u16*)smem, acc);
  const float* xb = m0 < TP ? P.x_p : P.x_s - (size_t)TP * 1024;
  float* Cs = (float*)smem;
  const int c4 = tid & 31, rsub = tid >> 5;
  const size_t tofs = (size_t)m0 * 1024 + n0 + c4 * 4;
  stage_acc(acc, Cs);
#pragma unroll 4
  for (int p = 0; p < 16; p++) {
    const int row = p * 8 + rsub;
    const f32x4 v = *(const f32x4*)(Cs + row * CSTR + c4 * 4);
    const f32x4 h1 = *(const f32x4*)(xb + tofs + (size_t)row * 1024) + v;
    *(u32x2*)(H1B + tofs + (size_t)row * 1024) = pack4(h1);
    float ss = h1.x * h1.x + h1.y * h1.y + h1.z * h1.z + h1.w * h1.w;
    ss += __shfl_xor(ss, 1);
    ss += __shfl_xor(ss, 2);
    ss += __shfl_xor(ss, 4);
    ss += __shfl_xor(ss, 8);
    ss += __shfl_xor(ss, 16);
    if (c4 == 0) SSQ2[(size_t)(m0 + row) * 16 + nt] = ss;
  }
}

DI void phase5_tile(const Params& P, int mt, int nt, char* smem) {
  const int tid = threadIdx.x, lane = tid & 63, w = tid >> 6, wm = w >> 1, wn = w & 1, r = lane & 15, quad = lane >> 4;
  const int m0 = mt * 128, n0 = nt * 128;
  char* ws = P.ws;
  const u16* H1B = (const u16*)(ws + W_QKV + SZ_ACT);
  u16* QP = (u16*)(ws + W_QKV + 2 * SZ_ACT);
  const float* SSQ2 = (const float*)(ws + W_SSQ2);
  float* rs_s = (float*)(smem + RS_OFF);
  __syncthreads();
  if (tid < 128) {
    float s = 0.f;
#pragma unroll
    for (int i = 0; i < 8; i++) s += SSQ2[(size_t)(m0 + tid) * 16 + i];
    rs_s[tid] = rsqrtf(s * (1.f / 1024.f) + EPS);
  }
  f32x4 acc[4][4];
  zero_acc(acc);
  gemm_mainloop(H1B + (size_t)m0 * 1024, 1024, (const u16*)(ws + W_WQ) + (size_t)n0 * 1024, 1024, 1024, (u16*)smem, acc);
  float* Cs = (float*)smem;
  const int c4 = tid & 31, rsub = tid >> 5;
  const size_t tofs = (size_t)m0 * 1024 + n0 + c4 * 4;
  stage_acc(acc, Cs);
#pragma unroll 4
  for (int p = 0; p < 16; p++) {
    const int row = p * 8 + rsub;
    const f32x4 v = *(const f32x4*)(Cs + row * CSTR + c4 * 4) * rs_s[row];
    *(u32x2*)(QP + tofs + (size_t)row * 1024) = pack4(v);
  }
}

DI void bitonic_merge16(u32 (&L)[16]) {
#pragma unroll
  for (int st = 8; st >= 1; st >>= 1)
#pragma unroll
    for (int i = 0; i < 16; i++)
      if ((i & st) == 0) { u32 hi = max(L[i], L[i + st]); u32 lo = min(L[i], L[i + st]); L[i] = hi; L[i + st] = lo; }
}
DI void bitonic_sort16(u32 (&L)[16]) {
#pragma unroll
  for (int k = 2; k <= 16; k <<= 1)
#pragma unroll
    for (int j = k >> 1; j > 0; j >>= 1)
#pragma unroll
      for (int i = 0; i < 16; i++) {
        const int l = i ^ j;
        if (l > i) {
          const u32 hi = max(L[i], L[l]), lo = min(L[i], L[l]);
          if ((i & k) == 0) { L[i] = hi; L[l] = lo; } else { L[i] = lo; L[l] = hi; }
        }
      }
}
DI void phase6a_unit(const Params& P, int unit, char* smem) {
  const int tid = threadIdx.x, lane = tid & 63, w = tid >> 6, r = lane & 15, quad = lane >> 4;
  char* ws = P.ws;
  const u16* QP = (const u16*)(ws + W_QKV + 2 * SZ_ACT);
  const u16* SK = (const u16*)(ws + W_SK);
  u16* IDXo = (u16*)(ws + W_IDX);
  float* Go = (float*)(ws + W_G);
  float* sc = (float*)smem;
  u32* hl = (u32*)smem;
  u32* xl = (u32*)smem + 256 * 17;
  u32* lists = (u32*)(smem + 128 * 129 * 4);
  unsigned char* tabi = (unsigned char*)(smem + 128 * 129 * 4 + 128 * 17 * 4);
  unsigned char* tabj = tabi + 64;
  const int tok0 = unit * 64;
  __syncthreads();
  if (tid == 0) {
    int c = 0;
    for (int i = 0; i < 16; i++)
      for (int j = i + 1; j < 16; j++)
        if ((i + 1) * (j + 1) <= 16) { tabi[c] = (unsigned char)i; tabj[c] = (unsigned char)j; tabi[32 + c] = (unsigned char)j; tabj[32 + c] = (unsigned char)i; c++; }
    tabi[23] = 0; tabj[23] = 0; tabi[24] = 1; tabj[24] = 1;
    tabi[55] = 2; tabj[55] = 2; tabi[56] = 3; tabj[56] = 3;
  }
  for (int h = 0; h < 8; h++) {
#pragma unroll
    for (int p = 0; p < 2; p++) {
      const int hp = h * 2 + p;
      bf16x8 qf[2];
#pragma unroll
      for (int ks = 0; ks < 2; ks++)
        qf[ks] = *(const bf16x8*)(QP + (size_t)(tok0 + w * 16 + r) * 1024 + hp * 64 + ks * 32 + quad * 8);
#pragma unroll
      for (int nt = 0; nt < 8; nt++) {
        f32x4 a4 = (f32x4){0.f, 0.f, 0.f, 0.f};
#pragma unroll
        for (int ks = 0; ks < 2; ks++) {
          bf16x8 kf = *(const bf16x8*)(SK + (size_t)(hp * 128 + nt * 16 + r) * 64 + ks * 32 + quad * 8);
          a4 = mfma16(kf, qf[ks], a4);
        }
        float* d = sc + (p * 64 + w * 16 + r) * 129 + nt * 16 + quad * 4;
        d[0] = a4[0]; d[1] = a4[1]; d[2] = a4[2]; d[3] = a4[3];
      }
    }
    __syncthreads();
    u32 L[16];
    {
      const int inst = tid & 127, half = tid >> 7;
      const float* row = sc + inst * 129 + half * 64;
#pragma unroll
      for (int i = 0; i < 16; i++) L[i] = (mono(row[i]) & ~127u) | (u32)(half * 64 + i);
      bitonic_sort16(L);
#pragma unroll 1
      for (int c = 1; c < 4; c++) {
        u32 N[16];
#pragma unroll
        for (int i = 0; i < 16; i++) N[i] = (mono(row[c * 16 + i]) & ~127u) | (u32)(half * 64 + c * 16 + i);
        bitonic_sort16(N);
#pragma unroll
        for (int i = 0; i < 16; i++) L[i] = max(L[i], N[15 - i]);
        bitonic_merge16(L);
      }
    }
    __syncthreads();
#pragma unroll
    for (int s = 0; s < 16; s++) hl[tid * 17 + s] = L[s];
    __syncthreads();
    if (tid < 128) {
      u32 M[16];
#pragma unroll
      for (int s = 0; s < 16; s++) M[s] = max(L[s], hl[(tid + 128) * 17 + 15 - s]);
      bitonic_merge16(M);
#pragma unroll
      for (int s = 0; s < 16; s++) lists[tid * 17 + s] = M[s];
    }
    __syncthreads();
    if (tid < 128) {
      const int tok = tid & 63;
      const bool part = tid >= 64;
      float fa[16], fb[16];
#pragma unroll
      for (int s = 0; s < 16; s++) {
        const float va = unmono(lists[tok * 17 + s] & ~127u);
        const float vb = unmono(lists[(64 + tok) * 17 + s] & ~127u);
        fa[s] = part ? vb : va;
        fb[s] = part ? va : vb;
      }
      u32 L2[16];
#pragma unroll
      for (int s = 0; s < 16; s++) L2[s] = 0u;
      const u32 cbase = part ? 32u : 0u;
      {
        int c = 0;
#pragma unroll
        for (int i = 0; i < 16; i++)
#pragma unroll
          for (int j = i + 1; j < 16; j++)
            if ((i + 1) * (j + 1) <= 16) {
              insert16(L2, (mono(fa[i] + fb[j]) & ~63u) | (cbase + (u32)c));
              c++;
            }
      }
      insert16(L2, (mono(part ? fa[2] + fb[2] : fa[0] + fb[0]) & ~63u) | (cbase + 23u));
      insert16(L2, (mono(part ? fa[3] + fb[3] : fa[1] + fb[1]) & ~63u) | (cbase + 24u));
#pragma unroll
      for (int s = 0; s < 16; s++) xl[tid * 17 + s] = L2[s];
    }
    __syncthreads();
    if (tid < 64) {
      float val[16];
      u32 idx[16];
      float mx = -1e30f;
#pragma unroll
      for (int s = 0; s < 16; s++) {
        const u32 m = max(xl[tid * 17 + s], xl[(tid + 64) * 17 + 15 - s]);
        const u32 sl = m & 63u;
        const int i = tabi[sl], j = tabj[sl];
        const u32 au = lists[tid * 17 + i], bu = lists[(64 + tid) * 17 + j];
        val[s] = unmono(au & ~127u) + unmono(bu & ~127u);
        idx[s] = (au & 127u) * 128u + (bu & 127u);
        mx = fmaxf(mx, val[s]);
      }
      float sum = 0.f;
#pragma unroll
      for (int s = 0; s < 16; s++) { val[s] = __expf(val[s] - mx); sum += val[s]; }
      const float inv = 1.f / sum;
      const size_t so = ((size_t)(tok0 + tid) * 8 + h) * 16;
      {
        u32* ib = (u32*)(IDXo + (size_t)(tok0 + tid) * 128 + h * 2);
#pragma unroll
        for (int gg = 0; gg < 8; gg++) ib[gg * 8] = idx[gg] | (idx[gg + 8] << 16);
      }
#pragma unroll
      for (int s = 0; s < 4; s++)
        *(f32x4*)(Go + so + s * 4) = (f32x4){val[s * 4] * inv, val[s * 4 + 1] * inv, val[s * 4 + 2] * inv, val[s * 4 + 3] * inv};
    }
    __syncthreads();
  }
}

typedef float f32x2 __attribute__((ext_vector_type(2)));
DI float dot4_fp8(u32 w, float x0, float x1, float x2, float x3, float acc) {
  f32x2 lo = __builtin_amdgcn_cvt_pk_f32_fp8((int)w, false);
  f32x2 hi = __builtin_amdgcn_cvt_pk_f32_fp8((int)w, true);
  acc = fmaf(lo[0], x0, acc);
  acc = fmaf(lo[1], x1, acc);
  acc = fmaf(hi[0], x2, acc);
  acc = fmaf(hi[1], x3, acc);
  return acc;
}
DI void axpy4_fp8(u32 w, float wgt, float& o0, float& o1, float& o2, float& o3) {
  f32x2 lo = __builtin_amdgcn_cvt_pk_f32_fp8((int)w, false);
  f32x2 hi = __builtin_amdgcn_cvt_pk_f32_fp8((int)w, true);
  o0 = fmaf(wgt, lo[0], o0);
  o1 = fmaf(wgt, lo[1], o1);
  o2 = fmaf(wgt, hi[0], o2);
  o3 = fmaf(wgt, hi[1], o3);
}

struct RowSet { u32x4 r[16]; };
DI void gather_rows(RowSet& R, const unsigned char* base, u32 lofs, u32x4 ea, u32x4 eb) {
  const u32 ev[8] = {ea.x, ea.y, ea.z, ea.w, eb.x, eb.y, eb.z, eb.w};
#pragma unroll
  for (int i = 0; i < 8; i++) {
    R.r[2 * i] = *(const u32x4*)(base + (((ev[i] & 0xffffu) << 7) + lofs));
    R.r[2 * i + 1] = *(const u32x4*)(base + (((ev[i] >> 16) << 7) + lofs));
  }
}
DI void b1_compute(const RowSet& R, u32x4 xa, u32x4 xb, u16* pr, int c, bool valid) {
  float xf[16];
  xf[0] = __uint_as_float(xa.x << 16); xf[1] = __uint_as_float(xa.x & 0xffff0000u);
  xf[2] = __uint_as_float(xa.y << 16); xf[3] = __uint_as_float(xa.y & 0xffff0000u);
  xf[4] = __uint_as_float(xa.z << 16); xf[5] = __uint_as_float(xa.z & 0xffff0000u);
  xf[6] = __uint_as_float(xa.w << 16); xf[7] = __uint_as_float(xa.w & 0xffff0000u);
  xf[8] = __uint_as_float(xb.x << 16); xf[9] = __uint_as_float(xb.x & 0xffff0000u);
  xf[10] = __uint_as_float(xb.y << 16); xf[11] = __uint_as_float(xb.y & 0xffff0000u);
  xf[12] = __uint_as_float(xb.z << 16); xf[13] = __uint_as_float(xb.z & 0xffff0000u);
  xf[14] = __uint_as_float(xb.w << 16); xf[15] = __uint_as_float(xb.w & 0xffff0000u);
  float p[16];
#pragma unroll
  for (int i = 0; i < 16; i++) {
    float a = dot4_fp8(R.r[i].x, xf[0], xf[1], xf[2], xf[3], 0.f);
    a = dot4_fp8(R.r[i].y, xf[4], xf[5], xf[6], xf[7], a);
    a = dot4_fp8(R.r[i].z, xf[8], xf[9], xf[10], xf[11], a);
    a = dot4_fp8(R.r[i].w, xf[12], xf[13], xf[14], xf[15], a);
    p[i] = a;
  }
#pragma unroll
  for (int i = 0; i < 8; i++) { float keep = (c & 4) ? p[i + 8] : p[i]; float send = (c & 4) ? p[i] : p[i + 8]; p[i] = keep + __shfl_xor(send, 4); }
#pragma unroll
  for (int i = 0; i < 4; i++) { float keep = (c & 2) ? p[i + 4] : p[i]; float send = (c & 2) ? p[i] : p[i + 4]; p[i] = keep + __shfl_xor(send, 2); }
#pragma unroll
  for (int i = 0; i < 2; i++) { float keep = (c & 1) ? p[i + 2] : p[i]; float send = (c & 1) ? p[i] : p[i + 2]; p[i] = keep + __shfl_xor(send, 1); }
  const int it0 = 2 * (c & 1) + 4 * ((c >> 1) & 1) + 8 * ((c >> 2) & 1);
  if (valid) {
    pr[it0 * 8] = f2bf(p[0]);
    pr[(it0 + 1) * 8] = f2bf(p[1]);
  }
}
DI void phase6b1(const Params& P) {
  const int lane = threadIdx.x & 63, g = lane >> 3, c = lane & 7;
  const int x = blockIdx.x & 7;
  const int wg = (blockIdx.x >> 3) * 4 + (threadIdx.x >> 6), nwg = (gridDim.x >> 3) * 4;
  char* ws = P.ws;
  const u16* H1B = (const u16*)(ws + W_QKV + SZ_ACT) + x * 128 + c * 16;
  const unsigned char* U8 = (const unsigned char*)(ws + W_UB) + ((size_t)x << 21);
  const u32 lofs = c * 16;
  const u16* IDX = (const u16*)(ws + W_IDX) + g * 16;
  u16* PH = ph_slice(ws, x) + g;
  const int n = (TT - wg + nwg - 1) / nwg;
#define TOK(i) min(wg + (i) * nwg, TT - 1)
  int t0 = TOK(0), t1 = TOK(1);
  u32x4 eA0 = *(const u32x4*)(IDX + (size_t)t0 * 128), eA1 = *(const u32x4*)(IDX + (size_t)t0 * 128 + 8);
  u32x4 eB0 = *(const u32x4*)(IDX + (size_t)t1 * 128), eB1 = *(const u32x4*)(IDX + (size_t)t1 * 128 + 8);
  RowSet RA, RB;
  gather_rows(RA, U8, lofs, eA0, eA1);
  u32x4 xA0 = *(const u32x4*)(H1B + (size_t)t0 * 1024), xA1 = *(const u32x4*)(H1B + (size_t)t0 * 1024 + 8);
#pragma unroll 1
  for (int i = 0; i < n; i += 2) {
    gather_rows(RB, U8, lofs, eB0, eB1);
    const u32x4 xB0 = *(const u32x4*)(H1B + (size_t)t1 * 1024), xB1 = *(const u32x4*)(H1B + (size_t)t1 * 1024 + 8);
    const int t2 = TOK(i + 2);
    eA0 = *(const u32x4*)(IDX + (size_t)t2 * 128);
    eA1 = *(const u32x4*)(IDX + (size_t)t2 * 128 + 8);
    b1_compute(RA, xA0, xA1, PH + (size_t)t0 * 128, c, true);
    gather_rows(RA, U8, lofs, eA0, eA1);
    xA0 = *(const u32x4*)(H1B + (size_t)t2 * 1024);
    xA1 = *(const u32x4*)(H1B + (size_t)t2 * 1024 + 8);
    const int t3 = TOK(i + 3);
    eB0 = *(const u32x4*)(IDX + (size_t)t3 * 128);
    eB1 = *(const u32x4*)(IDX + (size_t)t3 * 128 + 8);
    b1_compute(RB, xB0, xB1, PH + (size_t)t1 * 128, c, i + 1 < n);
    t0 = t2;
    t1 = t3;
  }
}

DI void phase6w(const Params& P) {
  const int lane = threadIdx.x & 63;
  const int gw = blockIdx.x * 4 + (threadIdx.x >> 6), nw = gridDim.x * 4;
  char* ws = P.ws;
  float* G = (float*)(ws + W_G);
  const float* SSQ2 = (const float*)(ws + W_SSQ2);
  for (int t = gw; t < TT; t += nw) {
    float ssq = lane < 8 ? SSQ2[(size_t)t * 16 + lane] : 0.f;
    float h0 = 0.f, h1v = 0.f;
    {
      const u16* ph = (const u16*)(ws + W_XB) + (size_t)t * 128 + lane;
#pragma unroll
      for (int xs = 0; xs < 8; xs++) { h0 += bf2f(ph[(size_t)xs * (SZ_PH / 2)]); h1v += bf2f(ph[(size_t)xs * (SZ_PH / 2) + 64]); }
    }
    const float g0 = G[(size_t)t * 128 + lane];
    const float g1 = G[(size_t)t * 128 + 64 + lane];
    const float rs2 = rsqrtf(wave_sum(ssq) * (1.f / 1024.f) + EPS);
    const float w0 = g0 * gelu_tanh(rs2 * (1.f / U_SCALE) * h0) * (1.f / V_SCALE);
    const float w1 = g1 * gelu_tanh(rs2 * (1.f / U_SCALE) * h1v) * (1.f / V_SCALE);
    u16* wrow = (u16*)(G + (size_t)t * 128);
    wrow[(lane & 7) * 16 + (lane >> 3)] = f2bf(w0);
    wrow[(lane & 7) * 16 + 8 + (lane >> 3)] = f2bf(w1);
  }
}

DI void b2_compute(const RowSet& R, u32x4 w0, u32x4 w1, u16* hb, float* sq, int g, int lane, bool valid) {
  const u32 hraw = *(const u32*)hb;
  const u32 wv[8] = {w0.x, w0.y, w0.z, w0.w, w1.x, w1.y, w1.z, w1.w};
  float o[16];
#pragma unroll
  for (int i = 0; i < 16; i++) o[i] = 0.f;
#pragma unroll
  for (int i = 0; i < 16; i++) {
    u32 r0 = R.r[i].x, r1 = R.r[i].y, r2 = R.r[i].z, r3 = R.r[i].w;
    asm volatile("" : "+v"(r0), "+v"(r1), "+v"(r2), "+v"(r3) : "v"(o[0]), "v"(o[15]));
    const float wgt = (i & 1) ? __uint_as_float(wv[i >> 1] & 0xffff0000u) : __uint_as_float(wv[i >> 1] << 16);
    axpy4_fp8(r0, wgt, o[0], o[1], o[2], o[3]);
    axpy4_fp8(r1, wgt, o[4], o[5], o[6], o[7]);
    axpy4_fp8(r2, wgt, o[8], o[9], o[10], o[11]);
    axpy4_fp8(r3, wgt, o[12], o[13], o[14], o[15]);
  }
#pragma unroll
  for (int i = 0; i < 8; i++) { float keep = (g & 4) ? o[i + 8] : o[i]; float send = (g & 4) ? o[i] : o[i + 8]; o[i] = keep + __shfl_xor(send, 32); }
#pragma unroll
  for (int i = 0; i < 4; i++) { float keep = (g & 2) ? o[i + 4] : o[i]; float send = (g & 2) ? o[i] : o[i + 4]; o[i] = keep + __shfl_xor(send, 16); }
#pragma unroll
  for (int i = 0; i < 2; i++) { float keep = (g & 1) ? o[i + 2] : o[i]; float send = (g & 1) ? o[i] : o[i + 2]; o[i] = keep + __shfl_xor(send, 8); }
  const float a0 = __uint_as_float(hraw << 16) + o[0], a1 = __uint_as_float(hraw & 0xffff0000u) + o[1];
  const float ss = wave_sum(a0 * a0 + a1 * a1);
  if (valid) {
    *(u32*)hb = pack2(a0, a1);
    if (lane == 0) *sq = ss;
  }
}
DI void phase6b2(const Params& P) {
  const int lane = threadIdx.x & 63, g = lane >> 3, c = lane & 7, w = threadIdx.x >> 6;
  const int x = blockIdx.x & 7;
  const int wg = (blockIdx.x >> 3) * 4 + w, nwg = (gridDim.x >> 3) * 4;
  char* ws = P.ws;
  const int col = x * 128 + c * 16 + 2 * (g & 1) + 4 * ((g >> 1) & 1) + 8 * ((g >> 2) & 1);
  u16* H1B = (u16*)(ws + W_QKV + SZ_ACT) + col;
  const unsigned char* V8 = (const unsigned char*)(ws + W_VB) + ((size_t)x << 21);
  const u32 lofs = c * 16;
  const u16* IDX = (const u16*)(ws + W_IDX) + g * 16;
  const u16* WG = (const u16*)(ws + W_G) + g * 16;
  float* SSQ3 = (float*)(ws + W_SSQ3) + x;
  const int n = (TT - wg + nwg - 1) / nwg;
  int t0 = TOK(0), t1 = TOK(1);
  u32x4 eA0 = *(const u32x4*)(IDX + (size_t)t0 * 128), eA1 = *(const u32x4*)(IDX + (size_t)t0 * 128 + 8);
  u32x4 eB0 = *(const u32x4*)(IDX + (size_t)t1 * 128), eB1 = *(const u32x4*)(IDX + (size_t)t1 * 128 + 8);
  RowSet RA, RB;
  gather_rows(RA, V8, lofs, eA0, eA1);
  u32x4 wA0 = *(const u32x4*)(WG + (size_t)t0 * 256), wA1 = *(const u32x4*)(WG + (size_t)t0 * 256 + 8);
#pragma unroll 1
  for (int i = 0; i < n; i += 2) {
    gather_rows(RB, V8, lofs, eB0, eB1);
    const u32x4 wB0 = *(const u32x4*)(WG + (size_t)t1 * 256), wB1 = *(const u32x4*)(WG + (size_t)t1 * 256 + 8);
    const int t2 = TOK(i + 2);
    eA0 = *(const u32x4*)(IDX + (size_t)t2 * 128);
    eA1 = *(const u32x4*)(IDX + (size_t)t2 * 128 + 8);
    b2_compute(RA, wA0, wA1, H1B + (size_t)t0 * 1024, SSQ3 + (size_t)t0 * 8, g, lane, true);
    gather_rows(RA, V8, lofs, eA0, eA1);
    wA0 = *(const u32x4*)(WG + (size_t)t2 * 256);
    wA1 = *(const u32x4*)(WG + (size_t)t2 * 256 + 8);
    const int t3 = TOK(i + 3);
    eB0 = *(const u32x4*)(IDX + (size_t)t3 * 128);
    eB1 = *(const u32x4*)(IDX + (size_t)t3 * 128 + 8);
    b2_compute(RB, wB0, wB1, H1B + (size_t)t1 * 1024, SSQ3 + (size_t)t1 * 8, g, lane, i + 1 < n);
    t0 = t2;
    t1 = t3;
  }
#undef TOK
}

DI void phase7_tile(const Params& P, int mt, int nt, char* smem) {
  const int tid = threadIdx.x, lane = tid & 63, w = tid >> 6, wm = w >> 1, wn = w & 1, r = lane & 15, quad = lane >> 4;
  const int m0 = mt * 128, n0 = nt * 128;
  char* ws = P.ws;
  const u16* H2B = (const u16*)(ws + W_QKV + SZ_ACT);
  const u16* PB = (const u16*)(ws + W_PB);
  const float* SSQ3 = (const float*)(ws + W_SSQ3);
  float* rs_s = (float*)(smem + RS_OFF);
  __syncthreads();
  if (tid < 128) {
    float q = 0.f;
#pragma unroll
    for (int i = 0; i < 8; i++) q += SSQ3[(size_t)(m0 + tid) * 8 + i];
    rs_s[tid] = rsqrtf(q * (1.f / 1024.f) + EPS);
  }
  u16* PJ = (u16*)(ws + W_QKV);
  f32x4 acc[4][4];
  zero_acc(acc);
  gemm_mainloop(PB + (size_t)m0 * 256, 256, (const u16*)(ws + W_WPP) + (size_t)n0 * 256, 256, 256, (u16*)smem, acc);
  float* Cs = (float*)smem;
  const int c4 = tid & 31, rsub = tid >> 5;
  const size_t tofs = (size_t)m0 * 1024 + n0 + c4 * 4;
  stage_acc(acc, Cs);
#pragma unroll 4
  for (int p = 0; p < 16; p++) {
    const int row = p * 8 + rsub;
    *(u32x2*)(PJ + tofs + (size_t)row * 1024) = pack4(*(const f32x4*)(Cs + row * CSTR + c4 * 4));
  }
  zero_acc(acc);
  gemm_mainloop(H2B + (size_t)m0 * 1024, 1024, (const u16*)(ws + W_WG) + (size_t)n0 * 1024, 1024, 1024, (u16*)smem, acc);
  stage_acc(acc, Cs);
#pragma unroll 4
  for (int p = 0; p < 16; p++) {
    const int row = p * 8 + rsub;
    const f32x4 v = *(const f32x4*)(Cs + row * CSTR + c4 * 4) * rs_s[row];
    const f32x4 pj = unpack4(*(const u32x2*)(PJ + tofs + (size_t)row * 1024));
    const f32x4 h2 = unpack4(*(const u32x2*)(H2B + tofs + (size_t)row * 1024));
    const f32x4 gate = (f32x4){sigmoidf_(v.x), sigmoidf_(v.y), sigmoidf_(v.z), sigmoidf_(v.w)};
    __builtin_nontemporal_store(h2 + gate * pj, (f32x4*)(P.out + tofs + (size_t)row * 1024));
  }
}

DI void late_convert(const Params& P, int kind, int skip) {
  if ((int)blockIdx.x < skip) return;
  const int nb = gridDim.x - skip, b = blockIdx.x - skip;
  char* ws = P.ws;
  if (kind == 0) {
    for (int t = b; t < 4096; t += nb) conv_unit_fp8(P.peer_u, (unsigned char*)(ws + W_UB), (size_t)t * 4096, P.g_ffn, U_SCALE);
  } else if (kind == 1) {
    for (int t = b; t < 4096; t += nb) conv_unit_fp8(P.peer_v, (unsigned char*)(ws + W_VB), (size_t)t * 4096, nullptr, V_SCALE);
  } else {
    for (int t = b; t < 4096 + 16; t += nb) {
      if (t < 4096) conv_unit(P.p_p, (u16*)(ws + W_PB), (size_t)t * 4096, nullptr);
      else conv_unit(P.p_s, (u16*)(ws + W_PB) + (size_t)TP * 256, (size_t)(t - 4096) * 4096, nullptr);
    }
  }
}

#define GEMM_TILES(NT, FN)                                                              \
  {                                                                                     \
    for (int t = blockIdx.x; t < 2 * (NT); t += gridDim.x) FN(P, 512 + t / (NT), t % (NT), smem); \
    const int x_ = blockIdx.x & 7, bpx_ = gridDim.x >> 3;                               \
    constexpr int NG_ = (NT) / 8;                                                       \
    for (int s_ = blockIdx.x >> 3; s_ < 64 * 8 * NG_; s_ += bpx_) {                     \
      const int R_ = s_ >> 6, q_ = s_ & 63;                                             \
      const int mg_ = R_ / NG_, ng_ = R_ % NG_;                                         \
      FN(P, ((mg_ * 8 + (q_ >> 3)) << 3) + x_, ng_ * 8 + (q_ & 7), smem);               \
    }                                                                                   \
  }

DI unsigned xcc_id() { return (unsigned)__builtin_amdgcn_s_getreg((3 << 11) | 20) & 0xFu; }
DI void grid_barrier(unsigned* bar, int k, const unsigned* st) {
  asm volatile("s_waitcnt vmcnt(0)" ::: "memory");
  __syncthreads();
  if (threadIdx.x == 0) {
    const unsigned nloc = st[0], nx = st[1], x = st[2];
    unsigned* slot = bar + k * BAR_SLOT;
    const unsigned old = __hip_atomic_fetch_add(slot + x * 64, 1u, __ATOMIC_RELAXED, __HIP_MEMORY_SCOPE_AGENT);
    if (old + 1u == nloc) {
      __builtin_amdgcn_fence(__ATOMIC_RELEASE, "agent");
      asm volatile("s_waitcnt vmcnt(0)" ::: "memory");
      __hip_atomic_fetch_add(slot + 16 * 64, 1u, __ATOMIC_RELAXED, __HIP_MEMORY_SCOPE_AGENT);
    }
    unsigned spins = 0;
    while (__hip_atomic_load(slot + 16 * 64, __ATOMIC_RELAXED, __HIP_MEMORY_SCOPE_AGENT) < nx) {
      __builtin_amdgcn_s_sleep(1);
      if (++spins > (1u << 24)) break;
    }
    __builtin_amdgcn_fence(__ATOMIC_ACQUIRE, "agent");
    asm volatile("s_waitcnt vmcnt(0)" ::: "memory");
  }
  __syncthreads();
}

__global__ void __launch_bounds__(256, 2) fwd_megakernel(Params P) {
  __shared__ __attribute__((aligned(16))) char smem[SMEM_BYTES];
  cg::grid_group grid = cg::this_grid();
  unsigned* bar = (unsigned*)(P.ws + W_BAR);
  __shared__ unsigned bst[4];
  unsigned* census = bar + 16 * BAR_SLOT;
  if (threadIdx.x == 0) {
    bst[2] = xcc_id();
    __hip_atomic_fetch_add(census + bst[2] * 64, 1u, __ATOMIC_RELAXED, __HIP_MEMORY_SCOPE_AGENT);
  }
  phase0(P, smem);
  if (P.out == nullptr) grid.sync();
  if (threadIdx.x == 0) {
    unsigned spins = 0;
    for (;;) {
      unsigned sum = 0, nx = 0, mine = 0;
      for (unsigned j = 0; j < 16; j++) {
        const unsigned c = __hip_atomic_load(census + j * 64, __ATOMIC_RELAXED, __HIP_MEMORY_SCOPE_AGENT);
        sum += c; nx += c ? 1u : 0u; mine = (j == bst[2]) ? c : mine;
      }
      bst[0] = mine; bst[1] = nx;
      if (sum == gridDim.x || ++spins > (1u << 22)) break;
      __builtin_amdgcn_s_sleep(1);
    }
  }
  __syncthreads();
  grid_barrier(bar, 15, bst);
  phase1_scans(P);
  GEMM_TILES(40, phase1_tile)
  late_convert(P, 0, 80);
  grid_barrier(bar, 0, bst);
  phase2(P, smem);
  grid_barrier(bar, 1, bst);
  GEMM_TILES(8, phase3_tile)
  late_convert(P, 1, 16);
  grid_barrier(bar, 2, bst);
  GEMM_TILES(8, phase4_tile)
  late_convert(P, 2, 16);
  grid_barrier(bar, 3, bst);
  GEMM_TILES(8, phase5_tile)
  grid_barrier(bar, 4, bst);
  for (int t = blockIdx.x; t < TT / 64; t += gridDim.x) phase6a_unit(P, t, smem);
  grid_barrier(bar, 5, bst);
  phase6b1(P);
  grid_barrier(bar, 6, bst);
  phase6w(P);
  grid_barrier(bar, 7, bst);
  phase6b2(P);
  grid_barrier(bar, 8, bst);
  GEMM_TILES(8, phase7_tile)
}

extern "C" void kernel_launch(void* const* d_in, const int* in_sizes, int n_in, void* d_out, int out_size, void* d_ws,
                              size_t ws_size, hipStream_t stream) {
  static int grid_blocks = 0;
  if (!grid_blocks) {
    int dev = 0, cus = 0, per_cu = 0;
    hipGetDevice(&dev);
    hipDeviceGetAttribute(&cus, hipDeviceAttributeMultiprocessorCount, dev);
    hipOccupancyMaxActiveBlocksPerMultiprocessor(&per_cu, fwd_megakernel, 256, 0);
    if (per_cu > 2) per_cu = 2;
    if (per_cu < 1) per_cu = 1;
    grid_blocks = cus * per_cu;
  }
  if (ws_size < W_END) { fprintf(stderr, "workspace too small: %zu < %zu\n", ws_size, (size_t)W_END); return; }
  Params p{};
  const float** pf = (const float**)&p;
  for (int i = 0; i < 28; i++) pf[i] = (const float*)d_in[i];
  p.out = (float*)d_out;
  p.ws = (char*)d_ws;
  hipMemsetAsync((char*)d_ws + W_BAR, 0, BAR_BYTES, stream);
  void* args[] = {&p};
  hipError_t e = hipLaunchCooperativeKernel((void*)fwd_megakernel, dim3(grid_blocks), dim3(256), args, 0, stream);
  if (e != hipSuccess) fprintf(stderr, "cooperative launch failed: %s (grid %d)\n", hipGetErrorString(e), grid_blocks);
}
```

```cpp
#include <hip/hip_runtime.h>
#include <hip/hip_cooperative_groups.h>
#include <cstdio>
namespace cg = cooperative_groups;

typedef unsigned short u16;
typedef unsigned int u32;
typedef short bf16x8 __attribute__((ext_vector_type(8)));
typedef short s16x4 __attribute__((ext_vector_type(4)));
typedef float f32x4 __attribute__((ext_vector_type(4)));
typedef unsigned int u32x4 __attribute__((ext_vector_type(4)));
typedef unsigned int u32x2 __attribute__((ext_vector_type(2)));
typedef __bf16 bf16x2_t __attribute__((ext_vector_type(2)));

#define DI __device__ __forceinline__
#define LAUNDER(x) asm volatile("" : "+v"(x))

constexpr int TP = 65536, TS = 256, TT = TP + TS;
constexpr float LOG2E = 1.4426950408889634f;
constexpr float EPS = 1e-6f;
constexpr float U_SCALE = 1024.f, V_SCALE = 128.f;

constexpr size_t O_AK_P = 67371008, O_AV_P = 100925440, O_AF_P = 134479872, O_BK_P = 135004160,
                 O_BV_P = 143392768, O_AK_S = 151781376, O_AV_S = 151912448, O_AF_S = 152043520,
                 O_BK_S = 152045568, O_BV_S = 152176640;

constexpr size_t SZ_ACT = (size_t)TT * 1024 * 2;
constexpr size_t SZ_HALF = (size_t)TT * 512 * 2;
constexpr size_t W_XB = 0;
constexpr size_t W_QKV = SZ_ACT;
constexpr size_t W_GA = W_QKV + 6 * SZ_HALF;
constexpr size_t W_GB = W_GA + SZ_ACT;
constexpr size_t W_PB = W_GB + SZ_ACT;
constexpr size_t W_WIN = W_PB + (size_t)TT * 256 * 2;
constexpr size_t W_WUPA = W_WIN + (size_t)5120 * 1024 * 2;
constexpr size_t W_WUPB = W_WUPA + 1024 * 512 * 2;
constexpr size_t W_WOUT = W_WUPB + 1024 * 512 * 2;
constexpr size_t W_WQ = W_WOUT + 1024 * 1024 * 2;
constexpr size_t W_WG = W_WQ + 1024 * 1024 * 2;
constexpr size_t W_WPP = W_WG + 1024 * 1024 * 2;
constexpr size_t W_UB = W_WPP + 1024 * 256 * 2;
constexpr size_t W_VB = W_UB + (size_t)16384 * 1024 * 2;
constexpr size_t W_SK = W_VB + (size_t)16384 * 1024 * 2;
constexpr size_t W_RS1 = W_SK + 131072 * 2;
constexpr size_t W_SSQ2 = W_RS1 + (size_t)TT * 4;
constexpr size_t W_RS3 = W_SSQ2 + (size_t)TT * 64;
constexpr size_t W_CUMP = W_RS3 + (size_t)TT * 4;
constexpr size_t W_CUMS = W_CUMP + (size_t)256 * 2048 * 4;
constexpr size_t W_SSQ3 = W_CUMS + (size_t)128 * 4112 * 4 + 1024;
constexpr size_t W_BAR = W_SSQ3 + (size_t)TT * 8 * 4;
constexpr int BAR_SLOT = 17 * 64;
constexpr size_t BAR_BYTES = (size_t)(16 * BAR_SLOT + 16 * 64) * 4;
constexpr size_t W_END = W_BAR + BAR_BYTES;
constexpr size_t W_IDX = W_GA;
constexpr size_t W_G = W_GA + (size_t)32 * 1024 * 1024;
constexpr size_t SZ_PH = (size_t)TT * 128 * 2;


struct Params {
  const float *x_p, *x_s, *cak, *cav, *caf, *cbk, *cbv, *p_p, *p_s, *g_mix, *w_in, *b_f, *qn_a, *kn_a,
      *qn_b, *kn_b, *relb, *w_up_a, *w_up_b, *w_out, *g_ffn, *peer_wq, *peer_sk, *peer_u, *peer_v, *g_ple,
      *w_gate, *w_proj;
  float* out;
  char* ws;
};

constexpr int SMEM_BYTES = 128 * 129 * 4 + 2 * 64 * 17 * 4 + 256;

DI u16* ph_slice(char* ws, int x) { return (u16*)(ws + W_XB + (size_t)x * SZ_PH); }
DI u16 f2bf(float x) { return __builtin_bit_cast(u16, (__bf16)x); }
DI float bf2f(u16 h) { return __uint_as_float(((u32)h) << 16); }
DI u32 pack2(float a, float b) { bf16x2_t v = {(__bf16)a, (__bf16)b}; return __builtin_bit_cast(u32, v); }
DI float wave_sum(float v) {
#pragma unroll
  for (int o = 32; o; o >>= 1) v += __shfl_xor(v, o);
  return v;
}
DI f32x4 mfma16(bf16x8 a, bf16x8 b, f32x4 c) { return __builtin_amdgcn_mfma_f32_16x16x32_bf16(a, b, c, 0, 0, 0); }
DI float sigmoidf_(float x) { return 1.f / (1.f + __expf(-x)); }
DI u32 mono(float x) { u32 u = __float_as_uint(x); u32 m = (u32)((int)u >> 31) | 0x80000000u; return u ^ m; }
DI float unmono(u32 k) { u32 m = ((k >> 31) - 1u) | 0x80000000u; return __uint_as_float(k ^ m); }
DI void insert16(u32 (&L)[16], u32 x) {
#pragma unroll
  for (int s = 0; s < 16; s++) { u32 mx = max(L[s], x); x = min(L[s], x); L[s] = mx; }
}
DI float gelu_tanh(float x) {
  float u = 0.7978845608028654f * (x + 0.044715f * x * x * x);
  float t = 1.f - 2.f / (1.f + __expf(2.f * u));
  return 0.5f * x * (1.f + t);
}

constexpr int GSTR = 72;
constexpr int GBUF = 2 * 128 * GSTR;
constexpr int RS_OFF = 2 * GBUF * 2;
DI void gemm_compute(const u16* As, const u16* Bs, f32x4 (&acc)[4][4], int wm, int wn, int r, int quad) {
#pragma unroll
  for (int ks = 0; ks < 2; ks++) {
    bf16x8 af[4], bfr[4];
#pragma unroll
    for (int mi = 0; mi < 4; mi++) af[mi] = *(const bf16x8*)(As + (wm * 64 + mi * 16 + r) * GSTR + ks * 32 + quad * 8);
#pragma unroll
    for (int ni = 0; ni < 4; ni++) bfr[ni] = *(const bf16x8*)(Bs + (wn * 64 + ni * 16 + r) * GSTR + ks * 32 + quad * 8);
#pragma unroll
    for (int mi = 0; mi < 4; mi++)
#pragma unroll
      for (int ni = 0; ni < 4; ni++) acc[mi][ni] = mfma16(af[mi], bfr[ni], acc[mi][ni]);
    if (ks == 0) __builtin_amdgcn_sched_barrier(0);
  }
}
DI void gemm_mainloop(const u16* __restrict__ A, int lda, const u16* __restrict__ B, int ldb, int K, u16* smem,
                      f32x4 (&acc)[4][4]) {
  const int tid = threadIdx.x, lane = tid & 63, w = tid >> 6, wm = w >> 1, wn = w & 1, r = lane & 15, quad = lane >> 4;
  u16* As0 = smem;
  u16* Bs0 = smem + 128 * GSTR;
  u16* As1 = smem + GBUF;
  u16* Bs1 = As1 + 128 * GSTR;
  u32x4 r0a[4], r0b[4], r1a[4], r1b[4];
  const int lrow = tid >> 3, lch = tid & 7;
  const u16* ap = A + (size_t)lrow * lda + lch * 8;
  const u16* bp = B + (size_t)lrow * ldb + lch * 8;
  const int lo = lrow * GSTR + lch * 8;
  const int nk = K >> 6, km = nk - 1;
  const int krot = 0;
#define KOFF(kt) ((((kt) + krot) & km) * 64)
#pragma unroll
  for (int i = 0; i < 4; i++) {
    r0a[i] = *(const u32x4*)(ap + (size_t)i * 32 * lda + KOFF(0));
    r0b[i] = *(const u32x4*)(bp + (size_t)i * 32 * ldb + KOFF(0));
  }
#pragma unroll
  for (int i = 0; i < 4; i++) {
    r1a[i] = *(const u32x4*)(ap + (size_t)i * 32 * lda + KOFF(1));
    r1b[i] = *(const u32x4*)(bp + (size_t)i * 32 * ldb + KOFF(1));
  }
  __syncthreads();
#pragma unroll 1
  for (int kt = 0; kt < nk - 2; kt += 2) {
#pragma unroll
    for (int i = 0; i < 4; i++) {
      *(u32x4*)(As0 + lo + i * 32 * GSTR) = r0a[i];
      *(u32x4*)(Bs0 + lo + i * 32 * GSTR) = r0b[i];
    }
    __syncthreads();
    {
      const int ko = KOFF(kt + 2);
#pragma unroll
      for (int i = 0; i < 4; i++) {
        r0a[i] = *(const u32x4*)(ap + (size_t)i * 32 * lda + ko);
        r0b[i] = *(const u32x4*)(bp + (size_t)i * 32 * ldb + ko);
      }
    }
    gemm_compute(As0, Bs0, acc, wm, wn, r, quad);
#pragma unroll
    for (int i = 0; i < 4; i++) {
      *(u32x4*)(As1 + lo + i * 32 * GSTR) = r1a[i];
      *(u32x4*)(Bs1 + lo + i * 32 * GSTR) = r1b[i];
    }
    __syncthreads();
    {
      const int ko = KOFF(kt + 3);
#pragma unroll
      for (int i = 0; i < 4; i++) {
        r1a[i] = *(const u32x4*)(ap + (size_t)i * 32 * lda + ko);
        r1b[i] = *(const u32x4*)(bp + (size_t)i * 32 * ldb + ko);
      }
    }
    gemm_compute(As1, Bs1, acc, wm, wn, r, quad);
  }
#pragma unroll
  for (int i = 0; i < 4; i++) {
    *(u32x4*)(As0 + lo + i * 32 * GSTR) = r0a[i];
    *(u32x4*)(Bs0 + lo + i * 32 * GSTR) = r0b[i];
  }
  __syncthreads();
  gemm_compute(As0, Bs0, acc, wm, wn, r, quad);
#pragma unroll
  for (int i = 0; i < 4; i++) {
    *(u32x4*)(As1 + lo + i * 32 * GSTR) = r1a[i];
    *(u32x4*)(Bs1 + lo + i * 32 * GSTR) = r1b[i];
  }
  __syncthreads();
  gemm_compute(As1, Bs1, acc, wm, wn, r, quad);
#undef KOFF
}

DI void zero_acc(f32x4 (&acc)[4][4]) {
#pragma unroll
  for (int i = 0; i < 4; i++)
#pragma unroll
    for (int j = 0; j < 4; j++) acc[i][j] = (f32x4){0.f, 0.f, 0.f, 0.f};
}

constexpr int CSTR = 132;
DI void stage_acc(const f32x4 (&acc)[4][4], float* Cs) {
  const int tid = threadIdx.x, lane = tid & 63, w = tid >> 6, wm = w >> 1, wn = w & 1, r = lane & 15, quad = lane >> 4;
  __syncthreads();
#pragma unroll
  for (int mi = 0; mi < 4; mi++)
#pragma unroll
    for (int ni = 0; ni < 4; ni++)
#pragma unroll
      for (int j = 0; j < 4; j++) Cs[(wm * 64 + mi * 16 + quad * 4 + j) * CSTR + wn * 64 + ni * 16 + r] = acc[mi][ni][j];
  __syncthreads();
}
DI u32x2 pack4(f32x4 v) { return (u32x2){pack2(v.x, v.y), pack2(v.z, v.w)}; }
DI f32x4 unpack4(u32x2 p) {
  return (f32x4){__uint_as_float(p.x << 16), __uint_as_float(p.x & 0xffff0000u), __uint_as_float(p.y << 16), __uint_as_float(p.y & 0xffff0000u)};
}

DI void transpose_tile(const float* __restrict__ W, int ldw, int K, const float* __restrict__ g, u16* __restrict__ dst,
                       int k0, int n0, int nsrc0, float* tile) {
  const int tid = threadIdx.x;
  __syncthreads();
  {
    const int ty = tid >> 4, tx = tid & 15;
#pragma unroll
    for (int i = 0; i < 4; i++) {
      int k = ty + i * 16;
      f32x4 v = *(const f32x4*)(W + (size_t)(k0 + k) * ldw + nsrc0 + tx * 4);
      float s = g ? g[k0 + k] : 1.f;
      tile[k * 65 + tx * 4 + 0] = v[0] * s;
      tile[k * 65 + tx * 4 + 1] = v[1] * s;
      tile[k * 65 + tx * 4 + 2] = v[2] * s;
      tile[k * 65 + tx * 4 + 3] = v[3] * s;
    }
  }
  __syncthreads();
  {
    const int n = tid >> 2, kc = (tid & 3) * 16;
    u32 pk[8];
#pragma unroll
    for (int i = 0; i < 8; i++) pk[i] = pack2(tile[(kc + 2 * i) * 65 + n], tile[(kc + 2 * i + 1) * 65 + n]);
    u16* d = dst + (size_t)(n0 + n) * K + k0 + kc;
    *(u32x4*)d = (u32x4){pk[0], pk[1], pk[2], pk[3]};
    *(u32x4*)(d + 8) = (u32x4){pk[4], pk[5], pk[6], pk[7]};
  }
}

DI void conv_unit(const float* __restrict__ src, u16* __restrict__ dst, size_t base, const float* __restrict__ colscale) {
  const int tid = threadIdx.x;
#pragma unroll
  for (int i = 0; i < 4; i++) {
    size_t e = base + (size_t)i * 1024 + tid * 4;
    f32x4 v = *(const f32x4*)(src + e);
    if (colscale) {
      f32x4 gg = *(const f32x4*)(colscale + (e & 1023));
      v = v * gg;
    }
    *(u32x2*)(dst + e) = (u32x2){pack2(v[0], v[1]), pack2(v[2], v[3])};
  }
}

DI void conv_unit_fp8(const float* __restrict__ src, unsigned char* __restrict__ dst, size_t base,
                      const float* __restrict__ colscale, float scale) {
  const int tid = threadIdx.x;
#pragma unroll
  for (int i = 0; i < 4; i++) {
    size_t e = base + (size_t)i * 1024 + tid * 4;
    f32x4 v = *(const f32x4*)(src + e);
    if (colscale) {
      f32x4 gg = *(const f32x4*)(colscale + (e & 1023));
      v = v * gg;
    }
    int w = __builtin_amdgcn_cvt_pk_fp8_f32(v[0] * scale, v[1] * scale, 0, false);
    w = __builtin_amdgcn_cvt_pk_fp8_f32(v[2] * scale, v[3] * scale, w, true);
    *(int*)(dst + (((e & 1023) >> 7) << 21) + ((e >> 10) << 7) + (e & 127)) = w;
  }
}

DI void phase0(const Params& P, char* smem) {
  const int tid = threadIdx.x, lane = tid & 63, w = tid >> 6;
  char* ws = P.ws;
  {
    float* tile = (float*)smem;
    constexpr int T_WIN = 16 * 80, T_UP = 8 * 16, T_SQ = 256, T_PP = 4 * 16;
    constexpr int NT = T_WIN + 2 * T_UP + 3 * T_SQ + T_PP;
    for (int t = blockIdx.x; t < NT; t += gridDim.x) {
      int u = t;
      if (u < T_WIN) {
        int kt = u / 80, nt = u % 80;
        int n0 = nt * 64;
        int ns = n0 < 1536 ? n0 : n0 + 8;
        transpose_tile(P.w_in, 5128, 1024, P.g_mix, (u16*)(ws + W_WIN), kt * 64, n0, ns, tile);
        continue;
      }
      u -= T_WIN;
      if (u < T_UP) { transpose_tile(P.w_up_a, 1024, 512, nullptr, (u16*)(ws + W_WUPA), (u / 16) * 64, (u % 16) * 64, (u % 16) * 64, tile); continue; }
      u -= T_UP;
      if (u < T_UP) { transpose_tile(P.w_up_b, 1024, 512, nullptr, (u16*)(ws + W_WUPB), (u / 16) * 64, (u % 16) * 64, (u % 16) * 64, tile); continue; }
      u -= T_UP;
      if (u < T_SQ) { transpose_tile(P.w_out, 1024, 1024, nullptr, (u16*)(ws + W_WOUT), (u / 16) * 64, (u % 16) * 64, (u % 16) * 64, tile); continue; }
      u -= T_SQ;
      if (u < T_SQ) { transpose_tile(P.peer_wq, 1024, 1024, P.g_ffn, (u16*)(ws + W_WQ), (u / 16) * 64, (u % 16) * 64, (u % 16) * 64, tile); continue; }
      u -= T_SQ;
      if (u < T_SQ) { transpose_tile(P.w_gate, 1024, 1024, P.g_ple, (u16*)(ws + W_WG), (u / 16) * 64, (u % 16) * 64, (u % 16) * 64, tile); continue; }
      u -= T_SQ;
      transpose_tile(P.w_proj, 1024, 256, nullptr, (u16*)(ws + W_WPP), (u / 16) * 64, (u % 16) * 64, (u % 16) * 64, tile);
    }
  }
  {
    for (int t = blockIdx.x; t < 32; t += gridDim.x) conv_unit(P.peer_sk, (u16*)(ws + W_SK), (size_t)t * 4096, nullptr);
  }
  {
    float* wfl = (float*)smem;
    __syncthreads();
    for (int i = tid; i < 8192; i += 256) {
      int k = i >> 3, h = i & 7;
      wfl[h * 1024 + k] = P.g_mix[k] * P.w_in[(size_t)k * 5128 + 1536 + h];
    }
    __syncthreads();
    u16* XB = (u16*)(ws + W_XB);
    float* RS1 = (float*)(ws + W_RS1);
    for (int t = blockIdx.x * 4 + w; t < TT; t += gridDim.x * 4) {
      const float* xr = t < TP ? P.x_p + (size_t)t * 1024 : P.x_s + (size_t)(t - TP) * 1024;
      f32x4 v[4];
#pragma unroll
      for (int i = 0; i < 4; i++) v[i] = *(const f32x4*)(xr + i * 256 + lane * 4);
      float ss = 0.f;
#pragma unroll
      for (int i = 0; i < 4; i++) ss += v[i][0] * v[i][0] + v[i][1] * v[i][1] + v[i][2] * v[i][2] + v[i][3] * v[i][3];
      float dots[8];
#pragma unroll
      for (int h = 0; h < 8; h++) {
        float d = 0.f;
#pragma unroll
        for (int i = 0; i < 4; i++) {
          f32x4 wv = *(const f32x4*)(wfl + h * 1024 + i * 256 + lane * 4);
          d += v[i][0] * wv[0] + v[i][1] * wv[1] + v[i][2] * wv[2] + v[i][3] * wv[3];
        }
        dots[h] = d;
      }
      ss = wave_sum(ss);
#pragma unroll
      for (int h = 0; h < 8; h++) dots[h] = wave_sum(dots[h]);
      float rs = rsqrtf(ss * (1.f / 1024.f) + EPS);
#pragma unroll
      for (int i = 0; i < 4; i++)
        *(u32x2*)(XB + (size_t)t * 1024 + i * 256 + lane * 4) = (u32x2){pack2(v[i][0], v[i][1]), pack2(v[i][2], v[i][3])};
      if (lane == 0) RS1[t] = rs;
      float myd = dots[0];
#pragma unroll
      for (int h = 1; h < 8; h++) myd = (lane == h) ? dots[h] : myd;
      if (lane < 8) {
        float z = rs * myd + P.b_f[lane];
        float lf = fminf(z, 0.f) - log1pf(expf(-fabsf(z)));
        float* o = t < TP ? P.out + O_AF_P + (size_t)t * 8 : P.out + O_AF_S + (size_t)(t - TP) * 8;
        o[lane] = lf;
      }
    }
  }
}

DI void phase1_scans(const Params& P) {
  const int lane = threadIdx.x & 63;
  const int gw = blockIdx.x * 4 + (threadIdx.x >> 6), nw = gridDim.x * 4;
  float* CUMP = (float*)(P.ws + W_CUMP);
  float* CUMS = (float*)(P.ws + W_CUMS);
  for (int row = gw; row < 384; row += nw) {
    float carry = 0.f;
    if (row < 256) {
      int b = row >> 3, h = row & 7;
      const float* src = P.out + O_AF_P + (size_t)b * 2048 * 8 + h;
      for (int p0 = 0; p0 < 2048; p0 += 64) {
        float v = src[(size_t)(p0 + lane) * 8];
#pragma unroll
        for (int o = 1; o < 64; o <<= 1) { float n = __shfl_up(v, o); if (lane >= o) v += n; }
        v += carry;
        CUMP[(size_t)row * 2048 + p0 + lane] = v * LOG2E;
        carry = __shfl(v, 63);
      }
    } else {
      int rr = row - 256;
      int b = rr >> 3, h = rr & 7;
      const float* src = P.caf + (size_t)b * 4096 * 8 + h;
      for (int p0 = 0; p0 < 4096; p0 += 64) {
        float v = src[(size_t)(p0 + lane) * 8];
#pragma unroll
        for (int o = 1; o < 64; o <<= 1) { float n = __shfl_up(v, o); if (lane >= o) v += n; }
        v += carry;
        CUMS[(size_t)rr * 4112 + p0 + lane] = v * LOG2E;
        carry = __shfl(v, 63);
      }
      {
        float v = lane < 16 ? P.out[O_AF_S + (size_t)(b * 16 + lane) * 8 + h] : 0.f;
#pragma unroll
        for (int o = 1; o < 64; o <<= 1) { float n = __shfl_up(v, o); if (lane >= o) v += n; }
        v += carry;
        if (lane < 16) CUMS[(size_t)rr * 4112 + 4096 + lane] = v * LOG2E;
      }
    }
  }
}

DI void phase1_tile(const Params& P, int mt, int nt, char* smem) {
  const int tid = threadIdx.x, lane = tid & 63, w = tid >> 6, wm = w >> 1, wn = w & 1, r = lane & 15, quad = lane >> 4;
  const int m0 = mt * 128, n0 = nt * 128;
  char* ws = P.ws;
  f32x4 acc[4][4];
  zero_acc(acc);
  gemm_mainloop((const u16*)(ws + W_XB) + (size_t)m0 * 1024, 1024, (const u16*)(ws + W_WIN) + (size_t)n0 * 1024, 1024, 1024,
                (u16*)smem, acc);
  float* Cs = (float*)smem;
  stage_acc(acc, Cs);
  const bool sample = m0 >= TP;
  const int c4 = tid & 31, rsub = tid >> 5;
  const float* RS1 = (const float*)(ws + W_RS1) + m0;
  if (n0 < 3072) {
    const int seg = n0 >> 9, hc = n0 & 511;
    const bool normed = (seg != 2 && seg != 5);
    const float* gain = seg == 0 ? P.qn_a : seg == 1 ? P.kn_a : seg == 3 ? P.qn_b : P.kn_b;
    const float qs = (seg == 0 || seg == 3) ? 0.125f * LOG2E : 1.f;
    f32x4 gn = (f32x4){1.f, 1.f, 1.f, 1.f};
    if (normed) gn = *(const f32x4*)(gain + (c4 & 15) * 4) * qs;
    u16* dp = (u16*)(ws + W_QKV + (size_t)seg * SZ_HALF) + (size_t)m0 * 512 + hc + c4 * 4;
    float* op = nullptr;
    if (seg == 1 || seg == 2) {
      op = sample ? P.out + (seg == 1 ? O_AK_S : O_AV_S) + (size_t)(m0 - TP) * 512 : P.out + (seg == 1 ? O_AK_P : O_AV_P) + (size_t)m0 * 512;
    } else if (seg == 4 || seg == 5) {
      if (sample) op = P.out + (seg == 4 ? O_BK_S : O_BV_S) + (size_t)(m0 - TP) * 512;
      else if ((m0 & 2047) >= 1536) op = P.out + (seg == 4 ? O_BK_P : O_BV_P) + ((size_t)(m0 >> 11) * 512 + ((m0 & 2047) - 1536)) * 512;
    }
    if (op) op += hc + c4 * 4;
#pragma unroll 4
    for (int p = 0; p < 16; p++) {
      const int row = p * 8 + rsub;
      f32x4 v = *(const f32x4*)(Cs + row * CSTR + c4 * 4) * RS1[row];
      if (normed) {
        float ss = v.x * v.x + v.y * v.y + v.z * v.z + v.w * v.w;
        ss += __shfl_xor(ss, 1);
        ss += __shfl_xor(ss, 2);
        ss += __shfl_xor(ss, 4);
        ss += __shfl_xor(ss, 8);
        v = v * gn * rsqrtf(ss * (1.f / 64.f) + EPS);
      }
      *(u32x2*)(dp + (size_t)row * 512) = pack4(v);
      if (op) __builtin_nontemporal_store(v, (f32x4*)(op + (size_t)row * 512));
    }
  } else {
    u16* dp = (n0 < 4096 ? (u16*)(ws + W_GA) + (n0 - 3072) : (u16*)(ws + W_GB) + (n0 - 4096)) + (size_t)m0 * 1024 + c4 * 4;
#pragma unroll 4
    for (int p = 0; p < 16; p++) {
      const int row = p * 8 + rsub;
      f32x4 v = *(const f32x4*)(Cs + row * CSTR + c4 * 4) * RS1[row];
      v = (f32x4){sigmoidf_(v.x), sigmoidf_(v.y), sigmoidf_(v.z), sigmoidf_(v.w)};
      *(u32x2*)(dp + (size_t)row * 1024) = pack4(v);
    }
  }
}

constexpr int ASTR = 72;
constexpr int ASTAGE = 2 * 64 * ASTR * 2 + 256;
constexpr int TAB_OFF = 2 * ASTAGE;
struct AttnState { f32x4 o[4]; float m, l; };

DI s16x4 tr_read(const u16* p) {
  return __builtin_amdgcn_ds_read_tr16_b64_v4i16((__attribute__((address_space(3))) s16x4*)(p));
}

template <int MODE>
DI void attn_step(const u16* Ks, const u16* Vs, const bf16x8 (&qf)[2], AttnState& st, int kpos0, int qpos, int qlim,
                  float cq, const float* cum, const float* tab, bool domask) {
  const int lane = threadIdx.x & 63, r = lane & 15, quad = lane >> 4;
  const bool farband = (MODE == 1) && (kpos0 + 31 - (qpos - r) <= -128);
  f32x4 s[2];
#pragma unroll
  for (int t = 0; t < 2; t++) {
    f32x4 a4 = (f32x4){0.f, 0.f, 0.f, 0.f};
#pragma unroll
    for (int ks = 0; ks < 2; ks++) {
      bf16x8 kf = *(const bf16x8*)(Ks + (t * 16 + r) * ASTR + ks * 32 + quad * 8);
      a4 = mfma16(kf, qf[ks], a4);
    }
    s[t] = a4;
  }
#pragma unroll
  for (int t = 0; t < 2; t++) {
    const int kb = kpos0 + t * 16 + quad * 4;
    if (MODE == 0) {
      f32x4 c4 = *(const f32x4*)(cum + kb);
#pragma unroll
      for (int j = 0; j < 4; j++) s[t][j] += cq - c4[j];
    } else if (farband) {
      const float b0 = tab[0];
#pragma unroll
      for (int j = 0; j < 4; j++) s[t][j] += b0;
    } else {
#pragma unroll
      for (int j = 0; j < 4; j++) {
        int rel = kb + j - qpos;
        rel = min(max(rel, -128), 128) + 128;
        s[t][j] += tab[rel];
      }
    }
    if (domask) {
#pragma unroll
      for (int j = 0; j < 4; j++)
        if (kb + j > qlim) s[t][j] = -1e30f;
    }
  }
  float p[8];
  float ls = 0.f;
#pragma unroll
  for (int t = 0; t < 2; t++)
#pragma unroll
    for (int j = 0; j < 4; j++) { p[t * 4 + j] = __builtin_amdgcn_exp2f(s[t][j]); ls += p[t * 4 + j]; }
  st.l += ls;
  u32x4 pk = (u32x4){pack2(p[0], p[1]), pack2(p[2], p[3]), pack2(p[4], p[5]), pack2(p[6], p[7])};
  bf16x8 pf = __builtin_bit_cast(bf16x8, pk);
  const int qq = (lane & 15) >> 2, pp = lane & 3;
#pragma unroll
  for (int dt = 0; dt < 4; dt++) {
    s16x4 lo = tr_read(Vs + (quad * 4 + qq) * ASTR + dt * 16 + pp * 4);
    s16x4 hi = tr_read(Vs + (16 + quad * 4 + qq) * ASTR + dt * 16 + pp * 4);
    bf16x8 vf = __builtin_shufflevector(lo, hi, 0, 1, 2, 3, 4, 5, 6, 7);
    st.o[dt] = mfma16(vf, pf, st.o[dt]);
  }
}

template <int MODE>
DI void attn_prompt_item(const Params& P, char* smem, int b, int h, int qt, float bound) {
  const int tid = threadIdx.x, lane = tid & 63, w = tid >> 6, r = lane & 15, quad = lane >> 4;
  char* ws = P.ws;
  const u16* Q = (const u16*)(ws + W_QKV + (size_t)(MODE == 0 ? 0 : 3) * SZ_HALF);
  const u16* Kg = (const u16*)(ws + W_QKV + (size_t)(MODE == 0 ? 1 : 4) * SZ_HALF);
  const u16* Vg = (const u16*)(ws + W_QKV + (size_t)(MODE == 0 ? 2 : 5) * SZ_HALF);
  u16* Y = (u16*)(ws + W_XB + (size_t)(MODE == 0 ? 0 : 1) * SZ_HALF);
  float* tab = (float*)(smem + TAB_OFF);
  __syncthreads();
  if (MODE == 1) {
    for (int i = tid; i < 257; i += 256) tab[i] = P.relb[h * 257 + i] * LOG2E - bound;
  }
  const int q0 = qt * 64;
  const int qpos = q0 + w * 16 + r;
  const size_t tokq = (size_t)b * 2048 + qpos;
  bf16x8 qf[2];
#pragma unroll
  for (int ks = 0; ks < 2; ks++) qf[ks] = *(const bf16x8*)(Q + tokq * 512 + h * 64 + ks * 32 + quad * 8);
  const float* cum = (const float*)(ws + W_CUMP) + (size_t)(b * 8 + h) * 2048;
  const float cq = MODE == 0 ? cum[qpos] - bound : 0.f;
  AttnState st;
#pragma unroll
  for (int dt = 0; dt < 4; dt++) st.o[dt] = (f32x4){0.f, 0.f, 0.f, 0.f};
  st.m = 0.f;
  st.l = 0.f;
  const int kt_lo = MODE == 0 ? 0 : max(0, qt - 8), kt_hi = qt;
  u32x4 rk[2], rv[2];
  f32x4 rc = (f32x4){0.f, 0.f, 0.f, 0.f};
  const int lkey = tid >> 3, lch = tid & 7;
  const u16* kp = Kg + ((size_t)b * 2048 + lkey) * 512 + h * 64 + lch * 8;
  const u16* vp = Vg + ((size_t)b * 2048 + lkey) * 512 + h * 64 + lch * 8;
  const int lofs = lkey * ASTR + lch * 8;
#pragma unroll
  for (int i = 0; i < 2; i++) {
    rk[i] = *(const u32x4*)(kp + (size_t)(kt_lo * 64 + i * 32) * 512);
    rv[i] = *(const u32x4*)(vp + (size_t)(kt_lo * 64 + i * 32) * 512);
  }
  if (MODE == 0 && tid < 16) rc = *(const f32x4*)(cum + kt_lo * 64 + tid * 4);
  {
    u16* Ks = (u16*)(smem + (kt_lo & 1) * ASTAGE);
    u16* Vs = Ks + 64 * ASTR;
#pragma unroll
    for (int i = 0; i < 2; i++) {
      *(u32x4*)(Ks + lofs + i * 32 * ASTR) = rk[i];
      *(u32x4*)(Vs + lofs + i * 32 * ASTR) = rv[i];
    }
    if (MODE == 0 && tid < 16) *(f32x4*)((float*)(Vs + 64 * ASTR) + tid * 4) = rc;
  }
  __syncthreads();
#pragma unroll 1
  for (int kt = kt_lo; kt <= kt_hi; kt++) {
    const int ktn = min(kt + 1, kt_hi);
#pragma unroll
    for (int i = 0; i < 2; i++) {
      rk[i] = *(const u32x4*)(kp + (size_t)(ktn * 64 + i * 32) * 512);
      rv[i] = *(const u32x4*)(vp + (size_t)(ktn * 64 + i * 32) * 512);
    }
    if (MODE == 0 && tid < 16) rc = *(const f32x4*)(cum + ktn * 64 + tid * 4);
    const u16* Ks = (const u16*)(smem + (kt & 1) * ASTAGE);
    const u16* Vs = Ks + 64 * ASTR;
    const float* cl = (const float*)(Vs + 64 * ASTR) - kt * 64;
    const bool diag = (MODE == 0) && (kt == qt);
#pragma unroll
    for (int half = 0; half < 2; half++) {
      const int kpos0 = kt * 64 + half * 32;
      if (diag && kpos0 > q0 + w * 16 + 15) continue;
      attn_step<MODE>(Ks + half * 32 * ASTR, Vs + half * 32 * ASTR, qf, st, kpos0, qpos, qpos, cq, cl, tab, diag);
    }
    if (kt < kt_hi) {
      u16* Kn = (u16*)(smem + ((kt + 1) & 1) * ASTAGE);
      u16* Vn = Kn + 64 * ASTR;
#pragma unroll
      for (int i = 0; i < 2; i++) {
        *(u32x4*)(Kn + lofs + i * 32 * ASTR) = rk[i];
        *(u32x4*)(Vn + lofs + i * 32 * ASTR) = rv[i];
      }
      if (MODE == 0 && tid < 16) *(f32x4*)((float*)(Vn + 64 * ASTR) + tid * 4) = rc;
    }
    __syncthreads();
  }
  float lt = st.l;
  lt += __shfl_xor(lt, 16);
  lt += __shfl_xor(lt, 32);
  const float inv = 1.f / lt;
#pragma unroll
  for (int dt = 0; dt < 4; dt++) {
    u32x2 o2 = (u32x2){pack2(st.o[dt][0] * inv, st.o[dt][1] * inv), pack2(st.o[dt][2] * inv, st.o[dt][3] * inv)};
    *(u32x2*)(Y + tokq * 512 + h * 64 + dt * 16 + quad * 4) = o2;
  }
}

template <int MODE>
DI void attn_sample_item(const Params& P, char* smem, int b, int h, float bound) {
  const int tid = threadIdx.x, lane = tid & 63, w = tid >> 6, r = lane & 15, quad = lane >> 4;
  constexpr int L = MODE == 0 ? 4096 : 512;
  char* ws = P.ws;
  const u16* Q = (const u16*)(ws + W_QKV + (size_t)(MODE == 0 ? 0 : 3) * SZ_HALF);
  const u16* Kn = (const u16*)(ws + W_QKV + (size_t)(MODE == 0 ? 1 : 4) * SZ_HALF);
  const u16* Vn = (const u16*)(ws + W_QKV + (size_t)(MODE == 0 ? 2 : 5) * SZ_HALF);
  u16* Y = (u16*)(ws + W_XB + (size_t)(MODE == 0 ? 0 : 1) * SZ_HALF);
  u16* Kw = (u16*)smem + w * (2 * 32 * ASTR);
  u16* Vw = Kw + 32 * ASTR;
  float* tab = (float*)(smem + TAB_OFF);
  __syncthreads();
  if (MODE == 1) {
    for (int i = tid; i < 257; i += 256) tab[i] = P.relb[h * 257 + i] * LOG2E - bound;
  }
  __syncthreads();
  const float* ck = (MODE == 0 ? P.cak : P.cbk) + ((size_t)b * L * 8 + h) * 64;
  const float* cv = (MODE == 0 ? P.cav : P.cbv) + ((size_t)b * L * 8 + h) * 64;
  const size_t tokbase = (size_t)TP + b * 16;
  bf16x8 qf[2];
#pragma unroll
  for (int ks = 0; ks < 2; ks++) qf[ks] = *(const bf16x8*)(Q + (tokbase + r) * 512 + h * 64 + ks * 32 + quad * 8);
  const int qpos = L + r;
  const float* cum = (const float*)(ws + W_CUMS) + (size_t)(b * 8 + h) * 4112;
  const float cq = MODE == 0 ? cum[qpos] - bound : 0.f;
  AttnState st;
#pragma unroll
  for (int dt = 0; dt < 4; dt++) st.o[dt] = (f32x4){0.f, 0.f, 0.f, 0.f};
  st.m = 0.f;
  st.l = 0.f;
  const int kbeg = w * (L / 4), kend = kbeg + L / 4;
#pragma unroll 1
  for (int k0 = kbeg; k0 < kend; k0 += 32) {
    {
      f32x4 kr[8];
#pragma unroll
      for (int i = 0; i < 8; i++) kr[i] = *(const f32x4*)(ck + (size_t)(k0 + i * 4 + quad) * 512 + r * 4);
#pragma unroll
      for (int i = 0; i < 8; i++)
        *(u32x2*)(Kw + (i * 4 + quad) * ASTR + r * 4) = (u32x2){pack2(kr[i][0], kr[i][1]), pack2(kr[i][2], kr[i][3])};
    }
    {
      f32x4 vr[8];
#pragma unroll
      for (int i = 0; i < 8; i++) vr[i] = *(const f32x4*)(cv + (size_t)(k0 + i * 4 + quad) * 512 + r * 4);
#pragma unroll
      for (int i = 0; i < 8; i++)
        *(u32x2*)(Vw + (i * 4 + quad) * ASTR + r * 4) = (u32x2){pack2(vr[i][0], vr[i][1]), pack2(vr[i][2], vr[i][3])};
    }
    asm volatile("s_waitcnt lgkmcnt(0)" ::: "memory");
    __builtin_amdgcn_wave_barrier();
    attn_step<MODE>(Kw, Vw, qf, st, k0, qpos, qpos, cq, cum, tab, false);
    __builtin_amdgcn_wave_barrier();
  }
  if (w == 0) {
#pragma unroll
    for (int i = 0; i < 2; i++) {
      int c = lane + i * 64;
      int key = c >> 3, ch = c & 7;
      u32x4 kk = *(const u32x4*)(Kn + (tokbase + key) * 512 + h * 64 + ch * 8);
      u32x4 vv = *(const u32x4*)(Vn + (tokbase + key) * 512 + h * 64 + ch * 8);
      *(u32x4*)(Kw + key * ASTR + ch * 8) = kk;
      *(u32x4*)(Vw + key * ASTR + ch * 8) = vv;
      *(u32x4*)(Kw + (16 + key) * ASTR + ch * 8) = (u32x4){0u, 0u, 0u, 0u};
      *(u32x4*)(Vw + (16 + key) * ASTR + ch * 8) = (u32x4){0u, 0u, 0u, 0u};
    }
    asm volatile("s_waitcnt lgkmcnt(0)" ::: "memory");
    __builtin_amdgcn_wave_barrier();
    attn_step<MODE>(Kw, Vw, qf, st, L, qpos, MODE == 0 ? qpos : L + 15, cq, cum, tab, true);
  }
  __syncthreads();
  float* comb = (float*)smem;
  float lt = st.l;
  lt += __shfl_xor(lt, 16);
  lt += __shfl_xor(lt, 32);
#pragma unroll
  for (int dt = 0; dt < 4; dt++)
#pragma unroll
    for (int j = 0; j < 4; j++) comb[(w * 16 + r) * 68 + dt * 16 + quad * 4 + j] = st.o[dt][j];
  if (quad == 0) comb[(w * 16 + r) * 68 + 65] = lt;
  __syncthreads();
  if (w == 0) {
    float Ls = 0.f;
#pragma unroll
    for (int i = 0; i < 4; i++) Ls += comb[(i * 16 + r) * 68 + 65];
    const float inv = 1.f / Ls;
#pragma unroll
    for (int dt = 0; dt < 4; dt++) {
      float ov[4];
#pragma unroll
      for (int j = 0; j < 4; j++) {
        float a = 0.f;
#pragma unroll
        for (int i = 0; i < 4; i++) a += comb[(i * 16 + r) * 68 + dt * 16 + quad * 4 + j];
        ov[j] = a * inv;
      }
      *(u32x2*)(Y + (tokbase + r) * 512 + h * 64 + dt * 16 + quad * 4) = (u32x2){pack2(ov[0], ov[1]), pack2(ov[2], ov[3])};
    }
  }
}

DI void phase2(const Params& P, char* smem) {
  constexpr int N_SA = 128, N_PA = 8192, N_PB = 8192, N_SB = 128;
  float bound_a, bound_b;
  {
    const int lane = threadIdx.x & 63;
    float qa = fabsf(P.qn_a[lane]), ka = fabsf(P.kn_a[lane]), qb = fabsf(P.qn_b[lane]), kb = fabsf(P.kn_b[lane]), rb = 0.f;
    for (int i = lane; i < 8 * 257; i += 64) rb = fmaxf(rb, fabsf(P.relb[i]));
#pragma unroll
    for (int o = 32; o; o >>= 1) {
      qa = fmaxf(qa, __shfl_xor(qa, o)); ka = fmaxf(ka, __shfl_xor(ka, o));
      qb = fmaxf(qb, __shfl_xor(qb, o)); kb = fmaxf(kb, __shfl_xor(kb, o));
      rb = fmaxf(rb, __shfl_xor(rb, o));
    }
    bound_a = 8.f * qa * ka * LOG2E;
    bound_b = (8.f * qb * kb + rb) * LOG2E;
  }
  for (int it = blockIdx.x; it < N_SA + N_PA + N_PB + N_SB; it += gridDim.x) {
    int u = it;
    if (u < N_SA) { attn_sample_item<0>(P, smem, u >> 3, u & 7, bound_a); continue; }
    u -= N_SA;
    if (u < N_PA) { int qt = 31 - (u >> 8), bh = u & 255; attn_prompt_item<0>(P, smem, bh >> 3, bh & 7, qt, bound_a); continue; }
    u -= N_PA;
    if (u < N_PB) { int qt = 31 - (u >> 8), bh = u & 255; attn_prompt_item<1>(P, smem, bh >> 3, bh & 7, qt, bound_b); continue; }
    u -= N_PB;
    attn_sample_item<1>(P, smem, u >> 3, u & 7, bound_b);
  }
}

DI void phase3_tile(const Params& P, int mt, int nt, char* smem) {
  const int tid = threadIdx.x, lane = tid & 63, w = tid >> 6, wm = w >> 1, wn = w & 1, r = lane & 15, quad = lane >> 4;
  const int m0 = mt * 128, n0 = nt * 128;
  char* ws = P.ws;
  const u16* YA = (const u16*)(ws + W_XB);
  const u16* YB = YA + (size_t)TT * 512;
  const u16* GA = (const u16*)(ws + W_GA);
  const u16* GB = (const u16*)(ws + W_GB);
  u16* MRG = (u16*)(ws + W_QKV);
  f32x4 acc[4][4];
  zero_acc(acc);
  gemm_mainloop(YA + (size_t)m0 * 512, 512, (const u16*)(ws + W_WUPA) + (size_t)n0 * 512, 512, 512, (u16*)smem, acc);
  float* Cs = (float*)smem;
  const int c4 = tid & 31, rsub = tid >> 5;
  const size_t tofs = (size_t)m0 * 1024 + n0 + c4 * 4;
  stage_acc(acc, Cs);
#pragma unroll 4
  for (int p = 0; p < 16; p++) {
    const int row = p * 8 + rsub;
    const f32x4 v = *(const f32x4*)(Cs + row * CSTR + c4 * 4);
    const f32x4 gv = unpack4(*(const u32x2*)(GA + tofs + (size_t)row * 1024));
    *(u32x2*)(MRG + tofs + (size_t)row * 1024) = pack4(v * gv);
  }
  zero_acc(acc);
  gemm_mainloop(YB + (size_t)m0 * 512, 512, (const u16*)(ws + W_WUPB) + (size_t)n0 * 512, 512, 512, (u16*)smem, acc);
  stage_acc(acc, Cs);
#pragma unroll 4
  for (int p = 0; p < 16; p++) {
    const int row = p * 8 + rsub;
    const f32x4 v = *(const f32x4*)(Cs + row * CSTR + c4 * 4);
    const f32x4 gv = unpack4(*(const u32x2*)(GB + tofs + (size_t)row * 1024));
    const f32x4 m1 = unpack4(*(const u32x2*)(MRG + tofs + (size_t)row * 1024));
    *(u32x2*)(MRG + tofs + (size_t)row * 1024) = pack4(m1 + v * gv);
  }
}

DI void phase4_tile(const Params& P, int mt, int nt, char* smem) {
  const int tid = threadIdx.x, lane = tid & 63, w = tid >> 6, wm = w >> 1, wn = w & 1, r = lane & 15, quad = lane >> 4;
  const int m0 = mt * 128, n0 = nt * 128;
  char* ws = P.ws;
  const u16* MRG = (const u16*)(ws + W_QKV);
  u16* H1B = (u16*)(ws + W_QKV + SZ_ACT);
  float* SSQ2 = (float*)(ws + W_SSQ2);
  f32x4 acc[4][4];
  zero_acc(acc);
  gemm_mainloop(MRG + (size_t)m0 * 1024, 1024, (const u16*)(ws + W_WOUT) + (size_t)n0 * 1024, 1024, 1024, (u16*)smem, acc);
  const float* xb = m0 < TP ? P.x_p : P.x_s - (size_t)TP * 1024;
  float* Cs = (float*)smem;
  const int c4 = tid & 31, rsub = tid >> 5;
  const size_t tofs = (size_t)m0 * 1024 + n0 + c4 * 4;
  stage_acc(acc, Cs);
#pragma unroll 4
  for (int p = 0; p < 16; p++) {
    const int row = p * 8 + rsub;
    const f32x4 v = *(const f32x4*)(Cs + row * CSTR + c4 * 4);
    const f32x4 h1 = *(const f32x4*)(xb + tofs + (size_t)row * 1024) + v;
    *(u32x2*)(H1B + tofs + (size_t)row * 1024) = pack4(h1);
    float ss = h1.x * h1.x + h1.y * h1.y + h1.z * h1.z + h1.w * h1.w;
    ss += __shfl_xor(ss, 1);
    ss += __shfl_xor(ss, 2);
    ss += __shfl_xor(ss, 4);
    ss += __shfl_xor(ss, 8);
    ss += __shfl_xor(ss, 16);
    if (c4 == 0) SSQ2[(size_t)(m0 + row) * 16 + nt] = ss;
  }
}

DI void phase5_tile(const Params& P, int mt, int nt, char* smem) {
  const int tid = threadIdx.x, lane = tid & 63, w = tid >> 6, wm = w >> 1, wn = w & 1, r = lane & 15, quad = lane >> 4;
  const int m0 = mt * 128, n0 = nt * 128;
  char* ws = P.ws;
  const u16* H1B = (const u16*)(ws + W_QKV + SZ_ACT);
  u16* QP = (u16*)(ws + W_QKV + 2 * SZ_ACT);
  const float* SSQ2 = (const float*)(ws + W_SSQ2);
  float* rs_s = (float*)(smem + RS_OFF);
  __syncthreads();
  if (tid < 128) {
    float s = 0.f;
#pragma unroll
    for (int i = 0; i < 8; i++) s += SSQ2[(size_t)(m0 + tid) * 16 + i];
    rs_s[tid] = rsqrtf(s * (1.f / 1024.f) + EPS);
  }
  f32x4 acc[4][4];
  zero_acc(acc);
  gemm_mainloop(H1B + (size_t)m0 * 1024, 1024, (const u16*)(ws + W_WQ) + (size_t)n0 * 1024, 1024, 1024, (u16*)smem, acc);
  float* Cs = (float*)smem;
  const int c4 = tid & 31, rsub = tid >> 5;
  const size_t tofs = (size_t)m0 * 1024 + n0 + c4 * 4;
  stage_acc(acc, Cs);
#pragma unroll 4
  for (int p = 0; p < 16; p++) {
    const int row = p * 8 + rsub;
    const f32x4 v = *(const f32x4*)(Cs + row * CSTR + c4 * 4) * rs_s[row];
    *(u32x2*)(QP + tofs + (size_t)row * 1024) = pack4(v);
  }
}

DI void bitonic_merge16(u32 (&L)[16]) {
#pragma unroll
  for (int st = 8; st >= 1; st >>= 1)
#pragma unroll
    for (int i = 0; i < 16; i++)
      if ((i & st) == 0) { u32 hi = max(L[i], L[i + st]); u32 lo = min(L[i], L[i + st]); L[i] = hi; L[i + st] = lo; }
}
DI void bitonic_sort16(u32 (&L)[16]) {
#pragma unroll
  for (int k = 2; k <= 16; k <<= 1)
#pragma unroll
    for (int j = k >> 1; j > 0; j >>= 1)
#pragma unroll
      for (int i = 0; i < 16; i++) {
        const int l = i ^ j;
        if (l > i) {
          const u32 hi = max(L[i], L[l]), lo = min(L[i], L[l]);
          if ((i & k) == 0) { L[i] = hi; L[l] = lo; } else { L[i] = lo; L[l] = hi; }
        }
      }
}
DI void phase6a_unit(const Params& P, int unit, char* smem, int h0, int h1) {
  const int tid = threadIdx.x, lane = tid & 63, w = tid >> 6, r = lane & 15, quad = lane >> 4;
  char* ws = P.ws;
  const u16* QP = (const u16*)(ws + W_QKV + 2 * SZ_ACT);
  const u16* SK = (const u16*)(ws + W_SK);
  u16* IDXo = (u16*)(ws + W_IDX);
  float* Go = (float*)(ws + W_G);
  float* sc = (float*)smem;
  u32* hl = (u32*)smem;
  u32* xl = (u32*)smem + 256 * 17;
  u32* lists = (u32*)(smem + 128 * 129 * 4);
  unsigned char* tabi = (unsigned char*)(smem + 128 * 129 * 4 + 128 * 17 * 4);
  unsigned char* tabj = tabi + 64;
  const int tok0 = unit * 64;
  __syncthreads();
  if (tid == 0) {
    int c = 0;
    for (int i = 0; i < 16; i++)
      for (int j = i + 1; j < 16; j++)
        if ((i + 1) * (j + 1) <= 16) { tabi[c] = (unsigned char)i; tabj[c] = (unsigned char)j; tabi[32 + c] = (unsigned char)j; tabj[32 + c] = (unsigned char)i; c++; }
    tabi[23] = 0; tabj[23] = 0; tabi[24] = 1; tabj[24] = 1;
    tabi[55] = 2; tabj[55] = 2; tabi[56] = 3; tabj[56] = 3;
  }
  for (int h = h0; h < h1; h++) {
#pragma unroll
    for (int p = 0; p < 2; p++) {
      const int hp = h * 2 + p;
      bf16x8 qf[2];
#pragma unroll
      for (int ks = 0; ks < 2; ks++)
        qf[ks] = *(const bf16x8*)(QP + (size_t)(tok0 + w * 16 + r) * 1024 + hp * 64 + ks * 32 + quad * 8);
#pragma unroll
      for (int nt = 0; nt < 8; nt++) {
        f32x4 a4 = (f32x4){0.f, 0.f, 0.f, 0.f};
#pragma unroll
        for (int ks = 0; ks < 2; ks++) {
          bf16x8 kf = *(const bf16x8*)(SK + (size_t)(hp * 128 + nt * 16 + r) * 64 + ks * 32 + quad * 8);
          a4 = mfma16(kf, qf[ks], a4);
        }
        float* d = sc + (p * 64 + w * 16 + r) * 129 + nt * 16 + quad * 4;
        d[0] = a4[0]; d[1] = a4[1]; d[2] = a4[2]; d[3] = a4[3];
      }
    }
    __syncthreads();
    u32 L[16];
    {
      const int inst = tid & 127, half = tid >> 7;
      const float* row = sc + inst * 129 + half * 64;
#pragma unroll
      for (int i = 0; i < 16; i++) L[i] = (mono(row[i]) & ~127u) | (u32)(half * 64 + i);
      bitonic_sort16(L);
#pragma unroll 1
      for (int c = 1; c < 4; c++) {
        u32 N[16];
#pragma unroll
        for (int i = 0; i < 16; i++) N[i] = (mono(row[c * 16 + i]) & ~127u) | (u32)(half * 64 + c * 16 + i);
        bitonic_sort16(N);
#pragma unroll
        for (int i = 0; i < 16; i++) L[i] = max(L[i], N[15 - i]);
        bitonic_merge16(L);
      }
    }
    __syncthreads();
#pragma unroll
    for (int s = 0; s < 16; s++) hl[tid * 17 + s] = L[s];
    __syncthreads();
    if (tid < 128) {
      u32 M[16];
#pragma unroll
      for (int s = 0; s < 16; s++) M[s] = max(L[s], hl[(tid + 128) * 17 + 15 - s]);
      bitonic_merge16(M);
#pragma unroll
      for (int s = 0; s < 16; s++) lists[tid * 17 + s] = M[s];
    }
    __syncthreads();
    if (tid < 128) {
      const int tok = tid & 63;
      const bool part = tid >= 64;
      float fa[16], fb[16];
#pragma unroll
      for (int s = 0; s < 16; s++) {
        const float va = unmono(lists[tok * 17 + s] & ~127u);
        const float vb = unmono(lists[(64 + tok) * 17 + s] & ~127u);
        fa[s] = part ? vb : va;
        fb[s] = part ? va : vb;
      }
      u32 L2[16];
#pragma unroll
      for (int s = 0; s < 16; s++) L2[s] = 0u;
      const u32 cbase = part ? 32u : 0u;
      {
        int c = 0;
#pragma unroll
        for (int i = 0; i < 16; i++)
#pragma unroll
          for (int j = i + 1; j < 16; j++)
            if ((i + 1) * (j + 1) <= 16) {
              insert16(L2, (mono(fa[i] + fb[j]) & ~63u) | (cbase + (u32)c));
              c++;
            }
      }
      insert16(L2, (mono(part ? fa[2] + fb[2] : fa[0] + fb[0]) & ~63u) | (cbase + 23u));
      insert16(L2, (mono(part ? fa[3] + fb[3] : fa[1] + fb[1]) & ~63u) | (cbase + 24u));
#pragma unroll
      for (int s = 0; s < 16; s++) xl[tid * 17 + s] = L2[s];
    }
    __syncthreads();
    if (tid < 64) {
      float val[16];
      u32 idx[16];
      float mx = -1e30f;
#pragma unroll
      for (int s = 0; s < 16; s++) {
        const u32 m = max(xl[tid * 17 + s], xl[(tid + 64) * 17 + 15 - s]);
        const u32 sl = m & 63u;
        const int i = tabi[sl], j = tabj[sl];
        const u32 au = lists[tid * 17 + i], bu = lists[(64 + tid) * 17 + j];
        val[s] = unmono(au & ~127u) + unmono(bu & ~127u);
        idx[s] = (au & 127u) * 128u + (bu & 127u);
        mx = fmaxf(mx, val[s]);
      }
      float sum = 0.f;
#pragma unroll
      for (int s = 0; s < 16; s++) { val[s] = __expf(val[s] - mx); sum += val[s]; }
      const float inv = 1.f / sum;
      const size_t so = ((size_t)(tok0 + tid) * 8 + h) * 16;
      {
        u32* ib = (u32*)(IDXo + (size_t)(tok0 + tid) * 128 + h * 2);
#pragma unroll
        for (int gg = 0; gg < 8; gg++) ib[gg * 8] = idx[gg] | (idx[gg + 8] << 16);
      }
#pragma unroll
      for (int s = 0; s < 4; s++)
        *(f32x4*)(Go + so + s * 4) = (f32x4){val[s * 4] * inv, val[s * 4 + 1] * inv, val[s * 4 + 2] * inv, val[s * 4 + 3] * inv};
    }
    __syncthreads();
  }
}

typedef float f32x2 __attribute__((ext_vector_type(2)));
DI float dot4_fp8(u32 w, float x0, float x1, float x2, float x3, float acc) {
  f32x2 lo = __builtin_amdgcn_cvt_pk_f32_fp8((int)w, false);
  f32x2 hi = __builtin_amdgcn_cvt_pk_f32_fp8((int)w, true);
  acc = fmaf(lo[0], x0, acc);
  acc = fmaf(lo[1], x1, acc);
  acc = fmaf(hi[0], x2, acc);
  acc = fmaf(hi[1], x3, acc);
  return acc;
}
DI void axpy4_fp8(u32 w, float wgt, float& o0, float& o1, float& o2, float& o3) {
  f32x2 lo = __builtin_amdgcn_cvt_pk_f32_fp8((int)w, false);
  f32x2 hi = __builtin_amdgcn_cvt_pk_f32_fp8((int)w, true);
  o0 = fmaf(wgt, lo[0], o0);
  o1 = fmaf(wgt, lo[1], o1);
  o2 = fmaf(wgt, hi[0], o2);
  o3 = fmaf(wgt, hi[1], o3);
}

struct RowSet { u32x4 r[16]; };
DI void gather_rows(RowSet& R, const unsigned char* base, u32 lofs, u32x4 ea, u32x4 eb) {
  const u32 ev[8] = {ea.x, ea.y, ea.z, ea.w, eb.x, eb.y, eb.z, eb.w};
#pragma unroll
  for (int i = 0; i < 8; i++) {
    R.r[2 * i] = *(const u32x4*)(base + (((ev[i] & 0xffffu) << 7) + lofs));
    R.r[2 * i + 1] = *(const u32x4*)(base + (((ev[i] >> 16) << 7) + lofs));
  }
}
DI void b1_compute(const RowSet& R, u32x4 xa, u32x4 xb, u16* pr, int c, bool valid) {
  float xf[16];
  xf[0] = __uint_as_float(xa.x << 16); xf[1] = __uint_as_float(xa.x & 0xffff0000u);
  xf[2] = __uint_as_float(xa.y << 16); xf[3] = __uint_as_float(xa.y & 0xffff0000u);
  xf[4] = __uint_as_float(xa.z << 16); xf[5] = __uint_as_float(xa.z & 0xffff0000u);
  xf[6] = __uint_as_float(xa.w << 16); xf[7] = __uint_as_float(xa.w & 0xffff0000u);
  xf[8] = __uint_as_float(xb.x << 16); xf[9] = __uint_as_float(xb.x & 0xffff0000u);
  xf[10] = __uint_as_float(xb.y << 16); xf[11] = __uint_as_float(xb.y & 0xffff0000u);
  xf[12] = __uint_as_float(xb.z << 16); xf[13] = __uint_as_float(xb.z & 0xffff0000u);
  xf[14] = __uint_as_float(xb.w << 16); xf[15] = __uint_as_float(xb.w & 0xffff0000u);
  float p[16];
#pragma unroll
  for (int i = 0; i < 16; i++) {
    float a = dot4_fp8(R.r[i].x, xf[0], xf[1], xf[2], xf[3], 0.f);
    a = dot4_fp8(R.r[i].y, xf[4], xf[5], xf[6], xf[7], a);
    a = dot4_fp8(R.r[i].z, xf[8], xf[9], xf[10], xf[11], a);
    a = dot4_fp8(R.r[i].w, xf[12], xf[13], xf[14], xf[15], a);
    p[i] = a;
  }
#pragma unroll
  for (int i = 0; i < 8; i++) { float keep = (c & 4) ? p[i + 8] : p[i]; float send = (c & 4) ? p[i] : p[i + 8]; p[i] = keep + __shfl_xor(send, 4); }
#pragma unroll
  for (int i = 0; i < 4; i++) { float keep = (c & 2) ? p[i + 4] : p[i]; float send = (c & 2) ? p[i] : p[i + 4]; p[i] = keep + __shfl_xor(send, 2); }
#pragma unroll
  for (int i = 0; i < 2; i++) { float keep = (c & 1) ? p[i + 2] : p[i]; float send = (c & 1) ? p[i] : p[i + 2]; p[i] = keep + __shfl_xor(send, 1); }
  const int it0 = 2 * (c & 1) + 4 * ((c >> 1) & 1) + 8 * ((c >> 2) & 1);
  if (valid) {
    pr[it0 * 8] = f2bf(p[0]);
    pr[(it0 + 1) * 8] = f2bf(p[1]);
  }
}
DI void phase6b1(const Params& P) {
  const int lane = threadIdx.x & 63, g = lane >> 3, c = lane & 7;
  const int x = blockIdx.x & 7;
  const int wg = (blockIdx.x >> 3) * 4 + (threadIdx.x >> 6), nwg = (gridDim.x >> 3) * 4;
  char* ws = P.ws;
  const u16* H1B = (const u16*)(ws + W_QKV + SZ_ACT) + x * 128 + c * 16;
  const unsigned char* U8 = (const unsigned char*)(ws + W_UB) + ((size_t)x << 21);
  const u32 lofs = c * 16;
  const u16* IDX = (const u16*)(ws + W_IDX) + g * 16;
  u16* PH = ph_slice(ws, x) + g;
  const int n = (TT - wg + nwg - 1) / nwg;
#define TOK(i) min(wg + (i) * nwg, TT - 1)
  int t0 = TOK(0), t1 = TOK(1);
  u32x4 eA0 = *(const u32x4*)(IDX + (size_t)t0 * 128), eA1 = *(const u32x4*)(IDX + (size_t)t0 * 128 + 8);
  u32x4 eB0 = *(const u32x4*)(IDX + (size_t)t1 * 128), eB1 = *(const u32x4*)(IDX + (size_t)t1 * 128 + 8);
  RowSet RA, RB;
  gather_rows(RA, U8, lofs, eA0, eA1);
  u32x4 xA0 = *(const u32x4*)(H1B + (size_t)t0 * 1024), xA1 = *(const u32x4*)(H1B + (size_t)t0 * 1024 + 8);
#pragma unroll 1
  for (int i = 0; i < n; i += 2) {
    gather_rows(RB, U8, lofs, eB0, eB1);
    const u32x4 xB0 = *(const u32x4*)(H1B + (size_t)t1 * 1024), xB1 = *(const u32x4*)(H1B + (size_t)t1 * 1024 + 8);
    const int t2 = TOK(i + 2);
    eA0 = *(const u32x4*)(IDX + (size_t)t2 * 128);
    eA1 = *(const u32x4*)(IDX + (size_t)t2 * 128 + 8);
    b1_compute(RA, xA0, xA1, PH + (size_t)t0 * 128, c, true);
    gather_rows(RA, U8, lofs, eA0, eA1);
    xA0 = *(const u32x4*)(H1B + (size_t)t2 * 1024);
    xA1 = *(const u32x4*)(H1B + (size_t)t2 * 1024 + 8);
    const int t3 = TOK(i + 3);
    eB0 = *(const u32x4*)(IDX + (size_t)t3 * 128);
    eB1 = *(const u32x4*)(IDX + (size_t)t3 * 128 + 8);
    b1_compute(RB, xB0, xB1, PH + (size_t)t1 * 128, c, i + 1 < n);
    t0 = t2;
    t1 = t3;
  }
}

DI void phase6w(const Params& P) {
  const int lane = threadIdx.x & 63;
  const int gw = blockIdx.x * 4 + (threadIdx.x >> 6), nw = gridDim.x * 4;
  char* ws = P.ws;
  float* G = (float*)(ws + W_G);
  const float* SSQ2 = (const float*)(ws + W_SSQ2);
  for (int t = gw; t < TT; t += nw) {
    float ssq = lane < 8 ? SSQ2[(size_t)t * 16 + lane] : 0.f;
    float h0 = 0.f, h1v = 0.f;
    {
      const u16* ph = (const u16*)(ws + W_XB) + (size_t)t * 128 + lane;
#pragma unroll
      for (int xs = 0; xs < 8; xs++) { h0 += bf2f(ph[(size_t)xs * (SZ_PH / 2)]); h1v += bf2f(ph[(size_t)xs * (SZ_PH / 2) + 64]); }
    }
    const float g0 = G[(size_t)t * 128 + lane];
    const float g1 = G[(size_t)t * 128 + 64 + lane];
    const float rs2 = rsqrtf(wave_sum(ssq) * (1.f / 1024.f) + EPS);
    const float w0 = g0 * gelu_tanh(rs2 * (1.f / U_SCALE) * h0) * (1.f / V_SCALE);
    const float w1 = g1 * gelu_tanh(rs2 * (1.f / U_SCALE) * h1v) * (1.f / V_SCALE);
    u16* wrow = (u16*)(G + (size_t)t * 128);
    wrow[(lane & 7) * 16 + (lane >> 3)] = f2bf(w0);
    wrow[(lane & 7) * 16 + 8 + (lane >> 3)] = f2bf(w1);
  }
}

DI void b2_compute(const RowSet& R, u32x4 w0, u32x4 w1, u16* hb, float* sq, int g, int lane, bool valid) {
  const u32 hraw = *(const u32*)hb;
  const u32 wv[8] = {w0.x, w0.y, w0.z, w0.w, w1.x, w1.y, w1.z, w1.w};
  float o[16];
#pragma unroll
  for (int i = 0; i < 16; i++) o[i] = 0.f;
#pragma unroll
  for (int i = 0; i < 16; i++) {
    u32 r0 = R.r[i].x, r1 = R.r[i].y, r2 = R.r[i].z, r3 = R.r[i].w;
    asm volatile("" : "+v"(r0), "+v"(r1), "+v"(r2), "+v"(r3) : "v"(o[0]), "v"(o[15]));
    const float wgt = (i & 1) ? __uint_as_float(wv[i >> 1] & 0xffff0000u) : __uint_as_float(wv[i >> 1] << 16);
    axpy4_fp8(r0, wgt, o[0], o[1], o[2], o[3]);
    axpy4_fp8(r1, wgt, o[4], o[5], o[6], o[7]);
    axpy4_fp8(r2, wgt, o[8], o[9], o[10], o[11]);
    axpy4_fp8(r3, wgt, o[12], o[13], o[14], o[15]);
  }
#pragma unroll
  for (int i = 0; i < 8; i++) { float keep = (g & 4) ? o[i + 8] : o[i]; float send = (g & 4) ? o[i] : o[i + 8]; o[i] = keep + __shfl_xor(send, 32); }
#pragma unroll
  for (int i = 0; i < 4; i++) { float keep = (g & 2) ? o[i + 4] : o[i]; float send = (g & 2) ? o[i] : o[i + 4]; o[i] = keep + __shfl_xor(send, 16); }
#pragma unroll
  for (int i = 0; i < 2; i++) { float keep = (g & 1) ? o[i + 2] : o[i]; float send = (g & 1) ? o[i] : o[i + 2]; o[i] = keep + __shfl_xor(send, 8); }
  const float a0 = __uint_as_float(hraw << 16) + o[0], a1 = __uint_as_float(hraw & 0xffff0000u) + o[1];
  const float ss = wave_sum(a0 * a0 + a1 * a1);
  if (valid) {
    *(u32*)hb = pack2(a0, a1);
    if (lane == 0) *sq = ss;
  }
}
DI void phase6b2(const Params& P) {
  const int lane = threadIdx.x & 63, g = lane >> 3, c = lane & 7, w = threadIdx.x >> 6;
  const int x = blockIdx.x & 7;
  const int wg = (blockIdx.x >> 3) * 4 + w, nwg = (gridDim.x >> 3) * 4;
  char* ws = P.ws;
  const int col = x * 128 + c * 16 + 2 * (g & 1) + 4 * ((g >> 1) & 1) + 8 * ((g >> 2) & 1);
  u16* H1B = (u16*)(ws + W_QKV + SZ_ACT) + col;
  const unsigned char* V8 = (const unsigned char*)(ws + W_VB) + ((size_t)x << 21);
  const u32 lofs = c * 16;
  const u16* IDX = (const u16*)(ws + W_IDX) + g * 16;
  const u16* WG = (const u16*)(ws + W_G) + g * 16;
  float* SSQ3 = (float*)(ws + W_SSQ3) + x;
  const int n = (TT - wg + nwg - 1) / nwg;
  int t0 = TOK(0), t1 = TOK(1);
  u32x4 eA0 = *(const u32x4*)(IDX + (size_t)t0 * 128), eA1 = *(const u32x4*)(IDX + (size_t)t0 * 128 + 8);
  u32x4 eB0 = *(const u32x4*)(IDX + (size_t)t1 * 128), eB1 = *(const u32x4*)(IDX + (size_t)t1 * 128 + 8);
  RowSet RA, RB;
  gather_rows(RA, V8, lofs, eA0, eA1);
  u32x4 wA0 = *(const u32x4*)(WG + (size_t)t0 * 256), wA1 = *(const u32x4*)(WG + (size_t)t0 * 256 + 8);
#pragma unroll 1
  for (int i = 0; i < n; i += 2) {
    gather_rows(RB, V8, lofs, eB0, eB1);
    const u32x4 wB0 = *(const u32x4*)(WG + (size_t)t1 * 256), wB1 = *(const u32x4*)(WG + (size_t)t1 * 256 + 8);
    const int t2 = TOK(i + 2);
    eA0 = *(const u32x4*)(IDX + (size_t)t2 * 128);
    eA1 = *(const u32x4*)(IDX + (size_t)t2 * 128 + 8);
    b2_compute(RA, wA0, wA1, H1B + (size_t)t0 * 1024, SSQ3 + (size_t)t0 * 8, g, lane, true);
    gather_rows(RA, V8, lofs, eA0, eA1);
    wA0 = *(const u32x4*)(WG + (size_t)t2 * 256);
    wA1 = *(const u32x4*)(WG + (size_t)t2 * 256 + 8);
    const int t3 = TOK(i + 3);
    eB0 = *(const u32x4*)(IDX + (size_t)t3 * 128);
    eB1 = *(const u32x4*)(IDX + (size_t)t3 * 128 + 8);
    b2_compute(RB, wB0, wB1, H1B + (size_t)t1 * 1024, SSQ3 + (size_t)t1 * 8, g, lane, i + 1 < n);
    t0 = t2;
    t1 = t3;
  }
#undef TOK
}

DI void phase7_tile(const Params& P, int mt, int nt, char* smem) {
  const int tid = threadIdx.x, lane = tid & 63, w = tid >> 6, wm = w >> 1, wn = w & 1, r = lane & 15, quad = lane >> 4;
  const int m0 = mt * 128, n0 = nt * 128;
  char* ws = P.ws;
  const u16* H2B = (const u16*)(ws + W_QKV + SZ_ACT);
  const u16* PB = (const u16*)(ws + W_PB);
  const float* SSQ3 = (const float*)(ws + W_SSQ3);
  float* rs_s = (float*)(smem + RS_OFF);
  __syncthreads();
  if (tid < 128) {
    float q = 0.f;
#pragma unroll
    for (int i = 0; i < 8; i++) q += SSQ3[(size_t)(m0 + tid) * 8 + i];
    rs_s[tid] = rsqrtf(q * (1.f / 1024.f) + EPS);
  }
  u16* PJ = (u16*)(ws + W_QKV);
  f32x4 acc[4][4];
  zero_acc(acc);
  gemm_mainloop(PB + (size_t)m0 * 256, 256, (const u16*)(ws + W_WPP) + (size_t)n0 * 256, 256, 256, (u16*)smem, acc);
  float* Cs = (float*)smem;
  const int c4 = tid & 31, rsub = tid >> 5;
  const size_t tofs = (size_t)m0 * 1024 + n0 + c4 * 4;
  stage_acc(acc, Cs);
#pragma unroll 4
  for (int p = 0; p < 16; p++) {
    const int row = p * 8 + rsub;
    *(u32x2*)(PJ + tofs + (size_t)row * 1024) = pack4(*(const f32x4*)(Cs + row * CSTR + c4 * 4));
  }
  zero_acc(acc);
  gemm_mainloop(H2B + (size_t)m0 * 1024, 1024, (const u16*)(ws + W_WG) + (size_t)n0 * 1024, 1024, 1024, (u16*)smem, acc);
  stage_acc(acc, Cs);
#pragma unroll 4
  for (int p = 0; p < 16; p++) {
    const int row = p * 8 + rsub;
    const f32x4 v = *(const f32x4*)(Cs + row * CSTR + c4 * 4) * rs_s[row];
    const f32x4 pj = unpack4(*(const u32x2*)(PJ + tofs + (size_t)row * 1024));
    const f32x4 h2 = unpack4(*(const u32x2*)(H2B + tofs + (size_t)row * 1024));
    const f32x4 gate = (f32x4){sigmoidf_(v.x), sigmoidf_(v.y), sigmoidf_(v.z), sigmoidf_(v.w)};
    __builtin_nontemporal_store(h2 + gate * pj, (f32x4*)(P.out + tofs + (size_t)row * 1024));
  }
}

DI void late_convert(const Params& P, int kind, int skip) {
  if ((int)blockIdx.x < skip) return;
  const int nb = gridDim.x - skip, b = blockIdx.x - skip;
  char* ws = P.ws;
  if (kind == 0) {
    for (int t = b; t < 4096; t += nb) conv_unit_fp8(P.peer_u, (unsigned char*)(ws + W_UB), (size_t)t * 4096, P.g_ffn, U_SCALE);
  } else if (kind == 1) {
    for (int t = b; t < 4096; t += nb) conv_unit_fp8(P.peer_v, (unsigned char*)(ws + W_VB), (size_t)t * 4096, nullptr, V_SCALE);
  } else {
    for (int t = b; t < 4096 + 16; t += nb) {
      if (t < 4096) conv_unit(P.p_p, (u16*)(ws + W_PB), (size_t)t * 4096, nullptr);
      else conv_unit(P.p_s, (u16*)(ws + W_PB) + (size_t)TP * 256, (size_t)(t - 4096) * 4096, nullptr);
    }
  }
}

#define GEMM_TILES(NT, FN)                                                              \
  {                                                                                     \
    for (int t = blockIdx.x; t < 2 * (NT); t += gridDim.x) FN(P, 512 + t / (NT), t % (NT), smem); \
    const int x_ = blockIdx.x & 7, bpx_ = gridDim.x >> 3;                               \
    constexpr int NG_ = (NT) / 8;                                                       \
    for (int s_ = blockIdx.x >> 3; s_ < 64 * 8 * NG_; s_ += bpx_) {                     \
      const int R_ = s_ >> 6, q_ = s_ & 63;                                             \
      const int mg_ = R_ / NG_, ng_ = R_ % NG_;                                         \
      FN(P, ((mg_ * 8 + (q_ >> 3)) << 3) + x_, ng_ * 8 + (q_ & 7), smem);               \
    }                                                                                   \
  }

DI unsigned xcc_id() { return (unsigned)__builtin_amdgcn_s_getreg((3 << 11) | 20) & 0xFu; }
DI void grid_barrier(unsigned* bar, int k, const unsigned* st) {
  asm volatile("s_waitcnt vmcnt(0)" ::: "memory");
  __syncthreads();
  if (threadIdx.x == 0) {
    const unsigned nloc = st[0], nx = st[1], x = st[2];
    unsigned* slot = bar + k * BAR_SLOT;
    const unsigned old = __hip_atomic_fetch_add(slot + x * 64, 1u, __ATOMIC_RELAXED, __HIP_MEMORY_SCOPE_AGENT);
    if (old + 1u == nloc) {
      __builtin_amdgcn_fence(__ATOMIC_RELEASE, "agent");
      asm volatile("s_waitcnt vmcnt(0)" ::: "memory");
      __hip_atomic_fetch_add(slot + 16 * 64, 1u, __ATOMIC_RELAXED, __HIP_MEMORY_SCOPE_AGENT);
    }
    unsigned spins = 0;
    while (__hip_atomic_load(slot + 16 * 64, __ATOMIC_RELAXED, __HIP_MEMORY_SCOPE_AGENT) < nx) {
      __builtin_amdgcn_s_sleep(1);
      if (++spins > (1u << 24)) break;
    }
    __builtin_amdgcn_fence(__ATOMIC_ACQUIRE, "agent");
    asm volatile("s_waitcnt vmcnt(0)" ::: "memory");
  }
  __syncthreads();
}

__global__ void __launch_bounds__(256, 2) fwd_megakernel(Params P) {
  __shared__ __attribute__((aligned(16))) char smem[SMEM_BYTES];
  cg::grid_group grid = cg::this_grid();
  unsigned* bar = (unsigned*)(P.ws + W_BAR);
  __shared__ unsigned bst[4];
  unsigned* census = bar + 16 * BAR_SLOT;
  if (threadIdx.x == 0) {
    bst[2] = xcc_id();
    __hip_atomic_fetch_add(census + bst[2] * 64, 1u, __ATOMIC_RELAXED, __HIP_MEMORY_SCOPE_AGENT);
  }
  phase0(P, smem);
  if (P.out == nullptr) grid.sync();
  if (threadIdx.x == 0) {
    unsigned spins = 0;
    for (;;) {
      unsigned sum = 0, nx = 0, mine = 0;
      for (unsigned j = 0; j < 16; j++) {
        const unsigned c = __hip_atomic_load(census + j * 64, __ATOMIC_RELAXED, __HIP_MEMORY_SCOPE_AGENT);
        sum += c; nx += c ? 1u : 0u; mine = (j == bst[2]) ? c : mine;
      }
      bst[0] = mine; bst[1] = nx;
      if (sum == gridDim.x || ++spins > (1u << 22)) break;
      __builtin_amdgcn_s_sleep(1);
    }
  }
  __syncthreads();
  grid_barrier(bar, 15, bst);
  phase1_scans(P);
  GEMM_TILES(40, phase1_tile)
  late_convert(P, 0, 80);
  grid_barrier(bar, 0, bst);
  phase2(P, smem);
  grid_barrier(bar, 1, bst);
  GEMM_TILES(8, phase3_tile)
  late_convert(P, 1, 16);
  grid_barrier(bar, 2, bst);
  GEMM_TILES(8, phase4_tile)
  late_convert(P, 2, 16);
  grid_barrier(bar, 3, bst);
  GEMM_TILES(8, phase5_tile)
  grid_barrier(bar, 4, bst);
  for (int t = blockIdx.x; t < TP / 64; t += gridDim.x) phase6a_unit(P, t, smem, 0, 8);
  for (int t = blockIdx.x; t < (TS / 64) * 8; t += gridDim.x) phase6a_unit(P, TP / 64 + (t >> 3), smem, t & 7, (t & 7) + 1);
  grid_barrier(bar, 5, bst);
  phase6b1(P);
  grid_barrier(bar, 6, bst);
  phase6w(P);
  grid_barrier(bar, 7, bst);
  phase6b2(P);
  grid_barrier(bar, 8, bst);
  GEMM_TILES(8, phase7_tile)
}

extern "C" void kernel_launch(void* const* d_in, const int* in_sizes, int n_in, void* d_out, int out_size, void* d_ws,
                              size_t ws_size, hipStream_t stream) {
  static int grid_blocks = 0;
  if (!grid_blocks) {
    int dev = 0, cus = 0, per_cu = 0;
    hipGetDevice(&dev);
    hipDeviceGetAttribute(&cus, hipDeviceAttributeMultiprocessorCount, dev);
    hipOccupancyMaxActiveBlocksPerMultiprocessor(&per_cu, fwd_megakernel, 256, 0);
    if (per_cu > 2) per_cu = 2;
    if (per_cu < 1) per_cu = 1;
    grid_blocks = cus * per_cu;
  }
  if (ws_size < W_END) { fprintf(stderr, "workspace too small: %zu < %zu\n", ws_size, (size_t)W_END); return; }
  Params p{};
  const float** pf = (const float**)&p;
  for (int i = 0; i < 28; i++) pf[i] = (const float*)d_in[i];
  p.out = (float*)d_out;
  p.ws = (char*)d_ws;
  hipMemsetAsync((char*)d_ws + W_BAR, 0, BAR_BYTES, stream);
  void* args[] = {&p};
  hipError_t e = hipLaunchCooperativeKernel((void*)fwd_megakernel, dim3(grid_blocks), dim3(256), args, 0, stream);
  if (e != hipSuccess) fprintf(stderr, "cooperative launch failed: %s (grid %d)\n", hipGetErrorString(e), grid_blocks);
}
```
